# Optimizing an MI355X kernel written in HIP

```python
import math
import jax
import jax.numpy as jnp
from jax import lax
import numpy as np

D_MODEL = 2048
BATCH = 2
SEQ = 16384
DEPTH = 4

GRID_W = 64
CTX_LEN = 256
D_MIX = D_MODEL
HEAD_DIM = 128
NA_WIDTH = D_MIX // 2
NA_HEADS = NA_WIDTH // HEAD_DIM
NA_KH = 8
NA_KW = 16
FN_WIDTH = D_MIX // 4
FN_GROUPS = 4
FN_GROUP_DIM = FN_WIDTH // FN_GROUPS
HY_WIDTH = D_MIX - NA_WIDTH - FN_WIDTH
HY_ORDER = 2
HY_BANDS = 16
HY_EMB = 1 + 2 * HY_BANDS
HY_FILTER_HIDDEN = 64
HY_FAST_DECAY = 0.3
HY_SLOW_DECAY = 1.5
HY_TARGET = 1e-2
HY_MIN_DECAY = math.log(HY_TARGET) / HY_SLOW_DECAY
HY_MAX_DECAY = math.log(HY_TARGET) / HY_FAST_DECAY
CONV_W = 3
D_FF = 11 * D_MODEL // 4
D_IN = 3 * NA_WIDTH + FN_WIDTH + (HY_ORDER + 1) * HY_WIDTH
N_MOD = 6
EPS = 1e-6

kernel_name = "hybrid_na_fourier_hyena_dit"


def rmsnorm(x, g):
    xf = x.astype(jnp.float32)
    y = xf * lax.rsqrt(jnp.mean(xf * xf, axis=-1, keepdims=True) + EPS)
    return (y * g.astype(jnp.float32)).astype(x.dtype)


def modulate(h, shift, scale):
    return h * (1 + scale) + shift


def dwconv_centred(x, w, b):
    L = x.shape[1]
    pad = CONV_W // 2
    xp = jnp.pad(x, ((0, 0), (pad, pad), (0, 0)))
    return sum(xp[:, j:j + L] * w[j] for j in range(CONV_W)) + b


def heads(t):
    return t.reshape(*t.shape[:-1], NA_HEADS, HEAD_DIM)


def split_projection(p):
    o1, o2, o3 = NA_WIDTH, 2 * NA_WIDTH, 3 * NA_WIDTH
    o4 = o3 + FN_WIDTH
    return p[..., :o1], p[..., o1:o2], p[..., o2:o3], p[..., o3:o4], p[..., o4:]


def neighbourhood_attention(q, k, v, kc, vc, rpb):
    B, L, H, Dh = q.shape
    rows = L // GRID_W
    kh = min(NA_KH, rows)
    n_loc = kh * NA_KW
    scale = Dh ** -0.5
    col = np.arange(GRID_W)
    col_start = np.clip(col - NA_KW // 2, 0, GRID_W - NA_KW)
    col_idx = col_start[:, None] + np.arange(NA_KW)[None, :]
    dcol = col_idx - col[:, None] + (NA_KW - 1)
    rpb_cols = rpb[:, :, dcol]
    kg = k.reshape(B, rows, GRID_W, H, Dh)
    vg = v.reshape(B, rows, GRID_W, H, Dh)
    q_rows = q.reshape(B, rows, GRID_W, H, Dh).transpose(1, 0, 2, 3, 4)

    def row_block(args):
        r, q_r = args
        r0 = jnp.clip(r - kh // 2, 0, rows - kh)
        k_rows = lax.dynamic_slice_in_dim(kg, r0, kh, axis=1)
        v_rows = lax.dynamic_slice_in_dim(vg, r0, kh, axis=1)
        k_win = jnp.take(k_rows, col_idx, axis=2)
        v_win = jnp.take(v_rows, col_idx, axis=2)
        drow = r0 + jnp.arange(kh) - r + (NA_KH - 1)
        bias = jnp.take(rpb_cols, drow, axis=1).transpose(0, 2, 1, 3)
        s_loc = jnp.einsum("bqhd,biqjhd->bhqij", q_r, k_win).astype(jnp.float32) * scale
        s_loc = s_loc + bias.astype(jnp.float32)
        s_ctx = jnp.einsum("bqhd,bchd->bhqc", q_r, kc).astype(jnp.float32) * scale
        s = jnp.concatenate([s_loc.reshape(B, H, GRID_W, n_loc), s_ctx], axis=-1)
        p = jax.nn.softmax(s, axis=-1).astype(v.dtype)
        p_loc = p[..., :n_loc].reshape(B, H, GRID_W, kh, NA_KW)
        return (jnp.einsum("bhqij,biqjhd->bqhd", p_loc, v_win)
                + jnp.einsum("bhqc,bchd->bqhd", p[..., n_loc:], vc))

    out = lax.map(row_block, (jnp.arange(rows), q_rows))
    return out.transpose(1, 0, 2, 3, 4).reshape(B, L, H * Dh)


def context_attention(qc, kc, vc):
    B, Lc, H, Dh = qc.shape
    s = jnp.einsum("bqhd,bkhd->bhqk", qc, kc).astype(jnp.float32) * (Dh ** -0.5)
    p = jax.nn.softmax(s, axis=-1).astype(vc.dtype)
    return jnp.einsum("bhqk,bkhd->bqhd", p, vc).reshape(B, Lc, H * Dh)


def fourier_mix(f):
    B, L, _ = f.shape
    fg = f.astype(jnp.float32).reshape(B, L, FN_GROUPS, FN_GROUP_DIM)
    y = jnp.fft.fft2(fg, axes=(1, 3), norm="ortho").real
    return y.reshape(B, L, FN_WIDTH).astype(f.dtype)


def hyena_kernel_spectrum(L, w1, b1, w2, b2, w3, freq):
    pos = jnp.arange(L, dtype=jnp.float32)[:, None]
    t = pos / max(L - 1, 1)
    bands = jnp.linspace(1e-4, HY_BANDS - 1, HY_BANDS, dtype=jnp.float32)
    ang = bands * (2.0 * math.pi / L) * pos
    z = jnp.concatenate([t, jnp.cos(ang), -jnp.sin(ang)], axis=-1)
    hdn = jnp.sin(freq * (z @ w1 + b1))
    hdn = jnp.sin(freq * (hdn @ w2 + b2))
    h = (hdn @ w3).astype(jnp.float32).reshape(L, HY_ORDER, 2, HY_WIDTH)
    deltas = jnp.linspace(HY_MIN_DECAY, HY_MAX_DECAY, HY_WIDTH, dtype=jnp.float32)
    h = h * jnp.exp(-t * jnp.abs(deltas))[:, None, None, :]
    hf, hb = h[:, :, 0], h[:, :, 1]
    kernel = jnp.concatenate([hf, jnp.zeros_like(hf[:1]), hb[:0:-1]], axis=0)
    return jnp.fft.rfft(kernel, axis=0)


def long_conv(z, k_spec, bias):
    L = z.shape[1]
    zf = z.astype(jnp.float32)
    y = jnp.fft.irfft(jnp.fft.rfft(zf, n=2 * L, axis=1) * k_spec, n=2 * L, axis=1)[:, :L]
    return (y + zf * bias).astype(z.dtype)


def hyena_mix(u, conv_w, conv_b, k_spec, bias):
    u = dwconv_centred(u, conv_w, conv_b)
    v, x1, x2 = jnp.split(u, HY_ORDER + 1, axis=-1)
    z = x1 * long_conv(v, k_spec[:, 0], bias[0])
    return x2 * long_conv(z, k_spec[:, 1], bias[1])


def merge_groups(a, f, hy, g):
    o1, o2 = NA_WIDTH, NA_WIDTH + FN_WIDTH
    return jnp.concatenate([rmsnorm(a, g[:o1]), rmsnorm(f, g[o1:o2]), rmsnorm(hy, g[o2:])], axis=-1)


def conv_gated_mlp(h, w_up, conv_w, conv_b, w_down):
    gate, up = jnp.split(h @ w_up, 2, axis=-1)
    return (jax.nn.gelu(dwconv_centred(gate, conv_w, conv_b), approximate=True) * up) @ w_down


def setup_inputs(seed: int = 0) -> dict:
    key = jax.random.key(seed)
    ks = jax.random.split(key, 26)

    def nrm(k, shape, s):
        return s * jax.random.normal(k, shape, dtype=jnp.float32)

    def gain(k, shape):
        return 1.0 + 0.02 * jax.random.normal(k, shape, dtype=jnp.float32)

    return {
        "x": nrm(ks[0], (BATCH, SEQ, D_MODEL), 1.0),
        "c": nrm(ks[1], (BATCH, D_MODEL), 1.0),
        "ctx": nrm(ks[2], (BATCH, CTX_LEN, D_MODEL), 1.0),
        "c_ctx": nrm(ks[3], (D_MODEL,), 1.0),
        "ada_w": nrm(ks[4], (DEPTH, D_MODEL, N_MOD * D_MODEL), 0.3 * D_MODEL ** -0.5),
        "ada_b": nrm(ks[5], (DEPTH, N_MOD * D_MODEL), 0.02),
        "norm1_g": gain(ks[6], (DEPTH, D_MODEL)),
        "norm2_g": gain(ks[7], (DEPTH, D_MODEL)),
        "w_in": nrm(ks[8], (DEPTH, D_MODEL, D_IN), D_MODEL ** -0.5),
        "na_rpb": nrm(ks[9], (DEPTH, NA_HEADS, 2 * NA_KH - 1, 2 * NA_KW - 1), 0.02),
        "hy_conv_w": nrm(ks[10], (DEPTH, CONV_W, (HY_ORDER + 1) * HY_WIDTH), CONV_W ** -0.5),
        "hy_conv_b": nrm(ks[11], (DEPTH, (HY_ORDER + 1) * HY_WIDTH), 0.02),
        "hy_w1": nrm(ks[12], (DEPTH, HY_EMB, HY_FILTER_HIDDEN), HY_EMB ** -0.5),
        "hy_b1": nrm(ks[13], (DEPTH, HY_FILTER_HIDDEN), 0.02),
        "hy_w2": nrm(ks[14], (DEPTH, HY_FILTER_HIDDEN, HY_FILTER_HIDDEN), HY_FILTER_HIDDEN ** -0.5),
        "hy_b2": nrm(ks[15], (DEPTH, HY_FILTER_HIDDEN), 0.02),
        "hy_w3": nrm(ks[16], (DEPTH, HY_FILTER_HIDDEN, HY_ORDER * 2 * HY_WIDTH), HY_FILTER_HIDDEN ** -0.5),
        "hy_freq": gain(ks[17], (DEPTH, HY_FILTER_HIDDEN)),
        "hy_bias": nrm(ks[18], (DEPTH, HY_ORDER, HY_WIDTH), 0.1),
        "mix_norm_g": gain(ks[19], (DEPTH, D_MIX)),
        "w_out": nrm(ks[20], (DEPTH, D_MIX, D_MODEL), D_MIX ** -0.5),
        "ffn_w_up": nrm(ks[21], (DEPTH, D_MODEL, 2 * D_FF), D_MODEL ** -0.5),
        "ffn_conv_w": nrm(ks[22], (DEPTH, CONV_W, D_FF), CONV_W ** -0.5),
        "ffn_conv_b": nrm(ks[23], (DEPTH, D_FF), 0.02),
        "ffn_w_down": nrm(ks[24], (DEPTH, D_FF, D_MODEL), D_FF ** -0.5),
        "final_norm_g": gain(ks[25], (D_MODEL,)),
    }


def reference(x, c, ctx, c_ctx, ada_w, ada_b, norm1_g, norm2_g, w_in, na_rpb,
              hy_conv_w, hy_conv_b, hy_w1, hy_b1, hy_w2, hy_b2, hy_w3, hy_freq, hy_bias,
              mix_norm_g, w_out, ffn_w_up, ffn_conv_w, ffn_conv_b, ffn_w_down, final_norm_g):
    L = x.shape[1]
    Lc = ctx.shape[1]
    xc = ctx
    s_lat = jax.nn.silu(c)
    s_ctx = jax.nn.silu(c_ctx)
    for l in range(DEPTH):
        update_ctx = l < DEPTH - 1
        mod = (s_lat @ ada_w[l] + ada_b[l])[:, None, :]
        sh1, sc1, g1, sh2, sc2, g2 = jnp.split(mod, N_MOD, axis=-1)
        mod_c = s_ctx @ ada_w[l] + ada_b[l]
        csh1, csc1, cg1, csh2, csc2, cg2 = jnp.split(mod_c, N_MOD, axis=-1)
        filt = (hy_w1[l], hy_b1[l], hy_w2[l], hy_b2[l], hy_w3[l], hy_freq[l])

        h = modulate(rmsnorm(x, norm1_g[l]), sh1, sc1)
        hc = modulate(rmsnorm(xc, norm1_g[l]), csh1, csc1)
        q, k, v, f, hy = split_projection(h @ w_in[l])
        if update_ctx:
            qc, kc, vc, fc, hyc = split_projection(hc @ w_in[l])
        else:
            kc, vc = jnp.split(hc @ w_in[l][:, NA_WIDTH:3 * NA_WIDTH], 2, axis=-1)
        kc_h, vc_h = heads(kc), heads(vc)
        a = neighbourhood_attention(heads(q), heads(k), heads(v), kc_h, vc_h, na_rpb[l])
        y = merge_groups(a, fourier_mix(f),
                         hyena_mix(hy, hy_conv_w[l], hy_conv_b[l], hyena_kernel_spectrum(L, *filt), hy_bias[l]),
                         mix_norm_g[l])
        x = x + g1 * (y @ w_out[l])
        if update_ctx:
            ac = context_attention(heads(qc), kc_h, vc_h)
            yc = merge_groups(ac, fourier_mix(fc),
                              hyena_mix(hyc, hy_conv_w[l], hy_conv_b[l], hyena_kernel_spectrum(Lc, *filt), hy_bias[l]),
                              mix_norm_g[l])
            xc = xc + cg1 * (yc @ w_out[l])

        ffn = (ffn_w_up[l], ffn_conv_w[l], ffn_conv_b[l], ffn_w_down[l])
        x = x + g2 * conv_gated_mlp(modulate(rmsnorm(x, norm2_g[l]), sh2, sc2), *ffn)
        if update_ctx:
            xc = xc + cg2 * conv_gated_mlp(modulate(rmsnorm(xc, norm2_g[l]), csh2, csc2), *ffn)
    return rmsnorm(x, final_norm_g)
```

```cpp
#include <hip/hip_runtime.h>
#include <cstdio>
#include <cstdint>
namespace pg8 {
#define PG8_LAS __attribute__((address_space(3)))
typedef unsigned short bf16_t;
typedef short bf16x8 __attribute__((ext_vector_type(8)));
typedef float f32x4 __attribute__((ext_vector_type(4)));
typedef unsigned u32x4 __attribute__((ext_vector_type(4)));
constexpr int BM = 256, BK = 64, HALF = 128, HTB = HALF * BK * 2  , STAGE_BYTES = 8 * HTB, NXCD = 8, WGM = 8;

__host__ __device__ __forceinline__ int lds_byte(int r, int c) { const int st = (r >> 4) * 2 + (c >> 5), rr = r & 15, cc = c & 31, ob = rr * 64 + cc * 2; return st * 1024 + (ob ^ (((ob >> 9) & 1) << 5)); }
__host__ __device__ __forceinline__ void stage_rc(int b, int& R, int& C) { const int st = b / 1024, sb = b % 1024, swz = sb ^ (((sb >> 9) & 1) << 5); R = (st >> 1) * 16 + swz / 64; C = (st & 1) * 32 + (swz % 64) / 2; }
__host__ __device__ __forceinline__ int perm32(int rho) { const int n = rho >> 4, i = rho & 15; return 8 * (i >> 2) + 4 * n + (i & 3); }

struct Unit { int pm, pn, type; };

__device__ __forceinline__ void map_unit(int w, int nwg, int nM, int nN, Unit& u) {
    { const int q = nwg / NXCD, r = nwg % NXCD, xcd = w % NXCD, off = w / NXCD; w = (xcd < r ? xcd * (q + 1) : r * (q + 1) + (xcd - r) * q) + off; }
    const int nig = WGM * nN, gid = w / nig, fm = gid * WGM, gsz = (nM - fm) < WGM ? (nM - fm) : WGM;
    u.pm = fm + ((w % nig) % gsz); u.pn = (w % nig) / gsz;
}
struct Sched2 {
    int n1, nM1, nN1, n2, nM2, nN2, G, c; const char *A1, *B1, *A2, *B2; size_t tstep;
    __device__ __forceinline__ bool next(int i, Unit& u) const {
        const long L = (long)i * G + c;
        if (L < n1) { map_unit((int)L, n1, nM1, nN1, u); u.type = 0; return true; }
        if (L < n1 + n2) { map_unit((int)L - n1, n2, nM2, nN2, u); u.type = 1; return true; }
        return false;
    }
    __device__ __forceinline__ const char* a_ptr(const Unit& u) const { return (u.type ? A2 : A1) + (size_t)u.pm * tstep; }
    __device__ __forceinline__ const char* b_ptr(const Unit& u) const { return (u.type ? B2 : B1) + (size_t)u.pn * tstep; }
    __device__ __forceinline__ void a_ready(const Unit&) const {}
    __device__ __forceinline__ void done(const Unit&) const {}
};

__device__ __forceinline__ unsigned cvt_pk_bf16(float lo, float hi) { unsigned r; asm volatile("v_cvt_pk_bf16_f32 %0, %1, %2" : "=v"(r) : "v"(lo), "v"(hi)); return r; }
typedef float f32x2 __attribute__((ext_vector_type(2)));

template <class Epi, class Sched, bool ALIGN_EPI = false, bool SP2 = false>
__device__ __forceinline__ void gemm_phase(PG8_LAS unsigned char* lds, const int Kdim, const Sched& S, const Epi& E) {
    int tid_ = threadIdx.x; asm volatile("" : "+v"(tid_));
    const int tid = tid_, wid = __builtin_amdgcn_readfirstlane(tid >> 6), lane = tid & 63, wr = wid >> 2, wc = wid & 3, fr = lane & 15, fq = lane >> 4;
    const int K = Kdim, nt = K / BK;
    unsigned voffA[2], voffB[2];
#pragma unroll
    for (int i = 0; i < 2; ++i) { int R, C; stage_rc(tid * 16 + i * 8192, R, C); const int Rb = Epi::PERM ? ((R & ~31) + perm32(R & 31)) : R;
        voffA[i] = (unsigned)(R * K + C) * 2u; voffB[i] = (unsigned)(Rb * K + C) * 2u; }
    const size_t kstep = (size_t)(BK * 2);
    const size_t hstep = (size_t)HALF * K * 2;
    const size_t tstep = 2 * hstep;
    const unsigned ldsw = (unsigned)wid * 1024u;
    const int aoff = lds_byte(wr * 64 + fr, fq * 8), boff = lds_byte(wc * 32 + fr, fq * 8);
#define PG8_SA(b, h) (((b) * 2 + (h)) * HTB)
#define PG8_SB(b, h) ((4 + (b) * 2 + (h)) * HTB)
#define PG8_STAGE(bufoff, gbase, voff) do { _Pragma("unroll") for (int _i = 0; _i < 2; ++_i) \
        __builtin_amdgcn_global_load_lds((const unsigned*)((const char*)(gbase) + (voff)[_i]), (PG8_LAS unsigned*)(lds + (bufoff) + ldsw + _i * 8192), 16, 0, 0); } while (0)
#define PG8_LDA(dst, b, h) do { _Pragma("unroll") for (int m = 0; m < 4; ++m) _Pragma("unroll") for (int k = 0; k < 2; ++k) dst[m][k] = *(const PG8_LAS bf16x8*)(lds + PG8_SA(b, h) + aoff + m * 2048 + k * 1024); } while (0)
#define PG8_LDB(dst, b, h) do { _Pragma("unroll") for (int n = 0; n < 2; ++n) _Pragma("unroll") for (int k = 0; k < 2; ++k) dst[n][k] = *(const PG8_LAS bf16x8*)(lds + PG8_SB(b, h) + boff + n * 2048 + k * 1024); } while (0)
#define PG8_MMA(ai, bj, At, Bt) do { __builtin_amdgcn_s_setprio(1); _Pragma("unroll") for (int m = 0; m < 4; ++m) _Pragma("unroll") for (int n = 0; n < 2; ++n) _Pragma("unroll") for (int k = 0; k < 2; ++k) \
        acc[ai][bj][m][n] = __builtin_amdgcn_mfma_f32_16x16x32_bf16(Bt[n][k], At[m][k], acc[ai][bj][m][n], 0, 0, 0); __builtin_amdgcn_s_setprio(0); } while (0)
#define PG8_WAIT_V(n) asm volatile("s_waitcnt vmcnt(" #n ")" ::: "memory")
#define PG8_WAIT_L(n) asm volatile("s_waitcnt lgkmcnt(" #n ")" ::: "memory")
#define PG8_BAR __builtin_amdgcn_s_barrier()
#define PG8_SCHED __builtin_amdgcn_sched_barrier(0)
    Unit cur, nxt; int ui = 0;
    if (!S.next(0, cur)) return;
    f32x4 acc[2][2][4][2];
#pragma unroll
    for (int a = 0; a < 2; ++a)
#pragma unroll
        for (int b = 0; b < 2; ++b)
#pragma unroll
            for (int m = 0; m < 4; ++m)
#pragma unroll
                for (int n = 0; n < 2; ++n) acc[a][b][m][n] = (f32x4){0.f, 0.f, 0.f, 0.f};
    bf16x8 At[4][2], B0[2][2], B1[2][2];
    const char* cA = S.a_ptr(cur); const char* cB = S.b_ptr(cur);
    S.a_ready(cur);
    if constexpr (SP2) {
        PG8_STAGE(PG8_SB(0, 0), cB, voffB); PG8_STAGE(PG8_SB(0, 1), cB + hstep, voffB); PG8_STAGE(PG8_SA(0, 0), cA, voffA); PG8_STAGE(PG8_SA(0, 1), cA + hstep, voffA);
        if (wr == 1) PG8_BAR;
        PG8_WAIT_V(2); PG8_BAR;
        PG8_STAGE(PG8_SB(1, 0), cB + kstep, voffB); PG8_STAGE(PG8_SA(1, 0), cA + kstep, voffA); PG8_STAGE(PG8_SB(1, 1), cB + hstep + kstep, voffB);
        PG8_WAIT_V(6); PG8_BAR;
    } else {
        PG8_STAGE(PG8_SB(0, 0), cB, voffB); PG8_STAGE(PG8_SA(0, 0), cA, voffA); PG8_STAGE(PG8_SB(0, 1), cB + hstep, voffB); PG8_STAGE(PG8_SA(0, 1), cA + hstep, voffA);
        if (wr == 1) PG8_BAR;
        PG8_WAIT_V(4); PG8_BAR;
        PG8_STAGE(PG8_SB(1, 0), cB + kstep, voffB); PG8_STAGE(PG8_SA(1, 0), cA + kstep, voffA); PG8_STAGE(PG8_SB(1, 1), cB + hstep + kstep, voffB);
        PG8_WAIT_V(6); PG8_BAR;
    }
    for (;;) {
        const bool has_next = S.next(ui + 1, nxt);
        const char* nA = has_next ? S.a_ptr(nxt) : cA; const char* nB = has_next ? S.b_ptr(nxt) : cB;
        for (int t = 0; t < nt; t += 2) {
            const bool last = (t == nt - 2);
            const char* a1 = cA + (size_t)(t + 1) * kstep;
            const char* a2 = last ? nA : cA + (size_t)(t + 2) * kstep; const char* b2 = last ? nB : cB + (size_t)(t + 2) * kstep;
            const char* a3 = a2 + kstep; const char* b3 = b2 + kstep;
            if (last && has_next) S.a_ready(nxt);
            if constexpr (SP2) {
            PG8_LDB(B0, 0, 0); PG8_LDB(B1, 0, 1); PG8_SCHED; PG8_LDA(At, 0, 0); PG8_STAGE(PG8_SA(1, 1), a1 + hstep, voffA);
            PG8_WAIT_V(8); PG8_WAIT_L(0); PG8_BAR; PG8_MMA(0, 0, At, B0); PG8_MMA(0, 1, At, B1); PG8_BAR; PG8_SCHED;
            PG8_LDA(At, 0, 1); PG8_STAGE(PG8_SB(0, 0), b2, voffB); PG8_STAGE(PG8_SB(0, 1), b2 + hstep, voffB); PG8_STAGE(PG8_SA(0, 0), a2, voffA);
            PG8_WAIT_V(8); PG8_WAIT_L(0); PG8_BAR; PG8_MMA(1, 0, At, B0); PG8_MMA(1, 1, At, B1); PG8_BAR; PG8_SCHED;
            PG8_LDB(B0, 1, 0); PG8_LDB(B1, 1, 1); PG8_SCHED; PG8_LDA(At, 1, 0); PG8_STAGE(PG8_SA(0, 1), a2 + hstep, voffA);
            PG8_WAIT_V(8); PG8_WAIT_L(0); PG8_BAR; PG8_MMA(0, 0, At, B0); PG8_MMA(0, 1, At, B1); PG8_BAR; PG8_SCHED;
            PG8_LDA(At, 1, 1); PG8_STAGE(PG8_SB(1, 0), b3, voffB); PG8_STAGE(PG8_SB(1, 1), b3 + hstep, voffB); PG8_STAGE(PG8_SA(1, 0), a3, voffA);
            PG8_WAIT_V(8); PG8_WAIT_L(0); PG8_BAR; PG8_MMA(1, 0, At, B0); PG8_MMA(1, 1, At, B1); PG8_BAR; PG8_SCHED;
            } else {
            PG8_LDB(B0, 0, 0); PG8_SCHED; PG8_LDA(At, 0, 0); PG8_STAGE(PG8_SA(1, 1), a1 + hstep, voffA);
            PG8_WAIT_L(8); PG8_BAR; PG8_WAIT_L(0); PG8_MMA(0, 0, At, B0); PG8_BAR; PG8_SCHED;
            PG8_LDB(B1, 0, 1); PG8_STAGE(PG8_SB(0, 0), b2, voffB);
            PG8_BAR; PG8_WAIT_L(0); PG8_MMA(0, 1, At, B1); PG8_BAR;
            PG8_LDA(At, 0, 1); PG8_STAGE(PG8_SA(0, 0), a2, voffA);
            PG8_BAR; PG8_WAIT_L(0); PG8_MMA(1, 0, At, B0); PG8_BAR; PG8_SCHED;
            PG8_STAGE(PG8_SB(0, 1), b2 + hstep, voffB);
            PG8_WAIT_V(6); PG8_BAR; PG8_MMA(1, 1, At, B1); PG8_BAR;
            PG8_LDB(B0, 1, 0); PG8_SCHED; PG8_LDA(At, 1, 0); PG8_STAGE(PG8_SA(0, 1), a2 + hstep, voffA);
            PG8_WAIT_L(8); PG8_BAR; PG8_WAIT_L(0); PG8_MMA(0, 0, At, B0); PG8_BAR; PG8_SCHED;
            PG8_LDB(B1, 1, 1); PG8_STAGE(PG8_SB(1, 0), b3, voffB);
            PG8_BAR; PG8_WAIT_L(0); PG8_MMA(0, 1, At, B1); PG8_BAR;
            PG8_LDA(At, 1, 1); PG8_STAGE(PG8_SA(1, 0), a3, voffA);
            PG8_BAR; PG8_WAIT_L(0); PG8_MMA(1, 0, At, B0); PG8_BAR; PG8_SCHED;
            PG8_STAGE(PG8_SB(1, 1), b3 + hstep, voffB);
            PG8_WAIT_V(6); PG8_BAR; PG8_MMA(1, 1, At, B1); PG8_BAR;
            }
        }
        if constexpr (ALIGN_EPI) { if (wr == 0) PG8_BAR; }
        if constexpr (!Epi::AFTER_DRAIN) { E(acc, cur, wr, wc, fr, fq); S.done(cur); }
        if (!has_next) break;
#pragma unroll
        for (int a = 0; a < 2; ++a)
#pragma unroll
            for (int b = 0; b < 2; ++b)
#pragma unroll
                for (int m = 0; m < 4; ++m)
#pragma unroll
                    for (int n = 0; n < 2; ++n) acc[a][b][m][n] = (f32x4){0.f, 0.f, 0.f, 0.f};
        cur = nxt; cA = nA; cB = nB; ++ui;
        if constexpr (ALIGN_EPI) { if (wr == 1) PG8_BAR; }
    }
    PG8_WAIT_V(0);
    if constexpr (!ALIGN_EPI) { if (wr == 0) PG8_BAR; }
    PG8_BAR;
    if constexpr (Epi::AFTER_DRAIN) { E.fused(acc, cur, wr, wc, fr, fq, lds, wid, lane); S.done(cur); }
#undef PG8_SA
#undef PG8_SB
#undef PG8_STAGE
#undef PG8_LDA
#undef PG8_LDB
#undef PG8_MMA
#undef PG8_WAIT_V
#undef PG8_WAIT_L
#undef PG8_BAR
#undef PG8_SCHED
}
}

constexpr int NWAVES = 8, NTHR = 512;
constexpr int DM = 2048, BATCH = 2, SEQ = 16384, DEPTH = 4, GRIDW = 64, GROWS = 256, CTXL = 256;
constexpr int NAW = 1024, NHEAD = 8, HDIM = 128, FNW = 512, HYW = 512, DFF = 5632, DIN = 5120, NMOD = 6;
constexpr int ML = BATCH * SEQ, MC = BATCH * CTXL, MT = ML + MC;
constexpr int PML = ML / 256, PMT = MT / 256;
constexpr int NEDGE = MT / 64 * 2;
constexpr float EPS = 1e-6f;
constexpr float LOG2E = 1.4426950408889634f;
constexpr float QSCALE = 0.08838834764831845f * LOG2E;
constexpr float HY_MIN_DECAY = -3.0701134573253945f, HY_MAX_DECAY = -15.350567286626973f;

constexpr size_t MiB = 1u << 20;
constexpr size_t WS_CTL = 0, CTL_ZERO_BYTES = 1 * MiB;
constexpr size_t WS_MOD = 1 * MiB;
constexpr size_t WS_XC = 2 * MiB;
constexpr size_t WS_HFC = 6 * MiB;
constexpr size_t WS_HF = 8 * MiB;
constexpr size_t WS_WIN = WS_HF + 128 * MiB;
constexpr size_t WS_WOUT = WS_WIN + 80 * MiB;
constexpr size_t WS_WUP = WS_WOUT + 32 * MiB;
constexpr size_t WS_WDN = WS_WUP + 176 * MiB;
constexpr size_t WS_H = WS_WDN + 88 * MiB;
constexpr size_t WS_QK = WS_H + 130 * MiB;
constexpr size_t WS_VT = WS_QK + 130 * MiB;
constexpr size_t WS_T32 = WS_VT + 65 * MiB;
constexpr size_t WS_A = WS_T32 + 260 * MiB;
constexpr size_t WS_HID = WS_QK;
constexpr size_t WS_EDGE = WS_A + 65 * MiB;
constexpr size_t EDGE_ELEMS = (size_t)NEDGE * DFF;
constexpr size_t WS_KS = WS_EDGE + 68 * MiB;
constexpr size_t WS_END = WS_KS + 64 * MiB;
static_assert((size_t)MT * DFF * 2 <= WS_EDGE - WS_QK, "hidden overlay");
static_assert(3 * EDGE_ELEMS * 4 <= 68 * MiB, "edge buffers");
static_assert((size_t)MT * DM * 2 == 130 * MiB && (size_t)1024 * MT * 2 == 65 * MiB && (size_t)2048 * MT * 4 == 260 * MiB, "sizes");
constexpr int CW_BAR = 4096;

constexpr int RING_BYTES = 131072;
constexpr int XTRA_OFF = RING_BYTES, XTRA_BYTES = 20480;
constexpr int MISC_OFF = XTRA_OFF + XTRA_BYTES;
constexpr int LDS_BYTES = MISC_OFF + 256;

#define GAS __attribute__((address_space(1)))
#define LAS __attribute__((address_space(3)))
typedef unsigned short bf16;
typedef unsigned v4u __attribute__((ext_vector_type(4)));
typedef unsigned v2u __attribute__((ext_vector_type(2)));
typedef float f32x4 __attribute__((ext_vector_type(4)));
typedef float f32x2 __attribute__((ext_vector_type(2)));
typedef short bf16x8 __attribute__((ext_vector_type(8)));
#define LDS_WAIT() asm volatile("s_waitcnt lgkmcnt(0)" ::: "memory")
__device__ __forceinline__ unsigned f2bf(float f) { unsigned u = __builtin_bit_cast(unsigned, f); return (u + 0x7fffu + ((u >> 16) & 1u)) >> 16; }
__device__ __forceinline__ unsigned pk2(float lo, float hi) { return f2bf(lo) | (f2bf(hi) << 16); }
__device__ __forceinline__ float bf2f(unsigned short b) { return __builtin_bit_cast(float, (unsigned)b << 16); }
__device__ __forceinline__ f32x2 cmul(f32x2 a, f32x2 b) { return (f32x2){a.x * b.x - a.y * b.y, a.x * b.y + a.y * b.x}; }
__device__ __forceinline__ f32x2 cconj(f32x2 a) { return (f32x2){a.x, -a.y}; }
__device__ __forceinline__ float lane_read(float v, int src_lane) { return __builtin_bit_cast(float, __builtin_amdgcn_ds_bpermute(src_lane << 2, __builtin_bit_cast(int, v))); }
__device__ __forceinline__ float wave_sum(float v, int lane) {
#pragma unroll
    for (int o = 1; o < 64; o <<= 1) v += lane_read(v, lane ^ o);
    return v;
}
__device__ __forceinline__ float gelu_tanh(float x) {
    const float t = x * (1.0f + 0.044715f * x * x) * (-2.302208198f);
    const float e = __builtin_amdgcn_exp2f(t);
    return x * __builtin_amdgcn_rcpf(1.0f + e);
}
#define XB_LAS_DEFINED
#define XB_TMO      128
#define XB_XCNT(j)  (256  + 64 * (j))
#define XB_XSUB(j)  (1280 + 64 * (j))
#define XB_XGEN(j)  (2304 + 64 * (j))
#define XB_TOP      3328
#define XB_TOPGEN   3392
#define XCD_BAR_WORDS 3456
#define XB_SPIN_CAP (1u << 18)

__device__ __forceinline__ unsigned xb_ld(unsigned* p)              { return __hip_atomic_load(p, __ATOMIC_RELAXED, __HIP_MEMORY_SCOPE_AGENT); }
__device__ __forceinline__ unsigned xb_add(unsigned* p, unsigned v) { return __hip_atomic_fetch_add(p, v, __ATOMIC_RELAXED, __HIP_MEMORY_SCOPE_AGENT); }
__device__ __forceinline__ unsigned xb_xcc_id() { return (unsigned)__builtin_amdgcn_s_getreg((3 << 11) | 20) & 0xFu; }
#define XB_SPIN(cond, bar) do { unsigned _sp = 0; while (cond) { __builtin_amdgcn_s_sleep(1); \
    if ((++_sp & 255u) == 0u) { if (xb_ld(&(bar)[XB_TMO])) break; if (_sp > XB_SPIN_CAP) { atomicAdd(&(bar)[XB_TMO], 1u); break; } } } } while (0)

struct XcdBarrier {
    unsigned* bar; unsigned x;
    volatile LAS unsigned* st;
};

__device__ __forceinline__ XcdBarrier xcd_barrier_post(unsigned* bar, volatile LAS unsigned* st) {
    XcdBarrier b; b.bar = bar; b.x = xb_xcc_id(); b.st = st;
    if (threadIdx.x == 0) (void)xb_add(&bar[XB_XCNT(b.x)], 1u);
    return b;
}
__device__ __forceinline__ void xcd_barrier_complete(unsigned* bar, unsigned x, unsigned& nloc, unsigned& nx) {
    const unsigned G = gridDim.x * gridDim.y * gridDim.z;
    unsigned sum, cnt, mine, sp = 0u;
    for (;;) {
        sum = 0u; cnt = 0u; mine = 0u;
#pragma unroll
        for (unsigned j = 0; j < 16; ++j) { const unsigned c = xb_ld(&bar[XB_XCNT(j)]); sum += c; cnt += (c > 0u) ? 1u : 0u; mine = (j == x) ? c : mine; }
        if (sum == G) break;
        __builtin_amdgcn_s_sleep(1);
        if ((++sp & 255u) == 0u) { if (xb_ld(&bar[XB_TMO])) break; if (sp > XB_SPIN_CAP) { atomicAdd(&bar[XB_TMO], 1u); break; } }
    }
    nloc = mine > 0u ? mine : 1u; nx = cnt > 0u ? cnt : 1u;
}

__device__ __forceinline__ void xcd_barrier(const XcdBarrier& b) {
    asm volatile("s_waitcnt vmcnt(0)" ::: "memory");
    __syncthreads();
    if (threadIdx.x == 0) {
        unsigned* bar = b.bar;
        __builtin_amdgcn_s_waitcnt(0);
        unsigned nloc = b.st[0], nx = b.st[1];
        if (nloc == 0u) { xcd_barrier_complete(bar, b.x, nloc, nx); b.st[0] = nloc; b.st[1] = nx; }
        const unsigned old = xb_add(&bar[XB_XSUB(b.x)], 1u);
        const unsigned gen = old / nloc;
        if (old + 1u == (gen + 1u) * nloc) {
            __builtin_amdgcn_fence(__ATOMIC_RELEASE, "agent");
            asm volatile("s_waitcnt vmcnt(0)" ::: "memory");
            const unsigned og = xb_add(&bar[XB_TOP], 1u);
            const unsigned tg = og / nx;
            if (og + 1u == (tg + 1u) * nx) xb_add(&bar[XB_TOPGEN], 1u);
            else XB_SPIN(xb_ld(&bar[XB_TOPGEN]) == tg, bar);
            __builtin_amdgcn_fence(__ATOMIC_ACQUIRE, "agent");
            xb_add(&bar[XB_XGEN(b.x)], 1u);
            asm volatile("s_waitcnt vmcnt(0)" ::: "memory");
        } else {
            XB_SPIN(xb_ld(&bar[XB_XGEN(b.x)]) == gen, bar);
            __builtin_amdgcn_fence(__ATOMIC_ACQUIRE, "agent");
            asm volatile("s_waitcnt vmcnt(0)" ::: "memory");
        }
    }
    __syncthreads();
}


struct Args { const float* in[26]; float* out; unsigned char* ws; };
struct Frame {
    LAS unsigned char* lds;
    int tid, lane, wave;
    int vcu, G;
    unsigned char* ws;
    float* out;
};
typedef const float* cfptr_t;
__device__ __forceinline__ const float* in_ptr(int k) { asm volatile("" : "+s"(k));
    const __attribute__((address_space(4))) cfptr_t* kp = (const __attribute__((address_space(4))) cfptr_t*)__builtin_amdgcn_kernarg_segment_ptr(); return kp[k]; }
enum { I_x, I_c, I_ctx, I_c_ctx, I_ada_w, I_ada_b, I_norm1_g, I_norm2_g, I_w_in, I_na_rpb, I_hy_conv_w, I_hy_conv_b, I_hy_w1, I_hy_b1, I_hy_w2, I_hy_b2, I_hy_w3, I_hy_freq, I_hy_bias,
       I_mix_norm_g, I_w_out, I_ffn_w_up, I_ffn_conv_w, I_ffn_conv_b, I_ffn_w_down, I_final_norm_g };
#define IN(name) in_ptr(I_##name)
#define WSP(T, off) ((T*)(F.ws + (off)))

__device__ __forceinline__ void pa_adaln(Frame& F) {
    LAS float* sv = (LAS float*)F.lds;
    LAS float* red = (LAS float*)(F.lds + 3 * DM * 4);
    const float* p_c = IN(c); const float* p_cc = IN(c_ctx); const float* p_aw = IN(ada_w); const float* p_ab = IN(ada_b);
    for (int i = F.tid; i < 3 * DM; i += NTHR) { const int s = i / DM, k = i % DM; const float v = s < 2 ? p_c[s * DM + k] : p_cc[k]; sv[i] = v / (1.0f + __expf(-v)); }
    __syncthreads();
    float* MOD = WSP(float, WS_MOD);
    const int cg = F.tid & 63, ks = F.tid >> 6;
    for (int item = F.vcu; item < DEPTH * 48; item += F.G) {
        const int l = item / 48, j0 = (item % 48) * 256;
        const float* wp = p_aw + ((size_t)l * DM + ks * 256) * (NMOD * DM) + j0 + 4 * cg;
        f32x4 a0 = {0.f, 0.f, 0.f, 0.f}, a1 = a0, a2 = a0;
#pragma unroll 8
        for (int kk = 0; kk < 256; ++kk) {
            const f32x4 w = *(const f32x4*)(wp + (size_t)kk * (NMOD * DM));
            const float s0 = sv[ks * 256 + kk], s1 = sv[DM + ks * 256 + kk], s2 = sv[2 * DM + ks * 256 + kk];
            a0 += w * s0; a1 += w * s1; a2 += w * s2;
        }
        *(LAS f32x4*)(red + (ks * 3 + 0) * 256 + 4 * cg) = a0; *(LAS f32x4*)(red + (ks * 3 + 1) * 256 + 4 * cg) = a1; *(LAS f32x4*)(red + (ks * 3 + 2) * 256 + 4 * cg) = a2;
        __syncthreads();
        if (F.tid < 192) {
            const int s = F.tid >> 6, cc = F.tid & 63;
            f32x4 t = *(const f32x4*)(p_ab + (size_t)l * (NMOD * DM) + j0 + 4 * cc);
#pragma unroll
            for (int q = 0; q < 8; ++q) t += *(LAS f32x4*)(red + (q * 3 + s) * 256 + 4 * cc);
            *(f32x4*)(MOD + ((size_t)l * 3 + s) * (NMOD * DM) + j0 + 4 * cc) = t;
        }
        __syncthreads();
    }
}
__device__ __forceinline__ void transpose_item(const float* W, int K, int N, bf16* WT, int k0, int n0, int drow0, LAS float* scr, int lane) {
#pragma unroll 8
    for (int i = 0; i < 32; ++i) { const int kk = 2 * i + (lane >> 5); scr[kk * 33 + (lane & 31)] = W[(size_t)(k0 + kk) * N + n0 + (lane & 31)]; }
    LDS_WAIT(); asm volatile("" ::: "memory");
    const int c = lane & 7;
#pragma unroll
    for (int j = 0; j < 4; ++j) { const int n = (lane >> 3) + 8 * j; const LAS float* s = scr + (8 * c) * 33 + n;
        v4u o; o.x = pk2(s[0 * 33], s[1 * 33]); o.y = pk2(s[2 * 33], s[3 * 33]); o.z = pk2(s[4 * 33], s[5 * 33]); o.w = pk2(s[6 * 33], s[7 * 33]);
        *(v4u*)(WT + (size_t)(drow0 + n) * K + k0 + 8 * c) = o; }
    LDS_WAIT(); asm volatile("" ::: "memory");
}
__device__ __forceinline__ void pa_weights(Frame& F) {
    const float* p_win = IN(w_in); const float* p_wout = IN(w_out); const float* p_wup = IN(ffn_w_up); const float* p_wdn = IN(ffn_w_down);
    {
        LAS float* wt = (LAS float*)F.lds;
        LAS float* tab = (LAS float*)(F.lds + 64 * 129 * 4);
        if (F.tid < 128) tab[F.tid] = cospif((float)F.tid * (1.0f / 64.0f));
        for (int item = F.vcu; item < DEPTH * 4 * 32; item += F.G) {
            const int l = item >> 7, g = (item >> 5) & 3, k0 = (item & 31) * 64;
            __syncthreads();
            for (int i = F.tid; i < 64 * 128; i += NTHR) { const int kk = i >> 7, cc = i & 127; wt[kk * 129 + cc] = p_win[((size_t)l * DM + k0 + kk) * DIN + 3072 + g * 128 + cc]; }
            __syncthreads();
            const int kk = F.tid & 63;
            bf16* dst = WSP(bf16, WS_WIN) + ((size_t)l * DIN + 3072 + g * 128) * DM + k0 + kk;
            for (int i = 0; i < 16; ++i) {
                const int mp = (F.tid >> 6) + 8 * i;
                const int mm = mp <= 64 ? mp : mp - 64, sh = mp <= 64 ? 0 : 96;
                float a = 0.f;
                const int add = mp <= 64 ? 0 : 32; (void)sh;
#pragma unroll 8
                for (int cc = 0; cc < 128; ++cc) a += wt[kk * 129 + cc] * tab[(mm * cc + add) & 127];
                dst[(size_t)mp * DM] = (bf16)f2bf(a);
            }
        }
        __syncthreads();
    }
    LAS float* scr = (LAS float*)(F.lds + F.wave * 16384);
    const int gw = F.vcu * NWAVES + F.wave, NGW = F.G * NWAVES;
    constexpr int I_IN = 32 * 144, I_OUT = 32 * 64, I_UP = 32 * 352, I_DN = 88 * 64, I_L = I_IN + I_OUT + I_UP + I_DN;
    for (int it = gw; it < DEPTH * I_L; it += NGW) {
        const int l = it / I_L; int r = it % I_L;
        if (r < I_IN) { const int kb = r / 144; int nb = r % 144; if (nb >= 96) nb += 16;
            transpose_item(p_win + (size_t)l * DM * DIN, DM, DIN, WSP(bf16, WS_WIN) + (size_t)l * DIN * DM, kb * 64, nb * 32, nb * 32, scr, F.lane); continue; }
        r -= I_IN;
        if (r < I_OUT) { const int kb = r / 64, nb = r % 64;
            transpose_item(p_wout + (size_t)l * DM * DM, DM, DM, WSP(bf16, WS_WOUT) + (size_t)l * DM * DM, kb * 64, nb * 32, nb * 32, scr, F.lane); continue; }
        r -= I_OUT;
        if (r < I_UP) { const int kb = r / 352, nb = r % 352; const int n0 = nb * 32;
            const int drow = n0 < DFF ? (n0 >> 7) * 256 + (n0 & 127) : ((n0 - DFF) >> 7) * 256 + 128 + ((n0 - DFF) & 127);
            transpose_item(p_wup + (size_t)l * DM * 2 * DFF, DM, 2 * DFF, WSP(bf16, WS_WUP) + (size_t)l * 2 * DFF * DM, kb * 64, n0, drow, scr, F.lane); continue; }
        r -= I_UP;
        { const int kb = r / 64, nb = r % 64;
            transpose_item(p_wdn + (size_t)l * DFF * DM, DFF, DM, WSP(bf16, WS_WDN) + (size_t)l * DM * DFF, kb * 64, nb * 32, nb * 32, scr, F.lane); }
    }
}

__device__ __forceinline__ void norm_phase(Frame& F, int l, int which, bool with_ctx) {
    const float* gain = (which ? IN(norm2_g) : IN(norm1_g)) + (size_t)l * DM;
    const float* MOD = WSP(float, WS_MOD) + (size_t)l * 3 * (NMOD * DM);
    const bool first = (l == 0 && which == 0);
    const float* xl = first ? IN(x) : F.out; const float* xc = first ? IN(ctx) : WSP(float, WS_XC);
    bf16* H = WSP(bf16, WS_H);
    const int gw = F.vcu * NWAVES + F.wave, NGW = F.G * NWAVES, nrows = with_ctx ? MT : ML;
    for (int row = gw; row < nrows; row += NGW) {
        const int s = row < SEQ ? 0 : row < ML ? 1 : 2;
        const float* xr = row < ML ? xl + (size_t)row * DM : xc + (size_t)(row - ML) * DM;
        const float* shp = MOD + (size_t)s * (NMOD * DM) + (which ? 3 : 0) * DM; const float* scp = shp + DM;
        f32x4 v[8]; float ss = 0.f;
#pragma unroll
        for (int j = 0; j < 8; ++j) { v[j] = *(const f32x4*)(xr + 4 * (F.lane + 64 * j)); ss += (v[j].x * v[j].x + v[j].y * v[j].y) + (v[j].z * v[j].z + v[j].w * v[j].w); }
        const float rstd = 1.0f / sqrtf(wave_sum(ss, F.lane) * (1.0f / DM) + EPS);
        bf16* hr = H + (size_t)row * DM;
#pragma unroll
        for (int j = 0; j < 8; ++j) { const int k = 4 * (F.lane + 64 * j);
            const f32x4 g = *(const f32x4*)(gain + k), sc = *(const f32x4*)(scp + k), sh = *(const f32x4*)(shp + k);
            const f32x4 y = (v[j] * rstd * g) * (1.0f + sc) + sh;
            v2u o; o.x = pk2(y.x, y.y); o.y = pk2(y.z, y.w); *(v2u*)(hr + k) = o; }
    }
}
__device__ __forceinline__ void final_norm_phase(Frame& F) {
    const float* p_g = IN(final_norm_g);
    const int gw = F.vcu * NWAVES + F.wave, NGW = F.G * NWAVES;
    for (int row = gw; row < ML; row += NGW) {
        float* xr = F.out + (size_t)row * DM;
        f32x4 v[8]; float ss = 0.f;
#pragma unroll
        for (int j = 0; j < 8; ++j) { v[j] = *(const f32x4*)(xr + 4 * (F.lane + 64 * j)); ss += (v[j].x * v[j].x + v[j].y * v[j].y) + (v[j].z * v[j].z + v[j].w * v[j].w); }
        const float rstd = 1.0f / sqrtf(wave_sum(ss, F.lane) * (1.0f / DM) + EPS);
#pragma unroll
        for (int j = 0; j < 8; ++j) { const int k = 4 * (F.lane + 64 * j); *(f32x4*)(xr + k) = v[j] * rstd * *(const f32x4*)(p_g + k); }
    }
}

__device__ __forceinline__ void filter_phase(Frame& F, int l, bool with_ctx) {
    LAS float* h1 = (LAS float*)F.lds;
    LAS float* h2 = (LAS float*)(F.lds + 64 * 65 * 4);
    const float* w1 = IN(hy_w1) + (size_t)l * 33 * 64; const float* b1 = IN(hy_b1) + (size_t)l * 64;
    const float* w2 = IN(hy_w2) + (size_t)l * 64 * 64; const float* b2 = IN(hy_b2) + (size_t)l * 64;
    const float* w3 = IN(hy_w3) + (size_t)l * 64 * 2048; const float* fq = IN(hy_freq) + (size_t)l * 64;
    const int nitems = with_ctx ? 260 : 256;
    for (int item = F.vcu; item < nitems; item += F.G) {
        const bool isc = item >= 256; const int Lq = isc ? CTXL : SEQ; const int n0 = (isc ? item - 256 : item) * 64;
        const int p = F.tid & 63, jg = F.wave, jgv = F.tid >> 6;
        const float pos = (float)(n0 + p), t = pos / (float)(Lq - 1);
        __syncthreads();
        {
            float zf[33]; zf[0] = t;
#pragma unroll
            for (int i = 0; i < 16; ++i) { const float band = 1e-4f + (float)i * ((15.0f - 1e-4f) / 15.0f); const float ang = band * (6.283185307179586f / (float)Lq) * pos; zf[1 + i] = cosf(ang); zf[17 + i] = -sinf(ang); }
#pragma unroll 1
            for (int jj = 0; jj < 8; ++jj) { const int j = jg * 8 + jj; float a = b1[j];
#pragma unroll
                for (int i = 0; i < 33; ++i) a += zf[i] * w1[i * 64 + j];
                h1[p * 65 + j] = sinf(fq[j] * a); }
        }
        __syncthreads();
#pragma unroll 1
        for (int jj = 0; jj < 8; ++jj) { const int j = jg * 8 + jj; float a = b2[j];
#pragma unroll 8
            for (int i = 0; i < 64; ++i) a += h1[p * 65 + i] * w2[i * 64 + j];
            h2[p * 65 + j] = sinf(fq[j] * a); }
        __syncthreads();
        float* dst = isc ? WSP(float, WS_HFC) : WSP(float, WS_HF);
        for (int cb = 0; cb < 32; ++cb) {
            const int col0 = jgv * 256 + cb * 8;
            float a[8];
#pragma unroll
            for (int q = 0; q < 8; ++q) a[q] = 0.f;
#pragma unroll 4
            for (int i = 0; i < 64; ++i) { const float hvi = h2[p * 65 + i]; const f32x4 wa = *(const f32x4*)(w3 + (size_t)i * 2048 + col0), wb = *(const f32x4*)(w3 + (size_t)i * 2048 + col0 + 4);
                a[0] += hvi * wa.x; a[1] += hvi * wa.y; a[2] += hvi * wa.z; a[3] += hvi * wa.w; a[4] += hvi * wb.x; a[5] += hvi * wb.y; a[6] += hvi * wb.z; a[7] += hvi * wb.w; }
#pragma unroll
            for (int q = 0; q < 8; ++q) { const int col = col0 + q, ch = col & 511;
                const float delta = fabsf(HY_MIN_DECAY + (HY_MAX_DECAY - HY_MIN_DECAY) * ((float)ch / 511.0f));
                dst[(size_t)col * Lq + n0 + p] = a[q] * __expf(-t * delta); }
        }
    }
}

struct EpiIn {
    static constexpr bool PERM = true, AFTER_DRAIN = false;
    bf16* QK; bf16* VT; float* T32;
    __device__ __forceinline__ void operator()(pg8::f32x4 (&acc)[2][2][4][2], const pg8::Unit& u, int wr_, int wc_, int fr_, int fq_) const {
        int t_ = threadIdx.x; asm volatile("" : "+v"(t_));
        const int fr = t_ & 15, fq = (t_ >> 4) & 3, wc = (t_ >> 6) & 3, wr = t_ >> 8; (void)wr_; (void)wc_; (void)fr_; (void)fq_;
        const int row0 = u.pm * 256 + wr * 64 + fr, col0 = u.pn * 256 + wc * 32 + 8 * fq;
        if (u.type == 0) {
            const float sc = u.pn < 4 ? QSCALE : 1.0f;
#pragma unroll
            for (int ai = 0; ai < 2; ++ai)
#pragma unroll
                for (int m = 0; m < 4; ++m) { bf16* rowp = QK + (size_t)(row0 + ai * 128 + m * 16) * 2048 + col0;
#pragma unroll
                    for (int bj = 0; bj < 2; ++bj) { const pg8::f32x4 v0 = acc[ai][bj][m][0] * sc, v1 = acc[ai][bj][m][1] * sc;
                        v4u w; w.x = pg8::cvt_pk_bf16(v0[0], v0[1]); w.y = pg8::cvt_pk_bf16(v0[2], v0[3]); w.z = pg8::cvt_pk_bf16(v1[0], v1[1]); w.w = pg8::cvt_pk_bf16(v1[2], v1[3]);
                        *(v4u*)(rowp + bj * 128) = w; } }
        } else if (u.pm < 4) {
#pragma unroll
            for (int ai = 0; ai < 2; ++ai)
#pragma unroll
                for (int m = 0; m < 4; ++m) { bf16* rowp = VT + (size_t)(row0 + ai * 128 + m * 16) * MT + col0;
#pragma unroll
                    for (int bj = 0; bj < 2; ++bj) { const pg8::f32x4 v0 = acc[ai][bj][m][0], v1 = acc[ai][bj][m][1];
                        v4u w; w.x = pg8::cvt_pk_bf16(v0[0], v0[1]); w.y = pg8::cvt_pk_bf16(v0[2], v0[3]); w.z = pg8::cvt_pk_bf16(v1[0], v1[1]); w.w = pg8::cvt_pk_bf16(v1[2], v1[3]);
                        *(v4u*)(rowp + bj * 128) = w; } }
        } else {
#pragma unroll
            for (int ai = 0; ai < 2; ++ai)
#pragma unroll
                for (int m = 0; m < 4; ++m) { float* rowp = T32 + (size_t)(row0 - 1024 + ai * 128 + m * 16) * MT + col0;
#pragma unroll
                    for (int bj = 0; bj < 2; ++bj) { *(pg8::f32x4*)(rowp + bj * 128) = acc[ai][bj][m][0]; *(pg8::f32x4*)(rowp + bj * 128 + 4) = acc[ai][bj][m][1]; } }
        }
    }
};
struct EpiRes {
    static constexpr bool PERM = false, AFTER_DRAIN = false;
    const float* base_l; const float* base_c; float* out_l; float* out_c; const float* gate;
    __device__ __forceinline__ void operator()(pg8::f32x4 (&acc)[2][2][4][2], const pg8::Unit& u, int wr_, int wc_, int fr_, int fq_) const {
        int t_ = threadIdx.x; asm volatile("" : "+v"(t_));
        const int fr = t_ & 15, fq = (t_ >> 4) & 3, wc = (t_ >> 6) & 3, wr = t_ >> 8; (void)wr_; (void)wc_; (void)fr_; (void)fq_;
        const int row0 = u.pm * 256 + wr * 64 + fr, col0 = u.pn * 256 + wc * 32 + 4 * fq;
        const int s = u.pm < PML / 2 ? 0 : u.pm < PML ? 1 : 2;
        const float* bs = u.pm < PML ? base_l + (size_t)row0 * DM : base_c + (size_t)(row0 - ML) * DM;
        float* os = u.pm < PML ? out_l + (size_t)row0 * DM : out_c + (size_t)(row0 - ML) * DM;
        pg8::f32x4 gv[2][2];
#pragma unroll
        for (int bj = 0; bj < 2; ++bj)
#pragma unroll
            for (int n = 0; n < 2; ++n) gv[bj][n] = *(const pg8::f32x4*)(gate + (size_t)s * (NMOD * DM) + col0 + bj * 128 + n * 16);
#pragma unroll
        for (int ai = 0; ai < 2; ++ai)
#pragma unroll
            for (int m = 0; m < 4; ++m) { const size_t off = (size_t)(ai * 128 + m * 16) * DM + col0;
#pragma unroll
                for (int bj = 0; bj < 2; ++bj)
#pragma unroll
                    for (int n = 0; n < 2; ++n) { const pg8::f32x4 b = *(const pg8::f32x4*)(bs + off + bj * 128 + n * 16);
                        *(pg8::f32x4*)(os + off + bj * 128 + n * 16) = b + gv[bj][n] * acc[ai][bj][m][n]; }
                asm volatile("" ::: "memory"); }
    }
};
struct EpiUp {
    static constexpr bool PERM = true, AFTER_DRAIN = false;
    bf16* HID; float* EG; float* EP; float* EU; const float* cw; const float* cb;
    __device__ __forceinline__ void operator()(pg8::f32x4 (&acc)[2][2][4][2], const pg8::Unit& u, int wr_, int wc_, int fr_, int fq_) const {
        int t_ = threadIdx.x; asm volatile("" : "+v"(t_));
        const int fr = t_ & 15, fq = (t_ >> 4) & 3, wc = (t_ >> 6) & 3, wr = t_ >> 8; (void)wr_; (void)wc_; (void)fr_; (void)fq_;
        const int lane = t_ & 63;
        const unsigned hc0 = (unsigned)(u.pn * 128 + wc * 32 + 8 * fq);
        const int src_prev = (lane & 48) | ((fr + 15) & 15), src_next = (lane & 48) | ((fr + 1) & 15);
        const bool e0 = fr == 0, e3 = fr == 15;
        __builtin_amdgcn_sched_barrier(0);
#pragma unroll
        for (int ai = 0; ai < 2; ++ai) {
            const int rbase = u.pm * 256 + ai * 128 + wr * 64;
            const unsigned eb0 = (unsigned)((rbase >> 6) << 1) * (unsigned)DFF, eb3 = eb0 + (unsigned)DFF;
#pragma unroll
            for (int n = 0; n < 2; ++n) {
                const unsigned hc = hc0 + 4u * (unsigned)n;
                const pg8::f32x4 w0 = *(const pg8::f32x4*)&cw[hc], w1 = *(const pg8::f32x4*)&cw[(unsigned)DFF + hc], w2 = *(const pg8::f32x4*)&cw[2u * (unsigned)DFF + hc], bb = *(const pg8::f32x4*)&cb[hc];
                if (e0) { *(pg8::f32x4*)&EG[eb0 + hc] = acc[ai][0][0][n]; *(pg8::f32x4*)&EU[eb0 + hc] = acc[ai][1][0][n]; }
                if (e3) { *(pg8::f32x4*)&EG[eb3 + hc] = acc[ai][0][3][n]; *(pg8::f32x4*)&EU[eb3 + hc] = acc[ai][1][3][n]; }
#pragma unroll
                for (int j = 0; j < 4; ++j) {
                    float pr[4], nx[4], gg[4];
#pragma unroll
                    for (int m = 0; m < 4; ++m) { gg[m] = acc[ai][0][m][n][j]; pr[m] = lane_read(gg[m], src_prev); nx[m] = lane_read(gg[m], src_next); }
#pragma unroll
                    for (int m = 0; m < 4; ++m) {
                        const float pv = fr > 0 ? pr[m] : (m > 0 ? pr[m > 0 ? m - 1 : 0] : 0.f);
                        const float nv = fr < 15 ? nx[m] : (m < 3 ? nx[m < 3 ? m + 1 : 3] : 0.f);
                        const float cv = w0[j] * pv + w1[j] * gg[m] + w2[j] * nv + bb[j];
                        if (m == 0) { if (e0) EP[eb0 + hc + (unsigned)j] = cv; } if (m == 3) { if (e3) EP[eb3 + hc + (unsigned)j] = cv; }
                        acc[ai][0][m][n][j] = gelu_tanh(cv) * acc[ai][1][m][n][j];
                    }
                }
                asm volatile("" ::: "memory"); __builtin_amdgcn_sched_barrier(0);
            }
#pragma unroll
            for (int m = 0; m < 4; ++m) {
                if (!((m == 0 && e0) || (m == 3 && e3))) {
                    const pg8::f32x4 v0 = acc[ai][0][m][0], v1 = acc[ai][0][m][1];
                    v4u w; w.x = pg8::cvt_pk_bf16(v0[0], v0[1]); w.y = pg8::cvt_pk_bf16(v0[2], v0[3]); w.z = pg8::cvt_pk_bf16(v1[0], v1[1]); w.w = pg8::cvt_pk_bf16(v1[2], v1[3]);
                    *(v4u*)&HID[(unsigned)(rbase + m * 16 + fr) * (unsigned)DFF + hc0] = w;
                }
            }
        }
    }
};
__device__ __forceinline__ void edge_fix_phase(Frame& F, int l, bool with_ctx) {
    const float* EG = WSP(float, WS_EDGE); const float* EP = EG + EDGE_ELEMS; const float* EU = EP + EDGE_ELEMS;
    const float* cw = IN(ffn_conv_w) + (size_t)l * 3 * DFF;
    bf16* HID = WSP(bf16, WS_HID);
    const int ne = with_ctx ? NEDGE : ML / 64 * 2, total = ne * (DFF / 4);
    for (int i = F.vcu * NTHR + F.tid; i < total; i += F.G * NTHR) {
        const int e = i / (DFF / 4), c = (i % (DFF / 4)) * 4;
        const int r = (e >> 1) * 64 + (e & 1) * 63;
        f32x4 p = *(const f32x4*)(EP + (size_t)e * DFF + c);
        if (e & 1) { const int nr = r + 1; if (nr != SEQ && nr != ML && nr != ML + CTXL && nr != MT) p += *(const f32x4*)(cw + 2 * DFF + c) * *(const f32x4*)(EG + (size_t)(e + 1) * DFF + c); }
        else { if (r != 0 && r != SEQ && r != ML && r != ML + CTXL) p += *(const f32x4*)(cw + c) * *(const f32x4*)(EG + (size_t)(e - 1) * DFF + c); }
        const f32x4 up = *(const f32x4*)(EU + (size_t)e * DFF + c);
        v2u o; o.x = pk2(gelu_tanh(p.x) * up.x, gelu_tanh(p.y) * up.y); o.y = pk2(gelu_tanh(p.z) * up.z, gelu_tanh(p.w) * up.w);
        *(v2u*)(HID + (size_t)r * DFF + c) = o;
    }
}

#define MFMA16(a, b, c) __builtin_amdgcn_mfma_f32_16x16x32_bf16((a), (b), (c), 0, 0, 0)
__device__ __forceinline__ void attn_chunk(const bf16* kbase  , const bf16* vbase  ,
                                           const bf16x8 (&qf)[4], f32x4 (&o)[8], float& mrun, float& lsum, int lane, int q, int g,
                                           bool masked, int keycol0, int cs, const LAS float* brow  , int cq) {
    bf16x8 kf[2][4], vf[8];
#pragma unroll
    for (int T = 0; T < 2; ++T) { const int kk = 8 * (q >> 2) + 4 * T + (q & 3);
#pragma unroll
        for (int dc = 0; dc < 4; ++dc) kf[T][dc] = *(const bf16x8*)(kbase + (size_t)kk * 2048 + 32 * dc + 8 * g); }
#pragma unroll
    for (int dt = 0; dt < 8; ++dt) vf[dt] = *(const bf16x8*)(vbase + (size_t)(16 * dt + q) * MT + 8 * g);
    f32x4 s[2];
#pragma unroll
    for (int T = 0; T < 2; ++T) { s[T] = (f32x4){0.f, 0.f, 0.f, 0.f};
#pragma unroll
        for (int dc = 0; dc < 4; ++dc) s[T] = MFMA16(kf[T][dc], qf[dc], s[T]); }
    if (masked) {
#pragma unroll
        for (int T = 0; T < 2; ++T)
#pragma unroll
            for (int i = 0; i < 4; ++i) { const int keycol = keycol0 + 8 * g + 4 * T + i; const bool ok = keycol >= cs && keycol < cs + 16;
                const int dcol = keycol - cq + 15; const float bv = brow[ok ? dcol : 0];
                s[T][i] = ok ? s[T][i] + bv : -1e30f; }
    }
    float cm = fmaxf(fmaxf(fmaxf(s[0][0], s[0][1]), fmaxf(s[0][2], s[0][3])), fmaxf(fmaxf(s[1][0], s[1][1]), fmaxf(s[1][2], s[1][3])));
    cm = fmaxf(cm, lane_read(cm, lane ^ 16)); cm = fmaxf(cm, lane_read(cm, lane ^ 32));
    const float mnew = fmaxf(mrun, cm), alpha = __builtin_amdgcn_exp2f(mrun - mnew);
    mrun = mnew;
    float p[8]; float ps = 0.f;
#pragma unroll
    for (int T = 0; T < 2; ++T)
#pragma unroll
        for (int i = 0; i < 4; ++i) { p[4 * T + i] = __builtin_amdgcn_exp2f(s[T][i] - mnew); ps += p[4 * T + i]; }
    lsum = lsum * alpha + ps;
    v4u pw; pw.x = pg8::cvt_pk_bf16(p[0], p[1]); pw.y = pg8::cvt_pk_bf16(p[2], p[3]); pw.z = pg8::cvt_pk_bf16(p[4], p[5]); pw.w = pg8::cvt_pk_bf16(p[6], p[7]);
    const bf16x8 pf = __builtin_bit_cast(bf16x8, pw);
#pragma unroll
    for (int dt = 0; dt < 8; ++dt) { o[dt] = o[dt] * alpha; o[dt] = MFMA16(vf[dt], pf, o[dt]); }
}
__device__ __forceinline__ void attn_tile(Frame& F, bool is_lat, int b, int h, int r, int c0, int qrow0, const LAS float* bias_h) {
    const bf16* QK = WSP(bf16, WS_QK); const bf16* VT = WSP(bf16, WS_VT); bf16* A = WSP(bf16, WS_A);
    const int q = F.lane & 15, g = F.lane >> 4;
    bf16x8 qf[4];
    { const bf16* qp = QK + (size_t)(qrow0 + q) * 2048 + h * 128 + 8 * g;
#pragma unroll
      for (int dc = 0; dc < 4; ++dc) qf[dc] = *(const bf16x8*)(qp + 32 * dc); }
    f32x4 o[8];
#pragma unroll
    for (int dt = 0; dt < 8; ++dt) o[dt] = (f32x4){0.f, 0.f, 0.f, 0.f};
    float mrun = -1e30f, lsum = 0.f;
    if (is_lat) {
        const int r0 = min(max(r - 4, 0), GROWS - 8), kc0 = min(max(c0 - 8, 0), 32), cq = c0 + q, cs = min(max(cq - 8, 0), 48);
        for (int ir = 0; ir < 8; ++ir) {
            const int keyrow = r0 + ir, tok = b * SEQ + keyrow * GRIDW + kc0, drow = keyrow - r + 7;
            attn_chunk(QK + (size_t)tok * 2048 + 1024 + h * 128, VT + (size_t)(h * 128) * MT + tok, qf, o, mrun, lsum, F.lane, q, g, true, kc0, cs, bias_h + drow * 31, cq);
        }
    }
    for (int cc = 0; cc < 8; ++cc) {
        const int tok = ML + b * CTXL + 32 * cc;
        attn_chunk(QK + (size_t)tok * 2048 + 1024 + h * 128, VT + (size_t)(h * 128) * MT + tok, qf, o, mrun, lsum, F.lane, q, g, false, 0, 0, bias_h, 0);
    }
    lsum += lane_read(lsum, F.lane ^ 16); lsum += lane_read(lsum, F.lane ^ 32);
    const float inv = 1.0f / lsum;
    bf16* ap = A + (size_t)(qrow0 + q) * 1024 + h * 128 + 4 * g;
#pragma unroll
    for (int dt = 0; dt < 8; ++dt) { v2u w; w.x = pg8::cvt_pk_bf16(o[dt][0] * inv, o[dt][1] * inv); w.y = pg8::cvt_pk_bf16(o[dt][2] * inv, o[dt][3] * inv); *(v2u*)(ap + 16 * dt) = w; }
}
__device__ __forceinline__ void attn_phase(Frame& F, int l, bool with_ctx) {
    LAS float* bias = (LAS float*)(F.lds + XTRA_OFF);
    const float* p_rpb = IN(na_rpb) + (size_t)l * NHEAD * 465;
    for (int i = F.tid; i < NHEAD * 465; i += NTHR) bias[i] = p_rpb[i] * LOG2E;
    __syncthreads();
    const int gw = F.vcu * NWAVES + F.wave, NGW = F.G * NWAVES;
    for (int job = gw; job < 2048; job += NGW) {
        const int combo = job >> 5, rb = job & 31, b = combo >> 5, h = (combo >> 2) & 7, c0 = 16 * (combo & 3);
        for (int rr = 0; rr < 8; ++rr) { const int r = rb * 8 + rr; attn_tile(F, true, b, h, r, c0, b * SEQ + r * GRIDW + c0, bias + h * 465); }
    }
    if (with_ctx)
        for (int job = gw; job < 256; job += NGW) { const int b = job >> 7, h = (job >> 4) & 7, t = job & 15; attn_tile(F, false, b, h, 0, 0, ML + b * CTXL + 16 * t, bias + h * 465); }
    __syncthreads();
}

constexpr int FFTN = 16384;
__device__ __forceinline__ f32x2 tw32k(const LAS f32x2* TH, const LAS f32x2* TL, int n) { return cmul(TH[n >> 7], TL[n & 127]); }
template <bool INV> __device__ __forceinline__ void fft_pass(LAS f32x2* X, const LAS f32x2* TH, const LAS f32x2* TL, int ls, int tid) {
    const int s = 1 << ls, msk = s - 1, sh = 13 - ls;
#pragma unroll 2
    for (int i = 0; i < 8; ++i) {
        const int b = tid + NTHR * i, j = b & msk, i0 = ((b >> ls) << (ls + 2)) + j;
        f32x2 x0 = X[i0], x1 = X[i0 + s], x2 = X[i0 + 2 * s], x3 = X[i0 + 3 * s];
        f32x2 w1 = tw32k(TH, TL, j << sh); if (INV) w1.y = -w1.y;
        const f32x2 w2 = cmul(w1, w1), w3 = cmul(w2, w1);
        f32x2 y0, y1, y2, y3;
        if (!INV) {
            const f32x2 a = x0 + x2, bq = x1 + x3, c = x0 - x2, e = x1 - x3, d = (f32x2){e.y, -e.x};
            y0 = a + bq; y1 = cmul(c + d, w1); y2 = cmul(a - bq, w2); y3 = cmul(c - d, w3);
        } else {
            const f32x2 t1 = cmul(x1, w1), t2 = cmul(x2, w2), t3 = cmul(x3, w3);
            const f32x2 a = x0 + t2, c = x0 - t2, bq = t1 + t3, e = t1 - t3, d = (f32x2){-e.y, e.x};
            y0 = a + bq; y1 = c + d; y2 = a - bq; y3 = c - d;
        }
        X[i0] = y0; X[i0 + s] = y1; X[i0 + 2 * s] = y2; X[i0 + 3 * s] = y3;
    }
}
__device__ __forceinline__ void fft_fwd(LAS f32x2* X, const LAS f32x2* TH, const LAS f32x2* TL, int tid) {
    for (int ls = 12; ls >= 0; ls -= 2) { fft_pass<false>(X, TH, TL, ls, tid); __syncthreads(); }
}
__device__ __forceinline__ void fft_inv(LAS f32x2* X, const LAS f32x2* TH, const LAS f32x2* TL, int tid) {
    for (int ls = 0; ls <= 12; ls += 2) { fft_pass<true>(X, TH, TL, ls, tid); __syncthreads(); }
}
__device__ __forceinline__ int digitrev14(int k) { const unsigned b = __brev((unsigned)k) >> 18; return (int)(((b & 0x2AAAu) >> 1) | ((b & 0x1555u) << 1)); }

__device__ __forceinline__ float conv3(const float* p, int n, int Lq, float w0, float w1, float w2, float bb) {
    float a = p[n] * w1 + bb; if (n > 0) a += p[n - 1] * w0; if (n < Lq - 1) a += p[n + 1] * w2; return a;
}

__device__ __forceinline__ void hyena_latent(Frame& F, int l, int ch, LAS f32x2* X, const LAS f32x2* TH, const LAS f32x2* TL, f32x2* KS) {
    float* T32 = WSP(float, WS_T32);
    float* hv = T32 + (size_t)(512 + ch) * MT; const float* hx1 = T32 + (size_t)(1024 + ch) * MT; const float* hx2 = T32 + (size_t)(1536 + ch) * MT;
    const float* cw = IN(hy_conv_w) + (size_t)l * 3 * 1536; const float* cb = IN(hy_conv_b) + (size_t)l * 1536;
    const float* HF = WSP(float, WS_HF); const float* p_hb = IN(hy_bias) + (size_t)l * 2 * HYW + ch;
    const int tid = F.tid;
    f32x2* KE = KS + FFTN;
    for (int o = 0; o < 2; ++o) {
        const float* hf = HF + (size_t)(o * 1024 + ch) * SEQ; const float* hb = HF + (size_t)(o * 1024 + 512 + ch) * SEQ;
        const float bias = p_hb[o * HYW];
        const float vw0 = cw[ch], vw1 = cw[1536 + ch], vw2 = cw[3072 + ch], vbb = cb[ch];
        const float* hx = o == 0 ? hx1 : hx2; const int xo = o == 0 ? 512 : 1024;
        const float xw0 = cw[xo + ch], xw1 = cw[1536 + xo + ch], xw2 = cw[3072 + xo + ch], xbb = cb[xo + ch];
        for (int par = 0; par < 2; ++par) {
#pragma unroll 4
            for (int i = 0; i < 32; ++i) { const int n = tid + NTHR * i; const float f = hf[n], bk = n >= 1 ? hb[SEQ - n] : 0.f;
                X[n] = par == 0 ? (f32x2){f + bk, 0.f} : tw32k(TH, TL, n) * (f - bk); }
            __syncthreads();
            fft_fwd(X, TH, TL, tid);
#pragma unroll 4
            for (int i = 0; i < 32; ++i) { const int n = tid + NTHR * i; KS[n] = X[n]; }
            __syncthreads();
#pragma unroll 4
            for (int i = 0; i < 32; ++i) { const int n = tid + NTHR * i;
                f32x2 z; if (o == 0) { z.x = conv3(hv, n, SEQ, vw0, vw1, vw2, vbb); z.y = conv3(hv + SEQ, n, SEQ, vw0, vw1, vw2, vbb); } else { z.x = hv[n]; z.y = hv[SEQ + n]; }
                X[n] = par == 0 ? z : cmul(z, tw32k(TH, TL, n)); }
            __syncthreads();
            fft_fwd(X, TH, TL, tid);
#pragma unroll 4
            for (int i = 0; i < 32; ++i) { const int n = tid + NTHR * i; X[n] = cmul(X[n], KS[n]); }
            __syncthreads();
            fft_inv(X, TH, TL, tid);
            if (par == 0) {
#pragma unroll 4
                for (int i = 0; i < 32; ++i) { const int n = tid + NTHR * i; KE[n] = X[n]; }
                __syncthreads();
            }
        }
#pragma unroll 2
        for (int i = 0; i < 32; ++i) { const int n = tid + NTHR * i;
            f32x2 z; if (o == 0) { z.x = conv3(hv, n, SEQ, vw0, vw1, vw2, vbb); z.y = conv3(hv + SEQ, n, SEQ, vw0, vw1, vw2, vbb); } else { z.x = hv[n]; z.y = hv[SEQ + n]; }
            const f32x2 y = (KE[n] + cmul(X[n], cconj(tw32k(TH, TL, n)))) * (1.0f / 32768.0f) + z * bias;
            X[n] = (f32x2){conv3(hx, n, SEQ, xw0, xw1, xw2, xbb) * y.x, conv3(hx + SEQ, n, SEQ, xw0, xw1, xw2, xbb) * y.y}; }
        __syncthreads();
#pragma unroll 4
        for (int i = 0; i < 32; ++i) { const int n = tid + NTHR * i; const f32x2 r = X[n]; hv[n] = r.x; hv[SEQ + n] = r.y; }
        __syncthreads();
    }
}
__device__ __forceinline__ void fourier_latent(Frame& F, int b, int gq, int m, LAS f32x2* X, const LAS f32x2* TH, const LAS f32x2* TL) {
    float* T32 = WSP(float, WS_T32);
    float* ra = T32 + (size_t)(gq * 128 + m) * MT + b * SEQ; float* rb = T32 + (size_t)(gq * 128 + 64 + m) * MT + b * SEQ;
    const int tid = F.tid;
#pragma unroll 4
    for (int i = 0; i < 32; ++i) { const int n = tid + NTHR * i; X[n] = (f32x2){ra[n], rb[n]}; }
    __syncthreads();
    fft_fwd(X, TH, TL, tid);
    const float sc = 6.9053396600248786e-4f;
#pragma unroll 4
    for (int i = 0; i < 32; ++i) { const int k = tid + NTHR * i; const f32x2 u = X[digitrev14(k)], v = X[digitrev14((FFTN - k) & (FFTN - 1))];
        if (m != 0) { ra[k] = u.x * sc; rb[k] = v.x * sc; } else { ra[k] = (u.x + v.x) * (0.5f * sc); rb[k] = (u.y + v.y) * (0.5f * sc); } }
    __syncthreads();
}
__device__ __forceinline__ void hyena_ctx(Frame& F, int l, int ch, LAS float* S) {
    float* T32 = WSP(float, WS_T32);
    float* hv = T32 + (size_t)(512 + ch) * MT + ML; const float* hx1 = T32 + (size_t)(1024 + ch) * MT + ML; const float* hx2 = T32 + (size_t)(1536 + ch) * MT + ML;
    const float* cw = IN(hy_conv_w) + (size_t)l * 3 * 1536; const float* cb = IN(hy_conv_b) + (size_t)l * 1536;
    const float* HFC = WSP(float, WS_HFC); const float* p_hb = IN(hy_bias) + (size_t)l * 2 * HYW + ch;
    LAS float* zb = S; LAS float* hfl = S + 512; LAS float* hbl = S + 768;
    const int n = F.tid & 255, b = F.tid >> 8;
    __syncthreads();
    zb[b * 256 + n] = conv3(hv + b * CTXL, n, CTXL, cw[ch], cw[1536 + ch], cw[3072 + ch], cb[ch]);
    for (int o = 0; o < 2; ++o) {
        if (F.tid < 256) hfl[n] = HFC[(size_t)(o * 1024 + ch) * CTXL + n]; else hbl[n] = HFC[(size_t)(o * 1024 + 512 + ch) * CTXL + n];
        __syncthreads();
        float y = 0.f;
        for (int mI = 0; mI < CTXL; ++mI) { const int d = n - mI; y += zb[b * 256 + mI] * (d >= 0 ? hfl[d] : hbl[-d]); }
        y += p_hb[o * HYW] * zb[b * 256 + n];
        const float* hx = o == 0 ? hx1 : hx2; const int xo = o == 0 ? 512 : 1024;
        const float r = conv3(hx + b * CTXL, n, CTXL, cw[xo + ch], cw[1536 + xo + ch], cw[3072 + xo + ch], cb[xo + ch]) * y;
        __syncthreads();
        if (o == 0) zb[b * 256 + n] = r; else hv[b * CTXL + n] = r;
        __syncthreads();
    }
}
__device__ __forceinline__ void fourier_ctx(Frame& F, int item, LAS float* S) {
    float* T32 = WSP(float, WS_T32);
    const int b = item >> 5, gq = (item >> 3) & 3, m0 = (item & 7) * 8;
    LAS float* cs = S; LAS float* re = S + 256; LAS float* im = S + 256 + 2048;
    __syncthreads();
    if (F.tid < 256) cs[F.tid] = cospif((float)F.tid * (1.0f / 128.0f));
    for (int i = F.tid; i < 8 * 256; i += NTHR) { const int mm = i >> 8, n = i & 255;
        re[i] = T32[(size_t)(gq * 128 + m0 + mm) * MT + ML + b * CTXL + n]; im[i] = T32[(size_t)(gq * 128 + 64 + m0 + mm) * MT + ML + b * CTXL + n]; }
    __syncthreads();
    const int k = F.tid & 255, mh = F.tid >> 8;
    const float sc = 5.5242717280199031e-3f;
    for (int mq = 0; mq < 4; ++mq) { const int mm = mh * 4 + mq, m = m0 + mm;
        float cr = 0.f, ci = 0.f, sr = 0.f, si = 0.f;
        for (int n = 0; n < 256; ++n) { const int ix = (k * n) & 255; const float c = cs[ix], sn = cs[(ix - 64) & 255]; const float a = re[mm * 256 + n], bq = im[mm * 256 + n];
            cr += a * c; ci += bq * c; sr += a * sn; si += bq * sn; }
        float oa, ob;
        if (m != 0) { oa = cr + si; ob = cr - si; } else { oa = cr; ob = ci; }
        T32[(size_t)(gq * 128 + m) * MT + ML + b * CTXL + k] = oa * sc; T32[(size_t)(gq * 128 + 64 + m) * MT + ML + b * CTXL + k] = ob * sc; }
    __syncthreads();
}
__device__ __forceinline__ void fft_phase(Frame& F, int l, bool with_ctx) {
    LAS f32x2* X = (LAS f32x2*)F.lds;
    LAS f32x2* TH = (LAS f32x2*)(F.lds + XTRA_OFF + 16384); LAS f32x2* TL = TH + 128;
    if (F.tid < 256) { const int a = F.tid & 127; const float fr = F.tid < 128 ? (float)(128 * a) * (1.0f / 16384.0f) : (float)a * (1.0f / 16384.0f);
        float sn, cn; sincospif(fr, &sn, &cn); (F.tid < 128 ? TH : TL)[a] = (f32x2){cn, -sn}; }
    __syncthreads();
    for (int ch = F.vcu; ch < HYW; ch += F.G) hyena_latent(F, l, ch, X, TH, TL, WSP(f32x2, WS_KS) + (size_t)F.vcu * 2 * FFTN);
    for (int fu = F.vcu; fu < 512; fu += F.G) fourier_latent(F, fu >> 8, (fu >> 6) & 3, fu & 63, X, TH, TL);
    if (with_ctx) {
        LAS float* S = (LAS float*)F.lds;
        for (int ch = F.vcu; ch < HYW; ch += F.G) hyena_ctx(F, l, ch, S);
        for (int it = F.vcu; it < 64; it += F.G) fourier_ctx(F, it, S);
    }
}

__device__ __forceinline__ void merge_phase(Frame& F, int l, bool with_ctx) {
    const bf16* A = WSP(bf16, WS_A); const float* T32 = WSP(float, WS_T32); bf16* H = WSP(bf16, WS_H);
    const float* gain = IN(mix_norm_g) + (size_t)l * DM;
    LAS float* tile = (LAS float*)F.lds;
    const int TI = with_ctx ? 65 : 64;
    for (int it = F.vcu; it < 512; it += F.G) {
        const int tok0 = it * TI;
        for (int tk = F.wave; tk < TI; tk += NWAVES) {
            const size_t row = (size_t)(tok0 + tk);
            const v4u r0 = *(const v4u*)(A + row * 1024 + 8 * F.lane), r1 = *(const v4u*)(A + row * 1024 + 512 + 8 * F.lane);
            float v[16];
            v[0] = bf2f(r0.x & 0xffff); v[1] = bf2f(r0.x >> 16); v[2] = bf2f(r0.y & 0xffff); v[3] = bf2f(r0.y >> 16); v[4] = bf2f(r0.z & 0xffff); v[5] = bf2f(r0.z >> 16); v[6] = bf2f(r0.w & 0xffff); v[7] = bf2f(r0.w >> 16);
            v[8] = bf2f(r1.x & 0xffff); v[9] = bf2f(r1.x >> 16); v[10] = bf2f(r1.y & 0xffff); v[11] = bf2f(r1.y >> 16); v[12] = bf2f(r1.z & 0xffff); v[13] = bf2f(r1.z >> 16); v[14] = bf2f(r1.w & 0xffff); v[15] = bf2f(r1.w >> 16);
            float ss = 0.f;
#pragma unroll
            for (int j = 0; j < 16; ++j) ss += v[j] * v[j];
            const float rstd = 1.0f / sqrtf(wave_sum(ss, F.lane) * (1.0f / NAW) + EPS);
            const f32x4 g0 = *(const f32x4*)(gain + 8 * F.lane), g1 = *(const f32x4*)(gain + 8 * F.lane + 4), g2 = *(const f32x4*)(gain + 512 + 8 * F.lane), g3 = *(const f32x4*)(gain + 512 + 8 * F.lane + 4);
            v4u o0, o1;
            o0.x = pk2(v[0] * rstd * g0.x, v[1] * rstd * g0.y); o0.y = pk2(v[2] * rstd * g0.z, v[3] * rstd * g0.w); o0.z = pk2(v[4] * rstd * g1.x, v[5] * rstd * g1.y); o0.w = pk2(v[6] * rstd * g1.z, v[7] * rstd * g1.w);
            o1.x = pk2(v[8] * rstd * g2.x, v[9] * rstd * g2.y); o1.y = pk2(v[10] * rstd * g2.z, v[11] * rstd * g2.w); o1.z = pk2(v[12] * rstd * g3.x, v[13] * rstd * g3.y); o1.w = pk2(v[14] * rstd * g3.z, v[15] * rstd * g3.w);
            *(v4u*)(H + row * DM + 8 * F.lane) = o0; *(v4u*)(H + row * DM + 512 + 8 * F.lane) = o1;
        }
        for (int grp = 0; grp < 2; ++grp) {
            __syncthreads();
            for (int chn = F.wave; chn < 512; chn += NWAVES) { const float* src = T32 + (size_t)(grp * 512 + chn) * MT + tok0;
                for (int tk = F.lane; tk < TI; tk += 64) tile[chn * 65 + tk] = src[tk]; }
            __syncthreads();
            for (int tk = F.wave; tk < TI; tk += NWAVES) {
                float vv[8]; float ss = 0.f;
#pragma unroll
                for (int i = 0; i < 8; ++i) { const int chn = F.lane + 64 * i; int srow = chn;
                    if (grp == 0) { const int cc = chn & 127; srow = (chn & ~127) + (cc <= 64 ? cc : 192 - cc); }
                    vv[i] = tile[srow * 65 + tk]; ss += vv[i] * vv[i]; }
                const float rstd = 1.0f / sqrtf(wave_sum(ss, F.lane) * (1.0f / 512.0f) + EPS);
                bf16* hp = H + (size_t)(tok0 + tk) * DM + NAW + grp * 512;
#pragma unroll
                for (int i = 0; i < 8; ++i) { const int chn = F.lane + 64 * i; hp[chn] = (bf16)f2bf(vv[i] * rstd * gain[NAW + grp * 512 + chn]); }
            }
        }
    }
}

#define REFRESH(F) do { int t_ = threadIdx.x; asm volatile("" : "+v"(t_)); F.tid = t_; F.lane = t_ & 63; F.wave = __builtin_amdgcn_readfirstlane(t_ >> 6); \
    unsigned char* w_ = args.ws; asm volatile("" : "+s"(w_)); F.ws = w_; float* o_ = args.out; asm volatile("" : "+s"(o_)); F.out = o_; } while (0)
__global__ void __launch_bounds__(NTHR, 2) fwd_kernel(Args args) {
    extern __shared__ __attribute__((aligned(16))) unsigned char lds[];
    Frame F;
    F.lds = (LAS unsigned char*)lds;
    F.tid = threadIdx.x; F.lane = F.tid & 63; F.wave = __builtin_amdgcn_readfirstlane(F.tid >> 6);
    F.G = gridDim.x; { const int bx = blockIdx.x; F.vcu = (F.G % 8 == 0) ? (bx % 8) * (F.G / 8) + bx / 8 : bx; }
    F.ws = args.ws; F.out = args.out;
    volatile LAS unsigned* MISC = (volatile LAS unsigned*)(F.lds + MISC_OFF);
    for (int u = F.tid; u < 64; u += NTHR) MISC[u] = 0u;
    __syncthreads();
    XcdBarrier bar = xcd_barrier_post((unsigned*)(F.ws + WS_CTL) + CW_BAR, MISC + 8);
    LAS unsigned char* ring = F.lds;
#define GRID_BAR() do { unsigned* bp_ = bar.bar; unsigned bx_ = bar.x; asm volatile("" : "+s"(bp_), "+s"(bx_)); XcdBarrier b_ = bar; b_.bar = bp_; b_.x = bx_; xcd_barrier(b_); } while (0)


#if !defined(OFF_PA)
    REFRESH(F); pa_adaln(F); __syncthreads(); pa_weights(F);
#endif

    GRID_BAR();

    for (int l = 0; l < DEPTH; ++l) {
        const bool uc = l < DEPTH - 1;
        const int npm = uc ? PMT : PML;
        const float* MODL = WSP(float, WS_MOD) + (size_t)l * 3 * (NMOD * DM);

#if !defined(OFF_P0)
        REFRESH(F); norm_phase(F, l, 0, true); __syncthreads();
#if !defined(OFF_FILT)
 REFRESH(F); filter_phase(F, l, uc);
#endif
#endif

        GRID_BAR();
        {
            const char* Hb = (const char*)WSP(bf16, WS_H); const char* Wb = (const char*)(WSP(bf16, WS_WIN) + (size_t)l * DIN * DM);
            pg8::Sched2 S; S.n1 = PMT * 8; S.nM1 = PMT; S.nN1 = 8; S.n2 = 12 * PMT; S.nM2 = 12; S.nN2 = PMT; S.G = F.G; S.c = (int)blockIdx.x;
            S.A1 = Hb; S.B1 = Wb; S.A2 = Wb + (size_t)2048 * DM * 2; S.B2 = Hb; S.tstep = (size_t)256 * DM * 2;
            EpiIn E{WSP(bf16, WS_QK), WSP(bf16, WS_VT), WSP(float, WS_T32)};

#if !defined(OFF_P1)
            pg8::gemm_phase<EpiIn, pg8::Sched2, true, true>(ring, DM, S, E);
#endif

        }
        GRID_BAR();

#if !defined(OFF_ATT)
        REFRESH(F); attn_phase(F, l, uc);
#endif
#if !defined(OFF_FFT)
        REFRESH(F); fft_phase(F, l, uc);
#endif

        GRID_BAR();

#if !defined(OFF_P3)
        REFRESH(F); merge_phase(F, l, uc);
#endif

        GRID_BAR();
        {
            pg8::Sched2 S; S.n1 = npm * 8; S.nM1 = npm; S.nN1 = 8; S.n2 = 0; S.nM2 = 1; S.nN2 = 1; S.G = F.G; S.c = (int)blockIdx.x;
            S.A1 = (const char*)WSP(bf16, WS_H); S.B1 = (const char*)(WSP(bf16, WS_WOUT) + (size_t)l * DM * DM); S.A2 = S.A1; S.B2 = S.B1; S.tstep = (size_t)256 * DM * 2;
            EpiRes E{l == 0 ? IN(x) : F.out, l == 0 ? IN(ctx) : WSP(float, WS_XC), F.out, WSP(float, WS_XC), MODL + 2 * DM};

#if !defined(OFF_P4)
            pg8::gemm_phase<EpiRes, pg8::Sched2, true, true>(ring, DM, S, E);
#endif

        }
        GRID_BAR();

#if !defined(OFF_P5)
        REFRESH(F); norm_phase(F, l, 1, uc);
#endif

        GRID_BAR();
        {
            pg8::Sched2 S; S.n1 = npm * 44; S.nM1 = npm; S.nN1 = 44; S.n2 = 0; S.nM2 = 1; S.nN2 = 1; S.G = F.G; S.c = (int)blockIdx.x;
            S.A1 = (const char*)WSP(bf16, WS_H); S.B1 = (const char*)(WSP(bf16, WS_WUP) + (size_t)l * 2 * DFF * DM); S.A2 = S.A1; S.B2 = S.B1; S.tstep = (size_t)256 * DM * 2;
            float* EG = WSP(float, WS_EDGE);
            EpiUp E{WSP(bf16, WS_HID), EG, EG + EDGE_ELEMS, EG + 2 * EDGE_ELEMS, IN(ffn_conv_w) + (size_t)l * 3 * DFF, IN(ffn_conv_b) + (size_t)l * DFF};

#if !defined(OFF_P6)
            pg8::gemm_phase<EpiUp, pg8::Sched2, true, true>(ring, DM, S, E);
#endif

        }
        GRID_BAR();

#if !defined(OFF_P6B)
        REFRESH(F); edge_fix_phase(F, l, uc);
#endif

        GRID_BAR();
        {
            pg8::Sched2 S; S.n1 = npm * 8; S.nM1 = npm; S.nN1 = 8; S.n2 = 0; S.nM2 = 1; S.nN2 = 1; S.G = F.G; S.c = (int)blockIdx.x;
            S.A1 = (const char*)WSP(bf16, WS_HID); S.B1 = (const char*)(WSP(bf16, WS_WDN) + (size_t)l * DM * DFF); S.A2 = S.A1; S.B2 = S.B1; S.tstep = (size_t)256 * DFF * 2;
            EpiRes E{F.out, WSP(float, WS_XC), F.out, WSP(float, WS_XC), MODL + 5 * DM};

#if !defined(OFF_P7)
            pg8::gemm_phase<EpiRes, pg8::Sched2, true, true>(ring, DFF, S, E);
#endif

        }
        GRID_BAR();
    }
    REFRESH(F); final_norm_phase(F);
}

extern "C" void kernel_launch(void* const* d_in, const int* in_sizes, int n_in, void* d_out, int out_size, void* d_ws, size_t ws_size, hipStream_t stream) {
    static int grid = 0;
    if (grid == 0) {
        if (n_in != 26 || in_sizes[0] != ML * DM || out_size != ML * DM || ws_size < WS_END) { fprintf(stderr, "kernel_launch: unexpected shapes (n_in %d, in0 %d, out %d, ws %zu < %zu)\n", n_in, n_in > 0 ? in_sizes[0] : -1, out_size, ws_size, (size_t)WS_END); grid = -1; return; }
        int dev = 0, cus = 0, per_cu = 0;
        if (hipGetDevice(&dev) != hipSuccess || hipDeviceGetAttribute(&cus, hipDeviceAttributeMultiprocessorCount, dev) != hipSuccess) { grid = -1; return; }
        if (hipFuncSetAttribute((const void*)fwd_kernel, hipFuncAttributeMaxDynamicSharedMemorySize, LDS_BYTES) != hipSuccess) { fprintf(stderr, "kernel_launch: hipFuncSetAttribute failed\n"); grid = -1; return; }
        if (hipOccupancyMaxActiveBlocksPerMultiprocessor(&per_cu, (const void*)fwd_kernel, NTHR, LDS_BYTES) != hipSuccess || per_cu < 1) { fprintf(stderr, "kernel_launch: occupancy query reports %d\n", per_cu); }
        (void)hipGetLastError();
        grid = cus;
    }
    if (grid < 0) return;
    if (hipMemsetAsync((char*)d_ws + WS_CTL, 0, CTL_ZERO_BYTES, stream) != hipSuccess) return;
    Args a{};
    for (int i = 0; i < 26; ++i) a.in[i] = (const float*)d_in[i];
    a.out = (float*)d_out; a.ws = (unsigned char*)d_ws;
    hipLaunchKernelGGL(fwd_kernel, dim3(grid), dim3(NTHR), LDS_BYTES, stream, a);
}
```

```cpp
#include <hip/hip_runtime.h>
#include <cstdio>
#include <cstdint>
namespace pg8 {
#define PG8_LAS __attribute__((address_space(3)))
typedef unsigned short bf16_t;
typedef short bf16x8 __attribute__((ext_vector_type(8)));
typedef float f32x4 __attribute__((ext_vector_type(4)));
typedef unsigned u32x4 __attribute__((ext_vector_type(4)));
constexpr int BM = 256, BK = 64, HALF = 128, HTB = HALF * BK * 2  , STAGE_BYTES = 8 * HTB, NXCD = 8, WGM = 8;

__host__ __device__ __forceinline__ int lds_byte(int r, int c) { const int st = (r >> 4) * 2 + (c >> 5), rr = r & 15, cc = c & 31, ob = rr * 64 + cc * 2; return st * 1024 + (ob ^ (((ob >> 9) & 1) << 5)); }
__host__ __device__ __forceinline__ void stage_rc(int b, int& R, int& C) { const int st = b / 1024, sb = b % 1024, swz = sb ^ (((sb >> 9) & 1) << 5); R = (st >> 1) * 16 + swz / 64; C = (st & 1) * 32 + (swz % 64) / 2; }
__host__ __device__ __forceinline__ int perm32(int rho) { const int n = rho >> 4, i = rho & 15; return 8 * (i >> 2) + 4 * n + (i & 3); }

struct Unit { int pm, pn, type; };

__device__ __forceinline__ void map_unit(int w, int nwg, int nM, int nN, Unit& u) {
    { const int q = nwg / NXCD, r = nwg % NXCD, xcd = w % NXCD, off = w / NXCD; w = (xcd < r ? xcd * (q + 1) : r * (q + 1) + (xcd - r) * q) + off; }
    const int nig = WGM * nN, gid = w / nig, fm = gid * WGM, gsz = (nM - fm) < WGM ? (nM - fm) : WGM;
    u.pm = fm + ((w % nig) % gsz); u.pn = (w % nig) / gsz;
}
struct Sched2 {
    int n1, nM1, nN1, n2, nM2, nN2, G, c; const char *A1, *B1, *A2, *B2; size_t tstep;
    __device__ __forceinline__ bool next(int i, Unit& u) const {
        const long L = (long)i * G + c;
        if (L < n1) { map_unit((int)L, n1, nM1, nN1, u); u.type = 0; return true; }
        if (L < n1 + n2) { map_unit((int)L - n1, n2, nM2, nN2, u); u.type = 1; return true; }
        return false;
    }
    __device__ __forceinline__ const char* a_ptr(const Unit& u) const { return (u.type ? A2 : A1) + (size_t)u.pm * tstep; }
    __device__ __forceinline__ const char* b_ptr(const Unit& u) const { return (u.type ? B2 : B1) + (size_t)u.pn * tstep; }
    __device__ __forceinline__ void a_ready(const Unit&) const {}
    __device__ __forceinline__ void done(const Unit&) const {}
};

__device__ __forceinline__ unsigned cvt_pk_bf16(float lo, float hi) { unsigned r; asm volatile("v_cvt_pk_bf16_f32 %0, %1, %2" : "=v"(r) : "v"(lo), "v"(hi)); return r; }
typedef float f32x2 __attribute__((ext_vector_type(2)));

template <class Epi, class Sched, bool ALIGN_EPI = false, bool SP2 = false>
__device__ __forceinline__ void gemm_phase(PG8_LAS unsigned char* lds, const int Kdim, const Sched& S, const Epi& E) {
    int tid_ = threadIdx.x; asm volatile("" : "+v"(tid_));
    const int tid = tid_, wid = __builtin_amdgcn_readfirstlane(tid >> 6), lane = tid & 63, wr = wid >> 2, wc = wid & 3, fr = lane & 15, fq = lane >> 4;
    const int K = Kdim, nt = K / BK;
    unsigned voffA[2], voffB[2];
#pragma unroll
    for (int i = 0; i < 2; ++i) { int R, C; stage_rc(tid * 16 + i * 8192, R, C); const int Rb = Epi::PERM ? ((R & ~31) + perm32(R & 31)) : R;
        voffA[i] = (unsigned)(R * K + C) * 2u; voffB[i] = (unsigned)(Rb * K + C) * 2u; }
    const size_t kstep = (size_t)(BK * 2);
    const size_t hstep = (size_t)HALF * K * 2;
    const size_t tstep = 2 * hstep;
    const unsigned ldsw = (unsigned)wid * 1024u;
    const int aoff = lds_byte(wr * 64 + fr, fq * 8), boff = lds_byte(wc * 32 + fr, fq * 8);
#define PG8_SA(b, h) (((b) * 2 + (h)) * HTB)
#define PG8_SB(b, h) ((4 + (b) * 2 + (h)) * HTB)
#define PG8_STAGE(bufoff, gbase, voff) do { _Pragma("unroll") for (int _i = 0; _i < 2; ++_i) \
        __builtin_amdgcn_global_load_lds((const unsigned*)((const char*)(gbase) + (voff)[_i]), (PG8_LAS unsigned*)(lds + (bufoff) + ldsw + _i * 8192), 16, 0, 0); } while (0)
#define PG8_LDA(dst, b, h) do { _Pragma("unroll") for (int m = 0; m < 4; ++m) _Pragma("unroll") for (int k = 0; k < 2; ++k) dst[m][k] = *(const PG8_LAS bf16x8*)(lds + PG8_SA(b, h) + aoff + m * 2048 + k * 1024); } while (0)
#define PG8_LDB(dst, b, h) do { _Pragma("unroll") for (int n = 0; n < 2; ++n) _Pragma("unroll") for (int k = 0; k < 2; ++k) dst[n][k] = *(const PG8_LAS bf16x8*)(lds + PG8_SB(b, h) + boff + n * 2048 + k * 1024); } while (0)
#define PG8_MMA(ai, bj, At, Bt) do { __builtin_amdgcn_s_setprio(1); _Pragma("unroll") for (int m = 0; m < 4; ++m) _Pragma("unroll") for (int n = 0; n < 2; ++n) _Pragma("unroll") for (int k = 0; k < 2; ++k) \
        acc[ai][bj][m][n] = __builtin_amdgcn_mfma_f32_16x16x32_bf16(Bt[n][k], At[m][k], acc[ai][bj][m][n], 0, 0, 0); __builtin_amdgcn_s_setprio(0); } while (0)
#define PG8_WAIT_V(n) asm volatile("s_waitcnt vmcnt(" #n ")" ::: "memory")
#define PG8_WAIT_L(n) asm volatile("s_waitcnt lgkmcnt(" #n ")" ::: "memory")
#define PG8_BAR __builtin_amdgcn_s_barrier()
#define PG8_SCHED __builtin_amdgcn_sched_barrier(0)
    Unit cur, nxt; int ui = 0;
    if (!S.next(0, cur)) return;
    f32x4 acc[2][2][4][2];
#pragma unroll
    for (int a = 0; a < 2; ++a)
#pragma unroll
        for (int b = 0; b < 2; ++b)
#pragma unroll
            for (int m = 0; m < 4; ++m)
#pragma unroll
                for (int n = 0; n < 2; ++n) acc[a][b][m][n] = (f32x4){0.f, 0.f, 0.f, 0.f};
    bf16x8 At[4][2], B0[2][2], B1[2][2];
    const char* cA = S.a_ptr(cur); const char* cB = S.b_ptr(cur);
    S.a_ready(cur);
    if constexpr (SP2) {
        PG8_STAGE(PG8_SB(0, 0), cB, voffB); PG8_STAGE(PG8_SB(0, 1), cB + hstep, voffB); PG8_STAGE(PG8_SA(0, 0), cA, voffA); PG8_STAGE(PG8_SA(0, 1), cA + hstep, voffA);
        if (wr == 1) PG8_BAR;
        PG8_WAIT_V(2); PG8_BAR;
        PG8_STAGE(PG8_SB(1, 0), cB + kstep, voffB); PG8_STAGE(PG8_SA(1, 0), cA + kstep, voffA); PG8_STAGE(PG8_SB(1, 1), cB + hstep + kstep, voffB);
        PG8_WAIT_V(6); PG8_BAR;
    } else {
        PG8_STAGE(PG8_SB(0, 0), cB, voffB); PG8_STAGE(PG8_SA(0, 0), cA, voffA); PG8_STAGE(PG8_SB(0, 1), cB + hstep, voffB); PG8_STAGE(PG8_SA(0, 1), cA + hstep, voffA);
        if (wr == 1) PG8_BAR;
        PG8_WAIT_V(4); PG8_BAR;
        PG8_STAGE(PG8_SB(1, 0), cB + kstep, voffB); PG8_STAGE(PG8_SA(1, 0), cA + kstep, voffA); PG8_STAGE(PG8_SB(1, 1), cB + hstep + kstep, voffB);
        PG8_WAIT_V(6); PG8_BAR;
    }
    for (;;) {
        const bool has_next = S.next(ui + 1, nxt);
        const char* nA = has_next ? S.a_ptr(nxt) : cA; const char* nB = has_next ? S.b_ptr(nxt) : cB;
        for (int t = 0; t < nt; t += 2) {
            const bool last = (t == nt - 2);
            const char* a1 = cA + (size_t)(t + 1) * kstep;
            const char* a2 = last ? nA : cA + (size_t)(t + 2) * kstep; const char* b2 = last ? nB : cB + (size_t)(t + 2) * kstep;
            const char* a3 = a2 + kstep; const char* b3 = b2 + kstep;
            if (last && has_next) S.a_ready(nxt);
            if constexpr (SP2) {
            PG8_LDB(B0, 0, 0); PG8_LDB(B1, 0, 1); PG8_SCHED; PG8_LDA(At, 0, 0); PG8_STAGE(PG8_SA(1, 1), a1 + hstep, voffA);
            PG8_WAIT_V(8); PG8_WAIT_L(0); PG8_BAR; PG8_MMA(0, 0, At, B0); PG8_MMA(0, 1, At, B1); PG8_BAR; PG8_SCHED;
            PG8_LDA(At, 0, 1); PG8_STAGE(PG8_SB(0, 0), b2, voffB); PG8_STAGE(PG8_SB(0, 1), b2 + hstep, voffB); PG8_STAGE(PG8_SA(0, 0), a2, voffA);
            PG8_WAIT_V(8); PG8_WAIT_L(0); PG8_BAR; PG8_MMA(1, 0, At, B0); PG8_MMA(1, 1, At, B1); PG8_BAR; PG8_SCHED;
            PG8_LDB(B0, 1, 0); PG8_LDB(B1, 1, 1); PG8_SCHED; PG8_LDA(At, 1, 0); PG8_STAGE(PG8_SA(0, 1), a2 + hstep, voffA);
            PG8_WAIT_V(8); PG8_WAIT_L(0); PG8_BAR; PG8_MMA(0, 0, At, B0); PG8_MMA(0, 1, At, B1); PG8_BAR; PG8_SCHED;
            PG8_LDA(At, 1, 1); PG8_STAGE(PG8_SB(1, 0), b3, voffB); PG8_STAGE(PG8_SB(1, 1), b3 + hstep, voffB); PG8_STAGE(PG8_SA(1, 0), a3, voffA);
            PG8_WAIT_V(8); PG8_WAIT_L(0); PG8_BAR; PG8_MMA(1, 0, At, B0); PG8_MMA(1, 1, At, B1); PG8_BAR; PG8_SCHED;
            } else {
            PG8_LDB(B0, 0, 0); PG8_SCHED; PG8_LDA(At, 0, 0); PG8_STAGE(PG8_SA(1, 1), a1 + hstep, voffA);
            PG8_WAIT_L(8); PG8_BAR; PG8_WAIT_L(0); PG8_MMA(0, 0, At, B0); PG8_BAR; PG8_SCHED;
            PG8_LDB(B1, 0, 1); PG8_STAGE(PG8_SB(0, 0), b2, voffB);
            PG8_BAR; PG8_WAIT_L(0); PG8_MMA(0, 1, At, B1); PG8_BAR;
            PG8_LDA(At, 0, 1); PG8_STAGE(PG8_SA(0, 0), a2, voffA);
            PG8_BAR; PG8_WAIT_L(0); PG8_MMA(1, 0, At, B0); PG8_BAR; PG8_SCHED;
            PG8_STAGE(PG8_SB(0, 1), b2 + hstep, voffB);
            PG8_WAIT_V(6); PG8_BAR; PG8_MMA(1, 1, At, B1); PG8_BAR;
            PG8_LDB(B0, 1, 0); PG8_SCHED; PG8_LDA(At, 1, 0); PG8_STAGE(PG8_SA(0, 1), a2 + hstep, voffA);
            PG8_WAIT_L(8); PG8_BAR; PG8_WAIT_L(0); PG8_MMA(0, 0, At, B0); PG8_BAR; PG8_SCHED;
            PG8_LDB(B1, 1, 1); PG8_STAGE(PG8_SB(1, 0), b3, voffB);
            PG8_BAR; PG8_WAIT_L(0); PG8_MMA(0, 1, At, B1); PG8_BAR;
            PG8_LDA(At, 1, 1); PG8_STAGE(PG8_SA(1, 0), a3, voffA);
            PG8_BAR; PG8_WAIT_L(0); PG8_MMA(1, 0, At, B0); PG8_BAR; PG8_SCHED;
            PG8_STAGE(PG8_SB(1, 1), b3 + hstep, voffB);
            PG8_WAIT_V(6); PG8_BAR; PG8_MMA(1, 1, At, B1); PG8_BAR;
            }
        }
        if constexpr (ALIGN_EPI) { if (wr == 0) PG8_BAR; }
        if constexpr (!Epi::AFTER_DRAIN) { E(acc, cur, wr, wc, fr, fq); S.done(cur); }
        if (!has_next) break;
#pragma unroll
        for (int a = 0; a < 2; ++a)
#pragma unroll
            for (int b = 0; b < 2; ++b)
#pragma unroll
                for (int m = 0; m < 4; ++m)
#pragma unroll
                    for (int n = 0; n < 2; ++n) acc[a][b][m][n] = (f32x4){0.f, 0.f, 0.f, 0.f};
        cur = nxt; cA = nA; cB = nB; ++ui;
        if constexpr (ALIGN_EPI) { if (wr == 1) PG8_BAR; }
    }
    PG8_WAIT_V(0);
    if constexpr (!ALIGN_EPI) { if (wr == 0) PG8_BAR; }
    PG8_BAR;
    if constexpr (Epi::AFTER_DRAIN) { E.fused(acc, cur, wr, wc, fr, fq, lds, wid, lane); S.done(cur); }
#undef PG8_SA
#undef PG8_SB
#undef PG8_STAGE
#undef PG8_LDA
#undef PG8_LDB
#undef PG8_MMA
#undef PG8_WAIT_V
#undef PG8_WAIT_L
#undef PG8_BAR
#undef PG8_SCHED
}
}

constexpr int NWAVES = 8, NTHR = 512;
constexpr int DM = 2048, BATCH = 2, SEQ = 16384, DEPTH = 4, GRIDW = 64, GROWS = 256, CTXL = 256;
constexpr int NAW = 1024, NHEAD = 8, HDIM = 128, FNW = 512, HYW = 512, DFF = 5632, DIN = 5120, NMOD = 6;
constexpr int ML = BATCH * SEQ, MC = BATCH * CTXL, MT = ML + MC;
constexpr int PML = ML / 256, PMT = MT / 256;
constexpr int NEDGE = MT / 64 * 2;
constexpr float EPS = 1e-6f;
constexpr float LOG2E = 1.4426950408889634f;
constexpr float QSCALE = 0.08838834764831845f * LOG2E;
constexpr float HY_MIN_DECAY = -3.0701134573253945f, HY_MAX_DECAY = -15.350567286626973f;

constexpr size_t MiB = 1u << 20;
constexpr size_t WS_CTL = 0, CTL_ZERO_BYTES = 1 * MiB;
constexpr size_t WS_MOD = 1 * MiB;
constexpr size_t WS_XC = 2 * MiB;
constexpr size_t WS_HFC = 6 * MiB;
constexpr size_t WS_HF = 8 * MiB;
constexpr size_t WS_WIN = WS_HF + 128 * MiB;
constexpr size_t WS_WOUT = WS_WIN + 80 * MiB;
constexpr size_t WS_WUP = WS_WOUT + 32 * MiB;
constexpr size_t WS_WDN = WS_WUP + 176 * MiB;
constexpr size_t WS_H = WS_WDN + 88 * MiB;
constexpr size_t WS_QK = WS_H + 130 * MiB;
constexpr size_t WS_VT = WS_QK + 130 * MiB;
constexpr size_t WS_T32 = WS_VT + 65 * MiB;
constexpr size_t WS_A = WS_T32 + 260 * MiB;
constexpr size_t WS_HID = WS_QK;
constexpr size_t WS_EDGE = WS_A + 65 * MiB;
constexpr size_t EDGE_ELEMS = (size_t)NEDGE * DFF;
constexpr size_t WS_KS = WS_EDGE + 68 * MiB;
constexpr size_t WS_END = WS_KS + 64 * MiB;
static_assert((size_t)MT * DFF * 2 <= WS_EDGE - WS_QK, "hidden overlay");
static_assert(3 * EDGE_ELEMS * 4 <= 68 * MiB, "edge buffers");
static_assert((size_t)MT * DM * 2 == 130 * MiB && (size_t)1024 * MT * 2 == 65 * MiB && (size_t)2048 * MT * 4 == 260 * MiB, "sizes");
constexpr int CW_BAR = 4096;

constexpr int RING_BYTES = 131072;
constexpr int XTRA_OFF = RING_BYTES, XTRA_BYTES = 20480;
constexpr int MISC_OFF = XTRA_OFF + XTRA_BYTES;
constexpr int LDS_BYTES = MISC_OFF + 256;

#define GAS __attribute__((address_space(1)))
#define LAS __attribute__((address_space(3)))
typedef unsigned short bf16;
typedef unsigned v4u __attribute__((ext_vector_type(4)));
typedef unsigned v2u __attribute__((ext_vector_type(2)));
typedef float f32x4 __attribute__((ext_vector_type(4)));
typedef float f32x2 __attribute__((ext_vector_type(2)));
typedef short bf16x8 __attribute__((ext_vector_type(8)));
#define LDS_WAIT() asm volatile("s_waitcnt lgkmcnt(0)" ::: "memory")
__device__ __forceinline__ unsigned f2bf(float f) { unsigned u = __builtin_bit_cast(unsigned, f); return (u + 0x7fffu + ((u >> 16) & 1u)) >> 16; }
__device__ __forceinline__ unsigned pk2(float lo, float hi) { return f2bf(lo) | (f2bf(hi) << 16); }
__device__ __forceinline__ float bf2f(unsigned short b) { return __builtin_bit_cast(float, (unsigned)b << 16); }
__device__ __forceinline__ f32x2 cmul(f32x2 a, f32x2 b) { return (f32x2){a.x * b.x - a.y * b.y, a.x * b.y + a.y * b.x}; }
__device__ __forceinline__ f32x2 cconj(f32x2 a) { return (f32x2){a.x, -a.y}; }
__device__ __forceinline__ float lane_read(float v, int src_lane) { return __builtin_bit_cast(float, __builtin_amdgcn_ds_bpermute(src_lane << 2, __builtin_bit_cast(int, v))); }
__device__ __forceinline__ float wave_sum(float v, int lane) {
#pragma unroll
    for (int o = 1; o < 64; o <<= 1) v += lane_read(v, lane ^ o);
    return v;
}
__device__ __forceinline__ float gelu_tanh(float x) {
    const float t = x * (1.0f + 0.044715f * x * x) * (-2.302208198f);
    const float e = __builtin_amdgcn_exp2f(t);
    return x * __builtin_amdgcn_rcpf(1.0f + e);
}
#define XB_LAS_DEFINED
#define XB_TMO      128
#define XB_XCNT(j)  (256  + 64 * (j))
#define XB_XSUB(j)  (1280 + 64 * (j))
#define XB_XGEN(j)  (2304 + 64 * (j))
#define XB_TOP      3328
#define XB_TOPGEN   3392
#define XCD_BAR_WORDS 3456
#define XB_SPIN_CAP (1u << 18)

__device__ __forceinline__ unsigned xb_ld(unsigned* p)              { return __hip_atomic_load(p, __ATOMIC_RELAXED, __HIP_MEMORY_SCOPE_AGENT); }
__device__ __forceinline__ unsigned xb_add(unsigned* p, unsigned v) { return __hip_atomic_fetch_add(p, v, __ATOMIC_RELAXED, __HIP_MEMORY_SCOPE_AGENT); }
__device__ __forceinline__ unsigned xb_xcc_id() { return (unsigned)__builtin_amdgcn_s_getreg((3 << 11) | 20) & 0xFu; }
#define XB_SPIN(cond, bar) do { unsigned _sp = 0; while (cond) { __builtin_amdgcn_s_sleep(1); \
    if ((++_sp & 255u) == 0u) { if (xb_ld(&(bar)[XB_TMO])) break; if (_sp > XB_SPIN_CAP) { atomicAdd(&(bar)[XB_TMO], 1u); break; } } } } while (0)

struct XcdBarrier {
    unsigned* bar; unsigned x;
    volatile LAS unsigned* st;
};

__device__ __forceinline__ XcdBarrier xcd_barrier_post(unsigned* bar, volatile LAS unsigned* st) {
    XcdBarrier b; b.bar = bar; b.x = xb_xcc_id(); b.st = st;
    if (threadIdx.x == 0) (void)xb_add(&bar[XB_XCNT(b.x)], 1u);
    return b;
}
__device__ __forceinline__ void xcd_barrier_complete(unsigned* bar, unsigned x, unsigned& nloc, unsigned& nx) {
    const unsigned G = gridDim.x * gridDim.y * gridDim.z;
    unsigned sum, cnt, mine, sp = 0u;
    for (;;) {
        sum = 0u; cnt = 0u; mine = 0u;
#pragma unroll
        for (unsigned j = 0; j < 16; ++j) { const unsigned c = xb_ld(&bar[XB_XCNT(j)]); sum += c; cnt += (c > 0u) ? 1u : 0u; mine = (j == x) ? c : mine; }
        if (sum == G) break;
        __builtin_amdgcn_s_sleep(1);
        if ((++sp & 255u) == 0u) { if (xb_ld(&bar[XB_TMO])) break; if (sp > XB_SPIN_CAP) { atomicAdd(&bar[XB_TMO], 1u); break; } }
    }
    nloc = mine > 0u ? mine : 1u; nx = cnt > 0u ? cnt : 1u;
}

__device__ __forceinline__ void xcd_barrier(const XcdBarrier& b) {
    asm volatile("s_waitcnt vmcnt(0)" ::: "memory");
    __syncthreads();
    if (threadIdx.x == 0) {
        unsigned* bar = b.bar;
        __builtin_amdgcn_s_waitcnt(0);
        unsigned nloc = b.st[0], nx = b.st[1];
        if (nloc == 0u) { xcd_barrier_complete(bar, b.x, nloc, nx); b.st[0] = nloc; b.st[1] = nx; }
        const unsigned old = xb_add(&bar[XB_XSUB(b.x)], 1u);
        const unsigned gen = old / nloc;
        if (old + 1u == (gen + 1u) * nloc) {
            __builtin_amdgcn_fence(__ATOMIC_RELEASE, "agent");
            asm volatile("s_waitcnt vmcnt(0)" ::: "memory");
            const unsigned og = xb_add(&bar[XB_TOP], 1u);
            const unsigned tg = og / nx;
            if (og + 1u == (tg + 1u) * nx) xb_add(&bar[XB_TOPGEN], 1u);
            else XB_SPIN(xb_ld(&bar[XB_TOPGEN]) == tg, bar);
            __builtin_amdgcn_fence(__ATOMIC_ACQUIRE, "agent");
            xb_add(&bar[XB_XGEN(b.x)], 1u);
            asm volatile("s_waitcnt vmcnt(0)" ::: "memory");
        } else {
            XB_SPIN(xb_ld(&bar[XB_XGEN(b.x)]) == gen, bar);
            __builtin_amdgcn_fence(__ATOMIC_ACQUIRE, "agent");
            asm volatile("s_waitcnt vmcnt(0)" ::: "memory");
        }
    }
    __syncthreads();
}


struct Args { const float* in[26]; float* out; unsigned char* ws; };
struct Frame {
    LAS unsigned char* lds;
    int tid, lane, wave;
    int vcu, G;
    unsigned char* ws;
    float* out;
};
typedef const float* cfptr_t;
__device__ __forceinline__ const float* in_ptr(int k) { asm volatile("" : "+s"(k));
    const __attribute__((address_space(4))) cfptr_t* kp = (const __attribute__((address_space(4))) cfptr_t*)__builtin_amdgcn_kernarg_segment_ptr(); return kp[k]; }
enum { I_x, I_c, I_ctx, I_c_ctx, I_ada_w, I_ada_b, I_norm1_g, I_norm2_g, I_w_in, I_na_rpb, I_hy_conv_w, I_hy_conv_b, I_hy_w1, I_hy_b1, I_hy_w2, I_hy_b2, I_hy_w3, I_hy_freq, I_hy_bias,
       I_mix_norm_g, I_w_out, I_ffn_w_up, I_ffn_conv_w, I_ffn_conv_b, I_ffn_w_down, I_final_norm_g };
#define IN(name) in_ptr(I_##name)
#define WSP(T, off) ((T*)(F.ws + (off)))

__device__ __forceinline__ void pa_adaln(Frame& F) {
    LAS float* sv = (LAS float*)F.lds;
    LAS float* red = (LAS float*)(F.lds + 3 * DM * 4);
    const float* p_c = IN(c); const float* p_cc = IN(c_ctx); const float* p_aw = IN(ada_w); const float* p_ab = IN(ada_b);
    for (int i = F.tid; i < 3 * DM; i += NTHR) { const int s = i / DM, k = i % DM; const float v = s < 2 ? p_c[s * DM + k] : p_cc[k]; sv[i] = v / (1.0f + __expf(-v)); }
    __syncthreads();
    float* MOD = WSP(float, WS_MOD);
    const int cg = F.tid & 63, ks = F.tid >> 6;
    for (int item = F.vcu; item < DEPTH * 48; item += F.G) {
        const int l = item / 48, j0 = (item % 48) * 256;
        const float* wp = p_aw + ((size_t)l * DM + ks * 256) * (NMOD * DM) + j0 + 4 * cg;
        f32x4 a0 = {0.f, 0.f, 0.f, 0.f}, a1 = a0, a2 = a0;
#pragma unroll 8
        for (int kk = 0; kk < 256; ++kk) {
            const f32x4 w = *(const f32x4*)(wp + (size_t)kk * (NMOD * DM));
            const float s0 = sv[ks * 256 + kk], s1 = sv[DM + ks * 256 + kk], s2 = sv[2 * DM + ks * 256 + kk];
            a0 += w * s0; a1 += w * s1; a2 += w * s2;
        }
        *(LAS f32x4*)(red + (ks * 3 + 0) * 256 + 4 * cg) = a0; *(LAS f32x4*)(red + (ks * 3 + 1) * 256 + 4 * cg) = a1; *(LAS f32x4*)(red + (ks * 3 + 2) * 256 + 4 * cg) = a2;
        __syncthreads();
        if (F.tid < 192) {
            const int s = F.tid >> 6, cc = F.tid & 63;
            f32x4 t = *(const f32x4*)(p_ab + (size_t)l * (NMOD * DM) + j0 + 4 * cc);
#pragma unroll
            for (int q = 0; q < 8; ++q) t += *(LAS f32x4*)(red + (q * 3 + s) * 256 + 4 * cc);
            *(f32x4*)(MOD + ((size_t)l * 3 + s) * (NMOD * DM) + j0 + 4 * cc) = t;
        }
        __syncthreads();
    }
}
__device__ __forceinline__ void transpose_item(const float* W, int K, int N, bf16* WT, int k0, int n0, int drow0, LAS float* scr, int lane) {
#pragma unroll 8
    for (int i = 0; i < 32; ++i) { const int kk = 2 * i + (lane >> 5); scr[kk * 33 + (lane & 31)] = W[(size_t)(k0 + kk) * N + n0 + (lane & 31)]; }
    LDS_WAIT(); asm volatile("" ::: "memory");
    const int c = lane & 7;
#pragma unroll
    for (int j = 0; j < 4; ++j) { const int n = (lane >> 3) + 8 * j; const LAS float* s = scr + (8 * c) * 33 + n;
        v4u o; o.x = pk2(s[0 * 33], s[1 * 33]); o.y = pk2(s[2 * 33], s[3 * 33]); o.z = pk2(s[4 * 33], s[5 * 33]); o.w = pk2(s[6 * 33], s[7 * 33]);
        *(v4u*)(WT + (size_t)(drow0 + n) * K + k0 + 8 * c) = o; }
    LDS_WAIT(); asm volatile("" ::: "memory");
}
__device__ __forceinline__ void pa_weights(Frame& F) {
    const float* p_win = IN(w_in); const float* p_wout = IN(w_out); const float* p_wup = IN(ffn_w_up); const float* p_wdn = IN(ffn_w_down);
    {
        LAS float* wt = (LAS float*)F.lds;
        LAS float* tab = (LAS float*)(F.lds + 64 * 129 * 4);
        if (F.tid < 128) tab[F.tid] = cospif((float)F.tid * (1.0f / 64.0f));
        for (int item = F.vcu; item < DEPTH * 4 * 32; item += F.G) {
            const int l = item >> 7, g = (item >> 5) & 3, k0 = (item & 31) * 64;
            __syncthreads();
            for (int i = F.tid; i < 64 * 128; i += NTHR) { const int kk = i >> 7, cc = i & 127; wt[kk * 129 + cc] = p_win[((size_t)l * DM + k0 + kk) * DIN + 3072 + g * 128 + cc]; }
            __syncthreads();
            const int kk = F.tid & 63;
            bf16* dst = WSP(bf16, WS_WIN) + ((size_t)l * DIN + 3072 + g * 128) * DM + k0 + kk;
            for (int i = 0; i < 16; ++i) {
                const int mp = (F.tid >> 6) + 8 * i;
                const int mm = mp <= 64 ? mp : mp - 64, sh = mp <= 64 ? 0 : 96;
                float a = 0.f;
                const int add = mp <= 64 ? 0 : 32; (void)sh;
#pragma unroll 8
                for (int cc = 0; cc < 128; ++cc) a += wt[kk * 129 + cc] * tab[(mm * cc + add) & 127];
                dst[(size_t)mp * DM] = (bf16)f2bf(a);
            }
        }
        __syncthreads();
    }
    LAS float* scr = (LAS float*)(F.lds + F.wave * 16384);
    const int gw = F.vcu * NWAVES + F.wave, NGW = F.G * NWAVES;
    constexpr int I_IN = 32 * 144, I_OUT = 32 * 64, I_UP = 32 * 352, I_DN = 88 * 64, I_L = I_IN + I_OUT + I_UP + I_DN;
    for (int it = gw; it < DEPTH * I_L; it += NGW) {
        const int l = it / I_L; int r = it % I_L;
        if (r < I_IN) { const int kb = r / 144; int nb = r % 144; if (nb >= 96) nb += 16;
            transpose_item(p_win + (size_t)l * DM * DIN, DM, DIN, WSP(bf16, WS_WIN) + (size_t)l * DIN * DM, kb * 64, nb * 32, nb * 32, scr, F.lane); continue; }
        r -= I_IN;
        if (r < I_OUT) { const int kb = r / 64, nb = r % 64;
            transpose_item(p_wout + (size_t)l * DM * DM, DM, DM, WSP(bf16, WS_WOUT) + (size_t)l * DM * DM, kb * 64, nb * 32, nb * 32, scr, F.lane); continue; }
        r -= I_OUT;
        if (r < I_UP) { const int kb = r / 352, nb = r % 352; const int n0 = nb * 32;
            const int drow = n0 < DFF ? (n0 >> 7) * 256 + (n0 & 127) : ((n0 - DFF) >> 7) * 256 + 128 + ((n0 - DFF) & 127);
            transpose_item(p_wup + (size_t)l * DM * 2 * DFF, DM, 2 * DFF, WSP(bf16, WS_WUP) + (size_t)l * 2 * DFF * DM, kb * 64, n0, drow, scr, F.lane); continue; }
        r -= I_UP;
        { const int kb = r / 64, nb = r % 64;
            transpose_item(p_wdn + (size_t)l * DFF * DM, DFF, DM, WSP(bf16, WS_WDN) + (size_t)l * DM * DFF, kb * 64, nb * 32, nb * 32, scr, F.lane); }
    }
}

__device__ __forceinline__ void norm_phase(Frame& F, int l, int which, bool with_ctx) {
    const float* gain = (which ? IN(norm2_g) : IN(norm1_g)) + (size_t)l * DM;
    const float* MOD = WSP(float, WS_MOD) + (size_t)l * 3 * (NMOD * DM);
    const bool first = (l == 0 && which == 0);
    const float* xl = first ? IN(x) : F.out; const float* xc = first ? IN(ctx) : WSP(float, WS_XC);
    bf16* H = WSP(bf16, WS_H);
    const int gw = F.vcu * NWAVES + F.wave, NGW = F.G * NWAVES, nrows = with_ctx ? MT : ML;
    for (int row = gw; row < nrows; row += NGW) {
        const int s = row < SEQ ? 0 : row < ML ? 1 : 2;
        const float* xr = row < ML ? xl + (size_t)row * DM : xc + (size_t)(row - ML) * DM;
        const float* shp = MOD + (size_t)s * (NMOD * DM) + (which ? 3 : 0) * DM; const float* scp = shp + DM;
        f32x4 v[8]; float ss = 0.f;
#pragma unroll
        for (int j = 0; j < 8; ++j) { v[j] = *(const f32x4*)(xr + 4 * (F.lane + 64 * j)); ss += (v[j].x * v[j].x + v[j].y * v[j].y) + (v[j].z * v[j].z + v[j].w * v[j].w); }
        const float rstd = 1.0f / sqrtf(wave_sum(ss, F.lane) * (1.0f / DM) + EPS);
        bf16* hr = H + (size_t)row * DM;
#pragma unroll
        for (int j = 0; j < 8; ++j) { const int k = 4 * (F.lane + 64 * j);
            const f32x4 g = *(const f32x4*)(gain + k), sc = *(const f32x4*)(scp + k), sh = *(const f32x4*)(shp + k);
            const f32x4 y = (v[j] * rstd * g) * (1.0f + sc) + sh;
            v2u o; o.x = pk2(y.x, y.y); o.y = pk2(y.z, y.w); *(v2u*)(hr + k) = o; }
    }
}
__device__ __forceinline__ void final_norm_phase(Frame& F) {
    const float* p_g = IN(final_norm_g);
    const int gw = F.vcu * NWAVES + F.wave, NGW = F.G * NWAVES;
    for (int row = gw; row < ML; row += NGW) {
        float* xr = F.out + (size_t)row * DM;
        f32x4 v[8]; float ss = 0.f;
#pragma unroll
        for (int j = 0; j < 8; ++j) { v[j] = *(const f32x4*)(xr + 4 * (F.lane + 64 * j)); ss += (v[j].x * v[j].x + v[j].y * v[j].y) + (v[j].z * v[j].z + v[j].w * v[j].w); }
        const float rstd = 1.0f / sqrtf(wave_sum(ss, F.lane) * (1.0f / DM) + EPS);
#pragma unroll
        for (int j = 0; j < 8; ++j) { const int k = 4 * (F.lane + 64 * j); *(f32x4*)(xr + k) = v[j] * rstd * *(const f32x4*)(p_g + k); }
    }
}

__device__ __forceinline__ void filter_phase(Frame& F, int l, bool with_ctx) {
    LAS float* h1 = (LAS float*)F.lds;
    LAS float* h2 = (LAS float*)(F.lds + 64 * 65 * 4);
    const float* w1 = IN(hy_w1) + (size_t)l * 33 * 64; const float* b1 = IN(hy_b1) + (size_t)l * 64;
    const float* w2 = IN(hy_w2) + (size_t)l * 64 * 64; const float* b2 = IN(hy_b2) + (size_t)l * 64;
    const float* w3 = IN(hy_w3) + (size_t)l * 64 * 2048; const float* fq = IN(hy_freq) + (size_t)l * 64;
    const int nitems = with_ctx ? 260 : 256;
    for (int item = F.vcu; item < nitems; item += F.G) {
        const bool isc = item >= 256; const int Lq = isc ? CTXL : SEQ; const int n0 = (isc ? item - 256 : item) * 64;
        const int p = F.tid & 63, jg = F.wave;
        const float pos = (float)(n0 + p), t = pos / (float)(Lq - 1);
        __syncthreads();
        {
            float zf[33]; zf[0] = t;
#pragma unroll
            for (int i = 0; i < 16; ++i) { const float band = 1e-4f + (float)i * ((15.0f - 1e-4f) / 15.0f); const float ang = band * (6.283185307179586f / (float)Lq) * pos; zf[1 + i] = cosf(ang); zf[17 + i] = -sinf(ang); }
#pragma unroll 1
            for (int jj = 0; jj < 8; ++jj) { const int j = jg * 8 + jj; float a = b1[j];
#pragma unroll
                for (int i = 0; i < 33; ++i) a += zf[i] * w1[i * 64 + j];
                h1[p * 65 + j] = sinf(fq[j] * a); }
        }
        __syncthreads();
#pragma unroll 1
        for (int jj = 0; jj < 8; ++jj) { const int j = jg * 8 + jj; float a = b2[j];
#pragma unroll 8
            for (int i = 0; i < 64; ++i) a += h1[p * 65 + i] * w2[i * 64 + j];
            h2[p * 65 + j] = sinf(fq[j] * a); }
        __syncthreads();
        float* dst = isc ? WSP(float, WS_HFC) : WSP(float, WS_HF);
        LAS float* w3s = (LAS float*)(F.lds + 2 * 64 * 65 * 4);
        for (int ck = 0; ck < 8; ++ck) {
            __syncthreads();
#pragma unroll 4
            for (int i = F.tid; i < 64 * 64; i += NTHR) { const int jr = i >> 6, c4 = (i & 63) * 4; *(LAS f32x4*)(w3s + jr * 256 + c4) = *(const f32x4*)(w3 + (size_t)jr * 2048 + ck * 256 + c4); }
            __syncthreads();
            f32x4 a[8];
#pragma unroll
            for (int q = 0; q < 8; ++q) a[q] = (f32x4){0.f, 0.f, 0.f, 0.f};
#pragma unroll 2
            for (int i = 0; i < 64; ++i) { const float hvi = h2[p * 65 + i]; const LAS f32x4* wr = (const LAS f32x4*)(w3s + i * 256 + jg * 32);
#pragma unroll
                for (int q = 0; q < 8; ++q) a[q] += wr[q] * hvi; }
#pragma unroll
            for (int q = 0; q < 8; ++q)
#pragma unroll
                for (int e = 0; e < 4; ++e) { const int col = ck * 256 + jg * 32 + q * 4 + e, ch = col & 511;
                    const float delta = fabsf(HY_MIN_DECAY + (HY_MAX_DECAY - HY_MIN_DECAY) * ((float)ch / 511.0f));
                    const float val = a[q][e] * __expf(-t * delta); const int n = n0 + p;
                    if (col & 512) dst[(size_t)col * Lq + ((Lq - n) & (Lq - 1))] = n == 0 ? 0.f : val;
                    else dst[(size_t)col * Lq + n] = val; }
        }
    }
}

struct EpiIn {
    static constexpr bool PERM = true, AFTER_DRAIN = false;
    bf16* QK; bf16* VT; float* T32;
    __device__ __forceinline__ void operator()(pg8::f32x4 (&acc)[2][2][4][2], const pg8::Unit& u, int wr_, int wc_, int fr_, int fq_) const {
        int t_ = threadIdx.x; asm volatile("" : "+v"(t_));
        const int fr = t_ & 15, fq = (t_ >> 4) & 3, wc = (t_ >> 6) & 3, wr = t_ >> 8; (void)wr_; (void)wc_; (void)fr_; (void)fq_;
        const int row0 = u.pm * 256 + wr * 64 + fr, col0 = u.pn * 256 + wc * 32 + 8 * fq;
        if (u.type == 0) {
            const float sc = u.pn < 4 ? QSCALE : 1.0f;
#pragma unroll
            for (int ai = 0; ai < 2; ++ai)
#pragma unroll
                for (int m = 0; m < 4; ++m) { bf16* rowp = QK + (size_t)(row0 + ai * 128 + m * 16) * 2048 + col0;
#pragma unroll
                    for (int bj = 0; bj < 2; ++bj) { const pg8::f32x4 v0 = acc[ai][bj][m][0] * sc, v1 = acc[ai][bj][m][1] * sc;
                        v4u w; w.x = pg8::cvt_pk_bf16(v0[0], v0[1]); w.y = pg8::cvt_pk_bf16(v0[2], v0[3]); w.z = pg8::cvt_pk_bf16(v1[0], v1[1]); w.w = pg8::cvt_pk_bf16(v1[2], v1[3]);
                        *(v4u*)(rowp + bj * 128) = w; } }
        } else if (u.pm < 4) {
#pragma unroll
            for (int ai = 0; ai < 2; ++ai)
#pragma unroll
                for (int m = 0; m < 4; ++m) { bf16* rowp = VT + (size_t)(row0 + ai * 128 + m * 16) * MT + col0;
#pragma unroll
                    for (int bj = 0; bj < 2; ++bj) { const pg8::f32x4 v0 = acc[ai][bj][m][0], v1 = acc[ai][bj][m][1];
                        v4u w; w.x = pg8::cvt_pk_bf16(v0[0], v0[1]); w.y = pg8::cvt_pk_bf16(v0[2], v0[3]); w.z = pg8::cvt_pk_bf16(v1[0], v1[1]); w.w = pg8::cvt_pk_bf16(v1[2], v1[3]);
                        *(v4u*)(rowp + bj * 128) = w; } }
        } else {
#pragma unroll
            for (int ai = 0; ai < 2; ++ai)
#pragma unroll
                for (int m = 0; m < 4; ++m) { float* rowp = T32 + (size_t)(row0 - 1024 + ai * 128 + m * 16) * MT + col0;
#pragma unroll
                    for (int bj = 0; bj < 2; ++bj) { *(pg8::f32x4*)(rowp + bj * 128) = acc[ai][bj][m][0]; *(pg8::f32x4*)(rowp + bj * 128 + 4) = acc[ai][bj][m][1]; } }
        }
    }
};
struct EpiRes {
    static constexpr bool PERM = false, AFTER_DRAIN = false;
    const float* base_l; const float* base_c; float* out_l; float* out_c; const float* gate;
    __device__ __forceinline__ void operator()(pg8::f32x4 (&acc)[2][2][4][2], const pg8::Unit& u, int wr_, int wc_, int fr_, int fq_) const {
        int t_ = threadIdx.x; asm volatile("" : "+v"(t_));
        const int fr = t_ & 15, fq = (t_ >> 4) & 3, wc = (t_ >> 6) & 3, wr = t_ >> 8; (void)wr_; (void)wc_; (void)fr_; (void)fq_;
        const int row0 = u.pm * 256 + wr * 64 + fr, col0 = u.pn * 256 + wc * 32 + 4 * fq;
        const int s = u.pm < PML / 2 ? 0 : u.pm < PML ? 1 : 2;
        const float* bs = u.pm < PML ? base_l + (size_t)row0 * DM : base_c + (size_t)(row0 - ML) * DM;
        float* os = u.pm < PML ? out_l + (size_t)row0 * DM : out_c + (size_t)(row0 - ML) * DM;
        pg8::f32x4 gv[2][2];
#pragma unroll
        for (int bj = 0; bj < 2; ++bj)
#pragma unroll
            for (int n = 0; n < 2; ++n) gv[bj][n] = *(const pg8::f32x4*)(gate + (size_t)s * (NMOD * DM) + col0 + bj * 128 + n * 16);
#pragma unroll
        for (int ai = 0; ai < 2; ++ai)
#pragma unroll
            for (int m = 0; m < 4; ++m) { const size_t off = (size_t)(ai * 128 + m * 16) * DM + col0;
#pragma unroll
                for (int bj = 0; bj < 2; ++bj)
#pragma unroll
                    for (int n = 0; n < 2; ++n) { const pg8::f32x4 b = *(const pg8::f32x4*)(bs + off + bj * 128 + n * 16);
                        *(pg8::f32x4*)(os + off + bj * 128 + n * 16) = b + gv[bj][n] * acc[ai][bj][m][n]; }
                asm volatile("" ::: "memory"); }
    }
};
struct EpiUp {
    static constexpr bool PERM = true, AFTER_DRAIN = false;
    bf16* HID; float* EG; float* EP; float* EU; const float* cw; const float* cb;
    __device__ __forceinline__ void operator()(pg8::f32x4 (&acc)[2][2][4][2], const pg8::Unit& u, int wr_, int wc_, int fr_, int fq_) const {
        int t_ = threadIdx.x; asm volatile("" : "+v"(t_));
        const int fr = t_ & 15, fq = (t_ >> 4) & 3, wc = (t_ >> 6) & 3, wr = t_ >> 8; (void)wr_; (void)wc_; (void)fr_; (void)fq_;
        const int lane = t_ & 63;
        const unsigned hc0 = (unsigned)(u.pn * 128 + wc * 32 + 8 * fq);
        const int src_prev = (lane & 48) | ((fr + 15) & 15), src_next = (lane & 48) | ((fr + 1) & 15);
        const bool e0 = fr == 0, e3 = fr == 15;
        __builtin_amdgcn_sched_barrier(0);
#pragma unroll
        for (int ai = 0; ai < 2; ++ai) {
            const int rbase = u.pm * 256 + ai * 128 + wr * 64;
            const unsigned eb0 = (unsigned)((rbase >> 6) << 1) * (unsigned)DFF, eb3 = eb0 + (unsigned)DFF;
#pragma unroll
            for (int n = 0; n < 2; ++n) {
                const unsigned hc = hc0 + 4u * (unsigned)n;
                const pg8::f32x4 w0 = *(const pg8::f32x4*)&cw[hc], w1 = *(const pg8::f32x4*)&cw[(unsigned)DFF + hc], w2 = *(const pg8::f32x4*)&cw[2u * (unsigned)DFF + hc], bb = *(const pg8::f32x4*)&cb[hc];
                if (e0) { *(pg8::f32x4*)&EG[eb0 + hc] = acc[ai][0][0][n]; *(pg8::f32x4*)&EU[eb0 + hc] = acc[ai][1][0][n]; }
                if (e3) { *(pg8::f32x4*)&EG[eb3 + hc] = acc[ai][0][3][n]; *(pg8::f32x4*)&EU[eb3 + hc] = acc[ai][1][3][n]; }
#pragma unroll
                for (int j = 0; j < 4; ++j) {
                    float pr[4], nx[4], gg[4];
#pragma unroll
                    for (int m = 0; m < 4; ++m) { gg[m] = acc[ai][0][m][n][j]; pr[m] = lane_read(gg[m], src_prev); nx[m] = lane_read(gg[m], src_next); }
#pragma unroll
                    for (int m = 0; m < 4; ++m) {
                        const float pv = fr > 0 ? pr[m] : (m > 0 ? pr[m > 0 ? m - 1 : 0] : 0.f);
                        const float nv = fr < 15 ? nx[m] : (m < 3 ? nx[m < 3 ? m + 1 : 3] : 0.f);
                        const float cv = w0[j] * pv + w1[j] * gg[m] + w2[j] * nv + bb[j];
                        if (m == 0) { if (e0) EP[eb0 + hc + (unsigned)j] = cv; } if (m == 3) { if (e3) EP[eb3 + hc + (unsigned)j] = cv; }
                        acc[ai][0][m][n][j] = gelu_tanh(cv) * acc[ai][1][m][n][j];
                    }
                }
                asm volatile("" ::: "memory"); __builtin_amdgcn_sched_barrier(0);
            }
#pragma unroll
            for (int m = 0; m < 4; ++m) {
                if (!((m == 0 && e0) || (m == 3 && e3))) {
                    const pg8::f32x4 v0 = acc[ai][0][m][0], v1 = acc[ai][0][m][1];
                    v4u w; w.x = pg8::cvt_pk_bf16(v0[0], v0[1]); w.y = pg8::cvt_pk_bf16(v0[2], v0[3]); w.z = pg8::cvt_pk_bf16(v1[0], v1[1]); w.w = pg8::cvt_pk_bf16(v1[2], v1[3]);
                    *(v4u*)&HID[(unsigned)(rbase + m * 16 + fr) * (unsigned)DFF + hc0] = w;
                }
            }
        }
    }
};
__device__ __forceinline__ void edge_fix_phase(Frame& F, int l, bool with_ctx) {
    const float* EG = WSP(float, WS_EDGE); const float* EP = EG + EDGE_ELEMS; const float* EU = EP + EDGE_ELEMS;
    const float* cw = IN(ffn_conv_w) + (size_t)l * 3 * DFF;
    bf16* HID = WSP(bf16, WS_HID);
    const int ne = with_ctx ? NEDGE : ML / 64 * 2, total = ne * (DFF / 4);
    for (int i = F.vcu * NTHR + F.tid; i < total; i += F.G * NTHR) {
        const int e = i / (DFF / 4), c = (i % (DFF / 4)) * 4;
        const int r = (e >> 1) * 64 + (e & 1) * 63;
        f32x4 p = *(const f32x4*)(EP + (size_t)e * DFF + c);
        if (e & 1) { const int nr = r + 1; if (nr != SEQ && nr != ML && nr != ML + CTXL && nr != MT) p += *(const f32x4*)(cw + 2 * DFF + c) * *(const f32x4*)(EG + (size_t)(e + 1) * DFF + c); }
        else { if (r != 0 && r != SEQ && r != ML && r != ML + CTXL) p += *(const f32x4*)(cw + c) * *(const f32x4*)(EG + (size_t)(e - 1) * DFF + c); }
        const f32x4 up = *(const f32x4*)(EU + (size_t)e * DFF + c);
        v2u o; o.x = pk2(gelu_tanh(p.x) * up.x, gelu_tanh(p.y) * up.y); o.y = pk2(gelu_tanh(p.z) * up.z, gelu_tanh(p.w) * up.w);
        *(v2u*)(HID + (size_t)r * DFF + c) = o;
    }
}

#define MFMA16(a, b, c) __builtin_amdgcn_mfma_f32_16x16x32_bf16((a), (b), (c), 0, 0, 0)
__device__ __forceinline__ void attn_chunk(const bf16* kbase  , const bf16* vbase  ,
                                           const bf16x8 (&qf)[4], f32x4 (&o)[8], float& mrun, float& lsum, int lane, int q, int g,
                                           bool masked, int keycol0, int cs, const LAS float* brow  , int cq) {
    bf16x8 kf[2][4], vf[8];
#pragma unroll
    for (int T = 0; T < 2; ++T) { const int kk = 8 * (q >> 2) + 4 * T + (q & 3);
#pragma unroll
        for (int dc = 0; dc < 4; ++dc) kf[T][dc] = *(const bf16x8*)(kbase + (size_t)kk * 2048 + 32 * dc + 8 * g); }
#pragma unroll
    for (int dt = 0; dt < 8; ++dt) vf[dt] = *(const bf16x8*)(vbase + (size_t)(16 * dt + q) * MT + 8 * g);
    f32x4 s[2];
#pragma unroll
    for (int T = 0; T < 2; ++T) { s[T] = (f32x4){0.f, 0.f, 0.f, 0.f};
#pragma unroll
        for (int dc = 0; dc < 4; ++dc) s[T] = MFMA16(kf[T][dc], qf[dc], s[T]); }
    if (masked) {
#pragma unroll
        for (int T = 0; T < 2; ++T)
#pragma unroll
            for (int i = 0; i < 4; ++i) { const int keycol = keycol0 + 8 * g + 4 * T + i; const bool ok = keycol >= cs && keycol < cs + 16;
                const int dcol = keycol - cq + 15; const float bv = brow[ok ? dcol : 0];
                s[T][i] = ok ? s[T][i] + bv : -1e30f; }
    }
    float cm = fmaxf(fmaxf(fmaxf(s[0][0], s[0][1]), fmaxf(s[0][2], s[0][3])), fmaxf(fmaxf(s[1][0], s[1][1]), fmaxf(s[1][2], s[1][3])));
    cm = fmaxf(cm, lane_read(cm, lane ^ 16)); cm = fmaxf(cm, lane_read(cm, lane ^ 32));
    const float mnew = fmaxf(mrun, cm), alpha = __builtin_amdgcn_exp2f(mrun - mnew);
    mrun = mnew;
    float p[8]; float ps = 0.f;
#pragma unroll
    for (int T = 0; T < 2; ++T)
#pragma unroll
        for (int i = 0; i < 4; ++i) { p[4 * T + i] = __builtin_amdgcn_exp2f(s[T][i] - mnew); ps += p[4 * T + i]; }
    lsum = lsum * alpha + ps;
    v4u pw; pw.x = pg8::cvt_pk_bf16(p[0], p[1]); pw.y = pg8::cvt_pk_bf16(p[2], p[3]); pw.z = pg8::cvt_pk_bf16(p[4], p[5]); pw.w = pg8::cvt_pk_bf16(p[6], p[7]);
    const bf16x8 pf = __builtin_bit_cast(bf16x8, pw);
#pragma unroll
    for (int dt = 0; dt < 8; ++dt) { o[dt] = o[dt] * alpha; o[dt] = MFMA16(vf[dt], pf, o[dt]); }
}
__device__ __forceinline__ void attn_tile(Frame& F, bool is_lat, int b, int h, int r, int c0, int qrow0, const LAS float* bias_h) {
    const bf16* QK = WSP(bf16, WS_QK); const bf16* VT = WSP(bf16, WS_VT); bf16* A = WSP(bf16, WS_A);
    const int q = F.lane & 15, g = F.lane >> 4;
    bf16x8 qf[4];
    { const bf16* qp = QK + (size_t)(qrow0 + q) * 2048 + h * 128 + 8 * g;
#pragma unroll
      for (int dc = 0; dc < 4; ++dc) qf[dc] = *(const bf16x8*)(qp + 32 * dc); }
    f32x4 o[8];
#pragma unroll
    for (int dt = 0; dt < 8; ++dt) o[dt] = (f32x4){0.f, 0.f, 0.f, 0.f};
    float mrun = -1e30f, lsum = 0.f;
    if (is_lat) {
        const int r0 = min(max(r - 4, 0), GROWS - 8), kc0 = min(max(c0 - 8, 0), 32), cq = c0 + q, cs = min(max(cq - 8, 0), 48);
        for (int ir = 0; ir < 8; ++ir) {
            const int keyrow = r0 + ir, tok = b * SEQ + keyrow * GRIDW + kc0, drow = keyrow - r + 7;
            attn_chunk(QK + (size_t)tok * 2048 + 1024 + h * 128, VT + (size_t)(h * 128) * MT + tok, qf, o, mrun, lsum, F.lane, q, g, true, kc0, cs, bias_h + drow * 31, cq);
        }
    }
    for (int cc = 0; cc < 8; ++cc) {
        const int tok = ML + b * CTXL + 32 * cc;
        attn_chunk(QK + (size_t)tok * 2048 + 1024 + h * 128, VT + (size_t)(h * 128) * MT + tok, qf, o, mrun, lsum, F.lane, q, g, false, 0, 0, bias_h, 0);
    }
    lsum += lane_read(lsum, F.lane ^ 16); lsum += lane_read(lsum, F.lane ^ 32);
    const float inv = 1.0f / lsum;
    bf16* ap = A + (size_t)(qrow0 + q) * 1024 + h * 128 + 4 * g;
#pragma unroll
    for (int dt = 0; dt < 8; ++dt) { v2u w; w.x = pg8::cvt_pk_bf16(o[dt][0] * inv, o[dt][1] * inv); w.y = pg8::cvt_pk_bf16(o[dt][2] * inv, o[dt][3] * inv); *(v2u*)(ap + 16 * dt) = w; }
}
__device__ __forceinline__ void attn_phase(Frame& F, int l, bool with_ctx) {
    LAS float* bias = (LAS float*)(F.lds + XTRA_OFF);
    const float* p_rpb = IN(na_rpb) + (size_t)l * NHEAD * 465;
    for (int i = F.tid; i < NHEAD * 465; i += NTHR) bias[i] = p_rpb[i] * LOG2E;
    __syncthreads();
    const int gw = F.vcu * NWAVES + F.wave, NGW = F.G * NWAVES;
    for (int job = gw; job < 2048; job += NGW) {
        const int combo = job >> 5, rb = job & 31, b = combo >> 5, h = (combo >> 2) & 7, c0 = 16 * (combo & 3);
        for (int rr = 0; rr < 8; ++rr) { const int r = rb * 8 + rr; attn_tile(F, true, b, h, r, c0, b * SEQ + r * GRIDW + c0, bias + h * 465); }
    }
    if (with_ctx)
        for (int job = gw; job < 256; job += NGW) { const int b = job >> 7, h = (job >> 4) & 7, t = job & 15; attn_tile(F, false, b, h, 0, 0, ML + b * CTXL + 16 * t, bias + h * 465); }
    __syncthreads();
}

constexpr int FFTN = 16384, FFT_PHYS = FFTN + FFTN / 16;
__device__ __forceinline__ int phys(int i) { return i + ((i >> 6) << 2); }
__device__ __forceinline__ f32x2 tw32k(const LAS f32x2* TH, const LAS f32x2* TL, int n) { return cmul(TH[n >> 7], TL[n & 127]); }
template <bool INV> __device__ __forceinline__ void r4(f32x2& x0, f32x2& x1, f32x2& x2, f32x2& x3) {
    const f32x2 a = x0 + x2, c = x0 - x2, b = x1 + x3, e = x1 - x3;
    const f32x2 d = INV ? (f32x2){-e.y, e.x} : (f32x2){e.y, -e.x};
    x0 = a + b; x1 = c + d; x2 = a - b; x3 = c - d;
}
template <bool INV> __device__ __forceinline__ void dft16(f32x2 (&x)[16]) {
#pragma unroll
    for (int b = 0; b < 4; ++b) r4<INV>(x[b], x[4 + b], x[8 + b], x[12 + b]);
    const float sg = INV ? -1.f : 1.f;
    const f32x2 W1 = {0.92387953251f, -0.38268343236f * sg}, W2 = {0.70710678118f, -0.70710678118f * sg}, W3 = {0.38268343236f, -0.92387953251f * sg},
                W4 = {0.f, -1.f * sg}, W6 = {-0.70710678118f, -0.70710678118f * sg}, W9 = {-0.92387953251f, 0.38268343236f * sg};
    x[5] = cmul(x[5], W1); x[9] = cmul(x[9], W2); x[13] = cmul(x[13], W3);
    x[6] = cmul(x[6], W2); x[10] = cmul(x[10], W4); x[14] = cmul(x[14], W6);
    x[7] = cmul(x[7], W3); x[11] = cmul(x[11], W6); x[15] = cmul(x[15], W9);
#pragma unroll
    for (int c = 0; c < 4; ++c) r4<INV>(x[4 * c], x[4 * c + 1], x[4 * c + 2], x[4 * c + 3]);
}
template <bool INV> __device__ __forceinline__ void bfly16(f32x2 (&x)[16], const LAS f32x2* TH, const LAS f32x2* TL, int tw) {
    f32x2 W = tw32k(TH, TL, tw); if (INV) W.y = -W.y;
    if (INV) { f32x2 p = W;
#pragma unroll
        for (int q = 1; q < 16; ++q) { x[q] = cmul(x[q], p); if (q < 15) p = cmul(p, W); } }
    dft16<INV>(x);
    if (!INV) { f32x2 p = W;
#pragma unroll
        for (int r = 1; r < 16; ++r) { x[4 * (r & 3) + (r >> 2)] = cmul(x[4 * (r & 3) + (r >> 2)], p); if (r < 15) p = cmul(p, W); } }
}
template <bool INV> __device__ __forceinline__ void pass16(LAS f32x2* X, const LAS f32x2* TH, const LAS f32x2* TL, int base, int stride, int tw) {
    f32x2 x[16];
#pragma unroll
    for (int q = 0; q < 16; ++q) x[q] = X[base + q * stride];
    bfly16<INV>(x, TH, TL, tw);
#pragma unroll
    for (int c = 0; c < 4; ++c)
#pragma unroll
        for (int d = 0; d < 4; ++d) X[base + (c + 4 * d) * stride] = x[4 * c + d];
}
template <bool INV> __device__ __forceinline__ void pass16_s4(LAS f32x2* X, const LAS f32x2* TH, const LAS f32x2* TL, int blk, int h) {
    LAS f32x4* P = (LAS f32x4*)(X + blk * 68 + 2 * h);
    f32x2 xa[16], xb[16];
#pragma unroll
    for (int q = 0; q < 16; ++q) { const f32x4 v = P[2 * q]; xa[q] = (f32x2){v.x, v.y}; xb[q] = (f32x2){v.z, v.w}; }
    bfly16<INV>(xa, TH, TL, (2 * h) * 512); bfly16<INV>(xb, TH, TL, (2 * h + 1) * 512);
#pragma unroll
    for (int c = 0; c < 4; ++c)
#pragma unroll
        for (int d = 0; d < 4; ++d) P[2 * (c + 4 * d)] = (f32x4){xa[4 * c + d].x, xa[4 * c + d].y, xb[4 * c + d].x, xb[4 * c + d].y};
}
template <bool INV> __device__ __forceinline__ void pass4_s1(LAS f32x2* X, int b) {
    LAS f32x4* P = (LAS f32x4*)(X + 4 * b + ((b >> 4) << 2));
    const f32x4 u = P[0], v = P[1];
    f32x2 x0 = {u.x, u.y}, x1 = {u.z, u.w}, x2 = {v.x, v.y}, x3 = {v.z, v.w};
    r4<INV>(x0, x1, x2, x3);
    P[0] = (f32x4){x0.x, x0.y, x1.x, x1.y}; P[1] = (f32x4){x2.x, x2.y, x3.x, x3.y};
}
__device__ __forceinline__ void fft_fwd(LAS f32x2* X, const LAS f32x2* TH, const LAS f32x2* TL, int tid) {
#pragma unroll 1
    for (int i = 0; i < 2; ++i) { const int j = tid + NTHR * i; pass16<false>(X, TH, TL, j + ((j >> 6) << 2), 1088, 2 * j); }
    __syncthreads();
#pragma unroll 1
    for (int i = 0; i < 2; ++i) { const int b = tid + NTHR * i, j = b & 63, blk = b >> 6; pass16<false>(X, TH, TL, blk * 1088 + j, 68, 32 * j); }
    __syncthreads();
    pass16_s4<false>(X, TH, TL, tid >> 1, tid & 1);
    __syncthreads();
#pragma unroll 2
    for (int i = 0; i < 8; ++i) pass4_s1<false>(X, tid + NTHR * i);
    __syncthreads();
}
__device__ __forceinline__ void fft_inv(LAS f32x2* X, const LAS f32x2* TH, const LAS f32x2* TL, int tid) {
#pragma unroll 2
    for (int i = 0; i < 8; ++i) pass4_s1<true>(X, tid + NTHR * i);
    __syncthreads();
    pass16_s4<true>(X, TH, TL, tid >> 1, tid & 1);
    __syncthreads();
#pragma unroll 1
    for (int i = 0; i < 2; ++i) { const int b = tid + NTHR * i, j = b & 63, blk = b >> 6; pass16<true>(X, TH, TL, blk * 1088 + j, 68, 32 * j); }
    __syncthreads();
#pragma unroll 1
    for (int i = 0; i < 2; ++i) { const int j = tid + NTHR * i; pass16<true>(X, TH, TL, j + ((j >> 6) << 2), 1088, 2 * j); }
    __syncthreads();
}
__device__ __forceinline__ int freq_pos(int k) { return phys(((k & 15) << 10) | (((k >> 4) & 15) << 6) | (((k >> 8) & 15) << 2) | (k >> 12)); }

__device__ __forceinline__ float conv3(const float* p, int n, int Lq, float w0, float w1, float w2, float bb) {
    float a = p[n] * w1 + bb; if (n > 0) a += p[n - 1] * w0; if (n < Lq - 1) a += p[n + 1] * w2; return a;
}
__device__ __forceinline__ f32x4 conv3v(const float* p, int n0, int Lq, float w0, float w1, float w2, float bb) {
    const f32x4 c = *(const f32x4*)(p + n0); const float l = n0 > 0 ? p[n0 - 1] : 0.f, r = n0 + 4 < Lq ? p[n0 + 4] : 0.f;
    return (f32x4){w0 * l + w1 * c.x + w2 * c.y + bb, w0 * c.x + w1 * c.y + w2 * c.z + bb, w0 * c.y + w1 * c.z + w2 * c.w + bb, w0 * c.z + w1 * c.w + w2 * r + bb};
}
__device__ __forceinline__ void tw4(const LAS f32x2* TH, const LAS f32x2* TL, int n0, f32x2 (&w)[4]) {
    const f32x2 th = TH[n0 >> 7]; const LAS f32x4* tl = (const LAS f32x4*)(TL + (n0 & 127)); const f32x4 a = tl[0], b = tl[1];
    w[0] = cmul(th, (f32x2){a.x, a.y}); w[1] = cmul(th, (f32x2){a.z, a.w}); w[2] = cmul(th, (f32x2){b.x, b.y}); w[3] = cmul(th, (f32x2){b.z, b.w});
}

#define LT() ({ int lt_ = tid; asm volatile("" : "+v"(lt_)); lt_; })
__device__ __forceinline__ void hyena_latent(Frame& F, int l, int ch, LAS f32x2* X, const LAS f32x2* TH, const LAS f32x2* TL, f32x2* KS) {
    float* T32 = WSP(float, WS_T32);
    float* hv = T32 + (size_t)(512 + ch) * MT; const float* hx1 = T32 + (size_t)(1024 + ch) * MT; const float* hx2 = T32 + (size_t)(1536 + ch) * MT;
    const float* cw = IN(hy_conv_w) + (size_t)l * 3 * 1536; const float* cb = IN(hy_conv_b) + (size_t)l * 1536;
    const float* HF = WSP(float, WS_HF); const float* p_hb = IN(hy_bias) + (size_t)l * 2 * HYW + ch;
    const int tid = F.tid;
    f32x4* KS4 = (f32x4*)KS; f32x4* KE4 = KS4 + FFTN / 2;
    for (int o = 0; o < 2; ++o) {
        const float* hf = HF + (size_t)(o * 1024 + ch) * SEQ; const float* hbr = HF + (size_t)(o * 1024 + 512 + ch) * SEQ;
        const float bias = p_hb[o * HYW];
        const float vw0 = cw[ch], vw1 = cw[1536 + ch], vw2 = cw[3072 + ch], vbb = cb[ch];
        const float* hx = o == 0 ? hx1 : hx2; const int xo = o == 0 ? 512 : 1024;
        const float xw0 = cw[xo + ch], xw1 = cw[1536 + xo + ch], xw2 = cw[3072 + xo + ch], xbb = cb[xo + ch];
        for (int par = 0; par < 2; ++par) {
#pragma unroll 4
            for (int i = 0; i < 8; ++i) { const int g = LT() + NTHR * i, n0 = 4 * g; const f32x4 f = *(const f32x4*)(hf + n0), bk = *(const f32x4*)(hbr + n0);
                LAS f32x4* XP = (LAS f32x4*)(X + phys(n0));
                if (par == 0) { XP[0] = (f32x4){f.x + bk.x, 0.f, f.y + bk.y, 0.f}; XP[1] = (f32x4){f.z + bk.z, 0.f, f.w + bk.w, 0.f}; }
                else { f32x2 w[4]; tw4(TH, TL, n0, w); const f32x4 d = f - bk;
                    XP[0] = (f32x4){w[0].x * d.x, w[0].y * d.x, w[1].x * d.y, w[1].y * d.y}; XP[1] = (f32x4){w[2].x * d.z, w[2].y * d.z, w[3].x * d.w, w[3].y * d.w}; } }
            __syncthreads();
            fft_fwd(X, TH, TL, tid);
#pragma unroll
            for (int i = 0; i < 8; ++i) { const int g = LT() + NTHR * i; const LAS f32x4* XP = (const LAS f32x4*)(X + phys(4 * g)); KS4[2 * g] = XP[0]; KS4[2 * g + 1] = XP[1]; }
            __syncthreads();
#pragma unroll 2
            for (int i = 0; i < 8; ++i) { const int g = LT() + NTHR * i, n0 = 4 * g;
                f32x4 z0, z1; if (o == 0) { z0 = conv3v(hv, n0, SEQ, vw0, vw1, vw2, vbb); z1 = conv3v(hv + SEQ, n0, SEQ, vw0, vw1, vw2, vbb); } else { z0 = *(const f32x4*)(hv + n0); z1 = *(const f32x4*)(hv + SEQ + n0); }
                LAS f32x4* XP = (LAS f32x4*)(X + phys(n0));
                if (par == 0) { XP[0] = (f32x4){z0.x, z1.x, z0.y, z1.y}; XP[1] = (f32x4){z0.z, z1.z, z0.w, z1.w}; }
                else { f32x2 w[4]; tw4(TH, TL, n0, w);
                    const f32x2 a0 = cmul((f32x2){z0.x, z1.x}, w[0]), a1 = cmul((f32x2){z0.y, z1.y}, w[1]), a2 = cmul((f32x2){z0.z, z1.z}, w[2]), a3 = cmul((f32x2){z0.w, z1.w}, w[3]);
                    XP[0] = (f32x4){a0.x, a0.y, a1.x, a1.y}; XP[1] = (f32x4){a2.x, a2.y, a3.x, a3.y}; } }
            __syncthreads();
            fft_fwd(X, TH, TL, tid);
#pragma unroll 4
            for (int i = 0; i < 8; ++i) { const int g = LT() + NTHR * i; LAS f32x4* XP = (LAS f32x4*)(X + phys(4 * g)); const f32x4 k0 = KS4[2 * g], k1 = KS4[2 * g + 1], u0 = XP[0], u1 = XP[1];
                const f32x2 a0 = cmul((f32x2){u0.x, u0.y}, (f32x2){k0.x, k0.y}), a1 = cmul((f32x2){u0.z, u0.w}, (f32x2){k0.z, k0.w}), a2 = cmul((f32x2){u1.x, u1.y}, (f32x2){k1.x, k1.y}), a3 = cmul((f32x2){u1.z, u1.w}, (f32x2){k1.z, k1.w});
                XP[0] = (f32x4){a0.x, a0.y, a1.x, a1.y}; XP[1] = (f32x4){a2.x, a2.y, a3.x, a3.y}; }
            __syncthreads();
            fft_inv(X, TH, TL, tid);
            if (par == 0) {
#pragma unroll
                for (int i = 0; i < 8; ++i) { const int g = LT() + NTHR * i; const LAS f32x4* XP = (const LAS f32x4*)(X + phys(4 * g)); KE4[2 * g] = XP[0]; KE4[2 * g + 1] = XP[1]; }
                __syncthreads();
            }
        }
#pragma unroll 2
        for (int i = 0; i < 8; ++i) { const int g = LT() + NTHR * i, n0 = 4 * g;
            f32x4 z0, z1; if (o == 0) { z0 = conv3v(hv, n0, SEQ, vw0, vw1, vw2, vbb); z1 = conv3v(hv + SEQ, n0, SEQ, vw0, vw1, vw2, vbb); } else { z0 = *(const f32x4*)(hv + n0); z1 = *(const f32x4*)(hv + SEQ + n0); }
            const f32x4 g0 = conv3v(hx, n0, SEQ, xw0, xw1, xw2, xbb), g1 = conv3v(hx + SEQ, n0, SEQ, xw0, xw1, xw2, xbb);
            const f32x4 e0 = KE4[2 * g], e1 = KE4[2 * g + 1];
            LAS f32x4* XP = (LAS f32x4*)(X + phys(n0)); const f32x4 u0 = XP[0], u1 = XP[1];
            f32x2 w[4]; tw4(TH, TL, n0, w);
            const f32x2 c0 = cmul((f32x2){u0.x, u0.y}, cconj(w[0])), c1 = cmul((f32x2){u0.z, u0.w}, cconj(w[1])), c2 = cmul((f32x2){u1.x, u1.y}, cconj(w[2])), c3 = cmul((f32x2){u1.z, u1.w}, cconj(w[3]));
            const float sc = 1.0f / 32768.0f;
            const f32x2 y0 = ((f32x2){e0.x, e0.y} + c0) * sc + (f32x2){z0.x, z1.x} * bias, y1 = ((f32x2){e0.z, e0.w} + c1) * sc + (f32x2){z0.y, z1.y} * bias,
                        y2 = ((f32x2){e1.x, e1.y} + c2) * sc + (f32x2){z0.z, z1.z} * bias, y3 = ((f32x2){e1.z, e1.w} + c3) * sc + (f32x2){z0.w, z1.w} * bias;
            XP[0] = (f32x4){g0.x * y0.x, g0.y * y1.x, g0.z * y2.x, g0.w * y3.x};
            XP[1] = (f32x4){g1.x * y0.y, g1.y * y1.y, g1.z * y2.y, g1.w * y3.y}; }
        __syncthreads();
#pragma unroll
        for (int i = 0; i < 8; ++i) { const int g = LT() + NTHR * i, n0 = 4 * g; const LAS f32x4* XP = (const LAS f32x4*)(X + phys(n0)); *(f32x4*)(hv + n0) = XP[0]; *(f32x4*)(hv + SEQ + n0) = XP[1]; }
        __syncthreads();
    }
}
__device__ __forceinline__ void fourier_latent(Frame& F, int b, int gq, int m, LAS f32x2* X, const LAS f32x2* TH, const LAS f32x2* TL) {
    float* T32 = WSP(float, WS_T32);
    float* ra = T32 + (size_t)(gq * 128 + m) * MT + b * SEQ; float* rb = T32 + (size_t)(gq * 128 + 64 + m) * MT + b * SEQ;
    const int tid = F.tid;
#pragma unroll
    for (int i = 0; i < 8; ++i) { const int g = LT() + NTHR * i, n0 = 4 * g; const f32x4 a = *(const f32x4*)(ra + n0), c = *(const f32x4*)(rb + n0);
        LAS f32x4* XP = (LAS f32x4*)(X + phys(n0)); XP[0] = (f32x4){a.x, c.x, a.y, c.y}; XP[1] = (f32x4){a.z, c.z, a.w, c.w}; }
    __syncthreads();
    fft_fwd(X, TH, TL, tid);
    const float sc = 6.9053396600248786e-4f;
#pragma unroll 2
    for (int i = 0; i < 8; ++i) { const int g = LT() + NTHR * i, k0 = 4 * g; f32x4 oa, ob;
#pragma unroll
        for (int e = 0; e < 4; ++e) { const int k = k0 + e; const f32x2 u = X[freq_pos(k)], v = X[freq_pos((FFTN - k) & (FFTN - 1))];
            if (m != 0) { oa[e] = u.x * sc; ob[e] = v.x * sc; } else { oa[e] = (u.x + v.x) * (0.5f * sc); ob[e] = (u.y + v.y) * (0.5f * sc); } }
        *(f32x4*)(ra + k0) = oa; *(f32x4*)(rb + k0) = ob; }
    __syncthreads();
}
__device__ __forceinline__ void hyena_ctx(Frame& F, int l, int ch, LAS float* S) {
    float* T32 = WSP(float, WS_T32);
    float* hv = T32 + (size_t)(512 + ch) * MT + ML; const float* hx1 = T32 + (size_t)(1024 + ch) * MT + ML; const float* hx2 = T32 + (size_t)(1536 + ch) * MT + ML;
    const float* cw = IN(hy_conv_w) + (size_t)l * 3 * 1536; const float* cb = IN(hy_conv_b) + (size_t)l * 1536;
    const float* HFC = WSP(float, WS_HFC); const float* p_hb = IN(hy_bias) + (size_t)l * 2 * HYW + ch;
    LAS float* zb = S; LAS float* hfl = S + 512; LAS float* hbl = S + 768;
    const int n = F.tid & 255, b = F.tid >> 8;
    __syncthreads();
    zb[b * 256 + n] = conv3(hv + b * CTXL, n, CTXL, cw[ch], cw[1536 + ch], cw[3072 + ch], cb[ch]);
    for (int o = 0; o < 2; ++o) {
        if (F.tid < 256) hfl[n] = HFC[(size_t)(o * 1024 + ch) * CTXL + n]; else hbl[n] = HFC[(size_t)(o * 1024 + 512 + ch) * CTXL + n];
        __syncthreads();
        float y = 0.f;
        for (int mI = 0; mI < CTXL; ++mI) { const int d = n - mI; y += zb[b * 256 + mI] * (d >= 0 ? hfl[d] : hbl[CTXL + d]); }
        y += p_hb[o * HYW] * zb[b * 256 + n];
        const float* hx = o == 0 ? hx1 : hx2; const int xo = o == 0 ? 512 : 1024;
        const float r = conv3(hx + b * CTXL, n, CTXL, cw[xo + ch], cw[1536 + xo + ch], cw[3072 + xo + ch], cb[xo + ch]) * y;
        __syncthreads();
        if (o == 0) zb[b * 256 + n] = r; else hv[b * CTXL + n] = r;
        __syncthreads();
    }
}
__device__ __forceinline__ void fourier_ctx(Frame& F, int item, LAS float* S) {
    float* T32 = WSP(float, WS_T32);
    const int b = item >> 5, gq = (item >> 3) & 3, m0 = (item & 7) * 8;
    LAS float* cs = S; LAS float* re = S + 256; LAS float* im = S + 256 + 2048;
    __syncthreads();
    if (F.tid < 256) cs[F.tid] = cospif((float)F.tid * (1.0f / 128.0f));
    for (int i = F.tid; i < 8 * 256; i += NTHR) { const int mm = i >> 8, n = i & 255;
        re[i] = T32[(size_t)(gq * 128 + m0 + mm) * MT + ML + b * CTXL + n]; im[i] = T32[(size_t)(gq * 128 + 64 + m0 + mm) * MT + ML + b * CTXL + n]; }
    __syncthreads();
    const int k = F.tid & 255, mh = F.tid >> 8;
    const float sc = 5.5242717280199031e-3f;
    for (int mq = 0; mq < 4; ++mq) { const int mm = mh * 4 + mq, m = m0 + mm;
        float cr = 0.f, ci = 0.f, sr = 0.f, si = 0.f;
        for (int n = 0; n < 256; ++n) { const int ix = (k * n) & 255; const float c = cs[ix], sn = cs[(ix - 64) & 255]; const float a = re[mm * 256 + n], bq = im[mm * 256 + n];
            cr += a * c; ci += bq * c; sr += a * sn; si += bq * sn; }
        float oa, ob;
        if (m != 0) { oa = cr + si; ob = cr - si; } else { oa = cr; ob = ci; }
        T32[(size_t)(gq * 128 + m) * MT + ML + b * CTXL + k] = oa * sc; T32[(size_t)(gq * 128 + 64 + m) * MT + ML + b * CTXL + k] = ob * sc; }
    __syncthreads();
}
__device__ __forceinline__ void fft_phase(Frame& F, int l, bool with_ctx) {
    LAS f32x2* X = (LAS f32x2*)F.lds;
    LAS f32x2* TH = (LAS f32x2*)(F.lds + XTRA_OFF + 16384); LAS f32x2* TL = TH + 128;
    if (F.tid < 256) { const int a = F.tid & 127; const float fr = F.tid < 128 ? (float)(128 * a) * (1.0f / 16384.0f) : (float)a * (1.0f / 16384.0f);
        float sn, cn; sincospif(fr, &sn, &cn); (F.tid < 128 ? TH : TL)[a] = (f32x2){cn, -sn}; }
    __syncthreads();
    for (int ch = F.vcu; ch < HYW; ch += F.G) hyena_latent(F, l, ch, X, TH, TL, WSP(f32x2, WS_KS) + (size_t)F.vcu * 2 * FFTN);
    for (int fu = F.vcu; fu < 512; fu += F.G) fourier_latent(F, fu >> 8, (fu >> 6) & 3, fu & 63, X, TH, TL);
    if (with_ctx) {
        LAS float* S = (LAS float*)F.lds;
        for (int ch = F.vcu; ch < HYW; ch += F.G) hyena_ctx(F, l, ch, S);
        for (int it = F.vcu; it < 64; it += F.G) fourier_ctx(F, it, S);
    }
}

__device__ __forceinline__ void merge_phase(Frame& F, int l, bool with_ctx) {
    const bf16* A = WSP(bf16, WS_A); const float* T32 = WSP(float, WS_T32); bf16* H = WSP(bf16, WS_H);
    const float* gain = IN(mix_norm_g) + (size_t)l * DM;
    LAS float* tile = (LAS float*)F.lds;
    const int TI = with_ctx ? 65 : 64;
    for (int it = F.vcu; it < 512; it += F.G) {
        const int tok0 = it * TI;
        for (int tk = F.wave; tk < TI; tk += NWAVES) {
            const size_t row = (size_t)(tok0 + tk);
            const v4u r0 = *(const v4u*)(A + row * 1024 + 8 * F.lane), r1 = *(const v4u*)(A + row * 1024 + 512 + 8 * F.lane);
            float v[16];
            v[0] = bf2f(r0.x & 0xffff); v[1] = bf2f(r0.x >> 16); v[2] = bf2f(r0.y & 0xffff); v[3] = bf2f(r0.y >> 16); v[4] = bf2f(r0.z & 0xffff); v[5] = bf2f(r0.z >> 16); v[6] = bf2f(r0.w & 0xffff); v[7] = bf2f(r0.w >> 16);
            v[8] = bf2f(r1.x & 0xffff); v[9] = bf2f(r1.x >> 16); v[10] = bf2f(r1.y & 0xffff); v[11] = bf2f(r1.y >> 16); v[12] = bf2f(r1.z & 0xffff); v[13] = bf2f(r1.z >> 16); v[14] = bf2f(r1.w & 0xffff); v[15] = bf2f(r1.w >> 16);
            float ss = 0.f;
#pragma unroll
            for (int j = 0; j < 16; ++j) ss += v[j] * v[j];
            const float rstd = 1.0f / sqrtf(wave_sum(ss, F.lane) * (1.0f / NAW) + EPS);
            const f32x4 g0 = *(const f32x4*)(gain + 8 * F.lane), g1 = *(const f32x4*)(gain + 8 * F.lane + 4), g2 = *(const f32x4*)(gain + 512 + 8 * F.lane), g3 = *(const f32x4*)(gain + 512 + 8 * F.lane + 4);
            v4u o0, o1;
            o0.x = pk2(v[0] * rstd * g0.x, v[1] * rstd * g0.y); o0.y = pk2(v[2] * rstd * g0.z, v[3] * rstd * g0.w); o0.z = pk2(v[4] * rstd * g1.x, v[5] * rstd * g1.y); o0.w = pk2(v[6] * rstd * g1.z, v[7] * rstd * g1.w);
            o1.x = pk2(v[8] * rstd * g2.x, v[9] * rstd * g2.y); o1.y = pk2(v[10] * rstd * g2.z, v[11] * rstd * g2.w); o1.z = pk2(v[12] * rstd * g3.x, v[13] * rstd * g3.y); o1.w = pk2(v[14] * rstd * g3.z, v[15] * rstd * g3.w);
            *(v4u*)(H + row * DM + 8 * F.lane) = o0; *(v4u*)(H + row * DM + 512 + 8 * F.lane) = o1;
        }
        for (int grp = 0; grp < 2; ++grp) {
            __syncthreads();
            for (int chn = F.wave; chn < 512; chn += NWAVES) { const float* src = T32 + (size_t)(grp * 512 + chn) * MT + tok0;
                for (int tk = F.lane; tk < TI; tk += 64) tile[chn * 65 + tk] = src[tk]; }
            __syncthreads();
            for (int tk = F.wave; tk < TI; tk += NWAVES) {
                float vv[8]; float ss = 0.f;
#pragma unroll
                for (int i = 0; i < 8; ++i) { const int chn = F.lane + 64 * i; int srow = chn;
                    if (grp == 0) { const int cc = chn & 127; srow = (chn & ~127) + (cc <= 64 ? cc : 192 - cc); }
                    vv[i] = tile[srow * 65 + tk]; ss += vv[i] * vv[i]; }
                const float rstd = 1.0f / sqrtf(wave_sum(ss, F.lane) * (1.0f / 512.0f) + EPS);
                bf16* hp = H + (size_t)(tok0 + tk) * DM + NAW + grp * 512;
#pragma unroll
                for (int i = 0; i < 8; ++i) { const int chn = F.lane + 64 * i; hp[chn] = (bf16)f2bf(vv[i] * rstd * gain[NAW + grp * 512 + chn]); }
            }
        }
    }
}

#define REFRESH(F) do { int t_ = threadIdx.x; asm volatile("" : "+v"(t_)); F.tid = t_; F.lane = t_ & 63; F.wave = __builtin_amdgcn_readfirstlane(t_ >> 6); \
    unsigned char* w_ = args.ws; asm volatile("" : "+s"(w_)); F.ws = w_; float* o_ = args.out; asm volatile("" : "+s"(o_)); F.out = o_; } while (0)
#ifndef REP_P1
#define REP_P1 1
#endif
#ifndef REP_P6
#define REP_P6 1
#endif
#ifndef REP_ATT
#define REP_ATT 1
#endif
#ifndef REP_THIN
#define REP_THIN 1
#endif
__device__ __forceinline__ int opaque_int(int v) { asm volatile("" : "+s"(v)); return v; }
__global__ void __launch_bounds__(NTHR, 2) fwd_kernel(Args args) {
    extern __shared__ __attribute__((aligned(16))) unsigned char lds[];
    Frame F;
    F.lds = (LAS unsigned char*)lds;
    F.tid = threadIdx.x; F.lane = F.tid & 63; F.wave = __builtin_amdgcn_readfirstlane(F.tid >> 6);
    F.G = gridDim.x; { const int bx = blockIdx.x; F.vcu = (F.G % 8 == 0) ? (bx % 8) * (F.G / 8) + bx / 8 : bx; }
    F.ws = args.ws; F.out = args.out;
    volatile LAS unsigned* MISC = (volatile LAS unsigned*)(F.lds + MISC_OFF);
    for (int u = F.tid; u < 64; u += NTHR) MISC[u] = 0u;
    __syncthreads();
    XcdBarrier bar = xcd_barrier_post((unsigned*)(F.ws + WS_CTL) + CW_BAR, MISC + 8);
    LAS unsigned char* ring = F.lds;
#define GRID_BAR() do { unsigned* bp_ = bar.bar; unsigned bx_ = bar.x; asm volatile("" : "+s"(bp_), "+s"(bx_)); XcdBarrier b_ = bar; b_.bar = bp_; b_.x = bx_; xcd_barrier(b_); } while (0)


#if !defined(OFF_PA)
    REFRESH(F); pa_adaln(F); __syncthreads(); pa_weights(F);
#endif

    GRID_BAR();

    for (int l = 0; l < DEPTH; ++l) {
        const bool uc = l < DEPTH - 1;
        const int npm = uc ? PMT : PML;
        const float* MODL = WSP(float, WS_MOD) + (size_t)l * 3 * (NMOD * DM);

#if !defined(OFF_P0)
        for (int rep = 0, nrep = opaque_int(REP_THIN); rep < nrep; ++rep) { REFRESH(F); norm_phase(F, l, 0, true); __syncthreads();
 REFRESH(F); filter_phase(F, l, uc); __syncthreads(); }
#endif

        GRID_BAR();
        {
            const char* Hb = (const char*)WSP(bf16, WS_H); const char* Wb = (const char*)(WSP(bf16, WS_WIN) + (size_t)l * DIN * DM);
            pg8::Sched2 S; S.n1 = PMT * 8; S.nM1 = PMT; S.nN1 = 8; S.n2 = 12 * PMT; S.nM2 = 12; S.nN2 = PMT; S.G = F.G; S.c = (int)blockIdx.x;
            S.A1 = Hb; S.B1 = Wb; S.A2 = Wb + (size_t)2048 * DM * 2; S.B2 = Hb; S.tstep = (size_t)256 * DM * 2;
            EpiIn E{WSP(bf16, WS_QK), WSP(bf16, WS_VT), WSP(float, WS_T32)};

#if !defined(OFF_P1)
            for (int rep = 0, nrep = opaque_int(REP_P1); rep < nrep; ++rep) { pg8::gemm_phase<EpiIn, pg8::Sched2, true, true>(ring, DM, S, E); __syncthreads(); }
#endif

        }
        GRID_BAR();

#if !defined(OFF_ATT)
        for (int rep = 0, nrep = opaque_int(REP_ATT); rep < nrep; ++rep) { REFRESH(F); attn_phase(F, l, uc); }
#endif
#if !defined(OFF_FFT)
        REFRESH(F); fft_phase(F, l, uc);
#endif

        GRID_BAR();

#if !defined(OFF_P3)
        for (int rep = 0, nrep = opaque_int(REP_THIN); rep < nrep; ++rep) { REFRESH(F); merge_phase(F, l, uc); __syncthreads(); }
#endif

        GRID_BAR();
        {
            pg8::Sched2 S; S.n1 = npm * 8; S.nM1 = npm; S.nN1 = 8; S.n2 = 0; S.nM2 = 1; S.nN2 = 1; S.G = F.G; S.c = (int)blockIdx.x;
            S.A1 = (const char*)WSP(bf16, WS_H); S.B1 = (const char*)(WSP(bf16, WS_WOUT) + (size_t)l * DM * DM); S.A2 = S.A1; S.B2 = S.B1; S.tstep = (size_t)256 * DM * 2;
            EpiRes E{l == 0 ? IN(x) : F.out, l == 0 ? IN(ctx) : WSP(float, WS_XC), F.out, WSP(float, WS_XC), MODL + 2 * DM};

#if !defined(OFF_P4)
            pg8::gemm_phase<EpiRes, pg8::Sched2, true, true>(ring, DM, S, E);
#endif

        }
        GRID_BAR();

#if !defined(OFF_P5)
        for (int rep = 0, nrep = opaque_int(REP_THIN); rep < nrep; ++rep) { REFRESH(F); norm_phase(F, l, 1, uc); }
#endif

        GRID_BAR();
        {
            pg8::Sched2 S; S.n1 = npm * 44; S.nM1 = npm; S.nN1 = 44; S.n2 = 0; S.nM2 = 1; S.nN2 = 1; S.G = F.G; S.c = (int)blockIdx.x;
            S.A1 = (const char*)WSP(bf16, WS_H); S.B1 = (const char*)(WSP(bf16, WS_WUP) + (size_t)l * 2 * DFF * DM); S.A2 = S.A1; S.B2 = S.B1; S.tstep = (size_t)256 * DM * 2;
            float* EG = WSP(float, WS_EDGE);
            EpiUp E{WSP(bf16, WS_HID), EG, EG + EDGE_ELEMS, EG + 2 * EDGE_ELEMS, IN(ffn_conv_w) + (size_t)l * 3 * DFF, IN(ffn_conv_b) + (size_t)l * DFF};

#if !defined(OFF_P6)
            for (int rep = 0, nrep = opaque_int(REP_P6); rep < nrep; ++rep) { pg8::gemm_phase<EpiUp, pg8::Sched2, true, true>(ring, DM, S, E); __syncthreads(); }
#endif

        }
        GRID_BAR();

#if !defined(OFF_P6B)
        for (int rep = 0, nrep = opaque_int(REP_THIN); rep < nrep; ++rep) { REFRESH(F); edge_fix_phase(F, l, uc); }
#endif

        GRID_BAR();
        {
            pg8::Sched2 S; S.n1 = npm * 8; S.nM1 = npm; S.nN1 = 8; S.n2 = 0; S.nM2 = 1; S.nN2 = 1; S.G = F.G; S.c = (int)blockIdx.x;
            S.A1 = (const char*)WSP(bf16, WS_HID); S.B1 = (const char*)(WSP(bf16, WS_WDN) + (size_t)l * DM * DFF); S.A2 = S.A1; S.B2 = S.B1; S.tstep = (size_t)256 * DFF * 2;
            EpiRes E{F.out, WSP(float, WS_XC), F.out, WSP(float, WS_XC), MODL + 5 * DM};

#if !defined(OFF_P7)
            pg8::gemm_phase<EpiRes, pg8::Sched2, true, true>(ring, DFF, S, E);
#endif

        }
        GRID_BAR();
    }
    REFRESH(F); final_norm_phase(F);
}

extern "C" void kernel_launch(void* const* d_in, const int* in_sizes, int n_in, void* d_out, int out_size, void* d_ws, size_t ws_size, hipStream_t stream) {
    static int grid = 0;
    if (grid == 0) {
        if (n_in != 26 || in_sizes[0] != ML * DM || out_size != ML * DM || ws_size < WS_END) { fprintf(stderr, "kernel_launch: unexpected shapes (n_in %d, in0 %d, out %d, ws %zu < %zu)\n", n_in, n_in > 0 ? in_sizes[0] : -1, out_size, ws_size, (size_t)WS_END); grid = -1; return; }
        int dev = 0, cus = 0, per_cu = 0;
        if (hipGetDevice(&dev) != hipSuccess || hipDeviceGetAttribute(&cus, hipDeviceAttributeMultiprocessorCount, dev) != hipSuccess) { grid = -1; return; }
        if (hipFuncSetAttribute((const void*)fwd_kernel, hipFuncAttributeMaxDynamicSharedMemorySize, LDS_BYTES) != hipSuccess) { fprintf(stderr, "kernel_launch: hipFuncSetAttribute failed\n"); grid = -1; return; }
        if (hipOccupancyMaxActiveBlocksPerMultiprocessor(&per_cu, (const void*)fwd_kernel, NTHR, LDS_BYTES) != hipSuccess || per_cu < 1) { fprintf(stderr, "kernel_launch: occupancy query reports %d\n", per_cu); }
        (void)hipGetLastError();
        grid = cus;
    }
    if (grid < 0) return;
    if (hipMemsetAsync((char*)d_ws + WS_CTL, 0, CTL_ZERO_BYTES, stream) != hipSuccess) return;
    Args a{};
    for (int i = 0; i < 26; ++i) a.in[i] = (const float*)d_in[i];
    a.out = (float*)d_out; a.ws = (unsigned char*)d_ws;
    hipLaunchKernelGGL(fwd_kernel, dim3(grid), dim3(NTHR), LDS_BYTES, stream, a);
}
```

```cpp
#include <hip/hip_runtime.h>
#include <cstdio>
#include <cstdint>
namespace pg8 {
#define PG8_LAS __attribute__((address_space(3)))
typedef unsigned short bf16_t;
typedef short bf16x8 __attribute__((ext_vector_type(8)));
typedef float f32x4 __attribute__((ext_vector_type(4)));
typedef unsigned u32x4 __attribute__((ext_vector_type(4)));
constexpr int BM = 256, BK = 64, HALF = 128, HTB = HALF * BK * 2  , STAGE_BYTES = 8 * HTB, NXCD = 8, WGM = 8;

__host__ __device__ __forceinline__ int lds_byte(int r, int c) { const int st = (r >> 4) * 2 + (c >> 5), rr = r & 15, cc = c & 31, ob = rr * 64 + cc * 2; return st * 1024 + (ob ^ (((ob >> 9) & 1) << 5)); }
__host__ __device__ __forceinline__ void stage_rc(int b, int& R, int& C) { const int st = b / 1024, sb = b % 1024, swz = sb ^ (((sb >> 9) & 1) << 5); R = (st >> 1) * 16 + swz / 64; C = (st & 1) * 32 + (swz % 64) / 2; }
__host__ __device__ __forceinline__ int perm32(int rho) { const int n = rho >> 4, i = rho & 15; return 8 * (i >> 2) + 4 * n + (i & 3); }

struct Unit { int pm, pn, type; };

__device__ __forceinline__ void map_unit(int w, int nwg, int nM, int nN, Unit& u) {
    { const int q = nwg / NXCD, r = nwg % NXCD, xcd = w % NXCD, off = w / NXCD; w = (xcd < r ? xcd * (q + 1) : r * (q + 1) + (xcd - r) * q) + off; }
    const int nig = WGM * nN, gid = w / nig, fm = gid * WGM, gsz = (nM - fm) < WGM ? (nM - fm) : WGM;
    u.pm = fm + ((w % nig) % gsz); u.pn = (w % nig) / gsz;
}
struct Sched2 {
    int n1, nM1, nN1, n2, nM2, nN2, G, c; const char *A1, *B1, *A2, *B2; size_t tstep;
    __device__ __forceinline__ bool next(int i, Unit& u) const {
        const long L = (long)i * G + c;
        if (L < n1) { map_unit((int)L, n1, nM1, nN1, u); u.type = 0; return true; }
        if (L < n1 + n2) { map_unit((int)L - n1, n2, nM2, nN2, u); u.type = 1; return true; }
        return false;
    }
    __device__ __forceinline__ const char* a_ptr(const Unit& u) const { return (u.type ? A2 : A1) + (size_t)u.pm * tstep; }
    __device__ __forceinline__ const char* b_ptr(const Unit& u) const { return (u.type ? B2 : B1) + (size_t)u.pn * tstep; }
    __device__ __forceinline__ void a_ready(const Unit&) const {}
    __device__ __forceinline__ void done(const Unit&) const {}
};

__device__ __forceinline__ unsigned cvt_pk_bf16(float lo, float hi) { unsigned r; asm volatile("v_cvt_pk_bf16_f32 %0, %1, %2" : "=v"(r) : "v"(lo), "v"(hi)); return r; }
typedef float f32x2 __attribute__((ext_vector_type(2)));

template <class Epi, class Sched, bool ALIGN_EPI = false, bool SP2 = false>
__device__ __forceinline__ void gemm_phase(PG8_LAS unsigned char* lds, const int Kdim, const Sched& S, const Epi& E) {
    int tid_ = threadIdx.x; asm volatile("" : "+v"(tid_));
    const int tid = tid_, wid = __builtin_amdgcn_readfirstlane(tid >> 6), lane = tid & 63, wr = wid >> 2, wc = wid & 3, fr = lane & 15, fq = lane >> 4;
    const int K = Kdim, nt = K / BK;
    unsigned voffA[2], voffB[2];
#pragma unroll
    for (int i = 0; i < 2; ++i) { int R, C; stage_rc(tid * 16 + i * 8192, R, C); const int Rb = Epi::PERM ? ((R & ~31) + perm32(R & 31)) : R;
        voffA[i] = (unsigned)(R * K + C) * 2u; voffB[i] = (unsigned)(Rb * K + C) * 2u; }
    const size_t kstep = (size_t)(BK * 2);
    const size_t hstep = (size_t)HALF * K * 2;
    const size_t tstep = 2 * hstep;
    const unsigned ldsw = (unsigned)wid * 1024u;
    const int aoff = lds_byte(wr * 64 + fr, fq * 8), boff = lds_byte(wc * 32 + fr, fq * 8);
#define PG8_SA(b, h) (((b) * 2 + (h)) * HTB)
#define PG8_SB(b, h) ((4 + (b) * 2 + (h)) * HTB)
#define PG8_STAGE(bufoff, gbase, voff) do { _Pragma("unroll") for (int _i = 0; _i < 2; ++_i) \
        __builtin_amdgcn_global_load_lds((const unsigned*)((const char*)(gbase) + (voff)[_i]), (PG8_LAS unsigned*)(lds + (bufoff) + ldsw + _i * 8192), 16, 0, 0); } while (0)
#define PG8_LDA(dst, b, h) do { _Pragma("unroll") for (int m = 0; m < 4; ++m) _Pragma("unroll") for (int k = 0; k < 2; ++k) dst[m][k] = *(const PG8_LAS bf16x8*)(lds + PG8_SA(b, h) + aoff + m * 2048 + k * 1024); } while (0)
#define PG8_LDB(dst, b, h) do { _Pragma("unroll") for (int n = 0; n < 2; ++n) _Pragma("unroll") for (int k = 0; k < 2; ++k) dst[n][k] = *(const PG8_LAS bf16x8*)(lds + PG8_SB(b, h) + boff + n * 2048 + k * 1024); } while (0)
#define PG8_MMA(ai, bj, At, Bt) do { __builtin_amdgcn_s_setprio(1); _Pragma("unroll") for (int m = 0; m < 4; ++m) _Pragma("unroll") for (int n = 0; n < 2; ++n) _Pragma("unroll") for (int k = 0; k < 2; ++k) \
        acc[ai][bj][m][n] = __builtin_amdgcn_mfma_f32_16x16x32_bf16(Bt[n][k], At[m][k], acc[ai][bj][m][n], 0, 0, 0); __builtin_amdgcn_s_setprio(0); } while (0)
#define PG8_WAIT_V(n) asm volatile("s_waitcnt vmcnt(" #n ")" ::: "memory")
#define PG8_WAIT_L(n) asm volatile("s_waitcnt lgkmcnt(" #n ")" ::: "memory")
#define PG8_BAR __builtin_amdgcn_s_barrier()
#define PG8_SCHED __builtin_amdgcn_sched_barrier(0)
    Unit cur, nxt; int ui = 0;
    if (!S.next(0, cur)) return;
    f32x4 acc[2][2][4][2];
#pragma unroll
    for (int a = 0; a < 2; ++a)
#pragma unroll
        for (int b = 0; b < 2; ++b)
#pragma unroll
            for (int m = 0; m < 4; ++m)
#pragma unroll
                for (int n = 0; n < 2; ++n) acc[a][b][m][n] = (f32x4){0.f, 0.f, 0.f, 0.f};
    bf16x8 At[4][2], B0[2][2], B1[2][2];
    const char* cA = S.a_ptr(cur); const char* cB = S.b_ptr(cur);
    S.a_ready(cur);
    if constexpr (SP2) {
        PG8_STAGE(PG8_SB(0, 0), cB, voffB); PG8_STAGE(PG8_SB(0, 1), cB + hstep, voffB); PG8_STAGE(PG8_SA(0, 0), cA, voffA); PG8_STAGE(PG8_SA(0, 1), cA + hstep, voffA);
        if (wr == 1) PG8_BAR;
        PG8_WAIT_V(2); PG8_BAR;
        PG8_STAGE(PG8_SB(1, 0), cB + kstep, voffB); PG8_STAGE(PG8_SA(1, 0), cA + kstep, voffA); PG8_STAGE(PG8_SB(1, 1), cB + hstep + kstep, voffB);
        PG8_WAIT_V(6); PG8_BAR;
    } else {
        PG8_STAGE(PG8_SB(0, 0), cB, voffB); PG8_STAGE(PG8_SA(0, 0), cA, voffA); PG8_STAGE(PG8_SB(0, 1), cB + hstep, voffB); PG8_STAGE(PG8_SA(0, 1), cA + hstep, voffA);
        if (wr == 1) PG8_BAR;
        PG8_WAIT_V(4); PG8_BAR;
        PG8_STAGE(PG8_SB(1, 0), cB + kstep, voffB); PG8_STAGE(PG8_SA(1, 0), cA + kstep, voffA); PG8_STAGE(PG8_SB(1, 1), cB + hstep + kstep, voffB);
        PG8_WAIT_V(6); PG8_BAR;
    }
    for (;;) {
        const bool has_next = S.next(ui + 1, nxt);
        const char* nA = has_next ? S.a_ptr(nxt) : cA; const char* nB = has_next ? S.b_ptr(nxt) : cB;
        for (int t = 0; t < nt; t += 2) {
            const bool last = (t == nt - 2);
            const char* a1 = cA + (size_t)(t + 1) * kstep;
            const char* a2 = last ? nA : cA + (size_t)(t + 2) * kstep; const char* b2 = last ? nB : cB + (size_t)(t + 2) * kstep;
            const char* a3 = a2 + kstep; const char* b3 = b2 + kstep;
            if (last && has_next) S.a_ready(nxt);
            if constexpr (SP2) {
            PG8_LDB(B0, 0, 0); PG8_LDB(B1, 0, 1); PG8_SCHED; PG8_LDA(At, 0, 0); PG8_STAGE(PG8_SA(1, 1), a1 + hstep, voffA);
            PG8_WAIT_V(8); PG8_WAIT_L(0); PG8_BAR; PG8_MMA(0, 0, At, B0); PG8_MMA(0, 1, At, B1); PG8_BAR; PG8_SCHED;
            PG8_LDA(At, 0, 1); PG8_STAGE(PG8_SB(0, 0), b2, voffB); PG8_STAGE(PG8_SB(0, 1), b2 + hstep, voffB); PG8_STAGE(PG8_SA(0, 0), a2, voffA);
            PG8_WAIT_V(8); PG8_WAIT_L(0); PG8_BAR; PG8_MMA(1, 0, At, B0); PG8_MMA(1, 1, At, B1); PG8_BAR; PG8_SCHED;
            PG8_LDB(B0, 1, 0); PG8_LDB(B1, 1, 1); PG8_SCHED; PG8_LDA(At, 1, 0); PG8_STAGE(PG8_SA(0, 1), a2 + hstep, voffA);
            PG8_WAIT_V(8); PG8_WAIT_L(0); PG8_BAR; PG8_MMA(0, 0, At, B0); PG8_MMA(0, 1, At, B1); PG8_BAR; PG8_SCHED;
            PG8_LDA(At, 1, 1); PG8_STAGE(PG8_SB(1, 0), b3, voffB); PG8_STAGE(PG8_SB(1, 1), b3 + hstep, voffB); PG8_STAGE(PG8_SA(1, 0), a3, voffA);
            PG8_WAIT_V(8); PG8_WAIT_L(0); PG8_BAR; PG8_MMA(1, 0, At, B0); PG8_MMA(1, 1, At, B1); PG8_BAR; PG8_SCHED;
            } else {
            PG8_LDB(B0, 0, 0); PG8_SCHED; PG8_LDA(At, 0, 0); PG8_STAGE(PG8_SA(1, 1), a1 + hstep, voffA);
            PG8_WAIT_L(8); PG8_BAR; PG8_WAIT_L(0); PG8_MMA(0, 0, At, B0); PG8_BAR; PG8_SCHED;
            PG8_LDB(B1, 0, 1); PG8_STAGE(PG8_SB(0, 0), b2, voffB);
            PG8_BAR; PG8_WAIT_L(0); PG8_MMA(0, 1, At, B1); PG8_BAR;
            PG8_LDA(At, 0, 1); PG8_STAGE(PG8_SA(0, 0), a2, voffA);
            PG8_BAR; PG8_WAIT_L(0); PG8_MMA(1, 0, At, B0); PG8_BAR; PG8_SCHED;
            PG8_STAGE(PG8_SB(0, 1), b2 + hstep, voffB);
            PG8_WAIT_V(6); PG8_BAR; PG8_MMA(1, 1, At, B1); PG8_BAR;
            PG8_LDB(B0, 1, 0); PG8_SCHED; PG8_LDA(At, 1, 0); PG8_STAGE(PG8_SA(0, 1), a2 + hstep, voffA);
            PG8_WAIT_L(8); PG8_BAR; PG8_WAIT_L(0); PG8_MMA(0, 0, At, B0); PG8_BAR; PG8_SCHED;
            PG8_LDB(B1, 1, 1); PG8_STAGE(PG8_SB(1, 0), b3, voffB);
            PG8_BAR; PG8_WAIT_L(0); PG8_MMA(0, 1, At, B1); PG8_BAR;
            PG8_LDA(At, 1, 1); PG8_STAGE(PG8_SA(1, 0), a3, voffA);
            PG8_BAR; PG8_WAIT_L(0); PG8_MMA(1, 0, At, B0); PG8_BAR; PG8_SCHED;
            PG8_STAGE(PG8_SB(1, 1), b3 + hstep, voffB);
            PG8_WAIT_V(6); PG8_BAR; PG8_MMA(1, 1, At, B1); PG8_BAR;
            }
        }
        if constexpr (ALIGN_EPI) { if (wr == 0) PG8_BAR; }
        if constexpr (!Epi::AFTER_DRAIN) { E(acc, cur, wr, wc, fr, fq); S.done(cur); }
        if (!has_next) break;
#pragma unroll
        for (int a = 0; a < 2; ++a)
#pragma unroll
            for (int b = 0; b < 2; ++b)
#pragma unroll
                for (int m = 0; m < 4; ++m)
#pragma unroll
                    for (int n = 0; n < 2; ++n) acc[a][b][m][n] = (f32x4){0.f, 0.f, 0.f, 0.f};
        cur = nxt; cA = nA; cB = nB; ++ui;
        if constexpr (ALIGN_EPI) { if (wr == 1) PG8_BAR; }
    }
    PG8_WAIT_V(0);
    if constexpr (!ALIGN_EPI) { if (wr == 0) PG8_BAR; }
    PG8_BAR;
    if constexpr (Epi::AFTER_DRAIN) { E.fused(acc, cur, wr, wc, fr, fq, lds, wid, lane); S.done(cur); }
#undef PG8_SA
#undef PG8_SB
#undef PG8_STAGE
#undef PG8_LDA
#undef PG8_LDB
#undef PG8_MMA
#undef PG8_WAIT_V
#undef PG8_WAIT_L
#undef PG8_BAR
#undef PG8_SCHED
}
}

constexpr int NWAVES = 8, NTHR = 512;
constexpr int DM = 2048, BATCH = 2, SEQ = 16384, DEPTH = 4, GRIDW = 64, GROWS = 256, CTXL = 256;
constexpr int NAW = 1024, NHEAD = 8, HDIM = 128, FNW = 512, HYW = 512, DFF = 5632, DIN = 5120, NMOD = 6;
constexpr int ML = BATCH * SEQ, MC = BATCH * CTXL, MT = ML + MC;
constexpr int PML = ML / 256, PMT = MT / 256;
constexpr int NEDGE = MT / 64 * 2;
constexpr float EPS = 1e-6f;
constexpr float LOG2E = 1.4426950408889634f;
constexpr float QSCALE = 0.08838834764831845f * LOG2E;
constexpr float HY_MIN_DECAY = -3.0701134573253945f, HY_MAX_DECAY = -15.350567286626973f;

constexpr size_t MiB = 1u << 20;
constexpr size_t WS_CTL = 0, CTL_ZERO_BYTES = 1 * MiB;
constexpr size_t WS_MOD = 1 * MiB;
constexpr size_t WS_XC = 2 * MiB;
constexpr size_t WS_HFC = 6 * MiB;
constexpr size_t WS_HF = 8 * MiB;
constexpr size_t WS_WIN = WS_HF + 128 * MiB;
constexpr size_t WS_WOUT = WS_WIN + 80 * MiB;
constexpr size_t WS_WUP = WS_WOUT + 32 * MiB;
constexpr size_t WS_WDN = WS_WUP + 176 * MiB;
constexpr size_t WS_H = WS_WDN + 88 * MiB;
constexpr size_t WS_QK = WS_H + 130 * MiB;
constexpr size_t WS_VT = WS_QK + 130 * MiB;
constexpr size_t WS_T32 = WS_VT + 65 * MiB;
constexpr size_t WS_A = WS_T32 + 260 * MiB;
constexpr size_t WS_HID = WS_QK;
constexpr size_t WS_EDGE = WS_A + 65 * MiB;
constexpr size_t EDGE_ELEMS = (size_t)NEDGE * DFF;
constexpr size_t WS_KS = WS_EDGE + 68 * MiB;
constexpr size_t WS_END = WS_KS + 64 * MiB;
static_assert((size_t)MT * DFF * 2 <= WS_EDGE - WS_QK, "hidden overlay");
static_assert(3 * EDGE_ELEMS * 4 <= 68 * MiB, "edge buffers");
static_assert((size_t)MT * DM * 2 == 130 * MiB && (size_t)1024 * MT * 2 == 65 * MiB && (size_t)2048 * MT * 4 == 260 * MiB, "sizes");
constexpr int CW_BAR = 4096;

constexpr int RING_BYTES = 131072;
constexpr int XTRA_OFF = RING_BYTES, XTRA_BYTES = 20480;
constexpr int MISC_OFF = XTRA_OFF + XTRA_BYTES;
constexpr int LDS_BYTES = MISC_OFF + 256;

#define GAS __attribute__((address_space(1)))
#define LAS __attribute__((address_space(3)))
typedef unsigned short bf16;
typedef unsigned v4u __attribute__((ext_vector_type(4)));
typedef unsigned v2u __attribute__((ext_vector_type(2)));
typedef float f32x4 __attribute__((ext_vector_type(4)));
typedef float f32x2 __attribute__((ext_vector_type(2)));
typedef short bf16x8 __attribute__((ext_vector_type(8)));
#define LDS_WAIT() asm volatile("s_waitcnt lgkmcnt(0)" ::: "memory")
__device__ __forceinline__ unsigned f2bf(float f) { unsigned u = __builtin_bit_cast(unsigned, f); return (u + 0x7fffu + ((u >> 16) & 1u)) >> 16; }
__device__ __forceinline__ unsigned pk2(float lo, float hi) { return f2bf(lo) | (f2bf(hi) << 16); }
__device__ __forceinline__ float bf2f(unsigned short b) { return __builtin_bit_cast(float, (unsigned)b << 16); }
__device__ __forceinline__ f32x2 cmul(f32x2 a, f32x2 b) { return (f32x2){a.x * b.x - a.y * b.y, a.x * b.y + a.y * b.x}; }
__device__ __forceinline__ f32x2 cconj(f32x2 a) { return (f32x2){a.x, -a.y}; }
__device__ __forceinline__ float lane_read(float v, int src_lane) { return __builtin_bit_cast(float, __builtin_amdgcn_ds_bpermute(src_lane << 2, __builtin_bit_cast(int, v))); }
__device__ __forceinline__ float wave_sum(float v, int lane) {
#pragma unroll
    for (int o = 1; o < 64; o <<= 1) v += lane_read(v, lane ^ o);
    return v;
}
__device__ __forceinline__ float gelu_tanh(float x) {
    const float t = x * (1.0f + 0.044715f * x * x) * (-2.302208198f);
    const float e = __builtin_amdgcn_exp2f(t);
    return x * __builtin_amdgcn_rcpf(1.0f + e);
}
#define XB_LAS_DEFINED
#define XB_TMO      128
#define XB_XCNT(j)  (256  + 64 * (j))
#define XB_XSUB(j)  (1280 + 64 * (j))
#define XB_XGEN(j)  (2304 + 64 * (j))
#define XB_TOP      3328
#define XB_TOPGEN   3392
#define XCD_BAR_WORDS 3456
#define XB_SPIN_CAP (1u << 18)

__device__ __forceinline__ unsigned xb_ld(unsigned* p)              { return __hip_atomic_load(p, __ATOMIC_RELAXED, __HIP_MEMORY_SCOPE_AGENT); }
__device__ __forceinline__ unsigned xb_add(unsigned* p, unsigned v) { return __hip_atomic_fetch_add(p, v, __ATOMIC_RELAXED, __HIP_MEMORY_SCOPE_AGENT); }
__device__ __forceinline__ unsigned xb_xcc_id() { return (unsigned)__builtin_amdgcn_s_getreg((3 << 11) | 20) & 0xFu; }
#define XB_SPIN(cond, bar) do { unsigned _sp = 0; while (cond) { __builtin_amdgcn_s_sleep(1); \
    if ((++_sp & 255u) == 0u) { if (xb_ld(&(bar)[XB_TMO])) break; if (_sp > XB_SPIN_CAP) { atomicAdd(&(bar)[XB_TMO], 1u); break; } } } } while (0)

struct XcdBarrier {
    unsigned* bar; unsigned x;
    volatile LAS unsigned* st;
};

__device__ __forceinline__ XcdBarrier xcd_barrier_post(unsigned* bar, volatile LAS unsigned* st) {
    XcdBarrier b; b.bar = bar; b.x = xb_xcc_id(); b.st = st;
    if (threadIdx.x == 0) (void)xb_add(&bar[XB_XCNT(b.x)], 1u);
    return b;
}
__device__ __forceinline__ void xcd_barrier_complete(unsigned* bar, unsigned x, unsigned& nloc, unsigned& nx) {
    const unsigned G = gridDim.x * gridDim.y * gridDim.z;
    unsigned sum, cnt, mine, sp = 0u;
    for (;;) {
        sum = 0u; cnt = 0u; mine = 0u;
#pragma unroll
        for (unsigned j = 0; j < 16; ++j) { const unsigned c = xb_ld(&bar[XB_XCNT(j)]); sum += c; cnt += (c > 0u) ? 1u : 0u; mine = (j == x) ? c : mine; }
        if (sum == G) break;
        __builtin_amdgcn_s_sleep(1);
        if ((++sp & 255u) == 0u) { if (xb_ld(&bar[XB_TMO])) break; if (sp > XB_SPIN_CAP) { atomicAdd(&bar[XB_TMO], 1u); break; } }
    }
    nloc = mine > 0u ? mine : 1u; nx = cnt > 0u ? cnt : 1u;
}

__device__ __forceinline__ void xcd_barrier(const XcdBarrier& b) {
    asm volatile("s_waitcnt vmcnt(0)" ::: "memory");
    __syncthreads();
    if (threadIdx.x == 0) {
        unsigned* bar = b.bar;
        __builtin_amdgcn_s_waitcnt(0);
        unsigned nloc = b.st[0], nx = b.st[1];
        if (nloc == 0u) { xcd_barrier_complete(bar, b.x, nloc, nx); b.st[0] = nloc; b.st[1] = nx; }
        const unsigned old = xb_add(&bar[XB_XSUB(b.x)], 1u);
        const unsigned gen = old / nloc;
        if (old + 1u == (gen + 1u) * nloc) {
            __builtin_amdgcn_fence(__ATOMIC_RELEASE, "agent");
            asm volatile("s_waitcnt vmcnt(0)" ::: "memory");
            const unsigned og = xb_add(&bar[XB_TOP], 1u);
            const unsigned tg = og / nx;
            if (og + 1u == (tg + 1u) * nx) xb_add(&bar[XB_TOPGEN], 1u);
            else XB_SPIN(xb_ld(&bar[XB_TOPGEN]) == tg, bar);
            __builtin_amdgcn_fence(__ATOMIC_ACQUIRE, "agent");
            xb_add(&bar[XB_XGEN(b.x)], 1u);
            asm volatile("s_waitcnt vmcnt(0)" ::: "memory");
        } else {
            XB_SPIN(xb_ld(&bar[XB_XGEN(b.x)]) == gen, bar);
            __builtin_amdgcn_fence(__ATOMIC_ACQUIRE, "agent");
            asm volatile("s_waitcnt vmcnt(0)" ::: "memory");
        }
    }
    __syncthreads();
}


struct Args { const GAS float* in[26]; GAS float* out; GAS unsigned char* ws; };
struct Frame {
    LAS unsigned char* lds;
    int tid, lane, wave;
    int vcu, G;
    GAS unsigned char* ws;
    GAS float* out;
};
typedef const float* cfptr_t;
__device__ __forceinline__ const GAS float* in_ptr(int k) { asm volatile("" : "+s"(k));
    const __attribute__((address_space(4))) cfptr_t* kp = (const __attribute__((address_space(4))) cfptr_t*)__builtin_amdgcn_kernarg_segment_ptr(); return (const GAS float*)kp[k]; }
enum { I_x, I_c, I_ctx, I_c_ctx, I_ada_w, I_ada_b, I_norm1_g, I_norm2_g, I_w_in, I_na_rpb, I_hy_conv_w, I_hy_conv_b, I_hy_w1, I_hy_b1, I_hy_w2, I_hy_b2, I_hy_w3, I_hy_freq, I_hy_bias,
       I_mix_norm_g, I_w_out, I_ffn_w_up, I_ffn_conv_w, I_ffn_conv_b, I_ffn_w_down, I_final_norm_g };
#define IN(name) in_ptr(I_##name)
#define WSP(T, off) ((GAS T*)(F.ws + (off)))

__device__ __forceinline__ void pa_adaln(Frame& F) {
    LAS float* sv = (LAS float*)F.lds;
    LAS float* red = (LAS float*)(F.lds + 3 * DM * 4);
    const GAS float* p_c = IN(c); const GAS float* p_cc = IN(c_ctx); const GAS float* p_aw = IN(ada_w); const GAS float* p_ab = IN(ada_b);
    for (int i = F.tid; i < 3 * DM; i += NTHR) { const int s = i / DM, k = i % DM; const float v = s < 2 ? p_c[s * DM + k] : p_cc[k]; sv[i] = v / (1.0f + __expf(-v)); }
    __syncthreads();
    GAS float* MOD = WSP(float, WS_MOD);
    const int cg = F.tid & 63, ks = F.tid >> 6;
    for (int item = F.vcu; item < DEPTH * 48; item += F.G) {
        const int l = item / 48, j0 = (item % 48) * 256;
        const GAS float* wp = p_aw + ((size_t)l * DM + ks * 256) * (NMOD * DM) + j0 + 4 * cg;
        f32x4 a0 = {0.f, 0.f, 0.f, 0.f}, a1 = a0, a2 = a0;
#pragma unroll 8
        for (int kk = 0; kk < 256; ++kk) {
            const f32x4 w = *(const GAS f32x4*)(wp + (size_t)kk * (NMOD * DM));
            const float s0 = sv[ks * 256 + kk], s1 = sv[DM + ks * 256 + kk], s2 = sv[2 * DM + ks * 256 + kk];
            a0 += w * s0; a1 += w * s1; a2 += w * s2;
        }
        *(LAS f32x4*)(red + (ks * 3 + 0) * 256 + 4 * cg) = a0; *(LAS f32x4*)(red + (ks * 3 + 1) * 256 + 4 * cg) = a1; *(LAS f32x4*)(red + (ks * 3 + 2) * 256 + 4 * cg) = a2;
        __syncthreads();
        if (F.tid < 192) {
            const int s = F.tid >> 6, cc = F.tid & 63;
            f32x4 t = *(const GAS f32x4*)(p_ab + (size_t)l * (NMOD * DM) + j0 + 4 * cc);
#pragma unroll
            for (int q = 0; q < 8; ++q) t += *(LAS f32x4*)(red + (q * 3 + s) * 256 + 4 * cc);
            *(GAS f32x4*)(MOD + ((size_t)l * 3 + s) * (NMOD * DM) + j0 + 4 * cc) = t;
        }
        __syncthreads();
    }
}
__device__ __forceinline__ void transpose_item(const GAS float* W, int K, int N, GAS bf16* WT, int k0, int n0, int drow0, LAS float* scr, int lane) {
#pragma unroll 8
    for (int i = 0; i < 32; ++i) { const int kk = 2 * i + (lane >> 5); scr[kk * 33 + (lane & 31)] = W[(size_t)(k0 + kk) * N + n0 + (lane & 31)]; }
    LDS_WAIT(); asm volatile("" ::: "memory");
    const int c = lane & 7;
#pragma unroll
    for (int j = 0; j < 4; ++j) { const int n = (lane >> 3) + 8 * j; const LAS float* s = scr + (8 * c) * 33 + n;
        v4u o; o.x = pk2(s[0 * 33], s[1 * 33]); o.y = pk2(s[2 * 33], s[3 * 33]); o.z = pk2(s[4 * 33], s[5 * 33]); o.w = pk2(s[6 * 33], s[7 * 33]);
        *(GAS v4u*)(WT + (size_t)(drow0 + n) * K + k0 + 8 * c) = o; }
    LDS_WAIT(); asm volatile("" ::: "memory");
}
__device__ __forceinline__ void pa_weights(Frame& F) {
    const GAS float* p_win = IN(w_in); const GAS float* p_wout = IN(w_out); const GAS float* p_wup = IN(ffn_w_up); const GAS float* p_wdn = IN(ffn_w_down);
    {
        LAS float* wt = (LAS float*)F.lds;
        LAS float* tab = (LAS float*)(F.lds + 64 * 129 * 4);
        if (F.tid < 128) tab[F.tid] = cospif((float)F.tid * (1.0f / 64.0f));
        for (int item = F.vcu; item < DEPTH * 4 * 32; item += F.G) {
            const int l = item >> 7, g = (item >> 5) & 3, k0 = (item & 31) * 64;
            __syncthreads();
            for (int i = F.tid; i < 64 * 128; i += NTHR) { const int kk = i >> 7, cc = i & 127; wt[kk * 129 + cc] = p_win[((size_t)l * DM + k0 + kk) * DIN + 3072 + g * 128 + cc]; }
            __syncthreads();
            const int kk = F.tid & 63;
            GAS bf16* dst = WSP(bf16, WS_WIN) + ((size_t)l * DIN + 3072 + g * 128) * DM + k0 + kk;
            for (int i = 0; i < 16; ++i) {
                const int mp = (F.tid >> 6) + 8 * i;
                const int mm = mp <= 64 ? mp : mp - 64, sh = mp <= 64 ? 0 : 96;
                float a = 0.f;
                const int add = mp <= 64 ? 0 : 32; (void)sh;
#pragma unroll 8
                for (int cc = 0; cc < 128; ++cc) a += wt[kk * 129 + cc] * tab[(mm * cc + add) & 127];
                dst[(size_t)mp * DM] = (bf16)f2bf(a);
            }
        }
        __syncthreads();
    }
    LAS float* scr = (LAS float*)(F.lds + F.wave * 16384);
    const int gw = F.vcu * NWAVES + F.wave, NGW = F.G * NWAVES;
    constexpr int I_IN = 32 * 144, I_OUT = 32 * 64, I_UP = 32 * 352, I_DN = 88 * 64, I_L = I_IN + I_OUT + I_UP + I_DN;
    for (int it = gw; it < DEPTH * I_L; it += NGW) {
        const int l = it / I_L; int r = it % I_L;
        if (r < I_IN) { const int kb = r / 144; int nb = r % 144; if (nb >= 96) nb += 16;
            transpose_item(p_win + (size_t)l * DM * DIN, DM, DIN, WSP(bf16, WS_WIN) + (size_t)l * DIN * DM, kb * 64, nb * 32, nb * 32, scr, F.lane); continue; }
        r -= I_IN;
        if (r < I_OUT) { const int kb = r / 64, nb = r % 64;
            transpose_item(p_wout + (size_t)l * DM * DM, DM, DM, WSP(bf16, WS_WOUT) + (size_t)l * DM * DM, kb * 64, nb * 32, nb * 32, scr, F.lane); continue; }
        r -= I_OUT;
        if (r < I_UP) { const int kb = r / 352, nb = r % 352; const int n0 = nb * 32;
            const int drow = n0 < DFF ? (n0 >> 7) * 256 + (n0 & 127) : ((n0 - DFF) >> 7) * 256 + 128 + ((n0 - DFF) & 127);
            transpose_item(p_wup + (size_t)l * DM * 2 * DFF, DM, 2 * DFF, WSP(bf16, WS_WUP) + (size_t)l * 2 * DFF * DM, kb * 64, n0, drow, scr, F.lane); continue; }
        r -= I_UP;
        { const int kb = r / 64, nb = r % 64;
            transpose_item(p_wdn + (size_t)l * DFF * DM, DFF, DM, WSP(bf16, WS_WDN) + (size_t)l * DM * DFF, kb * 64, nb * 32, nb * 32, scr, F.lane); }
    }
}

__device__ __forceinline__ void norm_phase(Frame& F, int l, int which, bool with_ctx) {
    const GAS float* gain = (which ? IN(norm2_g) : IN(norm1_g)) + (size_t)l * DM;
    const GAS float* MOD = WSP(float, WS_MOD) + (size_t)l * 3 * (NMOD * DM);
    const bool first = (l == 0 && which == 0);
    const GAS float* xl = first ? IN(x) : F.out; const GAS float* xc = first ? IN(ctx) : WSP(float, WS_XC);
    GAS bf16* H = WSP(bf16, WS_H);
    const int gw = F.vcu * NWAVES + F.wave, NGW = F.G * NWAVES, nrows = with_ctx ? MT : ML;
    for (int row = gw; row < nrows; row += NGW) {
        const int s = row < SEQ ? 0 : row < ML ? 1 : 2;
        const GAS float* xr = row < ML ? xl + (size_t)row * DM : xc + (size_t)(row - ML) * DM;
        const GAS float* shp = MOD + (size_t)s * (NMOD * DM) + (which ? 3 : 0) * DM; const GAS float* scp = shp + DM;
        f32x4 v[8]; float ss = 0.f;
#pragma unroll
        for (int j = 0; j < 8; ++j) { v[j] = *(const GAS f32x4*)(xr + 4 * (F.lane + 64 * j)); ss += (v[j].x * v[j].x + v[j].y * v[j].y) + (v[j].z * v[j].z + v[j].w * v[j].w); }
        const float rstd = 1.0f / sqrtf(wave_sum(ss, F.lane) * (1.0f / DM) + EPS);
        GAS bf16* hr = H + (size_t)row * DM;
#pragma unroll
        for (int j = 0; j < 8; ++j) { const int k = 4 * (F.lane + 64 * j);
            const f32x4 g = *(const GAS f32x4*)(gain + k), sc = *(const GAS f32x4*)(scp + k), sh = *(const GAS f32x4*)(shp + k);
            const f32x4 y = (v[j] * rstd * g) * (1.0f + sc) + sh;
            v2u o; o.x = pk2(y.x, y.y); o.y = pk2(y.z, y.w); *(GAS v2u*)(hr + k) = o; }
    }
}
__device__ __forceinline__ void final_norm_phase(Frame& F) {
    const GAS float* p_g = IN(final_norm_g);
    const int gw = F.vcu * NWAVES + F.wave, NGW = F.G * NWAVES;
    for (int row = gw; row < ML; row += NGW) {
        GAS float* xr = F.out + (size_t)row * DM;
        f32x4 v[8]; float ss = 0.f;
#pragma unroll
        for (int j = 0; j < 8; ++j) { v[j] = *(const GAS f32x4*)(xr + 4 * (F.lane + 64 * j)); ss += (v[j].x * v[j].x + v[j].y * v[j].y) + (v[j].z * v[j].z + v[j].w * v[j].w); }
        const float rstd = 1.0f / sqrtf(wave_sum(ss, F.lane) * (1.0f / DM) + EPS);
#pragma unroll
        for (int j = 0; j < 8; ++j) { const int k = 4 * (F.lane + 64 * j); *(GAS f32x4*)(xr + k) = v[j] * rstd * *(const GAS f32x4*)(p_g + k); }
    }
}

__device__ __forceinline__ void filter_phase(Frame& F, int l, bool with_ctx) {
    LAS float* h1 = (LAS float*)F.lds;
    LAS float* h2 = (LAS float*)(F.lds + 64 * 65 * 4);
    const GAS float* w1 = IN(hy_w1) + (size_t)l * 33 * 64; const GAS float* b1 = IN(hy_b1) + (size_t)l * 64;
    const GAS float* w2 = IN(hy_w2) + (size_t)l * 64 * 64; const GAS float* b2 = IN(hy_b2) + (size_t)l * 64;
    const GAS float* w3 = IN(hy_w3) + (size_t)l * 64 * 2048; const GAS float* fq = IN(hy_freq) + (size_t)l * 64;
    const int nitems = with_ctx ? 260 : 256;
    for (int item = F.vcu; item < nitems; item += F.G) {
        const bool isc = item >= 256; const int Lq = isc ? CTXL : SEQ; const int n0 = (isc ? item - 256 : item) * 64;
        const int p = F.tid & 63, jg = F.wave;
        const float pos = (float)(n0 + p), t = pos / (float)(Lq - 1);
        __syncthreads();
        {
            float zf[33]; zf[0] = t;
#pragma unroll
            for (int i = 0; i < 16; ++i) { const float band = 1e-4f + (float)i * ((15.0f - 1e-4f) / 15.0f); const float ang = band * (6.283185307179586f / (float)Lq) * pos; zf[1 + i] = cosf(ang); zf[17 + i] = -sinf(ang); }
#pragma unroll 1
            for (int jj = 0; jj < 8; ++jj) { const int j = jg * 8 + jj; float a = b1[j];
#pragma unroll
                for (int i = 0; i < 33; ++i) a += zf[i] * w1[i * 64 + j];
                h1[p * 65 + j] = sinf(fq[j] * a); }
        }
        __syncthreads();
#pragma unroll 1
        for (int jj = 0; jj < 8; ++jj) { const int j = jg * 8 + jj; float a = b2[j];
#pragma unroll 8
            for (int i = 0; i < 64; ++i) a += h1[p * 65 + i] * w2[i * 64 + j];
            h2[p * 65 + j] = sinf(fq[j] * a); }
        __syncthreads();
        GAS float* dst = isc ? WSP(float, WS_HFC) : WSP(float, WS_HF);
        LAS float* w3s = (LAS float*)(F.lds + 2 * 64 * 65 * 4);
        for (int ck = 0; ck < 8; ++ck) {
            __syncthreads();
#pragma unroll 4
            for (int i = F.tid; i < 64 * 64; i += NTHR) { const int jr = i >> 6, c4 = (i & 63) * 4; *(LAS f32x4*)(w3s + jr * 256 + c4) = *(const GAS f32x4*)(w3 + (size_t)jr * 2048 + ck * 256 + c4); }
            __syncthreads();
            f32x4 a[8];
#pragma unroll
            for (int q = 0; q < 8; ++q) a[q] = (f32x4){0.f, 0.f, 0.f, 0.f};
#pragma unroll 2
            for (int i = 0; i < 64; ++i) { const float hvi = h2[p * 65 + i]; const LAS f32x4* wr = (const LAS f32x4*)(w3s + i * 256 + jg * 32);
#pragma unroll
                for (int q = 0; q < 8; ++q) a[q] += wr[q] * hvi; }
#pragma unroll
            for (int q = 0; q < 8; ++q)
#pragma unroll
                for (int e = 0; e < 4; ++e) { const int col = ck * 256 + jg * 32 + q * 4 + e, ch = col & 511;
                    const float delta = fabsf(HY_MIN_DECAY + (HY_MAX_DECAY - HY_MIN_DECAY) * ((float)ch / 511.0f));
                    const float val = a[q][e] * __expf(-t * delta); const int n = n0 + p;
                    if (col & 512) dst[(size_t)col * Lq + ((Lq - n) & (Lq - 1))] = n == 0 ? 0.f : val;
                    else dst[(size_t)col * Lq + n] = val; }
        }
    }
}

struct EpiIn {
    static constexpr bool PERM = true, AFTER_DRAIN = false;
    GAS bf16* QK; GAS bf16* VT; GAS float* T32;
    __device__ __forceinline__ void operator()(pg8::f32x4 (&acc)[2][2][4][2], const pg8::Unit& u, int wr_, int wc_, int fr_, int fq_) const {
        int t_ = threadIdx.x; asm volatile("" : "+v"(t_));
        const int fr = t_ & 15, fq = (t_ >> 4) & 3, wc = (t_ >> 6) & 3, wr = t_ >> 8; (void)wr_; (void)wc_; (void)fr_; (void)fq_;
        const int row0 = u.pm * 256 + wr * 64 + fr, col0 = u.pn * 256 + wc * 32 + 8 * fq;
        if (u.type == 0) {
            const float sc = u.pn < 4 ? QSCALE : 1.0f;
#pragma unroll
            for (int ai = 0; ai < 2; ++ai)
#pragma unroll
                for (int m = 0; m < 4; ++m) { GAS bf16* rowp = QK + (size_t)(row0 + ai * 128 + m * 16) * 2048 + col0;
#pragma unroll
                    for (int bj = 0; bj < 2; ++bj) { const pg8::f32x4 v0 = acc[ai][bj][m][0] * sc, v1 = acc[ai][bj][m][1] * sc;
                        v4u w; w.x = pg8::cvt_pk_bf16(v0[0], v0[1]); w.y = pg8::cvt_pk_bf16(v0[2], v0[3]); w.z = pg8::cvt_pk_bf16(v1[0], v1[1]); w.w = pg8::cvt_pk_bf16(v1[2], v1[3]);
                        *(GAS v4u*)(rowp + bj * 128) = w; } }
        } else if (u.pm < 4) {
#pragma unroll
            for (int ai = 0; ai < 2; ++ai)
#pragma unroll
                for (int m = 0; m < 4; ++m) { GAS bf16* rowp = VT + (size_t)(row0 + ai * 128 + m * 16) * MT + col0;
#pragma unroll
                    for (int bj = 0; bj < 2; ++bj) { const pg8::f32x4 v0 = acc[ai][bj][m][0], v1 = acc[ai][bj][m][1];
                        v4u w; w.x = pg8::cvt_pk_bf16(v0[0], v0[1]); w.y = pg8::cvt_pk_bf16(v0[2], v0[3]); w.z = pg8::cvt_pk_bf16(v1[0], v1[1]); w.w = pg8::cvt_pk_bf16(v1[2], v1[3]);
                        *(GAS v4u*)(rowp + bj * 128) = w; } }
        } else {
#pragma unroll
            for (int ai = 0; ai < 2; ++ai)
#pragma unroll
                for (int m = 0; m < 4; ++m) { GAS float* rowp = T32 + (size_t)(row0 - 1024 + ai * 128 + m * 16) * MT + col0;
#pragma unroll
                    for (int bj = 0; bj < 2; ++bj) { *(GAS pg8::f32x4*)(rowp + bj * 128) = acc[ai][bj][m][0]; *(GAS pg8::f32x4*)(rowp + bj * 128 + 4) = acc[ai][bj][m][1]; } }
        }
    }
};
struct EpiRes {
    static constexpr bool PERM = false, AFTER_DRAIN = false;
    const GAS float* base_l; const GAS float* base_c; GAS float* out_l; GAS float* out_c; const GAS float* gate;
    __device__ __forceinline__ void operator()(pg8::f32x4 (&acc)[2][2][4][2], const pg8::Unit& u, int wr_, int wc_, int fr_, int fq_) const {
        int t_ = threadIdx.x; asm volatile("" : "+v"(t_));
        const int fr = t_ & 15, fq = (t_ >> 4) & 3, wc = (t_ >> 6) & 3, wr = t_ >> 8; (void)wr_; (void)wc_; (void)fr_; (void)fq_;
        const int row0 = u.pm * 256 + wr * 64 + fr, col0 = u.pn * 256 + wc * 32 + 4 * fq;
        const int s = u.pm < PML / 2 ? 0 : u.pm < PML ? 1 : 2;
        const GAS float* bs = u.pm < PML ? base_l + (size_t)row0 * DM : base_c + (size_t)(row0 - ML) * DM;
        GAS float* os = u.pm < PML ? out_l + (size_t)row0 * DM : out_c + (size_t)(row0 - ML) * DM;
        pg8::f32x4 gv[2][2];
#pragma unroll
        for (int bj = 0; bj < 2; ++bj)
#pragma unroll
            for (int n = 0; n < 2; ++n) gv[bj][n] = *(const GAS pg8::f32x4*)(gate + (size_t)s * (NMOD * DM) + col0 + bj * 128 + n * 16);
#pragma unroll
        for (int ai = 0; ai < 2; ++ai)
#pragma unroll
            for (int m = 0; m < 4; ++m) { const size_t off = (size_t)(ai * 128 + m * 16) * DM + col0;
#pragma unroll
                for (int bj = 0; bj < 2; ++bj)
#pragma unroll
                    for (int n = 0; n < 2; ++n) { const pg8::f32x4 b = *(const GAS pg8::f32x4*)(bs + off + bj * 128 + n * 16);
                        *(GAS pg8::f32x4*)(os + off + bj * 128 + n * 16) = b + gv[bj][n] * acc[ai][bj][m][n]; }
                asm volatile("" ::: "memory"); }
    }
};
struct EpiUp {
    static constexpr bool PERM = true, AFTER_DRAIN = false;
    GAS bf16* HID; GAS float* EG; GAS float* EP; GAS float* EU; const GAS float* cw; const GAS float* cb;
    __device__ __forceinline__ void operator()(pg8::f32x4 (&acc)[2][2][4][2], const pg8::Unit& u, int wr_, int wc_, int fr_, int fq_) const {
        int t_ = threadIdx.x; asm volatile("" : "+v"(t_));
        const int fr = t_ & 15, fq = (t_ >> 4) & 3, wc = (t_ >> 6) & 3, wr = t_ >> 8; (void)wr_; (void)wc_; (void)fr_; (void)fq_;
        const int lane = t_ & 63;
        const unsigned hc0 = (unsigned)(u.pn * 128 + wc * 32 + 8 * fq);
        const int src_prev = (lane & 48) | ((fr + 15) & 15), src_next = (lane & 48) | ((fr + 1) & 15);
        const bool e0 = fr == 0, e3 = fr == 15;
        __builtin_amdgcn_sched_barrier(0);
#pragma unroll
        for (int ai = 0; ai < 2; ++ai) {
            const int rbase = u.pm * 256 + ai * 128 + wr * 64;
            const unsigned eb0 = (unsigned)((rbase >> 6) << 1) * (unsigned)DFF, eb3 = eb0 + (unsigned)DFF;
#pragma unroll
            for (int n = 0; n < 2; ++n) {
                const unsigned hc = hc0 + 4u * (unsigned)n;
                const pg8::f32x4 w0 = *(const GAS pg8::f32x4*)&cw[hc], w1 = *(const GAS pg8::f32x4*)&cw[(unsigned)DFF + hc], w2 = *(const GAS pg8::f32x4*)&cw[2u * (unsigned)DFF + hc], bb = *(const GAS pg8::f32x4*)&cb[hc];
                if (e0) { *(GAS pg8::f32x4*)&EG[eb0 + hc] = acc[ai][0][0][n]; *(GAS pg8::f32x4*)&EU[eb0 + hc] = acc[ai][1][0][n]; }
                if (e3) { *(GAS pg8::f32x4*)&EG[eb3 + hc] = acc[ai][0][3][n]; *(GAS pg8::f32x4*)&EU[eb3 + hc] = acc[ai][1][3][n]; }
#pragma unroll
                for (int j = 0; j < 4; ++j) {
                    float pr[4], nx[4], gg[4];
#pragma unroll
                    for (int m = 0; m < 4; ++m) { gg[m] = acc[ai][0][m][n][j]; pr[m] = lane_read(gg[m], src_prev); nx[m] = lane_read(gg[m], src_next); }
#pragma unroll
                    for (int m = 0; m < 4; ++m) {
                        const float pv = fr > 0 ? pr[m] : (m > 0 ? pr[m > 0 ? m - 1 : 0] : 0.f);
                        const float nv = fr < 15 ? nx[m] : (m < 3 ? nx[m < 3 ? m + 1 : 3] : 0.f);
                        const float cv = w0[j] * pv + w1[j] * gg[m] + w2[j] * nv + bb[j];
                        if (m == 0) { if (e0) EP[eb0 + hc + (unsigned)j] = cv; } if (m == 3) { if (e3) EP[eb3 + hc + (unsigned)j] = cv; }
                        acc[ai][0][m][n][j] = gelu_tanh(cv) * acc[ai][1][m][n][j];
                    }
                }
                asm volatile("" ::: "memory"); __builtin_amdgcn_sched_barrier(0);
            }
#pragma unroll
            for (int m = 0; m < 4; ++m) {
                if (!((m == 0 && e0) || (m == 3 && e3))) {
                    const pg8::f32x4 v0 = acc[ai][0][m][0], v1 = acc[ai][0][m][1];
                    v4u w; w.x = pg8::cvt_pk_bf16(v0[0], v0[1]); w.y = pg8::cvt_pk_bf16(v0[2], v0[3]); w.z = pg8::cvt_pk_bf16(v1[0], v1[1]); w.w = pg8::cvt_pk_bf16(v1[2], v1[3]);
                    *(GAS v4u*)&HID[(unsigned)(rbase + m * 16 + fr) * (unsigned)DFF + hc0] = w;
                }
            }
        }
    }
};
__device__ __forceinline__ void edge_fix_phase(Frame& F, int l, bool with_ctx) {
    const GAS float* EG = WSP(float, WS_EDGE); const GAS float* EP = EG + EDGE_ELEMS; const GAS float* EU = EP + EDGE_ELEMS;
    const GAS float* cw = IN(ffn_conv_w) + (size_t)l * 3 * DFF;
    GAS bf16* HID = WSP(bf16, WS_HID);
    const int ne = with_ctx ? NEDGE : ML / 64 * 2, total = ne * (DFF / 4);
    for (int i = F.vcu * NTHR + F.tid; i < total; i += F.G * NTHR) {
        const int e = i / (DFF / 4), c = (i % (DFF / 4)) * 4;
        const int r = (e >> 1) * 64 + (e & 1) * 63;
        f32x4 p = *(const GAS f32x4*)(EP + (size_t)e * DFF + c);
        if (e & 1) { const int nr = r + 1; if (nr != SEQ && nr != ML && nr != ML + CTXL && nr != MT) p += *(const GAS f32x4*)(cw + 2 * DFF + c) * *(const GAS f32x4*)(EG + (size_t)(e + 1) * DFF + c); }
        else { if (r != 0 && r != SEQ && r != ML && r != ML + CTXL) p += *(const GAS f32x4*)(cw + c) * *(const GAS f32x4*)(EG + (size_t)(e - 1) * DFF + c); }
        const f32x4 up = *(const GAS f32x4*)(EU + (size_t)e * DFF + c);
        v2u o; o.x = pk2(gelu_tanh(p.x) * up.x, gelu_tanh(p.y) * up.y); o.y = pk2(gelu_tanh(p.z) * up.z, gelu_tanh(p.w) * up.w);
        *(GAS v2u*)(HID + (size_t)r * DFF + c) = o;
    }
}

#define MFMA16(a, b, c) __builtin_amdgcn_mfma_f32_16x16x32_bf16((a), (b), (c), 0, 0, 0)
struct AttnChunk { bf16x8 kf[2][4]; bf16x8 vf[8]; };
__device__ __forceinline__ void attn_load(AttnChunk& C, const GAS bf16* kbase  , const GAS bf16* vbase  , int q, int g) {
#pragma unroll
    for (int T = 0; T < 2; ++T) { const int kk = 8 * (q >> 2) + 4 * T + (q & 3);
#pragma unroll
        for (int dc = 0; dc < 4; ++dc) C.kf[T][dc] = *(const GAS bf16x8*)(kbase + (size_t)kk * 2048 + 32 * dc + 8 * g); }
#pragma unroll
    for (int dt = 0; dt < 8; ++dt) C.vf[dt] = *(const GAS bf16x8*)(vbase + (size_t)(16 * dt + q) * MT + 8 * g);
}
__device__ __forceinline__ void attn_compute(const AttnChunk& C, const bf16x8 (&qf)[4], f32x4 (&o)[8], float& mrun, float& lsum, int lane, int g,
                                             bool masked, int keycol0, int cs, const LAS float* brow  , int cq) {
    f32x4 s[2];
#pragma unroll
    for (int T = 0; T < 2; ++T) { s[T] = (f32x4){0.f, 0.f, 0.f, 0.f};
#pragma unroll
        for (int dc = 0; dc < 4; ++dc) s[T] = MFMA16(C.kf[T][dc], qf[dc], s[T]); }
    if (masked) {
#pragma unroll
        for (int T = 0; T < 2; ++T)
#pragma unroll
            for (int i = 0; i < 4; ++i) { const int keycol = keycol0 + 8 * g + 4 * T + i; const bool ok = keycol >= cs && keycol < cs + 16;
                const int dcol = keycol - cq + 15; const float bv = brow[ok ? dcol : 0];
                s[T][i] = ok ? s[T][i] + bv : -1e30f; }
    }
    float cm = fmaxf(fmaxf(fmaxf(s[0][0], s[0][1]), fmaxf(s[0][2], s[0][3])), fmaxf(fmaxf(s[1][0], s[1][1]), fmaxf(s[1][2], s[1][3])));
    cm = fmaxf(cm, lane_read(cm, lane ^ 16)); cm = fmaxf(cm, lane_read(cm, lane ^ 32));
    const float mnew = fmaxf(mrun, cm), alpha = __builtin_amdgcn_exp2f(mrun - mnew);
    mrun = mnew;
    float p[8]; float ps = 0.f;
#pragma unroll
    for (int T = 0; T < 2; ++T)
#pragma unroll
        for (int i = 0; i < 4; ++i) { p[4 * T + i] = __builtin_amdgcn_exp2f(s[T][i] - mnew); ps += p[4 * T + i]; }
    lsum = lsum * alpha + ps;
    v4u pw; pw.x = pg8::cvt_pk_bf16(p[0], p[1]); pw.y = pg8::cvt_pk_bf16(p[2], p[3]); pw.z = pg8::cvt_pk_bf16(p[4], p[5]); pw.w = pg8::cvt_pk_bf16(p[6], p[7]);
    const bf16x8 pf = __builtin_bit_cast(bf16x8, pw);
#pragma unroll
    for (int dt = 0; dt < 8; ++dt) { o[dt] = o[dt] * alpha; o[dt] = MFMA16(C.vf[dt], pf, o[dt]); }
}
__device__ __forceinline__ void attn_tile(Frame& F, bool is_lat, int b, int h, int r, int c0, int qrow0, const LAS float* bias_h) {
    const GAS bf16* QK = WSP(bf16, WS_QK); const GAS bf16* VT = WSP(bf16, WS_VT); GAS bf16* A = WSP(bf16, WS_A);
    const int q = F.lane & 15, g = F.lane >> 4;
    bf16x8 qf[4];
    { const GAS bf16* qp = QK + (size_t)(qrow0 + q) * 2048 + h * 128 + 8 * g;
#pragma unroll
      for (int dc = 0; dc < 4; ++dc) qf[dc] = *(const GAS bf16x8*)(qp + 32 * dc); }
    f32x4 o[8];
#pragma unroll
    for (int dt = 0; dt < 8; ++dt) o[dt] = (f32x4){0.f, 0.f, 0.f, 0.f};
    float mrun = -1e30f, lsum = 0.f;
    const int r0 = min(max(r - 4, 0), GROWS - 8), kc0 = min(max(c0 - 8, 0), 32), cq = c0 + q, cs = min(max(cq - 8, 0), 48);
    const GAS bf16* kh = QK + 1024 + h * 128; const GAS bf16* vh = VT + (size_t)(h * 128) * MT;
#define ATT_TOK(c) ((c) < 8 ? b * SEQ + (r0 + (c)) * GRIDW + kc0 : ML + b * CTXL + 32 * ((c) - 8))
#define ATT_LOAD(C, c) do { const int tok_ = ATT_TOK(c); attn_load(C, kh + (size_t)tok_ * 2048, vh + tok_, q, g); } while (0)
#define ATT_COMP(C, c) attn_compute(C, qf, o, mrun, lsum, F.lane, g, (c) < 8, kc0, cs, bias_h + (r0 + ((c) < 8 ? (c) : 0) - r + 7) * 31, cq)
    AttnChunk CA, CB;
    const int cbeg = is_lat ? 0 : 8;
    ATT_LOAD(CA, cbeg);
    for (int c = cbeg; c < 16; c += 2) {
        ATT_LOAD(CB, c + 1); __builtin_amdgcn_sched_barrier(0);
        ATT_COMP(CA, c); __builtin_amdgcn_sched_barrier(0);
        if (c + 2 < 16) ATT_LOAD(CA, c + 2);
        __builtin_amdgcn_sched_barrier(0);
        ATT_COMP(CB, c + 1); __builtin_amdgcn_sched_barrier(0);
    }
#undef ATT_TOK
#undef ATT_LOAD
#undef ATT_COMP
    lsum += lane_read(lsum, F.lane ^ 16); lsum += lane_read(lsum, F.lane ^ 32);
    const float inv = 1.0f / lsum;
    GAS bf16* ap = A + (size_t)(qrow0 + q) * 1024 + h * 128 + 4 * g;
#pragma unroll
    for (int dt = 0; dt < 8; ++dt) { v2u w; w.x = pg8::cvt_pk_bf16(o[dt][0] * inv, o[dt][1] * inv); w.y = pg8::cvt_pk_bf16(o[dt][2] * inv, o[dt][3] * inv); *(GAS v2u*)(ap + 16 * dt) = w; }
}
__device__ __forceinline__ void attn_phase(Frame& F, int l, bool with_ctx) {
    LAS float* bias = (LAS float*)(F.lds + XTRA_OFF);
    const GAS float* p_rpb = IN(na_rpb) + (size_t)l * NHEAD * 465;
    for (int i = F.tid; i < NHEAD * 465; i += NTHR) bias[i] = p_rpb[i] * LOG2E;
    __syncthreads();
    const int gw = F.vcu * NWAVES + F.wave, NGW = F.G * NWAVES;
    for (int job = gw; job < 2048; job += NGW) {
        const int combo = job >> 5, rb = job & 31, b = combo >> 5, h = (combo >> 2) & 7, c0 = 16 * (combo & 3);
        for (int rr = 0; rr < 8; ++rr) { const int r = rb * 8 + rr; attn_tile(F, true, b, h, r, c0, b * SEQ + r * GRIDW + c0, bias + h * 465); }
    }
    if (with_ctx)
        for (int job = gw; job < 256; job += NGW) { const int b = job >> 7, h = (job >> 4) & 7, t = job & 15; attn_tile(F, false, b, h, 0, 0, ML + b * CTXL + 16 * t, bias + h * 465); }
    __syncthreads();
}

constexpr int FFTN = 16384, FFT_PHYS = FFTN + FFTN / 16;
__device__ __forceinline__ int phys(int i) { return i + ((i >> 6) << 2); }
__device__ __forceinline__ f32x2 tw32k(const LAS f32x2* TH, const LAS f32x2* TL, int n) { return cmul(TH[n >> 7], TL[n & 127]); }
template <bool INV> __device__ __forceinline__ void r4(f32x2& x0, f32x2& x1, f32x2& x2, f32x2& x3) {
    const f32x2 a = x0 + x2, c = x0 - x2, b = x1 + x3, e = x1 - x3;
    const f32x2 d = INV ? (f32x2){-e.y, e.x} : (f32x2){e.y, -e.x};
    x0 = a + b; x1 = c + d; x2 = a - b; x3 = c - d;
}
template <bool INV> __device__ __forceinline__ void dft16(f32x2 (&x)[16]) {
#pragma unroll
    for (int b = 0; b < 4; ++b) r4<INV>(x[b], x[4 + b], x[8 + b], x[12 + b]);
    const float sg = INV ? -1.f : 1.f;
    const f32x2 W1 = {0.92387953251f, -0.38268343236f * sg}, W2 = {0.70710678118f, -0.70710678118f * sg}, W3 = {0.38268343236f, -0.92387953251f * sg},
                W4 = {0.f, -1.f * sg}, W6 = {-0.70710678118f, -0.70710678118f * sg}, W9 = {-0.92387953251f, 0.38268343236f * sg};
    x[5] = cmul(x[5], W1); x[9] = cmul(x[9], W2); x[13] = cmul(x[13], W3);
    x[6] = cmul(x[6], W2); x[10] = cmul(x[10], W4); x[14] = cmul(x[14], W6);
    x[7] = cmul(x[7], W3); x[11] = cmul(x[11], W6); x[15] = cmul(x[15], W9);
#pragma unroll
    for (int c = 0; c < 4; ++c) r4<INV>(x[4 * c], x[4 * c + 1], x[4 * c + 2], x[4 * c + 3]);
}
template <bool INV> __device__ __forceinline__ void bfly16(f32x2 (&x)[16], const LAS f32x2* TH, const LAS f32x2* TL, int tw) {
    f32x2 W = tw32k(TH, TL, tw); if (INV) W.y = -W.y;
    if (INV) { f32x2 p = W;
#pragma unroll
        for (int q = 1; q < 16; ++q) { x[q] = cmul(x[q], p); if (q < 15) p = cmul(p, W); } }
    dft16<INV>(x);
    if (!INV) { f32x2 p = W;
#pragma unroll
        for (int r = 1; r < 16; ++r) { x[4 * (r & 3) + (r >> 2)] = cmul(x[4 * (r & 3) + (r >> 2)], p); if (r < 15) p = cmul(p, W); } }
}
template <bool INV> __device__ __forceinline__ void pass16(LAS f32x2* X, const LAS f32x2* TH, const LAS f32x2* TL, int base, int stride, int tw) {
    f32x2 x[16];
#pragma unroll
    for (int q = 0; q < 16; ++q) x[q] = X[base + q * stride];
    bfly16<INV>(x, TH, TL, tw);
#pragma unroll
    for (int c = 0; c < 4; ++c)
#pragma unroll
        for (int d = 0; d < 4; ++d) X[base + (c + 4 * d) * stride] = x[4 * c + d];
}
template <bool INV> __device__ __forceinline__ void pass16_s4(LAS f32x2* X, const LAS f32x2* TH, const LAS f32x2* TL, int blk, int h) {
    LAS f32x4* P = (LAS f32x4*)(X + blk * 68 + 2 * h);
    f32x2 xa[16], xb[16];
#pragma unroll
    for (int q = 0; q < 16; ++q) { const f32x4 v = P[2 * q]; xa[q] = (f32x2){v.x, v.y}; xb[q] = (f32x2){v.z, v.w}; }
    bfly16<INV>(xa, TH, TL, (2 * h) * 512); bfly16<INV>(xb, TH, TL, (2 * h + 1) * 512);
#pragma unroll
    for (int c = 0; c < 4; ++c)
#pragma unroll
        for (int d = 0; d < 4; ++d) P[2 * (c + 4 * d)] = (f32x4){xa[4 * c + d].x, xa[4 * c + d].y, xb[4 * c + d].x, xb[4 * c + d].y};
}
template <bool INV> __device__ __forceinline__ void pass4_s1(LAS f32x2* X, int b) {
    LAS f32x4* P = (LAS f32x4*)(X + 4 * b + ((b >> 4) << 2));
    const f32x4 u = P[0], v = P[1];
    f32x2 x0 = {u.x, u.y}, x1 = {u.z, u.w}, x2 = {v.x, v.y}, x3 = {v.z, v.w};
    r4<INV>(x0, x1, x2, x3);
    P[0] = (f32x4){x0.x, x0.y, x1.x, x1.y}; P[1] = (f32x4){x2.x, x2.y, x3.x, x3.y};
}
__device__ __forceinline__ void fft_fwd(LAS f32x2* X, const LAS f32x2* TH, const LAS f32x2* TL, int tid) {
#pragma unroll 1
    for (int i = 0; i < 2; ++i) { const int j = tid + NTHR * i; pass16<false>(X, TH, TL, j + ((j >> 6) << 2), 1088, 2 * j); }
    __syncthreads();
#pragma unroll 1
    for (int i = 0; i < 2; ++i) { const int b = tid + NTHR * i, j = b & 63, blk = b >> 6; pass16<false>(X, TH, TL, blk * 1088 + j, 68, 32 * j); }
    __syncthreads();
    pass16_s4<false>(X, TH, TL, tid >> 1, tid & 1);
    __syncthreads();
#pragma unroll 2
    for (int i = 0; i < 8; ++i) pass4_s1<false>(X, tid + NTHR * i);
    __syncthreads();
}
__device__ __forceinline__ void fft_inv(LAS f32x2* X, const LAS f32x2* TH, const LAS f32x2* TL, int tid) {
#pragma unroll 2
    for (int i = 0; i < 8; ++i) pass4_s1<true>(X, tid + NTHR * i);
    __syncthreads();
    pass16_s4<true>(X, TH, TL, tid >> 1, tid & 1);
    __syncthreads();
#pragma unroll 1
    for (int i = 0; i < 2; ++i) { const int b = tid + NTHR * i, j = b & 63, blk = b >> 6; pass16<true>(X, TH, TL, blk * 1088 + j, 68, 32 * j); }
    __syncthreads();
#pragma unroll 1
    for (int i = 0; i < 2; ++i) { const int j = tid + NTHR * i; pass16<true>(X, TH, TL, j + ((j >> 6) << 2), 1088, 2 * j); }
    __syncthreads();
}
__device__ __forceinline__ int freq_pos(int k) { return phys(((k & 15) << 10) | (((k >> 4) & 15) << 6) | (((k >> 8) & 15) << 2) | (k >> 12)); }

__device__ __forceinline__ float conv3(const GAS float* p, int n, int Lq, float w0, float w1, float w2, float bb) {
    float a = p[n] * w1 + bb; if (n > 0) a += p[n - 1] * w0; if (n < Lq - 1) a += p[n + 1] * w2; return a;
}
__device__ __forceinline__ f32x4 conv3v(const GAS float* p, int n0, int Lq, float w0, float w1, float w2, float bb) {
    const f32x4 c = *(const GAS f32x4*)(p + n0); const float l = n0 > 0 ? p[n0 - 1] : 0.f, r = n0 + 4 < Lq ? p[n0 + 4] : 0.f;
    return (f32x4){w0 * l + w1 * c.x + w2 * c.y + bb, w0 * c.x + w1 * c.y + w2 * c.z + bb, w0 * c.y + w1 * c.z + w2 * c.w + bb, w0 * c.z + w1 * c.w + w2 * r + bb};
}
__device__ __forceinline__ void tw4(const LAS f32x2* TH, const LAS f32x2* TL, int n0, f32x2 (&w)[4]) {
    const f32x2 th = TH[n0 >> 7]; const LAS f32x4* tl = (const LAS f32x4*)(TL + (n0 & 127)); const f32x4 a = tl[0], b = tl[1];
    w[0] = cmul(th, (f32x2){a.x, a.y}); w[1] = cmul(th, (f32x2){a.z, a.w}); w[2] = cmul(th, (f32x2){b.x, b.y}); w[3] = cmul(th, (f32x2){b.z, b.w});
}

#define LT() ({ int lt_ = tid; asm volatile("" : "+v"(lt_)); lt_; })
__device__ __forceinline__ void hyena_latent(Frame& F, int l, int ch, LAS f32x2* X, const LAS f32x2* TH, const LAS f32x2* TL, GAS f32x2* KS) {
    GAS float* T32 = WSP(float, WS_T32);
    GAS float* hv = T32 + (size_t)(512 + ch) * MT; const GAS float* hx1 = T32 + (size_t)(1024 + ch) * MT; const GAS float* hx2 = T32 + (size_t)(1536 + ch) * MT;
    const GAS float* cw = IN(hy_conv_w) + (size_t)l * 3 * 1536; const GAS float* cb = IN(hy_conv_b) + (size_t)l * 1536;
    const GAS float* HF = WSP(float, WS_HF); const GAS float* p_hb = IN(hy_bias) + (size_t)l * 2 * HYW + ch;
    const int tid = F.tid;
    GAS f32x4* KS4 = (GAS f32x4*)KS; GAS f32x4* KE4 = KS4 + FFTN / 2;
    for (int o = 0; o < 2; ++o) {
        const GAS float* hf = HF + (size_t)(o * 1024 + ch) * SEQ; const GAS float* hbr = HF + (size_t)(o * 1024 + 512 + ch) * SEQ;
        const float bias = p_hb[o * HYW];
        const float vw0 = cw[ch], vw1 = cw[1536 + ch], vw2 = cw[3072 + ch], vbb = cb[ch];
        const GAS float* hx = o == 0 ? hx1 : hx2; const int xo = o == 0 ? 512 : 1024;
        const float xw0 = cw[xo + ch], xw1 = cw[1536 + xo + ch], xw2 = cw[3072 + xo + ch], xbb = cb[xo + ch];
        for (int par = 0; par < 2; ++par) {
#pragma unroll
            for (int i = 0; i < 8; ++i) { const int g = LT() + NTHR * i, n0 = 4 * g; const f32x4 f = *(const GAS f32x4*)(hf + n0), bk = *(const GAS f32x4*)(hbr + n0);
                LAS f32x4* XP = (LAS f32x4*)(X + phys(n0));
                if (par == 0) { XP[0] = (f32x4){f.x + bk.x, 0.f, f.y + bk.y, 0.f}; XP[1] = (f32x4){f.z + bk.z, 0.f, f.w + bk.w, 0.f}; }
                else { f32x2 w[4]; tw4(TH, TL, n0, w); const f32x4 d = f - bk;
                    XP[0] = (f32x4){w[0].x * d.x, w[0].y * d.x, w[1].x * d.y, w[1].y * d.y}; XP[1] = (f32x4){w[2].x * d.z, w[2].y * d.z, w[3].x * d.w, w[3].y * d.w}; } }
            __syncthreads();
            fft_fwd(X, TH, TL, tid);
#pragma unroll
            for (int i = 0; i < 8; ++i) { const int g = LT() + NTHR * i; const LAS f32x4* XP = (const LAS f32x4*)(X + phys(4 * g)); KS4[2 * g] = XP[0]; KS4[2 * g + 1] = XP[1]; }
            __syncthreads();
#pragma unroll 4
            for (int i = 0; i < 8; ++i) { const int g = LT() + NTHR * i, n0 = 4 * g;
                f32x4 z0, z1; if (o == 0) { z0 = conv3v(hv, n0, SEQ, vw0, vw1, vw2, vbb); z1 = conv3v(hv + SEQ, n0, SEQ, vw0, vw1, vw2, vbb); } else { z0 = *(const GAS f32x4*)(hv + n0); z1 = *(const GAS f32x4*)(hv + SEQ + n0); }
                LAS f32x4* XP = (LAS f32x4*)(X + phys(n0));
                if (par == 0) { XP[0] = (f32x4){z0.x, z1.x, z0.y, z1.y}; XP[1] = (f32x4){z0.z, z1.z, z0.w, z1.w}; }
                else { f32x2 w[4]; tw4(TH, TL, n0, w);
                    const f32x2 a0 = cmul((f32x2){z0.x, z1.x}, w[0]), a1 = cmul((f32x2){z0.y, z1.y}, w[1]), a2 = cmul((f32x2){z0.z, z1.z}, w[2]), a3 = cmul((f32x2){z0.w, z1.w}, w[3]);
                    XP[0] = (f32x4){a0.x, a0.y, a1.x, a1.y}; XP[1] = (f32x4){a2.x, a2.y, a3.x, a3.y}; } }
            __syncthreads();
            fft_fwd(X, TH, TL, tid);
#pragma unroll 4
            for (int i = 0; i < 8; ++i) { const int g = LT() + NTHR * i; LAS f32x4* XP = (LAS f32x4*)(X + phys(4 * g)); const f32x4 k0 = KS4[2 * g], k1 = KS4[2 * g + 1], u0 = XP[0], u1 = XP[1];
                const f32x2 a0 = cmul((f32x2){u0.x, u0.y}, (f32x2){k0.x, k0.y}), a1 = cmul((f32x2){u0.z, u0.w}, (f32x2){k0.z, k0.w}), a2 = cmul((f32x2){u1.x, u1.y}, (f32x2){k1.x, k1.y}), a3 = cmul((f32x2){u1.z, u1.w}, (f32x2){k1.z, k1.w});
                XP[0] = (f32x4){a0.x, a0.y, a1.x, a1.y}; XP[1] = (f32x4){a2.x, a2.y, a3.x, a3.y}; }
            __syncthreads();
            fft_inv(X, TH, TL, tid);
            if (par == 0) {
#pragma unroll
                for (int i = 0; i < 8; ++i) { const int g = LT() + NTHR * i; const LAS f32x4* XP = (const LAS f32x4*)(X + phys(4 * g)); KE4[2 * g] = XP[0]; KE4[2 * g + 1] = XP[1]; }
                __syncthreads();
            }
        }
#pragma unroll 4
        for (int i = 0; i < 8; ++i) { const int g = LT() + NTHR * i, n0 = 4 * g;
            f32x4 z0, z1; if (o == 0) { z0 = conv3v(hv, n0, SEQ, vw0, vw1, vw2, vbb); z1 = conv3v(hv + SEQ, n0, SEQ, vw0, vw1, vw2, vbb); } else { z0 = *(const GAS f32x4*)(hv + n0); z1 = *(const GAS f32x4*)(hv + SEQ + n0); }
            const f32x4 g0 = conv3v(hx, n0, SEQ, xw0, xw1, xw2, xbb), g1 = conv3v(hx + SEQ, n0, SEQ, xw0, xw1, xw2, xbb);
            const f32x4 e0 = KE4[2 * g], e1 = KE4[2 * g + 1];
            LAS f32x4* XP = (LAS f32x4*)(X + phys(n0)); const f32x4 u0 = XP[0], u1 = XP[1];
            f32x2 w[4]; tw4(TH, TL, n0, w);
            const f32x2 c0 = cmul((f32x2){u0.x, u0.y}, cconj(w[0])), c1 = cmul((f32x2){u0.z, u0.w}, cconj(w[1])), c2 = cmul((f32x2){u1.x, u1.y}, cconj(w[2])), c3 = cmul((f32x2){u1.z, u1.w}, cconj(w[3]));
            const float sc = 1.0f / 32768.0f;
            const f32x2 y0 = ((f32x2){e0.x, e0.y} + c0) * sc + (f32x2){z0.x, z1.x} * bias, y1 = ((f32x2){e0.z, e0.w} + c1) * sc + (f32x2){z0.y, z1.y} * bias,
                        y2 = ((f32x2){e1.x, e1.y} + c2) * sc + (f32x2){z0.z, z1.z} * bias, y3 = ((f32x2){e1.z, e1.w} + c3) * sc + (f32x2){z0.w, z1.w} * bias;
            XP[0] = (f32x4){g0.x * y0.x, g0.y * y1.x, g0.z * y2.x, g0.w * y3.x};
            XP[1] = (f32x4){g1.x * y0.y, g1.y * y1.y, g1.z * y2.y, g1.w * y3.y}; }
        __syncthreads();
#pragma unroll
        for (int i = 0; i < 8; ++i) { const int g = LT() + NTHR * i, n0 = 4 * g; const LAS f32x4* XP = (const LAS f32x4*)(X + phys(n0)); *(GAS f32x4*)(hv + n0) = XP[0]; *(GAS f32x4*)(hv + SEQ + n0) = XP[1]; }
        __syncthreads();
    }
}
__device__ __forceinline__ void fourier_latent(Frame& F, int b, int gq, int m, LAS f32x2* X, const LAS f32x2* TH, const LAS f32x2* TL) {
    GAS float* T32 = WSP(float, WS_T32);
    GAS float* ra = T32 + (size_t)(gq * 128 + m) * MT + b * SEQ; GAS float* rb = T32 + (size_t)(gq * 128 + 64 + m) * MT + b * SEQ;
    const int tid = F.tid;
#pragma unroll
    for (int i = 0; i < 8; ++i) { const int g = LT() + NTHR * i, n0 = 4 * g; const f32x4 a = *(const GAS f32x4*)(ra + n0), c = *(const GAS f32x4*)(rb + n0);
        LAS f32x4* XP = (LAS f32x4*)(X + phys(n0)); XP[0] = (f32x4){a.x, c.x, a.y, c.y}; XP[1] = (f32x4){a.z, c.z, a.w, c.w}; }
    __syncthreads();
    fft_fwd(X, TH, TL, tid);
    const float sc = 6.9053396600248786e-4f;
#pragma unroll 2
    for (int i = 0; i < 8; ++i) { const int g = LT() + NTHR * i, k0 = 4 * g; f32x4 oa, ob;
#pragma unroll
        for (int e = 0; e < 4; ++e) { const int k = k0 + e; const f32x2 u = X[freq_pos(k)], v = X[freq_pos((FFTN - k) & (FFTN - 1))];
            if (m != 0) { oa[e] = u.x * sc; ob[e] = v.x * sc; } else { oa[e] = (u.x + v.x) * (0.5f * sc); ob[e] = (u.y + v.y) * (0.5f * sc); } }
        *(GAS f32x4*)(ra + k0) = oa; *(GAS f32x4*)(rb + k0) = ob; }
    __syncthreads();
}
__device__ __forceinline__ void hyena_ctx(Frame& F, int l, int ch, LAS float* S) {
    GAS float* T32 = WSP(float, WS_T32);
    GAS float* hv = T32 + (size_t)(512 + ch) * MT + ML; const GAS float* hx1 = T32 + (size_t)(1024 + ch) * MT + ML; const GAS float* hx2 = T32 + (size_t)(1536 + ch) * MT + ML;
    const GAS float* cw = IN(hy_conv_w) + (size_t)l * 3 * 1536; const GAS float* cb = IN(hy_conv_b) + (size_t)l * 1536;
    const GAS float* HFC = WSP(float, WS_HFC); const GAS float* p_hb = IN(hy_bias) + (size_t)l * 2 * HYW + ch;
    LAS float* zb = S; LAS float* hfl = S + 512; LAS float* hbl = S + 768;
    const int n = F.tid & 255, b = F.tid >> 8;
    __syncthreads();
    zb[b * 256 + n] = conv3(hv + b * CTXL, n, CTXL, cw[ch], cw[1536 + ch], cw[3072 + ch], cb[ch]);
    for (int o = 0; o < 2; ++o) {
        if (F.tid < 256) hfl[n] = HFC[(size_t)(o * 1024 + ch) * CTXL + n]; else hbl[n] = HFC[(size_t)(o * 1024 + 512 + ch) * CTXL + n];
        __syncthreads();
        float y = 0.f;
        for (int mI = 0; mI < CTXL; ++mI) { const int d = n - mI; y += zb[b * 256 + mI] * (d >= 0 ? hfl[d] : hbl[CTXL + d]); }
        y += p_hb[o * HYW] * zb[b * 256 + n];
        const GAS float* hx = o == 0 ? hx1 : hx2; const int xo = o == 0 ? 512 : 1024;
        const float r = conv3(hx + b * CTXL, n, CTXL, cw[xo + ch], cw[1536 + xo + ch], cw[3072 + xo + ch], cb[xo + ch]) * y;
        __syncthreads();
        if (o == 0) zb[b * 256 + n] = r; else hv[b * CTXL + n] = r;
        __syncthreads();
    }
}
__device__ __forceinline__ void fourier_ctx(Frame& F, int item, LAS float* S) {
    GAS float* T32 = WSP(float, WS_T32);
    const int b = item >> 5, gq = (item >> 3) & 3, m0 = (item & 7) * 8;
    LAS float* cs = S; LAS float* re = S + 256; LAS float* im = S + 256 + 2048;
    __syncthreads();
    if (F.tid < 256) cs[F.tid] = cospif((float)F.tid * (1.0f / 128.0f));
    for (int i = F.tid; i < 8 * 256; i += NTHR) { const int mm = i >> 8, n = i & 255;
        re[i] = T32[(size_t)(gq * 128 + m0 + mm) * MT + ML + b * CTXL + n]; im[i] = T32[(size_t)(gq * 128 + 64 + m0 + mm) * MT + ML + b * CTXL + n]; }
    __syncthreads();
    const int k = F.tid & 255, mh = F.tid >> 8;
    const float sc = 5.5242717280199031e-3f;
    for (int mq = 0; mq < 4; ++mq) { const int mm = mh * 4 + mq, m = m0 + mm;
        float cr = 0.f, ci = 0.f, sr = 0.f, si = 0.f;
        for (int n = 0; n < 256; ++n) { const int ix = (k * n) & 255; const float c = cs[ix], sn = cs[(ix - 64) & 255]; const float a = re[mm * 256 + n], bq = im[mm * 256 + n];
            cr += a * c; ci += bq * c; sr += a * sn; si += bq * sn; }
        float oa, ob;
        if (m != 0) { oa = cr + si; ob = cr - si; } else { oa = cr; ob = ci; }
        T32[(size_t)(gq * 128 + m) * MT + ML + b * CTXL + k] = oa * sc; T32[(size_t)(gq * 128 + 64 + m) * MT + ML + b * CTXL + k] = ob * sc; }
    __syncthreads();
}
__device__ __forceinline__ void fft_phase(Frame& F, int l, bool with_ctx) {
    LAS f32x2* X = (LAS f32x2*)F.lds;
    LAS f32x2* TH = (LAS f32x2*)(F.lds + XTRA_OFF + 16384); LAS f32x2* TL = TH + 128;
    if (F.tid < 256) { const int a = F.tid & 127; const float fr = F.tid < 128 ? (float)(128 * a) * (1.0f / 16384.0f) : (float)a * (1.0f / 16384.0f);
        float sn, cn; sincospif(fr, &sn, &cn); (F.tid < 128 ? TH : TL)[a] = (f32x2){cn, -sn}; }
    __syncthreads();
    for (int ch = F.vcu; ch < HYW; ch += F.G) hyena_latent(F, l, ch, X, TH, TL, WSP(f32x2, WS_KS) + (size_t)F.vcu * 2 * FFTN);
    for (int fu = F.vcu; fu < 512; fu += F.G) fourier_latent(F, fu >> 8, (fu >> 6) & 3, fu & 63, X, TH, TL);
    if (with_ctx) {
        LAS float* S = (LAS float*)F.lds;
        for (int ch = F.vcu; ch < HYW; ch += F.G) hyena_ctx(F, l, ch, S);
        for (int it = F.vcu; it < 64; it += F.G) fourier_ctx(F, it, S);
    }
}

__device__ __forceinline__ void merge_phase(Frame& F, int l, bool with_ctx) {
    const GAS bf16* A = WSP(bf16, WS_A); const GAS float* T32 = WSP(float, WS_T32); GAS bf16* H = WSP(bf16, WS_H);
    const GAS float* gain = IN(mix_norm_g) + (size_t)l * DM;
    LAS float* tile = (LAS float*)F.lds;
    const int TI = with_ctx ? 65 : 64;
    for (int it = F.vcu; it < 512; it += F.G) {
        const int tok0 = it * TI;
        for (int tk = F.wave; tk < TI; tk += NWAVES) {
            const size_t row = (size_t)(tok0 + tk);
            const v4u r0 = *(const GAS v4u*)(A + row * 1024 + 8 * F.lane), r1 = *(const GAS v4u*)(A + row * 1024 + 512 + 8 * F.lane);
            float v[16];
            v[0] = bf2f(r0.x & 0xffff); v[1] = bf2f(r0.x >> 16); v[2] = bf2f(r0.y & 0xffff); v[3] = bf2f(r0.y >> 16); v[4] = bf2f(r0.z & 0xffff); v[5] = bf2f(r0.z >> 16); v[6] = bf2f(r0.w & 0xffff); v[7] = bf2f(r0.w >> 16);
            v[8] = bf2f(r1.x & 0xffff); v[9] = bf2f(r1.x >> 16); v[10] = bf2f(r1.y & 0xffff); v[11] = bf2f(r1.y >> 16); v[12] = bf2f(r1.z & 0xffff); v[13] = bf2f(r1.z >> 16); v[14] = bf2f(r1.w & 0xffff); v[15] = bf2f(r1.w >> 16);
            float ss = 0.f;
#pragma unroll
            for (int j = 0; j < 16; ++j) ss += v[j] * v[j];
            const float rstd = 1.0f / sqrtf(wave_sum(ss, F.lane) * (1.0f / NAW) + EPS);
            const f32x4 g0 = *(const GAS f32x4*)(gain + 8 * F.lane), g1 = *(const GAS f32x4*)(gain + 8 * F.lane + 4), g2 = *(const GAS f32x4*)(gain + 512 + 8 * F.lane), g3 = *(const GAS f32x4*)(gain + 512 + 8 * F.lane + 4);
            v4u o0, o1;
            o0.x = pk2(v[0] * rstd * g0.x, v[1] * rstd * g0.y); o0.y = pk2(v[2] * rstd * g0.z, v[3] * rstd * g0.w); o0.z = pk2(v[4] * rstd * g1.x, v[5] * rstd * g1.y); o0.w = pk2(v[6] * rstd * g1.z, v[7] * rstd * g1.w);
            o1.x = pk2(v[8] * rstd * g2.x, v[9] * rstd * g2.y); o1.y = pk2(v[10] * rstd * g2.z, v[11] * rstd * g2.w); o1.z = pk2(v[12] * rstd * g3.x, v[13] * rstd * g3.y); o1.w = pk2(v[14] * rstd * g3.z, v[15] * rstd * g3.w);
            *(GAS v4u*)(H + row * DM + 8 * F.lane) = o0; *(GAS v4u*)(H + row * DM + 512 + 8 * F.lane) = o1;
        }
        for (int grp = 0; grp < 2; ++grp) {
            __syncthreads();
            for (int c8 = F.wave * 64; c8 < F.wave * 64 + 64; c8 += 8) {
                float v[8], w[8];
#pragma unroll
                for (int u = 0; u < 8; ++u) { const GAS float* src = T32 + (size_t)(grp * 512 + c8 + u) * MT + tok0; v[u] = src[F.lane]; w[u] = (TI > 64 && F.lane == 0) ? src[64] : 0.f; }
#pragma unroll
                for (int u = 0; u < 8; ++u) { tile[(c8 + u) * 65 + F.lane] = v[u]; if (TI > 64 && F.lane == 0) tile[(c8 + u) * 65 + 64] = w[u]; }
            }
            __syncthreads();
            for (int tk = F.wave; tk < TI; tk += NWAVES) {
                float vv[8]; float ss = 0.f;
#pragma unroll
                for (int i = 0; i < 8; ++i) { const int chn = F.lane + 64 * i; int srow = chn;
                    if (grp == 0) { const int cc = chn & 127; srow = (chn & ~127) + (cc <= 64 ? cc : 192 - cc); }
                    vv[i] = tile[srow * 65 + tk]; ss += vv[i] * vv[i]; }
                const float rstd = 1.0f / sqrtf(wave_sum(ss, F.lane) * (1.0f / 512.0f) + EPS);
                GAS bf16* hp = H + (size_t)(tok0 + tk) * DM + NAW + grp * 512;
#pragma unroll
                for (int i = 0; i < 8; ++i) { const int chn = F.lane + 64 * i; hp[chn] = (bf16)f2bf(vv[i] * rstd * gain[NAW + grp * 512 + chn]); }
            }
        }
    }
}

#define REFRESH(F) do { int t_ = threadIdx.x; asm volatile("" : "+v"(t_)); F.tid = t_; F.lane = t_ & 63; F.wave = __builtin_amdgcn_readfirstlane(t_ >> 6); \
    GAS unsigned char* w_ = args.ws; asm volatile("" : "+s"(w_)); F.ws = w_; GAS float* o_ = args.out; asm volatile("" : "+s"(o_)); F.out = o_; } while (0)
#ifndef REP_P1
#define REP_P1 1
#endif
#ifndef REP_P6
#define REP_P6 1
#endif
#ifndef REP_ATT
#define REP_ATT 1
#endif
#ifndef REP_THIN
#define REP_THIN 1
#endif
__device__ __forceinline__ int opaque_int(int v) { asm volatile("" : "+s"(v)); return v; }
__global__ void __launch_bounds__(NTHR, 2) fwd_kernel(Args args) {
    extern __shared__ __attribute__((aligned(16))) unsigned char lds[];
    Frame F;
    F.lds = (LAS unsigned char*)lds;
    F.tid = threadIdx.x; F.lane = F.tid & 63; F.wave = __builtin_amdgcn_readfirstlane(F.tid >> 6);
    F.G = gridDim.x; { const int bx = blockIdx.x; F.vcu = (F.G % 8 == 0) ? (bx % 8) * (F.G / 8) + bx / 8 : bx; }
    F.ws = args.ws; F.out = args.out;
    volatile LAS unsigned* MISC = (volatile LAS unsigned*)(F.lds + MISC_OFF);
    for (int u = F.tid; u < 64; u += NTHR) MISC[u] = 0u;
    __syncthreads();
    XcdBarrier bar = xcd_barrier_post((unsigned*)(F.ws + WS_CTL) + CW_BAR, MISC + 8);
    LAS unsigned char* ring = F.lds;
#define GRID_BAR() do { unsigned* bp_ = bar.bar; unsigned bx_ = bar.x; asm volatile("" : "+s"(bp_), "+s"(bx_)); XcdBarrier b_ = bar; b_.bar = bp_; b_.x = bx_; xcd_barrier(b_); } while (0)


#if !defined(OFF_PA)
    REFRESH(F); pa_adaln(F); __syncthreads(); pa_weights(F);
#endif

    GRID_BAR();

    for (int l = 0; l < DEPTH; ++l) {
        const bool uc = l < DEPTH - 1;
        const int npm = uc ? PMT : PML;
        const GAS float* MODL = WSP(float, WS_MOD) + (size_t)l * 3 * (NMOD * DM);

#if !defined(OFF_P0)
        for (int rep = 0, nrep = opaque_int(REP_THIN); rep < nrep; ++rep) { REFRESH(F); norm_phase(F, l, 0, true); __syncthreads();
 REFRESH(F); filter_phase(F, l, uc); __syncthreads(); }
#endif

        GRID_BAR();
        {
            const char* Hb = (const char*)WSP(bf16, WS_H); const char* Wb = (const char*)(WSP(bf16, WS_WIN) + (size_t)l * DIN * DM);
            pg8::Sched2 S; S.n1 = PMT * 8; S.nM1 = PMT; S.nN1 = 8; S.n2 = 12 * PMT; S.nM2 = 12; S.nN2 = PMT; S.G = F.G; S.c = (int)blockIdx.x;
            S.A1 = Hb; S.B1 = Wb; S.A2 = Wb + (size_t)2048 * DM * 2; S.B2 = Hb; S.tstep = (size_t)256 * DM * 2;
            EpiIn E{WSP(bf16, WS_QK), WSP(bf16, WS_VT), WSP(float, WS_T32)};

#if !defined(OFF_P1)
            for (int rep = 0, nrep = opaque_int(REP_P1); rep < nrep; ++rep) { pg8::gemm_phase<EpiIn, pg8::Sched2, true, true>(ring, DM, S, E); __syncthreads(); }
#endif

        }
        GRID_BAR();

#if !defined(OFF_ATT)
        for (int rep = 0, nrep = opaque_int(REP_ATT); rep < nrep; ++rep) { REFRESH(F); attn_phase(F, l, uc); }
#endif
#if !defined(OFF_FFT)
        REFRESH(F); fft_phase(F, l, uc);
#endif

        GRID_BAR();

#if !defined(OFF_P3)
        for (int rep = 0, nrep = opaque_int(REP_THIN); rep < nrep; ++rep) { REFRESH(F); merge_phase(F, l, uc); __syncthreads(); }
#endif

        GRID_BAR();
        {
            pg8::Sched2 S; S.n1 = npm * 8; S.nM1 = npm; S.nN1 = 8; S.n2 = 0; S.nM2 = 1; S.nN2 = 1; S.G = F.G; S.c = (int)blockIdx.x;
            S.A1 = (const char*)WSP(bf16, WS_H); S.B1 = (const char*)(WSP(bf16, WS_WOUT) + (size_t)l * DM * DM); S.A2 = S.A1; S.B2 = S.B1; S.tstep = (size_t)256 * DM * 2;
            EpiRes E{l == 0 ? IN(x) : F.out, l == 0 ? IN(ctx) : WSP(float, WS_XC), F.out, WSP(float, WS_XC), MODL + 2 * DM};

#if !defined(OFF_P4)
            pg8::gemm_phase<EpiRes, pg8::Sched2, true, true>(ring, DM, S, E);
#endif

        }
        GRID_BAR();

#if !defined(OFF_P5)
        for (int rep = 0, nrep = opaque_int(REP_THIN); rep < nrep; ++rep) { REFRESH(F); norm_phase(F, l, 1, uc); }
#endif

        GRID_BAR();
        {
            pg8::Sched2 S; S.n1 = npm * 44; S.nM1 = npm; S.nN1 = 44; S.n2 = 0; S.nM2 = 1; S.nN2 = 1; S.G = F.G; S.c = (int)blockIdx.x;
            S.A1 = (const char*)WSP(bf16, WS_H); S.B1 = (const char*)(WSP(bf16, WS_WUP) + (size_t)l * 2 * DFF * DM); S.A2 = S.A1; S.B2 = S.B1; S.tstep = (size_t)256 * DM * 2;
            GAS float* EG = WSP(float, WS_EDGE);
            EpiUp E{WSP(bf16, WS_HID), EG, EG + EDGE_ELEMS, EG + 2 * EDGE_ELEMS, IN(ffn_conv_w) + (size_t)l * 3 * DFF, IN(ffn_conv_b) + (size_t)l * DFF};

#if !defined(OFF_P6)
            for (int rep = 0, nrep = opaque_int(REP_P6); rep < nrep; ++rep) { pg8::gemm_phase<EpiUp, pg8::Sched2, true, true>(ring, DM, S, E); __syncthreads(); }
#endif

        }
        GRID_BAR();

#if !defined(OFF_P6B)
        for (int rep = 0, nrep = opaque_int(REP_THIN); rep < nrep; ++rep) { REFRESH(F); edge_fix_phase(F, l, uc); }
#endif

        GRID_BAR();
        {
            pg8::Sched2 S; S.n1 = npm * 8; S.nM1 = npm; S.nN1 = 8; S.n2 = 0; S.nM2 = 1; S.nN2 = 1; S.G = F.G; S.c = (int)blockIdx.x;
            S.A1 = (const char*)WSP(bf16, WS_HID); S.B1 = (const char*)(WSP(bf16, WS_WDN) + (size_t)l * DM * DFF); S.A2 = S.A1; S.B2 = S.B1; S.tstep = (size_t)256 * DFF * 2;
            EpiRes E{F.out, WSP(float, WS_XC), F.out, WSP(float, WS_XC), MODL + 5 * DM};

#if !defined(OFF_P7)
            pg8::gemm_phase<EpiRes, pg8::Sched2, true, true>(ring, DFF, S, E);
#endif

        }
        GRID_BAR();
    }
    REFRESH(F); final_norm_phase(F);
}

extern "C" void kernel_launch(void* const* d_in, const int* in_sizes, int n_in, void* d_out, int out_size, void* d_ws, size_t ws_size, hipStream_t stream) {
    static int grid = 0;
    if (grid == 0) {
        if (n_in != 26 || in_sizes[0] != ML * DM || out_size != ML * DM || ws_size < WS_END) { fprintf(stderr, "kernel_launch: unexpected shapes (n_in %d, in0 %d, out %d, ws %zu < %zu)\n", n_in, n_in > 0 ? in_sizes[0] : -1, out_size, ws_size, (size_t)WS_END); grid = -1; return; }
        int dev = 0, cus = 0, per_cu = 0;
        if (hipGetDevice(&dev) != hipSuccess || hipDeviceGetAttribute(&cus, hipDeviceAttributeMultiprocessorCount, dev) != hipSuccess) { grid = -1; return; }
        if (hipFuncSetAttribute((const void*)fwd_kernel, hipFuncAttributeMaxDynamicSharedMemorySize, LDS_BYTES) != hipSuccess) { fprintf(stderr, "kernel_launch: hipFuncSetAttribute failed\n"); grid = -1; return; }
        if (hipOccupancyMaxActiveBlocksPerMultiprocessor(&per_cu, (const void*)fwd_kernel, NTHR, LDS_BYTES) != hipSuccess || per_cu < 1) { fprintf(stderr, "kernel_launch: occupancy query reports %d\n", per_cu); }
        (void)hipGetLastError();
        grid = cus;
    }
    if (grid < 0) return;
    if (hipMemsetAsync((char*)d_ws + WS_CTL, 0, CTL_ZERO_BYTES, stream) != hipSuccess) return;
    Args a{};
    for (int i = 0; i < 26; ++i) a.in[i] = (const GAS float*)d_in[i];
    a.out = (GAS float*)d_out; a.ws = (GAS unsigned char*)d_ws;
    hipLaunchKernelGGL(fwd_kernel, dim3(grid), dim3(NTHR), LDS_BYTES, stream, a);
}
```

```cpp
#include <hip/hip_runtime.h>
#include <cstdio>
#include <cstdint>
namespace pg8 {
#define PG8_LAS __attribute__((address_space(3)))
typedef unsigned short bf16_t;
typedef short bf16x8 __attribute__((ext_vector_type(8)));
typedef float f32x4 __attribute__((ext_vector_type(4)));
typedef unsigned u32x4 __attribute__((ext_vector_type(4)));
constexpr int BM = 256, BK = 64, HALF = 128, HTB = HALF * BK * 2  , STAGE_BYTES = 8 * HTB, NXCD = 8, WGM = 8;

__host__ __device__ __forceinline__ int lds_byte(int r, int c) { const int st = (r >> 4) * 2 + (c >> 5), rr = r & 15, cc = c & 31, ob = rr * 64 + cc * 2; return st * 1024 + (ob ^ (((ob >> 9) & 1) << 5)); }
__host__ __device__ __forceinline__ void stage_rc(int b, int& R, int& C) { const int st = b / 1024, sb = b % 1024, swz = sb ^ (((sb >> 9) & 1) << 5); R = (st >> 1) * 16 + swz / 64; C = (st & 1) * 32 + (swz % 64) / 2; }
__host__ __device__ __forceinline__ int perm32(int rho) { const int n = rho >> 4, i = rho & 15; return 8 * (i >> 2) + 4 * n + (i & 3); }

struct Unit { int pm, pn, type; };

__device__ __forceinline__ void map_unit(int w, int nwg, int nM, int nN, Unit& u) {
    { const int q = nwg / NXCD, r = nwg % NXCD, xcd = w % NXCD, off = w / NXCD; w = (xcd < r ? xcd * (q + 1) : r * (q + 1) + (xcd - r) * q) + off; }
    const int nig = WGM * nN, gid = w / nig, fm = gid * WGM, gsz = (nM - fm) < WGM ? (nM - fm) : WGM;
    u.pm = fm + ((w % nig) % gsz); u.pn = (w % nig) / gsz;
}
struct Sched2 {
    int n1, nM1, nN1, n2, nM2, nN2, G, c; const char *A1, *B1, *A2, *B2; size_t tstep;
    __device__ __forceinline__ bool next(int i, Unit& u) const {
        const long L = (long)i * G + c;
        if (L < n1) { map_unit((int)L, n1, nM1, nN1, u); u.type = 0; return true; }
        if (L < n1 + n2) { map_unit((int)L - n1, n2, nM2, nN2, u); u.type = 1; return true; }
        return false;
    }
    __device__ __forceinline__ const char* a_ptr(const Unit& u) const { return (u.type ? A2 : A1) + (size_t)u.pm * tstep; }
    __device__ __forceinline__ const char* b_ptr(const Unit& u) const { return (u.type ? B2 : B1) + (size_t)u.pn * tstep; }
    __device__ __forceinline__ void a_ready(const Unit&) const {}
    __device__ __forceinline__ void done(const Unit&) const {}
};

__device__ __forceinline__ unsigned cvt_pk_bf16(float lo, float hi) { unsigned r; asm volatile("v_cvt_pk_bf16_f32 %0, %1, %2" : "=v"(r) : "v"(lo), "v"(hi)); return r; }
typedef float f32x2 __attribute__((ext_vector_type(2)));

template <class Epi, class Sched, bool ALIGN_EPI = false, bool SP2 = false>
__device__ __forceinline__ void gemm_phase(PG8_LAS unsigned char* lds, const int Kdim, const Sched& S, const Epi& E) {
    int tid_ = threadIdx.x; asm volatile("" : "+v"(tid_));
    const int tid = tid_, wid = __builtin_amdgcn_readfirstlane(tid >> 6), lane = tid & 63, wr = wid >> 2, wc = wid & 3, fr = lane & 15, fq = lane >> 4;
    const int K = Kdim, nt = K / BK;
    unsigned voffA[2], voffB[2];
#pragma unroll
    for (int i = 0; i < 2; ++i) { int R, C; stage_rc(tid * 16 + i * 8192, R, C); const int Rb = Epi::PERM ? ((R & ~31) + perm32(R & 31)) : R;
        voffA[i] = (unsigned)(R * K + C) * 2u; voffB[i] = (unsigned)(Rb * K + C) * 2u; }
    const size_t kstep = (size_t)(BK * 2);
    const size_t hstep = (size_t)HALF * K * 2;
    const size_t tstep = 2 * hstep;
    const unsigned ldsw = (unsigned)wid * 1024u;
    const int aoff = lds_byte(wr * 64 + fr, fq * 8), boff = lds_byte(wc * 32 + fr, fq * 8);
#define PG8_SA(b, h) (((b) * 2 + (h)) * HTB)
#define PG8_SB(b, h) ((4 + (b) * 2 + (h)) * HTB)
#define PG8_STAGE(bufoff, gbase, voff) do { _Pragma("unroll") for (int _i = 0; _i < 2; ++_i) \
        __builtin_amdgcn_global_load_lds((const unsigned*)((const char*)(gbase) + (voff)[_i]), (PG8_LAS unsigned*)(lds + (bufoff) + ldsw + _i * 8192), 16, 0, 0); } while (0)
#define PG8_LDA(dst, b, h) do { _Pragma("unroll") for (int m = 0; m < 4; ++m) _Pragma("unroll") for (int k = 0; k < 2; ++k) dst[m][k] = *(const PG8_LAS bf16x8*)(lds + PG8_SA(b, h) + aoff + m * 2048 + k * 1024); } while (0)
#define PG8_LDB(dst, b, h) do { _Pragma("unroll") for (int n = 0; n < 2; ++n) _Pragma("unroll") for (int k = 0; k < 2; ++k) dst[n][k] = *(const PG8_LAS bf16x8*)(lds + PG8_SB(b, h) + boff + n * 2048 + k * 1024); } while (0)
#define PG8_MMA(ai, bj, At, Bt) do { __builtin_amdgcn_s_setprio(1); _Pragma("unroll") for (int m = 0; m < 4; ++m) _Pragma("unroll") for (int n = 0; n < 2; ++n) _Pragma("unroll") for (int k = 0; k < 2; ++k) \
        acc[ai][bj][m][n] = __builtin_amdgcn_mfma_f32_16x16x32_bf16(Bt[n][k], At[m][k], acc[ai][bj][m][n], 0, 0, 0); __builtin_amdgcn_s_setprio(0); } while (0)
#define PG8_WAIT_V(n) asm volatile("s_waitcnt vmcnt(" #n ")" ::: "memory")
#define PG8_WAIT_L(n) asm volatile("s_waitcnt lgkmcnt(" #n ")" ::: "memory")
#define PG8_BAR __builtin_amdgcn_s_barrier()
#define PG8_SCHED __builtin_amdgcn_sched_barrier(0)
    Unit cur, nxt; int ui = 0;
    if (!S.next(0, cur)) return;
    f32x4 acc[2][2][4][2];
#pragma unroll
    for (int a = 0; a < 2; ++a)
#pragma unroll
        for (int b = 0; b < 2; ++b)
#pragma unroll
            for (int m = 0; m < 4; ++m)
#pragma unroll
                for (int n = 0; n < 2; ++n) acc[a][b][m][n] = (f32x4){0.f, 0.f, 0.f, 0.f};
    bf16x8 At[4][2], B0[2][2], B1[2][2];
    const char* cA = S.a_ptr(cur); const char* cB = S.b_ptr(cur);
    S.a_ready(cur);
    if constexpr (SP2) {
        PG8_STAGE(PG8_SB(0, 0), cB, voffB); PG8_STAGE(PG8_SB(0, 1), cB + hstep, voffB); PG8_STAGE(PG8_SA(0, 0), cA, voffA); PG8_STAGE(PG8_SA(0, 1), cA + hstep, voffA);
        if (wr == 1) PG8_BAR;
        PG8_WAIT_V(2); PG8_BAR;
        PG8_STAGE(PG8_SB(1, 0), cB + kstep, voffB); PG8_STAGE(PG8_SA(1, 0), cA + kstep, voffA); PG8_STAGE(PG8_SB(1, 1), cB + hstep + kstep, voffB);
        PG8_WAIT_V(6); PG8_BAR;
    } else {
        PG8_STAGE(PG8_SB(0, 0), cB, voffB); PG8_STAGE(PG8_SA(0, 0), cA, voffA); PG8_STAGE(PG8_SB(0, 1), cB + hstep, voffB); PG8_STAGE(PG8_SA(0, 1), cA + hstep, voffA);
        if (wr == 1) PG8_BAR;
        PG8_WAIT_V(4); PG8_BAR;
        PG8_STAGE(PG8_SB(1, 0), cB + kstep, voffB); PG8_STAGE(PG8_SA(1, 0), cA + kstep, voffA); PG8_STAGE(PG8_SB(1, 1), cB + hstep + kstep, voffB);
        PG8_WAIT_V(6); PG8_BAR;
    }
    for (;;) {
        const bool has_next = S.next(ui + 1, nxt);
        const char* nA = has_next ? S.a_ptr(nxt) : cA; const char* nB = has_next ? S.b_ptr(nxt) : cB;
        for (int t = 0; t < nt; t += 2) {
            const bool last = (t == nt - 2);
            const char* a1 = cA + (size_t)(t + 1) * kstep;
            const char* a2 = last ? nA : cA + (size_t)(t + 2) * kstep; const char* b2 = last ? nB : cB + (size_t)(t + 2) * kstep;
            const char* a3 = a2 + kstep; const char* b3 = b2 + kstep;
            if (last && has_next) S.a_ready(nxt);
            if constexpr (SP2) {
            PG8_LDB(B0, 0, 0); PG8_LDB(B1, 0, 1); PG8_SCHED; PG8_LDA(At, 0, 0); PG8_STAGE(PG8_SA(1, 1), a1 + hstep, voffA);
            PG8_WAIT_V(8); PG8_WAIT_L(0); PG8_BAR; PG8_MMA(0, 0, At, B0); PG8_MMA(0, 1, At, B1); PG8_BAR; PG8_SCHED;
            PG8_LDA(At, 0, 1); PG8_STAGE(PG8_SB(0, 0), b2, voffB); PG8_STAGE(PG8_SB(0, 1), b2 + hstep, voffB); PG8_STAGE(PG8_SA(0, 0), a2, voffA);
            PG8_WAIT_V(8); PG8_WAIT_L(0); PG8_BAR; PG8_MMA(1, 0, At, B0); PG8_MMA(1, 1, At, B1); PG8_BAR; PG8_SCHED;
            PG8_LDB(B0, 1, 0); PG8_LDB(B1, 1, 1); PG8_SCHED; PG8_LDA(At, 1, 0); PG8_STAGE(PG8_SA(0, 1), a2 + hstep, voffA);
            PG8_WAIT_V(8); PG8_WAIT_L(0); PG8_BAR; PG8_MMA(0, 0, At, B0); PG8_MMA(0, 1, At, B1); PG8_BAR; PG8_SCHED;
            PG8_LDA(At, 1, 1); PG8_STAGE(PG8_SB(1, 0), b3, voffB); PG8_STAGE(PG8_SB(1, 1), b3 + hstep, voffB); PG8_STAGE(PG8_SA(1, 0), a3, voffA);
            PG8_WAIT_V(8); PG8_WAIT_L(0); PG8_BAR; PG8_MMA(1, 0, At, B0); PG8_MMA(1, 1, At, B1); PG8_BAR; PG8_SCHED;
            } else {
            PG8_LDB(B0, 0, 0); PG8_SCHED; PG8_LDA(At, 0, 0); PG8_STAGE(PG8_SA(1, 1), a1 + hstep, voffA);
            PG8_WAIT_L(8); PG8_BAR; PG8_WAIT_L(0); PG8_MMA(0, 0, At, B0); PG8_BAR; PG8_SCHED;
            PG8_LDB(B1, 0, 1); PG8_STAGE(PG8_SB(0, 0), b2, voffB);
            PG8_BAR; PG8_WAIT_L(0); PG8_MMA(0, 1, At, B1); PG8_BAR;
            PG8_LDA(At, 0, 1); PG8_STAGE(PG8_SA(0, 0), a2, voffA);
            PG8_BAR; PG8_WAIT_L(0); PG8_MMA(1, 0, At, B0); PG8_BAR; PG8_SCHED;
            PG8_STAGE(PG8_SB(0, 1), b2 + hstep, voffB);
            PG8_WAIT_V(6); PG8_BAR; PG8_MMA(1, 1, At, B1); PG8_BAR;
            PG8_LDB(B0, 1, 0); PG8_SCHED; PG8_LDA(At, 1, 0); PG8_STAGE(PG8_SA(0, 1), a2 + hstep, voffA);
            PG8_WAIT_L(8); PG8_BAR; PG8_WAIT_L(0); PG8_MMA(0, 0, At, B0); PG8_BAR; PG8_SCHED;
            PG8_LDB(B1, 1, 1); PG8_STAGE(PG8_SB(1, 0), b3, voffB);
            PG8_BAR; PG8_WAIT_L(0); PG8_MMA(0, 1, At, B1); PG8_BAR;
            PG8_LDA(At, 1, 1); PG8_STAGE(PG8_SA(1, 0), a3, voffA);
            PG8_BAR; PG8_WAIT_L(0); PG8_MMA(1, 0, At, B0); PG8_BAR; PG8_SCHED;
            PG8_STAGE(PG8_SB(1, 1), b3 + hstep, voffB);
            PG8_WAIT_V(6); PG8_BAR; PG8_MMA(1, 1, At, B1); PG8_BAR;
            }
        }
        if constexpr (ALIGN_EPI) { if (wr == 0) PG8_BAR; }
        if constexpr (!Epi::AFTER_DRAIN) { E(acc, cur, wr, wc, fr, fq); S.done(cur); }
        if (!has_next) break;
#pragma unroll
        for (int a = 0; a < 2; ++a)
#pragma unroll
            for (int b = 0; b < 2; ++b)
#pragma unroll
                for (int m = 0; m < 4; ++m)
#pragma unroll
                    for (int n = 0; n < 2; ++n) acc[a][b][m][n] = (f32x4){0.f, 0.f, 0.f, 0.f};
        cur = nxt; cA = nA; cB = nB; ++ui;
        if constexpr (ALIGN_EPI) { if (wr == 1) PG8_BAR; }
    }
    PG8_WAIT_V(0);
    if constexpr (!ALIGN_EPI) { if (wr == 0) PG8_BAR; }
    PG8_BAR;
    if constexpr (Epi::AFTER_DRAIN) { E.fused(acc, cur, wr, wc, fr, fq, lds, wid, lane); S.done(cur); }
#undef PG8_SA
#undef PG8_SB
#undef PG8_STAGE
#undef PG8_LDA
#undef PG8_LDB
#undef PG8_MMA
#undef PG8_WAIT_V
#undef PG8_WAIT_L
#undef PG8_BAR
#undef PG8_SCHED
}
}

constexpr int NWAVES = 8, NTHR = 512;
constexpr int DM = 2048, BATCH = 2, SEQ = 16384, DEPTH = 4, GRIDW = 64, GROWS = 256, CTXL = 256;
constexpr int NAW = 1024, NHEAD = 8, HDIM = 128, FNW = 512, HYW = 512, DFF = 5632, DIN = 5120, NMOD = 6;
constexpr int ML = BATCH * SEQ, MC = BATCH * CTXL, MT = ML + MC;
constexpr int PML = ML / 256, PMT = MT / 256;
constexpr int NEDGE = MT / 64 * 2;
constexpr float EPS = 1e-6f;
constexpr float LOG2E = 1.4426950408889634f;
constexpr float QSCALE = 0.08838834764831845f * LOG2E;
constexpr float HY_MIN_DECAY = -3.0701134573253945f, HY_MAX_DECAY = -15.350567286626973f;

constexpr size_t MiB = 1u << 20;
constexpr size_t WS_CTL = 0, CTL_ZERO_BYTES = 1 * MiB;
constexpr size_t WS_MOD = 1 * MiB;
constexpr size_t WS_XC = 2 * MiB;
constexpr size_t WS_HFC = 6 * MiB;
constexpr size_t WS_HF = 8 * MiB;
constexpr size_t WS_WIN = WS_HF + 128 * MiB;
constexpr size_t WS_WOUT = WS_WIN + 80 * MiB;
constexpr size_t WS_WUP = WS_WOUT + 32 * MiB;
constexpr size_t WS_WDN = WS_WUP + 176 * MiB;
constexpr size_t WS_H = WS_WDN + 88 * MiB;
constexpr size_t WS_QK = WS_H + 130 * MiB;
constexpr size_t WS_VT = WS_QK + 130 * MiB;
constexpr size_t WS_T32 = WS_VT + 65 * MiB;
constexpr size_t WS_A = WS_T32 + 260 * MiB;
constexpr size_t WS_HID = WS_QK;
constexpr size_t WS_EDGE = WS_A + 65 * MiB;
constexpr size_t EDGE_ELEMS = (size_t)NEDGE * DFF;
constexpr size_t WS_KS = WS_EDGE + 68 * MiB;
constexpr size_t WS_END = WS_KS + 64 * MiB;
static_assert((size_t)MT * DFF * 2 <= WS_EDGE - WS_QK, "hidden overlay");
static_assert(3 * EDGE_ELEMS * 4 <= 68 * MiB, "edge buffers");
static_assert((size_t)MT * DM * 2 == 130 * MiB && (size_t)1024 * MT * 2 == 65 * MiB && (size_t)2048 * MT * 4 == 260 * MiB, "sizes");
constexpr int CW_BAR = 4096;

constexpr int RING_BYTES = 131072;
constexpr int XTRA_OFF = RING_BYTES, XTRA_BYTES = 28672;
constexpr int MISC_OFF = XTRA_OFF + XTRA_BYTES;
constexpr int TW_OFF = XTRA_OFF + 24576;
constexpr int ATT_KC_OFF = 0, ATT_KC_PITCH = 272, ATT_VC_OFF = 256 * ATT_KC_PITCH, ATT_VC_PITCH = 528, ATT_BIAS_OFF = ATT_VC_OFF + 128 * ATT_VC_PITCH;
static_assert(ATT_BIAS_OFF + 8 * 465 * 4 <= TW_OFF, "attention LDS map");
constexpr int LDS_BYTES = MISC_OFF + 256;

#define GAS __attribute__((address_space(1)))
#define LAS __attribute__((address_space(3)))
typedef unsigned short bf16;
typedef unsigned v4u __attribute__((ext_vector_type(4)));
typedef unsigned v2u __attribute__((ext_vector_type(2)));
typedef float f32x4 __attribute__((ext_vector_type(4)));
typedef float f32x2 __attribute__((ext_vector_type(2)));
typedef short bf16x8 __attribute__((ext_vector_type(8)));
#define LDS_WAIT() asm volatile("s_waitcnt lgkmcnt(0)" ::: "memory")
__device__ __forceinline__ unsigned f2bf(float f) { unsigned u = __builtin_bit_cast(unsigned, f); return (u + 0x7fffu + ((u >> 16) & 1u)) >> 16; }
__device__ __forceinline__ unsigned pk2(float lo, float hi) { return f2bf(lo) | (f2bf(hi) << 16); }
__device__ __forceinline__ float bf2f(unsigned short b) { return __builtin_bit_cast(float, (unsigned)b << 16); }
__device__ __forceinline__ f32x2 cmul(f32x2 a, f32x2 b) { return (f32x2){a.x * b.x - a.y * b.y, a.x * b.y + a.y * b.x}; }
__device__ __forceinline__ f32x2 cconj(f32x2 a) { return (f32x2){a.x, -a.y}; }
__device__ __forceinline__ float lane_read(float v, int src_lane) { return __builtin_bit_cast(float, __builtin_amdgcn_ds_bpermute(src_lane << 2, __builtin_bit_cast(int, v))); }
__device__ __forceinline__ float wave_sum(float v, int lane) {
#pragma unroll
    for (int o = 1; o < 64; o <<= 1) v += lane_read(v, lane ^ o);
    return v;
}
__device__ __forceinline__ float gelu_tanh(float x) {
    const float t = x * (1.0f + 0.044715f * x * x) * (-2.302208198f);
    const float e = __builtin_amdgcn_exp2f(t);
    return x * __builtin_amdgcn_rcpf(1.0f + e);
}
#define XB_LAS_DEFINED
#define XB_TMO      128
#define XB_XCNT(j)  (256  + 64 * (j))
#define XB_XSUB(j)  (1280 + 64 * (j))
#define XB_XGEN(j)  (2304 + 64 * (j))
#define XB_TOP      3328
#define XB_TOPGEN   3392
#define XCD_BAR_WORDS 3456
#define XB_SPIN_CAP (1u << 18)

__device__ __forceinline__ unsigned xb_ld(unsigned* p)              { return __hip_atomic_load(p, __ATOMIC_RELAXED, __HIP_MEMORY_SCOPE_AGENT); }
__device__ __forceinline__ unsigned xb_add(unsigned* p, unsigned v) { return __hip_atomic_fetch_add(p, v, __ATOMIC_RELAXED, __HIP_MEMORY_SCOPE_AGENT); }
__device__ __forceinline__ unsigned xb_xcc_id() { return (unsigned)__builtin_amdgcn_s_getreg((3 << 11) | 20) & 0xFu; }
#define XB_SPIN(cond, bar) do { unsigned _sp = 0; while (cond) { __builtin_amdgcn_s_sleep(1); \
    if ((++_sp & 255u) == 0u) { if (xb_ld(&(bar)[XB_TMO])) break; if (_sp > XB_SPIN_CAP) { atomicAdd(&(bar)[XB_TMO], 1u); break; } } } } while (0)

struct XcdBarrier {
    unsigned* bar; unsigned x;
    volatile LAS unsigned* st;
};

__device__ __forceinline__ XcdBarrier xcd_barrier_post(unsigned* bar, volatile LAS unsigned* st) {
    XcdBarrier b; b.bar = bar; b.x = xb_xcc_id(); b.st = st;
    if (threadIdx.x == 0) (void)xb_add(&bar[XB_XCNT(b.x)], 1u);
    return b;
}
__device__ __forceinline__ void xcd_barrier_complete(unsigned* bar, unsigned x, unsigned& nloc, unsigned& nx) {
    const unsigned G = gridDim.x * gridDim.y * gridDim.z;
    unsigned sum, cnt, mine, sp = 0u;
    for (;;) {
        sum = 0u; cnt = 0u; mine = 0u;
#pragma unroll
        for (unsigned j = 0; j < 16; ++j) { const unsigned c = xb_ld(&bar[XB_XCNT(j)]); sum += c; cnt += (c > 0u) ? 1u : 0u; mine = (j == x) ? c : mine; }
        if (sum == G) break;
        __builtin_amdgcn_s_sleep(1);
        if ((++sp & 255u) == 0u) { if (xb_ld(&bar[XB_TMO])) break; if (sp > XB_SPIN_CAP) { atomicAdd(&bar[XB_TMO], 1u); break; } }
    }
    nloc = mine > 0u ? mine : 1u; nx = cnt > 0u ? cnt : 1u;
}

__device__ __forceinline__ void xcd_barrier(const XcdBarrier& b) {
    asm volatile("s_waitcnt vmcnt(0)" ::: "memory");
    __syncthreads();
    if (threadIdx.x == 0) {
        unsigned* bar = b.bar;
        __builtin_amdgcn_s_waitcnt(0);
        unsigned nloc = b.st[0], nx = b.st[1];
        if (nloc == 0u) { xcd_barrier_complete(bar, b.x, nloc, nx); b.st[0] = nloc; b.st[1] = nx; }
        const unsigned old = xb_add(&bar[XB_XSUB(b.x)], 1u);
        const unsigned gen = old / nloc;
        if (old + 1u == (gen + 1u) * nloc) {
            __builtin_amdgcn_fence(__ATOMIC_RELEASE, "agent");
            asm volatile("s_waitcnt vmcnt(0)" ::: "memory");
            const unsigned og = xb_add(&bar[XB_TOP], 1u);
            const unsigned tg = og / nx;
            if (og + 1u == (tg + 1u) * nx) xb_add(&bar[XB_TOPGEN], 1u);
            else XB_SPIN(xb_ld(&bar[XB_TOPGEN]) == tg, bar);
            __builtin_amdgcn_fence(__ATOMIC_ACQUIRE, "agent");
            xb_add(&bar[XB_XGEN(b.x)], 1u);
            asm volatile("s_waitcnt vmcnt(0)" ::: "memory");
        } else {
            XB_SPIN(xb_ld(&bar[XB_XGEN(b.x)]) == gen, bar);
            __builtin_amdgcn_fence(__ATOMIC_ACQUIRE, "agent");
            asm volatile("s_waitcnt vmcnt(0)" ::: "memory");
        }
    }
    __syncthreads();
}


struct Args { const GAS float* in[26]; GAS float* out; GAS unsigned char* ws; };
struct Frame {
    LAS unsigned char* lds;
    int tid, lane, wave;
    int vcu, G;
    GAS unsigned char* ws;
    GAS float* out;
};
typedef const float* cfptr_t;
__device__ __forceinline__ const GAS float* in_ptr(int k) { asm volatile("" : "+s"(k));
    const __attribute__((address_space(4))) cfptr_t* kp = (const __attribute__((address_space(4))) cfptr_t*)__builtin_amdgcn_kernarg_segment_ptr(); return (const GAS float*)kp[k]; }
enum { I_x, I_c, I_ctx, I_c_ctx, I_ada_w, I_ada_b, I_norm1_g, I_norm2_g, I_w_in, I_na_rpb, I_hy_conv_w, I_hy_conv_b, I_hy_w1, I_hy_b1, I_hy_w2, I_hy_b2, I_hy_w3, I_hy_freq, I_hy_bias,
       I_mix_norm_g, I_w_out, I_ffn_w_up, I_ffn_conv_w, I_ffn_conv_b, I_ffn_w_down, I_final_norm_g };
#define IN(name) in_ptr(I_##name)
#define WSP(T, off) ((GAS T*)(F.ws + (off)))

__device__ __forceinline__ void pa_adaln(Frame& F) {
    LAS float* sv = (LAS float*)F.lds;
    LAS float* red = (LAS float*)(F.lds + 3 * DM * 4);
    const GAS float* p_c = IN(c); const GAS float* p_cc = IN(c_ctx); const GAS float* p_aw = IN(ada_w); const GAS float* p_ab = IN(ada_b);
    for (int i = F.tid; i < 3 * DM; i += NTHR) { const int s = i / DM, k = i % DM; const float v = s < 2 ? p_c[s * DM + k] : p_cc[k]; sv[i] = v / (1.0f + __expf(-v)); }
    __syncthreads();
    GAS float* MOD = WSP(float, WS_MOD);
    const int cg = F.tid & 63, ks = F.tid >> 6;
    for (int item = F.vcu; item < DEPTH * 48; item += F.G) {
        const int l = item / 48, j0 = (item % 48) * 256;
        const GAS float* wp = p_aw + ((size_t)l * DM + ks * 256) * (NMOD * DM) + j0 + 4 * cg;
        f32x4 a0 = {0.f, 0.f, 0.f, 0.f}, a1 = a0, a2 = a0;
#pragma unroll 8
        for (int kk = 0; kk < 256; ++kk) {
            const f32x4 w = *(const GAS f32x4*)(wp + (size_t)kk * (NMOD * DM));
            const float s0 = sv[ks * 256 + kk], s1 = sv[DM + ks * 256 + kk], s2 = sv[2 * DM + ks * 256 + kk];
            a0 += w * s0; a1 += w * s1; a2 += w * s2;
        }
        *(LAS f32x4*)(red + (ks * 3 + 0) * 256 + 4 * cg) = a0; *(LAS f32x4*)(red + (ks * 3 + 1) * 256 + 4 * cg) = a1; *(LAS f32x4*)(red + (ks * 3 + 2) * 256 + 4 * cg) = a2;
        __syncthreads();
        if (F.tid < 192) {
            const int s = F.tid >> 6, cc = F.tid & 63;
            f32x4 t = *(const GAS f32x4*)(p_ab + (size_t)l * (NMOD * DM) + j0 + 4 * cc);
#pragma unroll
            for (int q = 0; q < 8; ++q) t += *(LAS f32x4*)(red + (q * 3 + s) * 256 + 4 * cc);
            *(GAS f32x4*)(MOD + ((size_t)l * 3 + s) * (NMOD * DM) + j0 + 4 * cc) = t;
        }
        __syncthreads();
    }
}
__device__ __forceinline__ void transpose_item(const GAS float* W, int K, int N, GAS bf16* WT, int k0, int n0, int drow0, LAS float* scr, int lane) {
#pragma unroll 8
    for (int i = 0; i < 32; ++i) { const int kk = 2 * i + (lane >> 5); scr[kk * 33 + (lane & 31)] = W[(size_t)(k0 + kk) * N + n0 + (lane & 31)]; }
    LDS_WAIT(); asm volatile("" ::: "memory");
    const int c = lane & 7;
#pragma unroll
    for (int j = 0; j < 4; ++j) { const int n = (lane >> 3) + 8 * j; const LAS float* s = scr + (8 * c) * 33 + n;
        v4u o; o.x = pk2(s[0 * 33], s[1 * 33]); o.y = pk2(s[2 * 33], s[3 * 33]); o.z = pk2(s[4 * 33], s[5 * 33]); o.w = pk2(s[6 * 33], s[7 * 33]);
        *(GAS v4u*)(WT + (size_t)(drow0 + n) * K + k0 + 8 * c) = o; }
    LDS_WAIT(); asm volatile("" ::: "memory");
}
__device__ __forceinline__ void pa_weights(Frame& F) {
    const GAS float* p_win = IN(w_in); const GAS float* p_wout = IN(w_out); const GAS float* p_wup = IN(ffn_w_up); const GAS float* p_wdn = IN(ffn_w_down);
    {
        LAS float* wt = (LAS float*)F.lds;
        LAS float* tab = (LAS float*)(F.lds + 64 * 129 * 4);
        if (F.tid < 128) tab[F.tid] = cospif((float)F.tid * (1.0f / 64.0f));
        for (int item = F.vcu; item < DEPTH * 4 * 32; item += F.G) {
            const int l = item >> 7, g = (item >> 5) & 3, k0 = (item & 31) * 64;
            __syncthreads();
            for (int i = F.tid; i < 64 * 128; i += NTHR) { const int kk = i >> 7, cc = i & 127; wt[kk * 129 + cc] = p_win[((size_t)l * DM + k0 + kk) * DIN + 3072 + g * 128 + cc]; }
            __syncthreads();
            const int kk = F.tid & 63;
            GAS bf16* dst = WSP(bf16, WS_WIN) + ((size_t)l * DIN + 3072 + g * 128) * DM + k0 + kk;
            for (int i = 0; i < 16; ++i) {
                const int mp = (F.tid >> 6) + 8 * i;
                const int mm = mp <= 64 ? mp : mp - 64, sh = mp <= 64 ? 0 : 96;
                float a = 0.f;
                const int add = mp <= 64 ? 0 : 32; (void)sh;
#pragma unroll 8
                for (int cc = 0; cc < 128; ++cc) a += wt[kk * 129 + cc] * tab[(mm * cc + add) & 127];
                dst[(size_t)mp * DM] = (bf16)f2bf(a);
            }
        }
        __syncthreads();
    }
    LAS float* scr = (LAS float*)(F.lds + F.wave * 16384);
    const int gw = F.vcu * NWAVES + F.wave, NGW = F.G * NWAVES;
    constexpr int I_IN = 32 * 144, I_OUT = 32 * 64, I_UP = 32 * 352, I_DN = 88 * 64, I_L = I_IN + I_OUT + I_UP + I_DN;
    for (int it = gw; it < DEPTH * I_L; it += NGW) {
        const int l = it / I_L; int r = it % I_L;
        if (r < I_IN) { const int kb = r / 144; int nb = r % 144; if (nb >= 96) nb += 16;
            transpose_item(p_win + (size_t)l * DM * DIN, DM, DIN, WSP(bf16, WS_WIN) + (size_t)l * DIN * DM, kb * 64, nb * 32, nb * 32, scr, F.lane); continue; }
        r -= I_IN;
        if (r < I_OUT) { const int kb = r / 64, nb = r % 64;
            transpose_item(p_wout + (size_t)l * DM * DM, DM, DM, WSP(bf16, WS_WOUT) + (size_t)l * DM * DM, kb * 64, nb * 32, nb * 32, scr, F.lane); continue; }
        r -= I_OUT;
        if (r < I_UP) { const int kb = r / 352, nb = r % 352; const int n0 = nb * 32;
            const int drow = n0 < DFF ? (n0 >> 7) * 256 + (n0 & 127) : ((n0 - DFF) >> 7) * 256 + 128 + ((n0 - DFF) & 127);
            transpose_item(p_wup + (size_t)l * DM * 2 * DFF, DM, 2 * DFF, WSP(bf16, WS_WUP) + (size_t)l * 2 * DFF * DM, kb * 64, n0, drow, scr, F.lane); continue; }
        r -= I_UP;
        { const int kb = r / 64, nb = r % 64;
            transpose_item(p_wdn + (size_t)l * DFF * DM, DFF, DM, WSP(bf16, WS_WDN) + (size_t)l * DM * DFF, kb * 64, nb * 32, nb * 32, scr, F.lane); }
    }
}

__device__ __forceinline__ void norm_phase(Frame& F, int l, int which, bool with_ctx) {
    const GAS float* gain = (which ? IN(norm2_g) : IN(norm1_g)) + (size_t)l * DM;
    const GAS float* MOD = WSP(float, WS_MOD) + (size_t)l * 3 * (NMOD * DM);
    const bool first = (l == 0 && which == 0);
    const GAS float* xl = first ? IN(x) : F.out; const GAS float* xc = first ? IN(ctx) : WSP(float, WS_XC);
    GAS bf16* H = WSP(bf16, WS_H);
    const int gw = F.vcu * NWAVES + F.wave, NGW = F.G * NWAVES, nrows = with_ctx ? MT : ML;
    for (int row = gw; row < nrows; row += NGW) {
        const int s = row < SEQ ? 0 : row < ML ? 1 : 2;
        const GAS float* xr = row < ML ? xl + (size_t)row * DM : xc + (size_t)(row - ML) * DM;
        const GAS float* shp = MOD + (size_t)s * (NMOD * DM) + (which ? 3 : 0) * DM; const GAS float* scp = shp + DM;
        f32x4 v[8]; float ss = 0.f;
#pragma unroll
        for (int j = 0; j < 8; ++j) { v[j] = *(const GAS f32x4*)(xr + 4 * (F.lane + 64 * j)); ss += (v[j].x * v[j].x + v[j].y * v[j].y) + (v[j].z * v[j].z + v[j].w * v[j].w); }
        const float rstd = 1.0f / sqrtf(wave_sum(ss, F.lane) * (1.0f / DM) + EPS);
        GAS bf16* hr = H + (size_t)row * DM;
#pragma unroll
        for (int j = 0; j < 8; ++j) { const int k = 4 * (F.lane + 64 * j);
            const f32x4 g = *(const GAS f32x4*)(gain + k), sc = *(const GAS f32x4*)(scp + k), sh = *(const GAS f32x4*)(shp + k);
            const f32x4 y = (v[j] * rstd * g) * (1.0f + sc) + sh;
            v2u o; o.x = pk2(y.x, y.y); o.y = pk2(y.z, y.w); *(GAS v2u*)(hr + k) = o; }
    }
}
__device__ __forceinline__ void final_norm_phase(Frame& F) {
    const GAS float* p_g = IN(final_norm_g);
    const int gw = F.vcu * NWAVES + F.wave, NGW = F.G * NWAVES;
    for (int row = gw; row < ML; row += NGW) {
        GAS float* xr = F.out + (size_t)row * DM;
        f32x4 v[8]; float ss = 0.f;
#pragma unroll
        for (int j = 0; j < 8; ++j) { v[j] = *(const GAS f32x4*)(xr + 4 * (F.lane + 64 * j)); ss += (v[j].x * v[j].x + v[j].y * v[j].y) + (v[j].z * v[j].z + v[j].w * v[j].w); }
        const float rstd = 1.0f / sqrtf(wave_sum(ss, F.lane) * (1.0f / DM) + EPS);
#pragma unroll
        for (int j = 0; j < 8; ++j) { const int k = 4 * (F.lane + 64 * j); *(GAS f32x4*)(xr + k) = v[j] * rstd * *(const GAS f32x4*)(p_g + k); }
    }
}

__device__ __forceinline__ void filter_phase(Frame& F, int l, bool with_ctx) {
    LAS float* h1 = (LAS float*)F.lds;
    LAS float* h2 = (LAS float*)(F.lds + 64 * 65 * 4);
    const GAS float* w1 = IN(hy_w1) + (size_t)l * 33 * 64; const GAS float* b1 = IN(hy_b1) + (size_t)l * 64;
    const GAS float* w2 = IN(hy_w2) + (size_t)l * 64 * 64; const GAS float* b2 = IN(hy_b2) + (size_t)l * 64;
    const GAS float* w3 = IN(hy_w3) + (size_t)l * 64 * 2048; const GAS float* fq = IN(hy_freq) + (size_t)l * 64;
    const int nitems = with_ctx ? 260 : 256;
    for (int item = F.vcu; item < nitems; item += F.G) {
        const bool isc = item >= 256; const int Lq = isc ? CTXL : SEQ; const int n0 = (isc ? item - 256 : item) * 64;
        const int p = F.tid & 63, jg = F.wave;
        const float pos = (float)(n0 + p), t = pos / (float)(Lq - 1);
        __syncthreads();
        {
            float zf[33]; zf[0] = t;
#pragma unroll
            for (int i = 0; i < 16; ++i) { const float band = 1e-4f + (float)i * ((15.0f - 1e-4f) / 15.0f); const float ang = band * (6.283185307179586f / (float)Lq) * pos; zf[1 + i] = cosf(ang); zf[17 + i] = -sinf(ang); }
#pragma unroll 1
            for (int jj = 0; jj < 8; ++jj) { const int j = jg * 8 + jj; float a = b1[j];
#pragma unroll
                for (int i = 0; i < 33; ++i) a += zf[i] * w1[i * 64 + j];
                h1[p * 65 + j] = sinf(fq[j] * a); }
        }
        __syncthreads();
#pragma unroll 1
        for (int jj = 0; jj < 8; ++jj) { const int j = jg * 8 + jj; float a = b2[j];
#pragma unroll 8
            for (int i = 0; i < 64; ++i) a += h1[p * 65 + i] * w2[i * 64 + j];
            h2[p * 65 + j] = sinf(fq[j] * a); }
        __syncthreads();
        GAS float* dst = isc ? WSP(float, WS_HFC) : WSP(float, WS_HF);
        LAS float* w3s = (LAS float*)(F.lds + 2 * 64 * 65 * 4);
        for (int ck = 0; ck < 8; ++ck) {
            __syncthreads();
#pragma unroll 4
            for (int i = F.tid; i < 64 * 64; i += NTHR) { const int jr = i >> 6, c4 = (i & 63) * 4; *(LAS f32x4*)(w3s + jr * 256 + c4) = *(const GAS f32x4*)(w3 + (size_t)jr * 2048 + ck * 256 + c4); }
            __syncthreads();
            f32x4 a[8];
#pragma unroll
            for (int q = 0; q < 8; ++q) a[q] = (f32x4){0.f, 0.f, 0.f, 0.f};
#pragma unroll 2
            for (int i = 0; i < 64; ++i) { const float hvi = h2[p * 65 + i]; const LAS f32x4* wr = (const LAS f32x4*)(w3s + i * 256 + jg * 32);
#pragma unroll
                for (int q = 0; q < 8; ++q) a[q] += wr[q] * hvi; }
#pragma unroll
            for (int q = 0; q < 8; ++q)
#pragma unroll
                for (int e = 0; e < 4; ++e) { const int col = ck * 256 + jg * 32 + q * 4 + e, ch = col & 511;
                    const float delta = fabsf(HY_MIN_DECAY + (HY_MAX_DECAY - HY_MIN_DECAY) * ((float)ch / 511.0f));
                    const float val = a[q][e] * __expf(-t * delta); const int n = n0 + p;
                    if (col & 512) dst[(size_t)col * Lq + ((Lq - n) & (Lq - 1))] = n == 0 ? 0.f : val;
                    else dst[(size_t)col * Lq + n] = val; }
        }
    }
}

struct EpiIn {
    static constexpr bool PERM = true, AFTER_DRAIN = false;
    GAS bf16* QK; GAS bf16* VT; GAS float* T32;
    __device__ __forceinline__ void operator()(pg8::f32x4 (&acc)[2][2][4][2], const pg8::Unit& u, int wr_, int wc_, int fr_, int fq_) const {
        int t_ = threadIdx.x; asm volatile("" : "+v"(t_));
        const int fr = t_ & 15, fq = (t_ >> 4) & 3, wc = (t_ >> 6) & 3, wr = t_ >> 8; (void)wr_; (void)wc_; (void)fr_; (void)fq_;
        const int row0 = u.pm * 256 + wr * 64 + fr, col0 = u.pn * 256 + wc * 32 + 8 * fq;
        if (u.type == 0) {
            const float sc = u.pn < 4 ? QSCALE : 1.0f;
#pragma unroll
            for (int ai = 0; ai < 2; ++ai)
#pragma unroll
                for (int m = 0; m < 4; ++m) { GAS bf16* rowp = QK + (size_t)(row0 + ai * 128 + m * 16) * 2048 + col0;
#pragma unroll
                    for (int bj = 0; bj < 2; ++bj) { const pg8::f32x4 v0 = acc[ai][bj][m][0] * sc, v1 = acc[ai][bj][m][1] * sc;
                        v4u w; w.x = pg8::cvt_pk_bf16(v0[0], v0[1]); w.y = pg8::cvt_pk_bf16(v0[2], v0[3]); w.z = pg8::cvt_pk_bf16(v1[0], v1[1]); w.w = pg8::cvt_pk_bf16(v1[2], v1[3]);
                        *(GAS v4u*)(rowp + bj * 128) = w; } }
        } else if (u.pm < 4) {
#pragma unroll
            for (int ai = 0; ai < 2; ++ai)
#pragma unroll
                for (int m = 0; m < 4; ++m) { GAS bf16* rowp = VT + (size_t)(row0 + ai * 128 + m * 16) * MT + col0;
#pragma unroll
                    for (int bj = 0; bj < 2; ++bj) { const pg8::f32x4 v0 = acc[ai][bj][m][0], v1 = acc[ai][bj][m][1];
                        v4u w; w.x = pg8::cvt_pk_bf16(v0[0], v0[1]); w.y = pg8::cvt_pk_bf16(v0[2], v0[3]); w.z = pg8::cvt_pk_bf16(v1[0], v1[1]); w.w = pg8::cvt_pk_bf16(v1[2], v1[3]);
                        *(GAS v4u*)(rowp + bj * 128) = w; } }
        } else {
#pragma unroll
            for (int ai = 0; ai < 2; ++ai)
#pragma unroll
                for (int m = 0; m < 4; ++m) { GAS float* rowp = T32 + (size_t)(row0 - 1024 + ai * 128 + m * 16) * MT + col0;
#pragma unroll
                    for (int bj = 0; bj < 2; ++bj) { *(GAS pg8::f32x4*)(rowp + bj * 128) = acc[ai][bj][m][0]; *(GAS pg8::f32x4*)(rowp + bj * 128 + 4) = acc[ai][bj][m][1]; } }
        }
    }
};
struct EpiRes {
    static constexpr bool PERM = false, AFTER_DRAIN = false;
    const GAS float* base_l; const GAS float* base_c; GAS float* out_l; GAS float* out_c; const GAS float* gate;
    __device__ __forceinline__ void operator()(pg8::f32x4 (&acc)[2][2][4][2], const pg8::Unit& u, int wr_, int wc_, int fr_, int fq_) const {
        int t_ = threadIdx.x; asm volatile("" : "+v"(t_));
        const int fr = t_ & 15, fq = (t_ >> 4) & 3, wc = (t_ >> 6) & 3, wr = t_ >> 8; (void)wr_; (void)wc_; (void)fr_; (void)fq_;
        const int row0 = u.pm * 256 + wr * 64 + fr, col0 = u.pn * 256 + wc * 32 + 4 * fq;
        const int s = u.pm < PML / 2 ? 0 : u.pm < PML ? 1 : 2;
        const GAS float* bs = u.pm < PML ? base_l + (size_t)row0 * DM : base_c + (size_t)(row0 - ML) * DM;
        GAS float* os = u.pm < PML ? out_l + (size_t)row0 * DM : out_c + (size_t)(row0 - ML) * DM;
        pg8::f32x4 gv[2][2];
#pragma unroll
        for (int bj = 0; bj < 2; ++bj)
#pragma unroll
            for (int n = 0; n < 2; ++n) gv[bj][n] = *(const GAS pg8::f32x4*)(gate + (size_t)s * (NMOD * DM) + col0 + bj * 128 + n * 16);
#pragma unroll
        for (int ai = 0; ai < 2; ++ai)
#pragma unroll
            for (int m = 0; m < 4; ++m) { const size_t off = (size_t)(ai * 128 + m * 16) * DM + col0;
#pragma unroll
                for (int bj = 0; bj < 2; ++bj)
#pragma unroll
                    for (int n = 0; n < 2; ++n) { const pg8::f32x4 b = *(const GAS pg8::f32x4*)(bs + off + bj * 128 + n * 16);
                        *(GAS pg8::f32x4*)(os + off + bj * 128 + n * 16) = b + gv[bj][n] * acc[ai][bj][m][n]; }
                asm volatile("" ::: "memory"); }
    }
};
struct EpiUp {
    static constexpr bool PERM = true, AFTER_DRAIN = false;
    GAS bf16* HID; GAS float* EG; GAS float* EP; GAS float* EU; const GAS float* cw; const GAS float* cb;
    __device__ __forceinline__ void operator()(pg8::f32x4 (&acc)[2][2][4][2], const pg8::Unit& u, int wr_, int wc_, int fr_, int fq_) const {
        int t_ = threadIdx.x; asm volatile("" : "+v"(t_));
        const int fr = t_ & 15, fq = (t_ >> 4) & 3, wc = (t_ >> 6) & 3, wr = t_ >> 8; (void)wr_; (void)wc_; (void)fr_; (void)fq_;
        const int lane = t_ & 63;
        const unsigned hc0 = (unsigned)(u.pn * 128 + wc * 32 + 8 * fq);
        const int src_prev = (lane & 48) | ((fr + 15) & 15), src_next = (lane & 48) | ((fr + 1) & 15);
        const bool e0 = fr == 0, e3 = fr == 15;
        __builtin_amdgcn_sched_barrier(0);
#pragma unroll
        for (int ai = 0; ai < 2; ++ai) {
            const int rbase = u.pm * 256 + ai * 128 + wr * 64;
            const unsigned eb0 = (unsigned)((rbase >> 6) << 1) * (unsigned)DFF, eb3 = eb0 + (unsigned)DFF;
#pragma unroll
            for (int n = 0; n < 2; ++n) {
                const unsigned hc = hc0 + 4u * (unsigned)n;
                const pg8::f32x4 w0 = *(const GAS pg8::f32x4*)&cw[hc], w1 = *(const GAS pg8::f32x4*)&cw[(unsigned)DFF + hc], w2 = *(const GAS pg8::f32x4*)&cw[2u * (unsigned)DFF + hc], bb = *(const GAS pg8::f32x4*)&cb[hc];
                if (e0) { *(GAS pg8::f32x4*)&EG[eb0 + hc] = acc[ai][0][0][n]; *(GAS pg8::f32x4*)&EU[eb0 + hc] = acc[ai][1][0][n]; }
                if (e3) { *(GAS pg8::f32x4*)&EG[eb3 + hc] = acc[ai][0][3][n]; *(GAS pg8::f32x4*)&EU[eb3 + hc] = acc[ai][1][3][n]; }
#pragma unroll
                for (int j = 0; j < 4; ++j) {
                    float pr[4], nx[4], gg[4];
#pragma unroll
                    for (int m = 0; m < 4; ++m) { gg[m] = acc[ai][0][m][n][j]; pr[m] = lane_read(gg[m], src_prev); nx[m] = lane_read(gg[m], src_next); }
#pragma unroll
                    for (int m = 0; m < 4; ++m) {
                        const float pv = fr > 0 ? pr[m] : (m > 0 ? pr[m > 0 ? m - 1 : 0] : 0.f);
                        const float nv = fr < 15 ? nx[m] : (m < 3 ? nx[m < 3 ? m + 1 : 3] : 0.f);
                        const float cv = w0[j] * pv + w1[j] * gg[m] + w2[j] * nv + bb[j];
                        if (m == 0) { if (e0) EP[eb0 + hc + (unsigned)j] = cv; } if (m == 3) { if (e3) EP[eb3 + hc + (unsigned)j] = cv; }
                        acc[ai][0][m][n][j] = gelu_tanh(cv) * acc[ai][1][m][n][j];
                    }
                }
                asm volatile("" ::: "memory"); __builtin_amdgcn_sched_barrier(0);
            }
#pragma unroll
            for (int m = 0; m < 4; ++m) {
                if (!((m == 0 && e0) || (m == 3 && e3))) {
                    const pg8::f32x4 v0 = acc[ai][0][m][0], v1 = acc[ai][0][m][1];
                    v4u w; w.x = pg8::cvt_pk_bf16(v0[0], v0[1]); w.y = pg8::cvt_pk_bf16(v0[2], v0[3]); w.z = pg8::cvt_pk_bf16(v1[0], v1[1]); w.w = pg8::cvt_pk_bf16(v1[2], v1[3]);
                    *(GAS v4u*)&HID[(unsigned)(rbase + m * 16 + fr) * (unsigned)DFF + hc0] = w;
                }
            }
        }
    }
};
__device__ __forceinline__ void edge_fix_phase(Frame& F, int l, bool with_ctx) {
    const GAS float* EG = WSP(float, WS_EDGE); const GAS float* EP = EG + EDGE_ELEMS; const GAS float* EU = EP + EDGE_ELEMS;
    const GAS float* cw = IN(ffn_conv_w) + (size_t)l * 3 * DFF;
    GAS bf16* HID = WSP(bf16, WS_HID);
    const int ne = with_ctx ? NEDGE : ML / 64 * 2, total = ne * (DFF / 4);
    for (int i = F.vcu * NTHR + F.tid; i < total; i += F.G * NTHR) {
        const int e = i / (DFF / 4), c = (i % (DFF / 4)) * 4;
        const int r = (e >> 1) * 64 + (e & 1) * 63;
        f32x4 p = *(const GAS f32x4*)(EP + (size_t)e * DFF + c);
        if (e & 1) { const int nr = r + 1; if (nr != SEQ && nr != ML && nr != ML + CTXL && nr != MT) p += *(const GAS f32x4*)(cw + 2 * DFF + c) * *(const GAS f32x4*)(EG + (size_t)(e + 1) * DFF + c); }
        else { if (r != 0 && r != SEQ && r != ML && r != ML + CTXL) p += *(const GAS f32x4*)(cw + c) * *(const GAS f32x4*)(EG + (size_t)(e - 1) * DFF + c); }
        const f32x4 up = *(const GAS f32x4*)(EU + (size_t)e * DFF + c);
        v2u o; o.x = pk2(gelu_tanh(p.x) * up.x, gelu_tanh(p.y) * up.y); o.y = pk2(gelu_tanh(p.z) * up.z, gelu_tanh(p.w) * up.w);
        *(GAS v2u*)(HID + (size_t)r * DFF + c) = o;
    }
}

#define MFMA16(a, b, c) __builtin_amdgcn_mfma_f32_16x16x32_bf16((a), (b), (c), 0, 0, 0)
struct AttnK { bf16x8 kf[2][4]; };
struct AttnV { bf16x8 vf[8]; };
__device__ __forceinline__ void attn_load_k(AttnK& C, const GAS bf16* kbase  , int q, int g) {
#pragma unroll
    for (int T = 0; T < 2; ++T) { const unsigned koff = (unsigned)((8 * (q >> 2) + 4 * T + (q & 3)) * 2048 + 8 * g);
#pragma unroll
        for (int dc = 0; dc < 4; ++dc) C.kf[T][dc] = *(const GAS bf16x8*)(kbase + koff + 32 * dc); }
}
__device__ __forceinline__ void attn_load_v(AttnV& C, const GAS bf16* vbase  , int q, int g) {
    const unsigned voff = (unsigned)(q * MT + 8 * g);
#pragma unroll
    for (int dt = 0; dt < 8; ++dt) { const GAS bf16* vrow = vbase + (size_t)dt * 16 * MT; C.vf[dt] = *(const GAS bf16x8*)(vrow + voff); }
}
__device__ __forceinline__ void attn_load_k_ctx(AttnK& C, const LAS unsigned char* KC, int cc, int q, int g) {
#pragma unroll
    for (int T = 0; T < 2; ++T) { const int kk = 8 * (q >> 2) + 4 * T + (q & 3);
#pragma unroll
        for (int dc = 0; dc < 4; ++dc) C.kf[T][dc] = *(const LAS bf16x8*)(KC + (32 * cc + kk) * ATT_KC_PITCH + (32 * dc + 8 * g) * 2); }
}
__device__ __forceinline__ void attn_load_v_ctx(AttnV& C, const LAS unsigned char* VC, int cc, int q, int g) {
#pragma unroll
    for (int dt = 0; dt < 8; ++dt) C.vf[dt] = *(const LAS bf16x8*)(VC + (16 * dt + q) * ATT_VC_PITCH + (32 * cc + 8 * g) * 2);
}
__device__ __forceinline__ void attn_compute(const AttnK& C, const AttnV& V, const bf16x8 (&qf)[4], f32x4 (&o)[8], float& mrun, float& lsum, int lane, int g,
                                             bool masked, int keycol0, int cs, const LAS float* brow  , int cq) {
    f32x4 s[2];
#pragma unroll
    for (int T = 0; T < 2; ++T) { s[T] = (f32x4){0.f, 0.f, 0.f, 0.f};
#pragma unroll
        for (int dc = 0; dc < 4; ++dc) s[T] = MFMA16(C.kf[T][dc], qf[dc], s[T]); }
    if (masked) {
#pragma unroll
        for (int T = 0; T < 2; ++T)
#pragma unroll
            for (int i = 0; i < 4; ++i) { const int keycol = keycol0 + 8 * g + 4 * T + i; const bool ok = keycol >= cs && keycol < cs + 16;
                const int dcol = keycol - cq + 15; const float bv = brow[ok ? dcol : 0];
                s[T][i] = ok ? s[T][i] + bv : -1e30f; }
    }
    float cm = fmaxf(fmaxf(fmaxf(s[0][0], s[0][1]), fmaxf(s[0][2], s[0][3])), fmaxf(fmaxf(s[1][0], s[1][1]), fmaxf(s[1][2], s[1][3])));
    cm = fmaxf(cm, lane_read(cm, lane ^ 16)); cm = fmaxf(cm, lane_read(cm, lane ^ 32));
    const float mnew = fmaxf(mrun, cm), alpha = __builtin_amdgcn_exp2f(mrun - mnew);
    mrun = mnew;
    float p[8]; float ps = 0.f;
#pragma unroll
    for (int T = 0; T < 2; ++T)
#pragma unroll
        for (int i = 0; i < 4; ++i) { p[4 * T + i] = __builtin_amdgcn_exp2f(s[T][i] - mnew); ps += p[4 * T + i]; }
    lsum = lsum * alpha + ps;
    v4u pw; pw.x = pg8::cvt_pk_bf16(p[0], p[1]); pw.y = pg8::cvt_pk_bf16(p[2], p[3]); pw.z = pg8::cvt_pk_bf16(p[4], p[5]); pw.w = pg8::cvt_pk_bf16(p[6], p[7]);
    const bf16x8 pf = __builtin_bit_cast(bf16x8, pw);
#pragma unroll
    for (int dt = 0; dt < 8; ++dt) { o[dt] = o[dt] * alpha; o[dt] = MFMA16(V.vf[dt], pf, o[dt]); }
}
__device__ __forceinline__ void attn_tile(Frame& F, bool is_lat, int b, int h, int r, int c0, int qrow0, const LAS float* bias_h) {
    const GAS bf16* QK = WSP(bf16, WS_QK); const GAS bf16* VT = WSP(bf16, WS_VT); GAS bf16* A = WSP(bf16, WS_A);
    const int q = F.lane & 15, g = F.lane >> 4;
    bf16x8 qf[4];
    { const GAS bf16* qp = QK + (size_t)(qrow0 + q) * 2048 + h * 128 + 8 * g;
#pragma unroll
      for (int dc = 0; dc < 4; ++dc) qf[dc] = *(const GAS bf16x8*)(qp + 32 * dc); }
    f32x4 o[8];
#pragma unroll
    for (int dt = 0; dt < 8; ++dt) o[dt] = (f32x4){0.f, 0.f, 0.f, 0.f};
    float mrun = -1e30f, lsum = 0.f;
    const int r0 = min(max(r - 4, 0), GROWS - 8), kc0 = min(max(c0 - 8, 0), 32), cq = c0 + q, cs = min(max(cq - 8, 0), 48);
    const GAS bf16* kh = QK + 1024 + h * 128; const GAS bf16* vh = VT + (size_t)(h * 128) * MT;
#define ATT_TOK(c) ((c) < 8 ? b * SEQ + (r0 + (c)) * GRIDW + kc0 : ML + b * CTXL + 32 * ((c) - 8))
#define ATT_LOADK(C, c) do { if ((c) < 8) { const int tok_ = ATT_TOK(c); attn_load_k(C, kh + (size_t)tok_ * 2048, q, g); } else attn_load_k_ctx(C, F.lds + ATT_KC_OFF, (c) - 8, q, g); } while (0)
#define ATT_LOADV(C, c) do { if ((c) < 8) { const int tok_ = ATT_TOK(c); attn_load_v(C, vh + tok_, q, g); } else attn_load_v_ctx(C, F.lds + ATT_VC_OFF, (c) - 8, q, g); } while (0)
#define ATT_COMP(C, V, c) attn_compute(C, V, qf, o, mrun, lsum, F.lane, g, (c) < 8, kc0, cs, bias_h + (r0 + ((c) < 8 ? (c) : 0) - r + 7) * 31, cq)
    AttnK KA, KB; AttnV VV;
    const int cbeg = is_lat ? 0 : 8;
    ATT_LOADK(KA, cbeg);
    for (int c = cbeg; c < 16; c += 2) {
        ATT_LOADV(VV, c); ATT_LOADK(KB, c + 1); __builtin_amdgcn_sched_barrier(0);
        ATT_COMP(KA, VV, c); __builtin_amdgcn_sched_barrier(0);
        ATT_LOADV(VV, c + 1); if (c + 2 < 16) ATT_LOADK(KA, c + 2);
        __builtin_amdgcn_sched_barrier(0);
        ATT_COMP(KB, VV, c + 1); __builtin_amdgcn_sched_barrier(0);
    }
#undef ATT_TOK
#undef ATT_LOADK
#undef ATT_LOADV
#undef ATT_COMP
    lsum += lane_read(lsum, F.lane ^ 16); lsum += lane_read(lsum, F.lane ^ 32);
    const float inv = 1.0f / lsum;
    GAS bf16* ap = A + (size_t)(qrow0 + q) * 1024 + h * 128 + 4 * g;
#pragma unroll
    for (int dt = 0; dt < 8; ++dt) { v2u w; w.x = pg8::cvt_pk_bf16(o[dt][0] * inv, o[dt][1] * inv); w.y = pg8::cvt_pk_bf16(o[dt][2] * inv, o[dt][3] * inv); *(GAS v2u*)(ap + 16 * dt) = w; }
}
__device__ __forceinline__ void attn_phase(Frame& F, int l, bool with_ctx) {
    LAS float* bias = (LAS float*)(F.lds + ATT_BIAS_OFF);
    const GAS float* p_rpb = IN(na_rpb) + (size_t)l * NHEAD * 465;
    for (int i = F.tid; i < NHEAD * 465; i += NTHR) bias[i] = p_rpb[i] * LOG2E;
    const GAS bf16* QK = WSP(bf16, WS_QK); const GAS bf16* VT = WSP(bf16, WS_VT);
    for (int wgi = F.vcu; wgi < 256; wgi += F.G) {
        const int bh = wgi >> 4, b = bh >> 3, h = bh & 7, sub = wgi & 15;
        __syncthreads();
#pragma unroll 4
        for (int i = F.tid; i < 256 * 16; i += NTHR) { const int row = i >> 4, pc = i & 15;
            *(LAS v4u*)(F.lds + ATT_KC_OFF + row * ATT_KC_PITCH + pc * 16) = *(const GAS v4u*)(QK + (size_t)(ML + b * CTXL + row) * 2048 + 1024 + h * 128 + 8 * pc); }
#pragma unroll 4
        for (int i = F.tid; i < 128 * 32; i += NTHR) { const int row = i >> 5, pc = i & 31;
            *(LAS v4u*)(F.lds + ATT_VC_OFF + row * ATT_VC_PITCH + pc * 16) = *(const GAS v4u*)(VT + (size_t)(h * 128 + row) * MT + ML + b * CTXL + 8 * pc); }
        __syncthreads();
        const int rb = sub * 2 + (F.wave >> 2), c0 = 16 * (F.wave & 3);
        for (int rr = 0; rr < 8; ++rr) { const int r = rb * 8 + rr; attn_tile(F, true, b, h, r, c0, b * SEQ + r * GRIDW + c0, bias + h * 465); }
        if (with_ctx) {
            if ((F.wave & 3) == 0) { const int t = sub; if ((F.wave >> 2) == (t & 1)) attn_tile(F, false, b, h, 0, 0, ML + b * CTXL + 16 * t, bias + h * 465); }
        }
    }
    __syncthreads();
}

constexpr int FFTN = 16384, FFT_PHYS = FFTN + FFTN / 16;
__device__ __forceinline__ int phys(int i) { return i + ((i >> 6) << 2); }
__device__ __forceinline__ f32x2 tw32k(const LAS f32x2* TH, const LAS f32x2* TL, int n) { return cmul(TH[n >> 7], TL[n & 127]); }
template <bool INV> __device__ __forceinline__ void r4(f32x2& x0, f32x2& x1, f32x2& x2, f32x2& x3) {
    const f32x2 a = x0 + x2, c = x0 - x2, b = x1 + x3, e = x1 - x3;
    const f32x2 d = INV ? (f32x2){-e.y, e.x} : (f32x2){e.y, -e.x};
    x0 = a + b; x1 = c + d; x2 = a - b; x3 = c - d;
}
template <bool INV> __device__ __forceinline__ void dft16(f32x2 (&x)[16]) {
#pragma unroll
    for (int b = 0; b < 4; ++b) r4<INV>(x[b], x[4 + b], x[8 + b], x[12 + b]);
    const float sg = INV ? -1.f : 1.f;
    const f32x2 W1 = {0.92387953251f, -0.38268343236f * sg}, W2 = {0.70710678118f, -0.70710678118f * sg}, W3 = {0.38268343236f, -0.92387953251f * sg},
                W4 = {0.f, -1.f * sg}, W6 = {-0.70710678118f, -0.70710678118f * sg}, W9 = {-0.92387953251f, 0.38268343236f * sg};
    x[5] = cmul(x[5], W1); x[9] = cmul(x[9], W2); x[13] = cmul(x[13], W3);
    x[6] = cmul(x[6], W2); x[10] = cmul(x[10], W4); x[14] = cmul(x[14], W6);
    x[7] = cmul(x[7], W3); x[11] = cmul(x[11], W6); x[15] = cmul(x[15], W9);
#pragma unroll
    for (int c = 0; c < 4; ++c) r4<INV>(x[4 * c], x[4 * c + 1], x[4 * c + 2], x[4 * c + 3]);
}
template <bool INV> __device__ __forceinline__ void bfly16(f32x2 (&x)[16], const LAS f32x2* TH, const LAS f32x2* TL, int tw) {
    f32x2 W = tw32k(TH, TL, tw); if (INV) W.y = -W.y;
    if (INV) { f32x2 p = W;
#pragma unroll
        for (int q = 1; q < 16; ++q) { x[q] = cmul(x[q], p); if (q < 15) p = cmul(p, W); } }
    dft16<INV>(x);
    if (!INV) { f32x2 p = W;
#pragma unroll
        for (int r = 1; r < 16; ++r) { x[4 * (r & 3) + (r >> 2)] = cmul(x[4 * (r & 3) + (r >> 2)], p); if (r < 15) p = cmul(p, W); } }
}
template <bool INV> __device__ __forceinline__ void pass16(LAS f32x2* X, const LAS f32x2* TH, const LAS f32x2* TL, int base, int stride, int tw) {
    f32x2 x[16];
#pragma unroll
    for (int q = 0; q < 16; ++q) x[q] = X[base + q * stride];
    bfly16<INV>(x, TH, TL, tw);
#pragma unroll
    for (int c = 0; c < 4; ++c)
#pragma unroll
        for (int d = 0; d < 4; ++d) X[base + (c + 4 * d) * stride] = x[4 * c + d];
}
template <bool INV> __device__ __forceinline__ void pass16_s4(LAS f32x2* X, const LAS f32x2* TH, const LAS f32x2* TL, int blk, int h) {
    LAS f32x4* P = (LAS f32x4*)(X + blk * 68 + 2 * h);
    f32x2 xa[16], xb[16];
#pragma unroll
    for (int q = 0; q < 16; ++q) { const f32x4 v = P[2 * q]; xa[q] = (f32x2){v.x, v.y}; xb[q] = (f32x2){v.z, v.w}; }
    bfly16<INV>(xa, TH, TL, (2 * h) * 512); bfly16<INV>(xb, TH, TL, (2 * h + 1) * 512);
#pragma unroll
    for (int c = 0; c < 4; ++c)
#pragma unroll
        for (int d = 0; d < 4; ++d) P[2 * (c + 4 * d)] = (f32x4){xa[4 * c + d].x, xa[4 * c + d].y, xb[4 * c + d].x, xb[4 * c + d].y};
}
template <bool INV> __device__ __forceinline__ void pass4_s1(LAS f32x2* X, int b) {
    LAS f32x4* P = (LAS f32x4*)(X + 4 * b + ((b >> 4) << 2));
    const f32x4 u = P[0], v = P[1];
    f32x2 x0 = {u.x, u.y}, x1 = {u.z, u.w}, x2 = {v.x, v.y}, x3 = {v.z, v.w};
    r4<INV>(x0, x1, x2, x3);
    P[0] = (f32x4){x0.x, x0.y, x1.x, x1.y}; P[1] = (f32x4){x2.x, x2.y, x3.x, x3.y};
}
__device__ __forceinline__ void fft_fwd(LAS f32x2* X, const LAS f32x2* TH, const LAS f32x2* TL, int tid) {
#pragma unroll 1
    for (int i = 0; i < 2; ++i) { const int j = tid + NTHR * i; pass16<false>(X, TH, TL, j + ((j >> 6) << 2), 1088, 2 * j); }
    __syncthreads();
#pragma unroll 1
    for (int i = 0; i < 2; ++i) { const int b = tid + NTHR * i, j = b & 63, blk = b >> 6; pass16<false>(X, TH, TL, blk * 1088 + j, 68, 32 * j); }
    __syncthreads();
    pass16_s4<false>(X, TH, TL, tid >> 1, tid & 1);
    __syncthreads();
#pragma unroll 2
    for (int i = 0; i < 8; ++i) pass4_s1<false>(X, tid + NTHR * i);
    __syncthreads();
}
__device__ __forceinline__ void fft_inv(LAS f32x2* X, const LAS f32x2* TH, const LAS f32x2* TL, int tid) {
#pragma unroll 2
    for (int i = 0; i < 8; ++i) pass4_s1<true>(X, tid + NTHR * i);
    __syncthreads();
    pass16_s4<true>(X, TH, TL, tid >> 1, tid & 1);
    __syncthreads();
#pragma unroll 1
    for (int i = 0; i < 2; ++i) { const int b = tid + NTHR * i, j = b & 63, blk = b >> 6; pass16<true>(X, TH, TL, blk * 1088 + j, 68, 32 * j); }
    __syncthreads();
#pragma unroll 1
    for (int i = 0; i < 2; ++i) { const int j = tid + NTHR * i; pass16<true>(X, TH, TL, j + ((j >> 6) << 2), 1088, 2 * j); }
    __syncthreads();
}
__device__ __forceinline__ int freq_pos(int k) { return phys(((k & 15) << 10) | (((k >> 4) & 15) << 6) | (((k >> 8) & 15) << 2) | (k >> 12)); }

__device__ __forceinline__ float conv3(const GAS float* p, int n, int Lq, float w0, float w1, float w2, float bb) {
    float a = p[n] * w1 + bb; if (n > 0) a += p[n - 1] * w0; if (n < Lq - 1) a += p[n + 1] * w2; return a;
}
__device__ __forceinline__ f32x4 conv3v(const GAS float* p, int n0, int Lq, float w0, float w1, float w2, float bb) {
    const f32x4 c = *(const GAS f32x4*)(p + n0); const float l = n0 > 0 ? p[n0 - 1] : 0.f, r = n0 + 4 < Lq ? p[n0 + 4] : 0.f;
    return (f32x4){w0 * l + w1 * c.x + w2 * c.y + bb, w0 * c.x + w1 * c.y + w2 * c.z + bb, w0 * c.y + w1 * c.z + w2 * c.w + bb, w0 * c.z + w1 * c.w + w2 * r + bb};
}
__device__ __forceinline__ void tw4(const LAS f32x2* TH, const LAS f32x2* TL, int n0, f32x2 (&w)[4]) {
    const f32x2 th = TH[n0 >> 7]; const LAS f32x4* tl = (const LAS f32x4*)(TL + (n0 & 127)); const f32x4 a = tl[0], b = tl[1];
    w[0] = cmul(th, (f32x2){a.x, a.y}); w[1] = cmul(th, (f32x2){a.z, a.w}); w[2] = cmul(th, (f32x2){b.x, b.y}); w[3] = cmul(th, (f32x2){b.z, b.w});
}

#define LT() ({ int lt_ = tid; asm volatile("" : "+v"(lt_)); lt_; })
__device__ __forceinline__ void hyena_latent(Frame& F, int l, int ch, LAS f32x2* X, const LAS f32x2* TH, const LAS f32x2* TL, GAS f32x2* KS) {
    GAS float* T32 = WSP(float, WS_T32);
    GAS float* hv = T32 + (size_t)(512 + ch) * MT; const GAS float* hx1 = T32 + (size_t)(1024 + ch) * MT; const GAS float* hx2 = T32 + (size_t)(1536 + ch) * MT;
    const GAS float* cw = IN(hy_conv_w) + (size_t)l * 3 * 1536; const GAS float* cb = IN(hy_conv_b) + (size_t)l * 1536;
    const GAS float* HF = WSP(float, WS_HF); const GAS float* p_hb = IN(hy_bias) + (size_t)l * 2 * HYW + ch;
    const int tid = F.tid;
    GAS f32x4* KS4 = (GAS f32x4*)KS; GAS f32x4* KE4 = KS4 + FFTN / 2;
    for (int o = 0; o < 2; ++o) {
        const GAS float* hf = HF + (size_t)(o * 1024 + ch) * SEQ; const GAS float* hbr = HF + (size_t)(o * 1024 + 512 + ch) * SEQ;
        const float bias = p_hb[o * HYW];
        const float vw0 = cw[ch], vw1 = cw[1536 + ch], vw2 = cw[3072 + ch], vbb = cb[ch];
        const GAS float* hx = o == 0 ? hx1 : hx2; const int xo = o == 0 ? 512 : 1024;
        const float xw0 = cw[xo + ch], xw1 = cw[1536 + xo + ch], xw2 = cw[3072 + xo + ch], xbb = cb[xo + ch];
        for (int par = 0; par < 2; ++par) {
#pragma unroll
            for (int i = 0; i < 8; ++i) { const int g = LT() + NTHR * i, n0 = 4 * g; const f32x4 f = *(const GAS f32x4*)(hf + n0), bk = *(const GAS f32x4*)(hbr + n0);
                LAS f32x4* XP = (LAS f32x4*)(X + phys(n0));
                if (par == 0) { XP[0] = (f32x4){f.x + bk.x, 0.f, f.y + bk.y, 0.f}; XP[1] = (f32x4){f.z + bk.z, 0.f, f.w + bk.w, 0.f}; }
                else { f32x2 w[4]; tw4(TH, TL, n0, w); const f32x4 d = f - bk;
                    XP[0] = (f32x4){w[0].x * d.x, w[0].y * d.x, w[1].x * d.y, w[1].y * d.y}; XP[1] = (f32x4){w[2].x * d.z, w[2].y * d.z, w[3].x * d.w, w[3].y * d.w}; } }
            __syncthreads();
            fft_fwd(X, TH, TL, tid);
#pragma unroll
            for (int i = 0; i < 8; ++i) { const int g = LT() + NTHR * i; const LAS f32x4* XP = (const LAS f32x4*)(X + phys(4 * g)); KS4[2 * g] = XP[0]; KS4[2 * g + 1] = XP[1]; }
            __syncthreads();
#pragma unroll 4
            for (int i = 0; i < 8; ++i) { const int g = LT() + NTHR * i, n0 = 4 * g;
                f32x4 z0, z1; if (o == 0) { z0 = conv3v(hv, n0, SEQ, vw0, vw1, vw2, vbb); z1 = conv3v(hv + SEQ, n0, SEQ, vw0, vw1, vw2, vbb); } else { z0 = *(const GAS f32x4*)(hv + n0); z1 = *(const GAS f32x4*)(hv + SEQ + n0); }
                LAS f32x4* XP = (LAS f32x4*)(X + phys(n0));
                if (par == 0) { XP[0] = (f32x4){z0.x, z1.x, z0.y, z1.y}; XP[1] = (f32x4){z0.z, z1.z, z0.w, z1.w}; }
                else { f32x2 w[4]; tw4(TH, TL, n0, w);
                    const f32x2 a0 = cmul((f32x2){z0.x, z1.x}, w[0]), a1 = cmul((f32x2){z0.y, z1.y}, w[1]), a2 = cmul((f32x2){z0.z, z1.z}, w[2]), a3 = cmul((f32x2){z0.w, z1.w}, w[3]);
                    XP[0] = (f32x4){a0.x, a0.y, a1.x, a1.y}; XP[1] = (f32x4){a2.x, a2.y, a3.x, a3.y}; } }
            __syncthreads();
            fft_fwd(X, TH, TL, tid);
#pragma unroll 4
            for (int i = 0; i < 8; ++i) { const int g = LT() + NTHR * i; LAS f32x4* XP = (LAS f32x4*)(X + phys(4 * g)); const f32x4 k0 = KS4[2 * g], k1 = KS4[2 * g + 1], u0 = XP[0], u1 = XP[1];
                const f32x2 a0 = cmul((f32x2){u0.x, u0.y}, (f32x2){k0.x, k0.y}), a1 = cmul((f32x2){u0.z, u0.w}, (f32x2){k0.z, k0.w}), a2 = cmul((f32x2){u1.x, u1.y}, (f32x2){k1.x, k1.y}), a3 = cmul((f32x2){u1.z, u1.w}, (f32x2){k1.z, k1.w});
                XP[0] = (f32x4){a0.x, a0.y, a1.x, a1.y}; XP[1] = (f32x4){a2.x, a2.y, a3.x, a3.y}; }
            __syncthreads();
            fft_inv(X, TH, TL, tid);
            if (par == 0) {
#pragma unroll
                for (int i = 0; i < 8; ++i) { const int g = LT() + NTHR * i; const LAS f32x4* XP = (const LAS f32x4*)(X + phys(4 * g)); KE4[2 * g] = XP[0]; KE4[2 * g + 1] = XP[1]; }
                __syncthreads();
            }
        }
#pragma unroll 4
        for (int i = 0; i < 8; ++i) { const int g = LT() + NTHR * i, n0 = 4 * g;
            f32x4 z0, z1; if (o == 0) { z0 = conv3v(hv, n0, SEQ, vw0, vw1, vw2, vbb); z1 = conv3v(hv + SEQ, n0, SEQ, vw0, vw1, vw2, vbb); } else { z0 = *(const GAS f32x4*)(hv + n0); z1 = *(const GAS f32x4*)(hv + SEQ + n0); }
            const f32x4 g0 = conv3v(hx, n0, SEQ, xw0, xw1, xw2, xbb), g1 = conv3v(hx + SEQ, n0, SEQ, xw0, xw1, xw2, xbb);
            const f32x4 e0 = KE4[2 * g], e1 = KE4[2 * g + 1];
            LAS f32x4* XP = (LAS f32x4*)(X + phys(n0)); const f32x4 u0 = XP[0], u1 = XP[1];
            f32x2 w[4]; tw4(TH, TL, n0, w);
            const f32x2 c0 = cmul((f32x2){u0.x, u0.y}, cconj(w[0])), c1 = cmul((f32x2){u0.z, u0.w}, cconj(w[1])), c2 = cmul((f32x2){u1.x, u1.y}, cconj(w[2])), c3 = cmul((f32x2){u1.z, u1.w}, cconj(w[3]));
            const float sc = 1.0f / 32768.0f;
            const f32x2 y0 = ((f32x2){e0.x, e0.y} + c0) * sc + (f32x2){z0.x, z1.x} * bias, y1 = ((f32x2){e0.z, e0.w} + c1) * sc + (f32x2){z0.y, z1.y} * bias,
                        y2 = ((f32x2){e1.x, e1.y} + c2) * sc + (f32x2){z0.z, z1.z} * bias, y3 = ((f32x2){e1.z, e1.w} + c3) * sc + (f32x2){z0.w, z1.w} * bias;
            XP[0] = (f32x4){g0.x * y0.x, g0.y * y1.x, g0.z * y2.x, g0.w * y3.x};
            XP[1] = (f32x4){g1.x * y0.y, g1.y * y1.y, g1.z * y2.y, g1.w * y3.y}; }
        __syncthreads();
#pragma unroll
        for (int i = 0; i < 8; ++i) { const int g = LT() + NTHR * i, n0 = 4 * g; const LAS f32x4* XP = (const LAS f32x4*)(X + phys(n0)); *(GAS f32x4*)(hv + n0) = XP[0]; *(GAS f32x4*)(hv + SEQ + n0) = XP[1]; }
        __syncthreads();
    }
}
__device__ __forceinline__ void fourier_latent(Frame& F, int b, int gq, int m, LAS f32x2* X, const LAS f32x2* TH, const LAS f32x2* TL) {
    GAS float* T32 = WSP(float, WS_T32);
    GAS float* ra = T32 + (size_t)(gq * 128 + m) * MT + b * SEQ; GAS float* rb = T32 + (size_t)(gq * 128 + 64 + m) * MT + b * SEQ;
    const int tid = F.tid;
#pragma unroll
    for (int i = 0; i < 8; ++i) { const int g = LT() + NTHR * i, n0 = 4 * g; const f32x4 a = *(const GAS f32x4*)(ra + n0), c = *(const GAS f32x4*)(rb + n0);
        LAS f32x4* XP = (LAS f32x4*)(X + phys(n0)); XP[0] = (f32x4){a.x, c.x, a.y, c.y}; XP[1] = (f32x4){a.z, c.z, a.w, c.w}; }
    __syncthreads();
    fft_fwd(X, TH, TL, tid);
    const float sc = 6.9053396600248786e-4f;
#pragma unroll 2
    for (int i = 0; i < 8; ++i) { const int g = LT() + NTHR * i, k0 = 4 * g; f32x4 oa, ob;
#pragma unroll
        for (int e = 0; e < 4; ++e) { const int k = k0 + e; const f32x2 u = X[freq_pos(k)], v = X[freq_pos((FFTN - k) & (FFTN - 1))];
            if (m != 0) { oa[e] = u.x * sc; ob[e] = v.x * sc; } else { oa[e] = (u.x + v.x) * (0.5f * sc); ob[e] = (u.y + v.y) * (0.5f * sc); } }
        *(GAS f32x4*)(ra + k0) = oa; *(GAS f32x4*)(rb + k0) = ob; }
    __syncthreads();
}
__device__ __forceinline__ void hyena_ctx(Frame& F, int l, int ch, LAS float* S) {
    GAS float* T32 = WSP(float, WS_T32);
    GAS float* hv = T32 + (size_t)(512 + ch) * MT + ML; const GAS float* hx1 = T32 + (size_t)(1024 + ch) * MT + ML; const GAS float* hx2 = T32 + (size_t)(1536 + ch) * MT + ML;
    const GAS float* cw = IN(hy_conv_w) + (size_t)l * 3 * 1536; const GAS float* cb = IN(hy_conv_b) + (size_t)l * 1536;
    const GAS float* HFC = WSP(float, WS_HFC); const GAS float* p_hb = IN(hy_bias) + (size_t)l * 2 * HYW + ch;
    LAS float* zb = S; LAS float* hfl = S + 512; LAS float* hbl = S + 768;
    const int n = F.tid & 255, b = F.tid >> 8;
    __syncthreads();
    zb[b * 256 + n] = conv3(hv + b * CTXL, n, CTXL, cw[ch], cw[1536 + ch], cw[3072 + ch], cb[ch]);
    for (int o = 0; o < 2; ++o) {
        if (F.tid < 256) hfl[n] = HFC[(size_t)(o * 1024 + ch) * CTXL + n]; else hbl[n] = HFC[(size_t)(o * 1024 + 512 + ch) * CTXL + n];
        __syncthreads();
        float y = 0.f;
        for (int mI = 0; mI < CTXL; ++mI) { const int d = n - mI; y += zb[b * 256 + mI] * (d >= 0 ? hfl[d] : hbl[CTXL + d]); }
        y += p_hb[o * HYW] * zb[b * 256 + n];
        const GAS float* hx = o == 0 ? hx1 : hx2; const int xo = o == 0 ? 512 : 1024;
        const float r = conv3(hx + b * CTXL, n, CTXL, cw[xo + ch], cw[1536 + xo + ch], cw[3072 + xo + ch], cb[xo + ch]) * y;
        __syncthreads();
        if (o == 0) zb[b * 256 + n] = r; else hv[b * CTXL + n] = r;
        __syncthreads();
    }
}
__device__ __forceinline__ void fourier_ctx(Frame& F, int item, LAS float* S) {
    GAS float* T32 = WSP(float, WS_T32);
    const int b = item >> 5, gq = (item >> 3) & 3, m0 = (item & 7) * 8;
    LAS float* cs = S; LAS float* re = S + 256; LAS float* im = S + 256 + 2048;
    __syncthreads();
    if (F.tid < 256) cs[F.tid] = cospif((float)F.tid * (1.0f / 128.0f));
    for (int i = F.tid; i < 8 * 256; i += NTHR) { const int mm = i >> 8, n = i & 255;
        re[i] = T32[(size_t)(gq * 128 + m0 + mm) * MT + ML + b * CTXL + n]; im[i] = T32[(size_t)(gq * 128 + 64 + m0 + mm) * MT + ML + b * CTXL + n]; }
    __syncthreads();
    const int k = F.tid & 255, mh = F.tid >> 8;
    const float sc = 5.5242717280199031e-3f;
    for (int mq = 0; mq < 4; ++mq) { const int mm = mh * 4 + mq, m = m0 + mm;
        float cr = 0.f, ci = 0.f, sr = 0.f, si = 0.f;
        for (int n = 0; n < 256; ++n) { const int ix = (k * n) & 255; const float c = cs[ix], sn = cs[(ix - 64) & 255]; const float a = re[mm * 256 + n], bq = im[mm * 256 + n];
            cr += a * c; ci += bq * c; sr += a * sn; si += bq * sn; }
        float oa, ob;
        if (m != 0) { oa = cr + si; ob = cr - si; } else { oa = cr; ob = ci; }
        T32[(size_t)(gq * 128 + m) * MT + ML + b * CTXL + k] = oa * sc; T32[(size_t)(gq * 128 + 64 + m) * MT + ML + b * CTXL + k] = ob * sc; }
    __syncthreads();
}
__device__ __forceinline__ void fft_phase(Frame& F, int l, bool with_ctx) {
    LAS f32x2* X = (LAS f32x2*)F.lds;
    LAS f32x2* TH = (LAS f32x2*)(F.lds + TW_OFF); LAS f32x2* TL = TH + 128;
    if (F.tid < 256) { const int a = F.tid & 127; const float fr = F.tid < 128 ? (float)(128 * a) * (1.0f / 16384.0f) : (float)a * (1.0f / 16384.0f);
        float sn, cn; sincospif(fr, &sn, &cn); (F.tid < 128 ? TH : TL)[a] = (f32x2){cn, -sn}; }
    __syncthreads();
    for (int ch = F.vcu; ch < HYW; ch += F.G) hyena_latent(F, l, ch, X, TH, TL, WSP(f32x2, WS_KS) + (size_t)F.vcu * 2 * FFTN);
    for (int fu = F.vcu; fu < 512; fu += F.G) fourier_latent(F, fu >> 8, (fu >> 6) & 3, fu & 63, X, TH, TL);
    if (with_ctx) {
        LAS float* S = (LAS float*)F.lds;
        for (int ch = F.vcu; ch < HYW; ch += F.G) hyena_ctx(F, l, ch, S);
        for (int it = F.vcu; it < 64; it += F.G) fourier_ctx(F, it, S);
    }
}

__device__ __forceinline__ void merge_phase(Frame& F, int l, bool with_ctx) {
    const GAS bf16* A = WSP(bf16, WS_A); const GAS float* T32 = WSP(float, WS_T32); GAS bf16* H = WSP(bf16, WS_H);
    const GAS float* gain = IN(mix_norm_g) + (size_t)l * DM;
    LAS float* tile = (LAS float*)F.lds;
    const int TI = with_ctx ? 65 : 64;
    for (int it = F.vcu; it < 512; it += F.G) {
        const int tok0 = it * TI;
        for (int tk = F.wave; tk < TI; tk += NWAVES) {
            const size_t row = (size_t)(tok0 + tk);
            const v4u r0 = *(const GAS v4u*)(A + row * 1024 + 8 * F.lane), r1 = *(const GAS v4u*)(A + row * 1024 + 512 + 8 * F.lane);
            float v[16];
            v[0] = bf2f(r0.x & 0xffff); v[1] = bf2f(r0.x >> 16); v[2] = bf2f(r0.y & 0xffff); v[3] = bf2f(r0.y >> 16); v[4] = bf2f(r0.z & 0xffff); v[5] = bf2f(r0.z >> 16); v[6] = bf2f(r0.w & 0xffff); v[7] = bf2f(r0.w >> 16);
            v[8] = bf2f(r1.x & 0xffff); v[9] = bf2f(r1.x >> 16); v[10] = bf2f(r1.y & 0xffff); v[11] = bf2f(r1.y >> 16); v[12] = bf2f(r1.z & 0xffff); v[13] = bf2f(r1.z >> 16); v[14] = bf2f(r1.w & 0xffff); v[15] = bf2f(r1.w >> 16);
            float ss = 0.f;
#pragma unroll
            for (int j = 0; j < 16; ++j) ss += v[j] * v[j];
            const float rstd = 1.0f / sqrtf(wave_sum(ss, F.lane) * (1.0f / NAW) + EPS);
            const f32x4 g0 = *(const GAS f32x4*)(gain + 8 * F.lane), g1 = *(const GAS f32x4*)(gain + 8 * F.lane + 4), g2 = *(const GAS f32x4*)(gain + 512 + 8 * F.lane), g3 = *(const GAS f32x4*)(gain + 512 + 8 * F.lane + 4);
            v4u o0, o1;
            o0.x = pk2(v[0] * rstd * g0.x, v[1] * rstd * g0.y); o0.y = pk2(v[2] * rstd * g0.z, v[3] * rstd * g0.w); o0.z = pk2(v[4] * rstd * g1.x, v[5] * rstd * g1.y); o0.w = pk2(v[6] * rstd * g1.z, v[7] * rstd * g1.w);
            o1.x = pk2(v[8] * rstd * g2.x, v[9] * rstd * g2.y); o1.y = pk2(v[10] * rstd * g2.z, v[11] * rstd * g2.w); o1.z = pk2(v[12] * rstd * g3.x, v[13] * rstd * g3.y); o1.w = pk2(v[14] * rstd * g3.z, v[15] * rstd * g3.w);
            *(GAS v4u*)(H + row * DM + 8 * F.lane) = o0; *(GAS v4u*)(H + row * DM + 512 + 8 * F.lane) = o1;
        }
        for (int grp = 0; grp < 2; ++grp) {
            __syncthreads();
            for (int c8 = F.wave * 64; c8 < F.wave * 64 + 64; c8 += 8) {
                float v[8], w[8];
#pragma unroll
                for (int u = 0; u < 8; ++u) { const GAS float* src = T32 + (size_t)(grp * 512 + c8 + u) * MT + tok0; v[u] = src[F.lane]; w[u] = (TI > 64 && F.lane == 0) ? src[64] : 0.f; }
#pragma unroll
                for (int u = 0; u < 8; ++u) { tile[(c8 + u) * 65 + F.lane] = v[u]; if (TI > 64 && F.lane == 0) tile[(c8 + u) * 65 + 64] = w[u]; }
            }
            __syncthreads();
            for (int tk = F.wave; tk < TI; tk += NWAVES) {
                float vv[8]; float ss = 0.f;
#pragma unroll
                for (int i = 0; i < 8; ++i) { const int chn = F.lane + 64 * i; int srow = chn;
                    if (grp == 0) { const int cc = chn & 127; srow = (chn & ~127) + (cc <= 64 ? cc : 192 - cc); }
                    vv[i] = tile[srow * 65 + tk]; ss += vv[i] * vv[i]; }
                const float rstd = 1.0f / sqrtf(wave_sum(ss, F.lane) * (1.0f / 512.0f) + EPS);
                GAS bf16* hp = H + (size_t)(tok0 + tk) * DM + NAW + grp * 512;
#pragma unroll
                for (int i = 0; i < 8; ++i) { const int chn = F.lane + 64 * i; hp[chn] = (bf16)f2bf(vv[i] * rstd * gain[NAW + grp * 512 + chn]); }
            }
        }
    }
}

#define REFRESH(F) do { int t_ = threadIdx.x; asm volatile("" : "+v"(t_)); F.tid = t_; F.lane = t_ & 63; F.wave = __builtin_amdgcn_readfirstlane(t_ >> 6); \
    GAS unsigned char* w_ = args.ws; asm volatile("" : "+s"(w_)); F.ws = w_; GAS float* o_ = args.out; asm volatile("" : "+s"(o_)); F.out = o_; } while (0)
#ifndef REP_P1
#define REP_P1 1
#endif
#ifndef REP_P6
#define REP_P6 1
#endif
#ifndef REP_ATT
#define REP_ATT 1
#endif
#ifndef REP_PA
#define REP_PA 1
#endif
#ifndef REP_THIN
#define REP_THIN 1
#endif
__device__ __forceinline__ int opaque_int(int v) { asm volatile("" : "+s"(v)); return v; }
__global__ void __launch_bounds__(NTHR, 2) fwd_kernel(Args args) {
    extern __shared__ __attribute__((aligned(16))) unsigned char lds[];
    Frame F;
    F.lds = (LAS unsigned char*)lds;
    F.tid = threadIdx.x; F.lane = F.tid & 63; F.wave = __builtin_amdgcn_readfirstlane(F.tid >> 6);
    F.G = gridDim.x; { const int bx = blockIdx.x; F.vcu = (F.G % 8 == 0) ? (bx % 8) * (F.G / 8) + bx / 8 : bx; }
    F.ws = args.ws; F.out = args.out;
    volatile LAS unsigned* MISC = (volatile LAS unsigned*)(F.lds + MISC_OFF);
    for (int u = F.tid; u < 64; u += NTHR) MISC[u] = 0u;
    __syncthreads();
    XcdBarrier bar = xcd_barrier_post((unsigned*)(F.ws + WS_CTL) + CW_BAR, MISC + 8);
    LAS unsigned char* ring = F.lds;
#define GRID_BAR() do { unsigned* bp_ = bar.bar; unsigned bx_ = bar.x; asm volatile("" : "+s"(bp_), "+s"(bx_)); XcdBarrier b_ = bar; b_.bar = bp_; b_.x = bx_; xcd_barrier(b_); } while (0)


#if !defined(OFF_PA)
    for (int rep = 0, nrep = opaque_int(REP_PA); rep < nrep; ++rep) { REFRESH(F); pa_adaln(F); __syncthreads(); pa_weights(F); __syncthreads(); }
#endif

    GRID_BAR();

    for (int l = 0; l < DEPTH; ++l) {
        const bool uc = l < DEPTH - 1;
        const int npm = uc ? PMT : PML;
        const GAS float* MODL = WSP(float, WS_MOD) + (size_t)l * 3 * (NMOD * DM);

#if !defined(OFF_P0)
        for (int rep = 0, nrep = opaque_int(REP_THIN); rep < nrep; ++rep) { REFRESH(F); norm_phase(F, l, 0, true); __syncthreads();
 REFRESH(F); filter_phase(F, l, uc); __syncthreads(); }
#endif

        GRID_BAR();
        {
            const char* Hb = (const char*)WSP(bf16, WS_H); const char* Wb = (const char*)(WSP(bf16, WS_WIN) + (size_t)l * DIN * DM);
            pg8::Sched2 S; S.n1 = PMT * 8; S.nM1 = PMT; S.nN1 = 8; S.n2 = 12 * PMT; S.nM2 = 12; S.nN2 = PMT; S.G = F.G; S.c = (int)blockIdx.x;
            S.A1 = Hb; S.B1 = Wb; S.A2 = Wb + (size_t)2048 * DM * 2; S.B2 = Hb; S.tstep = (size_t)256 * DM * 2;
            EpiIn E{WSP(bf16, WS_QK), WSP(bf16, WS_VT), WSP(float, WS_T32)};

#if !defined(OFF_P1)
            for (int rep = 0, nrep = opaque_int(REP_P1); rep < nrep; ++rep) { pg8::gemm_phase<EpiIn, pg8::Sched2, true, true>(ring, DM, S, E); __syncthreads(); }
#endif

        }
        GRID_BAR();

#if !defined(OFF_ATT)
        for (int rep = 0, nrep = opaque_int(REP_ATT); rep < nrep; ++rep) { REFRESH(F); attn_phase(F, l, uc); }
#endif
#if !defined(OFF_FFT)
        REFRESH(F); fft_phase(F, l, uc);
#endif

        GRID_BAR();

#if !defined(OFF_P3)
        for (int rep = 0, nrep = opaque_int(REP_THIN); rep < nrep; ++rep) { REFRESH(F); merge_phase(F, l, uc); __syncthreads(); }
#endif

        GRID_BAR();
        {
            pg8::Sched2 S; S.n1 = npm * 8; S.nM1 = npm; S.nN1 = 8; S.n2 = 0; S.nM2 = 1; S.nN2 = 1; S.G = F.G; S.c = (int)blockIdx.x;
            S.A1 = (const char*)WSP(bf16, WS_H); S.B1 = (const char*)(WSP(bf16, WS_WOUT) + (size_t)l * DM * DM); S.A2 = S.A1; S.B2 = S.B1; S.tstep = (size_t)256 * DM * 2;
            EpiRes E{l == 0 ? IN(x) : F.out, l == 0 ? IN(ctx) : WSP(float, WS_XC), F.out, WSP(float, WS_XC), MODL + 2 * DM};

#if !defined(OFF_P4)
            pg8::gemm_phase<EpiRes, pg8::Sched2, true, true>(ring, DM, S, E);
#endif

        }
        GRID_BAR();

#if !defined(OFF_P5)
        for (int rep = 0, nrep = opaque_int(REP_THIN); rep < nrep; ++rep) { REFRESH(F); norm_phase(F, l, 1, uc); }
#endif

        GRID_BAR();
        {
            pg8::Sched2 S; S.n1 = npm * 44; S.nM1 = npm; S.nN1 = 44; S.n2 = 0; S.nM2 = 1; S.nN2 = 1; S.G = F.G; S.c = (int)blockIdx.x;
            S.A1 = (const char*)WSP(bf16, WS_H); S.B1 = (const char*)(WSP(bf16, WS_WUP) + (size_t)l * 2 * DFF * DM); S.A2 = S.A1; S.B2 = S.B1; S.tstep = (size_t)256 * DM * 2;
            GAS float* EG = WSP(float, WS_EDGE);
            EpiUp E{WSP(bf16, WS_HID), EG, EG + EDGE_ELEMS, EG + 2 * EDGE_ELEMS, IN(ffn_conv_w) + (size_t)l * 3 * DFF, IN(ffn_conv_b) + (size_t)l * DFF};

#if !defined(OFF_P6)
            for (int rep = 0, nrep = opaque_int(REP_P6); rep < nrep; ++rep) { pg8::gemm_phase<EpiUp, pg8::Sched2, true, true>(ring, DM, S, E); __syncthreads(); }
#endif

        }
        GRID_BAR();

#if !defined(OFF_P6B)
        for (int rep = 0, nrep = opaque_int(REP_THIN); rep < nrep; ++rep) { REFRESH(F); edge_fix_phase(F, l, uc); }
#endif

        GRID_BAR();
        {
            pg8::Sched2 S; S.n1 = npm * 8; S.nM1 = npm; S.nN1 = 8; S.n2 = 0; S.nM2 = 1; S.nN2 = 1; S.G = F.G; S.c = (int)blockIdx.x;
            S.A1 = (const char*)WSP(bf16, WS_HID); S.B1 = (const char*)(WSP(bf16, WS_WDN) + (size_t)l * DM * DFF); S.A2 = S.A1; S.B2 = S.B1; S.tstep = (size_t)256 * DFF * 2;
            EpiRes E{F.out, WSP(float, WS_XC), F.out, WSP(float, WS_XC), MODL + 5 * DM};

#if !defined(OFF_P7)
            pg8::gemm_phase<EpiRes, pg8::Sched2, true, true>(ring, DFF, S, E);
#endif

        }
        GRID_BAR();
    }
    REFRESH(F); final_norm_phase(F);
}

extern "C" void kernel_launch(void* const* d_in, const int* in_sizes, int n_in, void* d_out, int out_size, void* d_ws, size_t ws_size, hipStream_t stream) {
    static int grid = 0;
    if (grid == 0) {
        if (n_in != 26 || in_sizes[0] != ML * DM || out_size != ML * DM || ws_size < WS_END) { fprintf(stderr, "kernel_launch: unexpected shapes (n_in %d, in0 %d, out %d, ws %zu < %zu)\n", n_in, n_in > 0 ? in_sizes[0] : -1, out_size, ws_size, (size_t)WS_END); grid = -1; return; }
        int dev = 0, cus = 0, per_cu = 0;
        if (hipGetDevice(&dev) != hipSuccess || hipDeviceGetAttribute(&cus, hipDeviceAttributeMultiprocessorCount, dev) != hipSuccess) { grid = -1; return; }
        if (hipFuncSetAttribute((const void*)fwd_kernel, hipFuncAttributeMaxDynamicSharedMemorySize, LDS_BYTES) != hipSuccess) { fprintf(stderr, "kernel_launch: hipFuncSetAttribute failed\n"); grid = -1; return; }
        if (hipOccupancyMaxActiveBlocksPerMultiprocessor(&per_cu, (const void*)fwd_kernel, NTHR, LDS_BYTES) != hipSuccess || per_cu < 1) { fprintf(stderr, "kernel_launch: occupancy query reports %d\n", per_cu); }
        (void)hipGetLastError();
        grid = cus;
    }
    if (grid < 0) return;
    if (hipMemsetAsync((char*)d_ws + WS_CTL, 0, CTL_ZERO_BYTES, stream) != hipSuccess) return;
    Args a{};
    for (int i = 0; i < 26; ++i) a.in[i] = (const GAS float*)d_in[i];
    a.out = (GAS float*)d_out; a.ws = (GAS unsigned char*)d_ws;
    hipLaunchKernelGGL(fwd_kernel, dim3(grid), dim3(NTHR), LDS_BYTES, stream, a);
}
```

```cpp
#include <hip/hip_runtime.h>
#include <cstdio>
#include <cstdint>
namespace pg8 {
#define PG8_LAS __attribute__((address_space(3)))
typedef unsigned short bf16_t;
typedef short bf16x8 __attribute__((ext_vector_type(8)));
typedef float f32x4 __attribute__((ext_vector_type(4)));
typedef unsigned u32x4 __attribute__((ext_vector_type(4)));
constexpr int BM = 256, BK = 64, HALF = 128, HTB = HALF * BK * 2  , STAGE_BYTES = 8 * HTB, NXCD = 8, WGM = 8;

__host__ __device__ __forceinline__ int lds_byte(int r, int c) { const int st = (r >> 4) * 2 + (c >> 5), rr = r & 15, cc = c & 31, ob = rr * 64 + cc * 2; return st * 1024 + (ob ^ (((ob >> 9) & 1) << 5)); }
__host__ __device__ __forceinline__ void stage_rc(int b, int& R, int& C) { const int st = b / 1024, sb = b % 1024, swz = sb ^ (((sb >> 9) & 1) << 5); R = (st >> 1) * 16 + swz / 64; C = (st & 1) * 32 + (swz % 64) / 2; }
__host__ __device__ __forceinline__ int perm32(int rho) { const int n = rho >> 4, i = rho & 15; return 8 * (i >> 2) + 4 * n + (i & 3); }

struct Unit { int pm, pn, type; };

__device__ __forceinline__ void map_unit(int w, int nwg, int nM, int nN, Unit& u) {
    { const int q = nwg / NXCD, r = nwg % NXCD, xcd = w % NXCD, off = w / NXCD; w = (xcd < r ? xcd * (q + 1) : r * (q + 1) + (xcd - r) * q) + off; }
    const int nig = WGM * nN, gid = w / nig, fm = gid * WGM, gsz = (nM - fm) < WGM ? (nM - fm) : WGM;
    u.pm = fm + ((w % nig) % gsz); u.pn = (w % nig) / gsz;
}
struct Sched2 {
    int n1, nM1, nN1, n2, nM2, nN2, G, c; const char *A1, *B1, *A2, *B2; size_t tstep;
    __device__ __forceinline__ bool next(int i, Unit& u) const {
        const long L = (long)i * G + c;
        if (L < n1) { map_unit((int)L, n1, nM1, nN1, u); u.type = 0; return true; }
        if (L < n1 + n2) { map_unit((int)L - n1, n2, nM2, nN2, u); u.type = 1; return true; }
        return false;
    }
    __device__ __forceinline__ const char* a_ptr(const Unit& u) const { return (u.type ? A2 : A1) + (size_t)u.pm * tstep; }
    __device__ __forceinline__ const char* b_ptr(const Unit& u) const { return (u.type ? B2 : B1) + (size_t)u.pn * tstep; }
    __device__ __forceinline__ void a_ready(const Unit&) const {}
    __device__ __forceinline__ void done(const Unit&) const {}
};

struct SchedK {
    int nsub, nN, ksplit, pm0, G, c; const char *A, *B; size_t tstep, kbytes;
    __device__ __forceinline__ bool next(int i, Unit& u) const {
        const long L = (long)i * G + c; if (L >= nsub) return false;
        const int j = (int)L / ksplit; u.type = (int)L % ksplit; u.pm = pm0 + j / nN; u.pn = j % nN; return true;
    }
    __device__ __forceinline__ const char* a_ptr(const Unit& u) const { return A + (size_t)u.pm * tstep + (size_t)u.type * kbytes; }
    __device__ __forceinline__ const char* b_ptr(const Unit& u) const { return B + (size_t)u.pn * tstep + (size_t)u.type * kbytes; }
    __device__ __forceinline__ void a_ready(const Unit&) const {}
    __device__ __forceinline__ void done(const Unit&) const {}
};

__device__ __forceinline__ unsigned cvt_pk_bf16(float lo, float hi) { unsigned r; asm volatile("v_cvt_pk_bf16_f32 %0, %1, %2" : "=v"(r) : "v"(lo), "v"(hi)); return r; }
typedef float f32x2 __attribute__((ext_vector_type(2)));

template <class Epi, class Sched, bool ALIGN_EPI = false, bool SP2 = false>
__device__ __forceinline__ void gemm_phase(PG8_LAS unsigned char* lds, const int Kdim  , const int Klen  , const Sched& S, const Epi& E) {
    int tid_ = threadIdx.x; asm volatile("" : "+v"(tid_));
    const int tid = tid_, wid = __builtin_amdgcn_readfirstlane(tid >> 6), lane = tid & 63, wr = wid >> 2, wc = wid & 3, fr = lane & 15, fq = lane >> 4;
    const int K = Kdim, nt = Klen / BK;
    unsigned voffA[2], voffB[2];
#pragma unroll
    for (int i = 0; i < 2; ++i) { int R, C; stage_rc(tid * 16 + i * 8192, R, C); const int Rb = Epi::PERM ? ((R & ~31) + perm32(R & 31)) : R;
        voffA[i] = (unsigned)(R * K + C) * 2u; voffB[i] = (unsigned)(Rb * K + C) * 2u; }
    const size_t kstep = (size_t)(BK * 2);
    const size_t hstep = (size_t)HALF * K * 2;
    const size_t tstep = 2 * hstep;
    const unsigned ldsw = (unsigned)wid * 1024u;
    const int aoff = lds_byte(wr * 64 + fr, fq * 8), boff = lds_byte(wc * 32 + fr, fq * 8);
#define PG8_SA(b, h) (((b) * 2 + (h)) * HTB)
#define PG8_SB(b, h) ((4 + (b) * 2 + (h)) * HTB)
#define PG8_STAGE(bufoff, gbase, voff) do { _Pragma("unroll") for (int _i = 0; _i < 2; ++_i) \
        __builtin_amdgcn_global_load_lds((const unsigned*)((const char*)(gbase) + (voff)[_i]), (PG8_LAS unsigned*)(lds + (bufoff) + ldsw + _i * 8192), 16, 0, 0); } while (0)
#define PG8_LDA(dst, b, h) do { _Pragma("unroll") for (int m = 0; m < 4; ++m) _Pragma("unroll") for (int k = 0; k < 2; ++k) dst[m][k] = *(const PG8_LAS bf16x8*)(lds + PG8_SA(b, h) + aoff + m * 2048 + k * 1024); } while (0)
#define PG8_LDB(dst, b, h) do { _Pragma("unroll") for (int n = 0; n < 2; ++n) _Pragma("unroll") for (int k = 0; k < 2; ++k) dst[n][k] = *(const PG8_LAS bf16x8*)(lds + PG8_SB(b, h) + boff + n * 2048 + k * 1024); } while (0)
#define PG8_MMA(ai, bj, At, Bt) do { __builtin_amdgcn_s_setprio(1); _Pragma("unroll") for (int m = 0; m < 4; ++m) _Pragma("unroll") for (int n = 0; n < 2; ++n) _Pragma("unroll") for (int k = 0; k < 2; ++k) \
        acc[ai][bj][m][n] = __builtin_amdgcn_mfma_f32_16x16x32_bf16(Bt[n][k], At[m][k], acc[ai][bj][m][n], 0, 0, 0); __builtin_amdgcn_s_setprio(0); } while (0)
#define PG8_WAIT_V(n) asm volatile("s_waitcnt vmcnt(" #n ")" ::: "memory")
#define PG8_WAIT_L(n) asm volatile("s_waitcnt lgkmcnt(" #n ")" ::: "memory")
#define PG8_BAR __builtin_amdgcn_s_barrier()
#define PG8_SCHED __builtin_amdgcn_sched_barrier(0)
    Unit cur, nxt; int ui = 0;
    if (!S.next(0, cur)) return;
    f32x4 acc[2][2][4][2];
#pragma unroll
    for (int a = 0; a < 2; ++a)
#pragma unroll
        for (int b = 0; b < 2; ++b)
#pragma unroll
            for (int m = 0; m < 4; ++m)
#pragma unroll
                for (int n = 0; n < 2; ++n) acc[a][b][m][n] = (f32x4){0.f, 0.f, 0.f, 0.f};
    bf16x8 At[4][2], B0[2][2], B1[2][2];
    const char* cA = S.a_ptr(cur); const char* cB = S.b_ptr(cur);
    S.a_ready(cur);
    if constexpr (SP2) {
        PG8_STAGE(PG8_SB(0, 0), cB, voffB); PG8_STAGE(PG8_SB(0, 1), cB + hstep, voffB); PG8_STAGE(PG8_SA(0, 0), cA, voffA); PG8_STAGE(PG8_SA(0, 1), cA + hstep, voffA);
        if (wr == 1) PG8_BAR;
        PG8_WAIT_V(2); PG8_BAR;
        PG8_STAGE(PG8_SB(1, 0), cB + kstep, voffB); PG8_STAGE(PG8_SA(1, 0), cA + kstep, voffA); PG8_STAGE(PG8_SB(1, 1), cB + hstep + kstep, voffB);
        PG8_WAIT_V(6); PG8_BAR;
    } else {
        PG8_STAGE(PG8_SB(0, 0), cB, voffB); PG8_STAGE(PG8_SA(0, 0), cA, voffA); PG8_STAGE(PG8_SB(0, 1), cB + hstep, voffB); PG8_STAGE(PG8_SA(0, 1), cA + hstep, voffA);
        if (wr == 1) PG8_BAR;
        PG8_WAIT_V(4); PG8_BAR;
        PG8_STAGE(PG8_SB(1, 0), cB + kstep, voffB); PG8_STAGE(PG8_SA(1, 0), cA + kstep, voffA); PG8_STAGE(PG8_SB(1, 1), cB + hstep + kstep, voffB);
        PG8_WAIT_V(6); PG8_BAR;
    }
    for (;;) {
        const bool has_next = S.next(ui + 1, nxt);
        const char* nA = has_next ? S.a_ptr(nxt) : cA; const char* nB = has_next ? S.b_ptr(nxt) : cB;
        for (int t = 0; t < nt; t += 2) {
            const bool last = (t == nt - 2);
            const char* a1 = cA + (size_t)(t + 1) * kstep;
            const char* a2 = last ? nA : cA + (size_t)(t + 2) * kstep; const char* b2 = last ? nB : cB + (size_t)(t + 2) * kstep;
            const char* a3 = a2 + kstep; const char* b3 = b2 + kstep;
            if (last && has_next) S.a_ready(nxt);
            if constexpr (SP2) {
            PG8_LDB(B0, 0, 0); PG8_LDB(B1, 0, 1); PG8_SCHED; PG8_LDA(At, 0, 0); PG8_STAGE(PG8_SA(1, 1), a1 + hstep, voffA);
            PG8_WAIT_V(8); PG8_WAIT_L(0); PG8_BAR; PG8_MMA(0, 0, At, B0); PG8_MMA(0, 1, At, B1); PG8_BAR; PG8_SCHED;
            PG8_LDA(At, 0, 1); PG8_STAGE(PG8_SB(0, 0), b2, voffB); PG8_STAGE(PG8_SB(0, 1), b2 + hstep, voffB); PG8_STAGE(PG8_SA(0, 0), a2, voffA);
            PG8_WAIT_V(8); PG8_WAIT_L(0); PG8_BAR; PG8_MMA(1, 0, At, B0); PG8_MMA(1, 1, At, B1); PG8_BAR; PG8_SCHED;
            PG8_LDB(B0, 1, 0); PG8_LDB(B1, 1, 1); PG8_SCHED; PG8_LDA(At, 1, 0); PG8_STAGE(PG8_SA(0, 1), a2 + hstep, voffA);
            PG8_WAIT_V(8); PG8_WAIT_L(0); PG8_BAR; PG8_MMA(0, 0, At, B0); PG8_MMA(0, 1, At, B1); PG8_BAR; PG8_SCHED;
            PG8_LDA(At, 1, 1); PG8_STAGE(PG8_SB(1, 0), b3, voffB); PG8_STAGE(PG8_SB(1, 1), b3 + hstep, voffB); PG8_STAGE(PG8_SA(1, 0), a3, voffA);
            PG8_WAIT_V(8); PG8_WAIT_L(0); PG8_BAR; PG8_MMA(1, 0, At, B0); PG8_MMA(1, 1, At, B1); PG8_BAR; PG8_SCHED;
            } else {
            PG8_LDB(B0, 0, 0); PG8_SCHED; PG8_LDA(At, 0, 0); PG8_STAGE(PG8_SA(1, 1), a1 + hstep, voffA);
            PG8_WAIT_L(8); PG8_BAR; PG8_WAIT_L(0); PG8_MMA(0, 0, At, B0); PG8_BAR; PG8_SCHED;
            PG8_LDB(B1, 0, 1); PG8_STAGE(PG8_SB(0, 0), b2, voffB);
            PG8_BAR; PG8_WAIT_L(0); PG8_MMA(0, 1, At, B1); PG8_BAR;
            PG8_LDA(At, 0, 1); PG8_STAGE(PG8_SA(0, 0), a2, voffA);
            PG8_BAR; PG8_WAIT_L(0); PG8_MMA(1, 0, At, B0); PG8_BAR; PG8_SCHED;
            PG8_STAGE(PG8_SB(0, 1), b2 + hstep, voffB);
            PG8_WAIT_V(6); PG8_BAR; PG8_MMA(1, 1, At, B1); PG8_BAR;
            PG8_LDB(B0, 1, 0); PG8_SCHED; PG8_LDA(At, 1, 0); PG8_STAGE(PG8_SA(0, 1), a2 + hstep, voffA);
            PG8_WAIT_L(8); PG8_BAR; PG8_WAIT_L(0); PG8_MMA(0, 0, At, B0); PG8_BAR; PG8_SCHED;
            PG8_LDB(B1, 1, 1); PG8_STAGE(PG8_SB(1, 0), b3, voffB);
            PG8_BAR; PG8_WAIT_L(0); PG8_MMA(0, 1, At, B1); PG8_BAR;
            PG8_LDA(At, 1, 1); PG8_STAGE(PG8_SA(1, 0), a3, voffA);
            PG8_BAR; PG8_WAIT_L(0); PG8_MMA(1, 0, At, B0); PG8_BAR; PG8_SCHED;
            PG8_STAGE(PG8_SB(1, 1), b3 + hstep, voffB);
            PG8_WAIT_V(6); PG8_BAR; PG8_MMA(1, 1, At, B1); PG8_BAR;
            }
        }
        if constexpr (ALIGN_EPI) { if (wr == 0) PG8_BAR; }
        if constexpr (!Epi::AFTER_DRAIN) { E(acc, cur, wr, wc, fr, fq); S.done(cur); }
        if (!has_next) break;
#pragma unroll
        for (int a = 0; a < 2; ++a)
#pragma unroll
            for (int b = 0; b < 2; ++b)
#pragma unroll
                for (int m = 0; m < 4; ++m)
#pragma unroll
                    for (int n = 0; n < 2; ++n) acc[a][b][m][n] = (f32x4){0.f, 0.f, 0.f, 0.f};
        cur = nxt; cA = nA; cB = nB; ++ui;
        if constexpr (ALIGN_EPI) { if (wr == 1) PG8_BAR; }
    }
    PG8_WAIT_V(0);
    if constexpr (!ALIGN_EPI) { if (wr == 0) PG8_BAR; }
    PG8_BAR;
    if constexpr (Epi::AFTER_DRAIN) { E.fused(acc, cur, wr, wc, fr, fq, lds, wid, lane); S.done(cur); }
#undef PG8_SA
#undef PG8_SB
#undef PG8_STAGE
#undef PG8_LDA
#undef PG8_LDB
#undef PG8_MMA
#undef PG8_WAIT_V
#undef PG8_WAIT_L
#undef PG8_BAR
#undef PG8_SCHED
}
}

constexpr int NWAVES = 8, NTHR = 512;
constexpr int DM = 2048, BATCH = 2, SEQ = 16384, DEPTH = 4, GRIDW = 64, GROWS = 256, CTXL = 256;
constexpr int NAW = 1024, NHEAD = 8, HDIM = 128, FNW = 512, HYW = 512, DFF = 5632, DIN = 5120, NMOD = 6;
constexpr int ML = BATCH * SEQ, MC = BATCH * CTXL, MT = ML + MC;
constexpr int PML = ML / 256, PMT = MT / 256;
constexpr int NEDGE = MT / 64 * 2;
constexpr float EPS = 1e-6f;
constexpr float LOG2E = 1.4426950408889634f;
constexpr float QSCALE = 0.08838834764831845f * LOG2E;
constexpr float HY_MIN_DECAY = -3.0701134573253945f, HY_MAX_DECAY = -15.350567286626973f;

constexpr size_t MiB = 1u << 20;
constexpr size_t WS_CTL = 0, CTL_ZERO_BYTES = 1 * MiB;
constexpr size_t WS_MOD = 1 * MiB;
constexpr size_t WS_XC = 2 * MiB;
constexpr size_t WS_HFC = 6 * MiB;
constexpr size_t WS_HF = 8 * MiB;
constexpr size_t WS_WIN = WS_HF + 128 * MiB;
constexpr size_t WS_WOUT = WS_WIN + 80 * MiB;
constexpr size_t WS_WUP = WS_WOUT + 32 * MiB;
constexpr size_t WS_WDN = WS_WUP + 176 * MiB;
constexpr size_t WS_H = WS_WDN + 88 * MiB;
constexpr size_t WS_QK = WS_H + 130 * MiB;
constexpr size_t WS_VT = WS_QK + 130 * MiB;
constexpr size_t WS_T32 = WS_VT + 65 * MiB;
constexpr size_t WS_A = WS_T32 + 260 * MiB;
constexpr size_t WS_HID = WS_QK;
constexpr size_t WS_EDGE = WS_A + 65 * MiB;
constexpr size_t EDGE_ELEMS = (size_t)NEDGE * DFF;
constexpr size_t WS_KS = WS_EDGE + 68 * MiB;
constexpr size_t WS_SLAB = WS_KS + 64 * MiB;
constexpr size_t WS_END = WS_SLAB + 16 * MiB;
static_assert((size_t)MT * DFF * 2 <= WS_EDGE - WS_QK, "hidden overlay");
static_assert(3 * EDGE_ELEMS * 4 <= 68 * MiB, "edge buffers");
static_assert((size_t)MT * DM * 2 == 130 * MiB && (size_t)1024 * MT * 2 == 65 * MiB && (size_t)2048 * MT * 4 == 260 * MiB, "sizes");
constexpr int CW_BAR = 4096;

constexpr int RING_BYTES = 131072;
constexpr int XTRA_OFF = RING_BYTES, XTRA_BYTES = 28672;
constexpr int MISC_OFF = XTRA_OFF + XTRA_BYTES;
constexpr int TW_OFF = XTRA_OFF + 24576;
constexpr int ATT_KC_OFF = 0, ATT_KC_PITCH = 272, ATT_VC_OFF = 256 * ATT_KC_PITCH, ATT_VC_PITCH = 528, ATT_BIAS_OFF = ATT_VC_OFF + 128 * ATT_VC_PITCH;
static_assert(ATT_BIAS_OFF + 8 * 465 * 4 <= TW_OFF, "attention LDS map");
constexpr int LDS_BYTES = MISC_OFF + 256;

#define GAS __attribute__((address_space(1)))
#define LAS __attribute__((address_space(3)))
typedef unsigned short bf16;
typedef unsigned v4u __attribute__((ext_vector_type(4)));
typedef unsigned v2u __attribute__((ext_vector_type(2)));
typedef float f32x4 __attribute__((ext_vector_type(4)));
typedef float f32x2 __attribute__((ext_vector_type(2)));
typedef short bf16x8 __attribute__((ext_vector_type(8)));
#define LDS_WAIT() asm volatile("s_waitcnt lgkmcnt(0)" ::: "memory")
__device__ __forceinline__ unsigned f2bf(float f) { unsigned u = __builtin_bit_cast(unsigned, f); return (u + 0x7fffu + ((u >> 16) & 1u)) >> 16; }
__device__ __forceinline__ unsigned pk2(float lo, float hi) { return f2bf(lo) | (f2bf(hi) << 16); }
__device__ __forceinline__ float bf2f(unsigned short b) { return __builtin_bit_cast(float, (unsigned)b << 16); }
__device__ __forceinline__ f32x2 cmul(f32x2 a, f32x2 b) { return (f32x2){a.x * b.x - a.y * b.y, a.x * b.y + a.y * b.x}; }
__device__ __forceinline__ f32x2 cconj(f32x2 a) { return (f32x2){a.x, -a.y}; }
__device__ __forceinline__ float lane_read(float v, int src_lane) { return __builtin_bit_cast(float, __builtin_amdgcn_ds_bpermute(src_lane << 2, __builtin_bit_cast(int, v))); }
__device__ __forceinline__ float wave_sum(float v, int lane) {
#pragma unroll
    for (int o = 1; o < 64; o <<= 1) v += lane_read(v, lane ^ o);
    return v;
}
__device__ __forceinline__ float gelu_tanh(float x) {
    const float t = x * (1.0f + 0.044715f * x * x) * (-2.302208198f);
    const float e = __builtin_amdgcn_exp2f(t);
    return x * __builtin_amdgcn_rcpf(1.0f + e);
}
#define XB_LAS_DEFINED
#define XB_TMO      128
#define XB_XCNT(j)  (256  + 64 * (j))
#define XB_XSUB(j)  (1280 + 64 * (j))
#define XB_XGEN(j)  (2304 + 64 * (j))
#define XB_TOP      3328
#define XB_TOPGEN   3392
#define XCD_BAR_WORDS 3456
#define XB_SPIN_CAP (1u << 18)

__device__ __forceinline__ unsigned xb_ld(unsigned* p)              { return __hip_atomic_load(p, __ATOMIC_RELAXED, __HIP_MEMORY_SCOPE_AGENT); }
__device__ __forceinline__ unsigned xb_add(unsigned* p, unsigned v) { return __hip_atomic_fetch_add(p, v, __ATOMIC_RELAXED, __HIP_MEMORY_SCOPE_AGENT); }
__device__ __forceinline__ unsigned xb_xcc_id() { return (unsigned)__builtin_amdgcn_s_getreg((3 << 11) | 20) & 0xFu; }
#define XB_SPIN(cond, bar) do { unsigned _sp = 0; while (cond) { __builtin_amdgcn_s_sleep(1); \
    if ((++_sp & 255u) == 0u) { if (xb_ld(&(bar)[XB_TMO])) break; if (_sp > XB_SPIN_CAP) { atomicAdd(&(bar)[XB_TMO], 1u); break; } } } } while (0)

struct XcdBarrier {
    unsigned* bar; unsigned x;
    volatile LAS unsigned* st;
};

__device__ __forceinline__ XcdBarrier xcd_barrier_post(unsigned* bar, volatile LAS unsigned* st) {
    XcdBarrier b; b.bar = bar; b.x = xb_xcc_id(); b.st = st;
    if (threadIdx.x == 0) (void)xb_add(&bar[XB_XCNT(b.x)], 1u);
    return b;
}
__device__ __forceinline__ void xcd_barrier_complete(unsigned* bar, unsigned x, unsigned& nloc, unsigned& nx) {
    const unsigned G = gridDim.x * gridDim.y * gridDim.z;
    unsigned sum, cnt, mine, sp = 0u;
    for (;;) {
        sum = 0u; cnt = 0u; mine = 0u;
#pragma unroll
        for (unsigned j = 0; j < 16; ++j) { const unsigned c = xb_ld(&bar[XB_XCNT(j)]); sum += c; cnt += (c > 0u) ? 1u : 0u; mine = (j == x) ? c : mine; }
        if (sum == G) break;
        __builtin_amdgcn_s_sleep(1);
        if ((++sp & 255u) == 0u) { if (xb_ld(&bar[XB_TMO])) break; if (sp > XB_SPIN_CAP) { atomicAdd(&bar[XB_TMO], 1u); break; } }
    }
    nloc = mine > 0u ? mine : 1u; nx = cnt > 0u ? cnt : 1u;
}

__device__ __forceinline__ void xcd_barrier(const XcdBarrier& b) {
    asm volatile("s_waitcnt vmcnt(0)" ::: "memory");
    __syncthreads();
    if (threadIdx.x == 0) {
        unsigned* bar = b.bar;
        __builtin_amdgcn_s_waitcnt(0);
        unsigned nloc = b.st[0], nx = b.st[1];
        if (nloc == 0u) { xcd_barrier_complete(bar, b.x, nloc, nx); b.st[0] = nloc; b.st[1] = nx; }
        const unsigned old = xb_add(&bar[XB_XSUB(b.x)], 1u);
        const unsigned gen = old / nloc;
        if (old + 1u == (gen + 1u) * nloc) {
            __builtin_amdgcn_fence(__ATOMIC_RELEASE, "agent");
            asm volatile("s_waitcnt vmcnt(0)" ::: "memory");
            const unsigned og = xb_add(&bar[XB_TOP], 1u);
            const unsigned tg = og / nx;
            if (og + 1u == (tg + 1u) * nx) xb_add(&bar[XB_TOPGEN], 1u);
            else XB_SPIN(xb_ld(&bar[XB_TOPGEN]) == tg, bar);
            __builtin_amdgcn_fence(__ATOMIC_ACQUIRE, "agent");
            xb_add(&bar[XB_XGEN(b.x)], 1u);
            asm volatile("s_waitcnt vmcnt(0)" ::: "memory");
        } else {
            XB_SPIN(xb_ld(&bar[XB_XGEN(b.x)]) == gen, bar);
            __builtin_amdgcn_fence(__ATOMIC_ACQUIRE, "agent");
            asm volatile("s_waitcnt vmcnt(0)" ::: "memory");
        }
    }
    __syncthreads();
}


struct Args { const GAS float* in[26]; GAS float* out; GAS unsigned char* ws; };
struct Frame {
    LAS unsigned char* lds;
    int tid, lane, wave;
    int vcu, G;
    GAS unsigned char* ws;
    GAS float* out;
};
typedef const float* cfptr_t;
__device__ __forceinline__ const GAS float* in_ptr(int k) { asm volatile("" : "+s"(k));
    const __attribute__((address_space(4))) cfptr_t* kp = (const __attribute__((address_space(4))) cfptr_t*)__builtin_amdgcn_kernarg_segment_ptr(); return (const GAS float*)kp[k]; }
enum { I_x, I_c, I_ctx, I_c_ctx, I_ada_w, I_ada_b, I_norm1_g, I_norm2_g, I_w_in, I_na_rpb, I_hy_conv_w, I_hy_conv_b, I_hy_w1, I_hy_b1, I_hy_w2, I_hy_b2, I_hy_w3, I_hy_freq, I_hy_bias,
       I_mix_norm_g, I_w_out, I_ffn_w_up, I_ffn_conv_w, I_ffn_conv_b, I_ffn_w_down, I_final_norm_g };
#define IN(name) in_ptr(I_##name)
#define WSP(T, off) ((GAS T*)(F.ws + (off)))

__device__ __forceinline__ void pa_adaln(Frame& F) {
    LAS float* sv = (LAS float*)F.lds;
    LAS float* red = (LAS float*)(F.lds + 3 * DM * 4);
    const GAS float* p_c = IN(c); const GAS float* p_cc = IN(c_ctx); const GAS float* p_aw = IN(ada_w); const GAS float* p_ab = IN(ada_b);
    for (int i = F.tid; i < 3 * DM; i += NTHR) { const int s = i / DM, k = i % DM; const float v = s < 2 ? p_c[s * DM + k] : p_cc[k]; sv[i] = v / (1.0f + __expf(-v)); }
    __syncthreads();
    GAS float* MOD = WSP(float, WS_MOD);
    const int cg = F.tid & 63, ks = F.tid >> 6;
    for (int item = F.vcu; item < DEPTH * 48; item += F.G) {
        const int l = item / 48, j0 = (item % 48) * 256;
        const GAS float* wp = p_aw + ((size_t)l * DM + ks * 256) * (NMOD * DM) + j0 + 4 * cg;
        f32x4 a0 = {0.f, 0.f, 0.f, 0.f}, a1 = a0, a2 = a0;
#pragma unroll 8
        for (int kk = 0; kk < 256; ++kk) {
            const f32x4 w = *(const GAS f32x4*)(wp + (size_t)kk * (NMOD * DM));
            const float s0 = sv[ks * 256 + kk], s1 = sv[DM + ks * 256 + kk], s2 = sv[2 * DM + ks * 256 + kk];
            a0 += w * s0; a1 += w * s1; a2 += w * s2;
        }
        *(LAS f32x4*)(red + (ks * 3 + 0) * 256 + 4 * cg) = a0; *(LAS f32x4*)(red + (ks * 3 + 1) * 256 + 4 * cg) = a1; *(LAS f32x4*)(red + (ks * 3 + 2) * 256 + 4 * cg) = a2;
        __syncthreads();
        if (F.tid < 192) {
            const int s = F.tid >> 6, cc = F.tid & 63;
            f32x4 t = *(const GAS f32x4*)(p_ab + (size_t)l * (NMOD * DM) + j0 + 4 * cc);
#pragma unroll
            for (int q = 0; q < 8; ++q) t += *(LAS f32x4*)(red + (q * 3 + s) * 256 + 4 * cc);
            *(GAS f32x4*)(MOD + ((size_t)l * 3 + s) * (NMOD * DM) + j0 + 4 * cc) = t;
        }
        __syncthreads();
    }
}
__device__ __forceinline__ void transpose_item(const GAS float* W, int K, int N, GAS bf16* WT, int k0, int n0, int drow0, LAS float* scr, int lane) {
#pragma unroll 8
    for (int i = 0; i < 32; ++i) { const int kk = 2 * i + (lane >> 5); scr[kk * 33 + (lane & 31)] = W[(size_t)(k0 + kk) * N + n0 + (lane & 31)]; }
    LDS_WAIT(); asm volatile("" ::: "memory");
    const int c = lane & 7;
#pragma unroll
    for (int j = 0; j < 4; ++j) { const int n = (lane >> 3) + 8 * j; const LAS float* s = scr + (8 * c) * 33 + n;
        v4u o; o.x = pk2(s[0 * 33], s[1 * 33]); o.y = pk2(s[2 * 33], s[3 * 33]); o.z = pk2(s[4 * 33], s[5 * 33]); o.w = pk2(s[6 * 33], s[7 * 33]);
        *(GAS v4u*)(WT + (size_t)(drow0 + n) * K + k0 + 8 * c) = o; }
    LDS_WAIT(); asm volatile("" ::: "memory");
}
__device__ __forceinline__ void pa_ctx_copy(Frame& F) {
    const GAS f32x4* src = (const GAS f32x4*)IN(ctx); GAS f32x4* dst = WSP(f32x4, WS_XC);
    for (int i = F.vcu * NTHR + F.tid; i < MC * DM / 4; i += F.G * NTHR) dst[i] = src[i];
}
__device__ __forceinline__ void pa_weights(Frame& F) {
    const GAS float* p_win = IN(w_in); const GAS float* p_wout = IN(w_out); const GAS float* p_wup = IN(ffn_w_up); const GAS float* p_wdn = IN(ffn_w_down);
    {
        LAS float* wt = (LAS float*)F.lds;
        LAS float* tab = (LAS float*)(F.lds + 64 * 129 * 4);
        if (F.tid < 128) tab[F.tid] = cospif((float)F.tid * (1.0f / 64.0f));
        for (int item = F.vcu; item < DEPTH * 4 * 32; item += F.G) {
            const int l = item >> 7, g = (item >> 5) & 3, k0 = (item & 31) * 64;
            __syncthreads();
            for (int i = F.tid; i < 64 * 128; i += NTHR) { const int kk = i >> 7, cc = i & 127; wt[kk * 129 + cc] = p_win[((size_t)l * DM + k0 + kk) * DIN + 3072 + g * 128 + cc]; }
            __syncthreads();
            const int kk = F.tid & 63;
            GAS bf16* dst = WSP(bf16, WS_WIN) + ((size_t)l * DIN + 3072 + g * 128) * DM + k0 + kk;
            for (int i = 0; i < 16; ++i) {
                const int mp = (F.tid >> 6) + 8 * i;
                const int mm = mp <= 64 ? mp : mp - 64, sh = mp <= 64 ? 0 : 96;
                float a = 0.f;
                const int add = mp <= 64 ? 0 : 32; (void)sh;
#pragma unroll 8
                for (int cc = 0; cc < 128; ++cc) a += wt[kk * 129 + cc] * tab[(mm * cc + add) & 127];
                dst[(size_t)mp * DM] = (bf16)f2bf(a);
            }
        }
        __syncthreads();
    }
    LAS float* scr = (LAS float*)(F.lds + F.wave * 16384);
    const int gw = F.vcu * NWAVES + F.wave, NGW = F.G * NWAVES;
    constexpr int I_IN = 32 * 144, I_OUT = 32 * 64, I_UP = 32 * 352, I_DN = 88 * 64, I_L = I_IN + I_OUT + I_UP + I_DN;
    for (int it = gw; it < DEPTH * I_L; it += NGW) {
        const int l = it / I_L; int r = it % I_L;
        if (r < I_IN) { const int kb = r / 144; int nb = r % 144; if (nb >= 96) nb += 16;
            transpose_item(p_win + (size_t)l * DM * DIN, DM, DIN, WSP(bf16, WS_WIN) + (size_t)l * DIN * DM, kb * 64, nb * 32, nb * 32, scr, F.lane); continue; }
        r -= I_IN;
        if (r < I_OUT) { const int kb = r / 64, nb = r % 64;
            transpose_item(p_wout + (size_t)l * DM * DM, DM, DM, WSP(bf16, WS_WOUT) + (size_t)l * DM * DM, kb * 64, nb * 32, nb * 32, scr, F.lane); continue; }
        r -= I_OUT;
        if (r < I_UP) { const int kb = r / 352, nb = r % 352; const int n0 = nb * 32;
            const int drow = n0 < DFF ? (n0 >> 7) * 256 + (n0 & 127) : ((n0 - DFF) >> 7) * 256 + 128 + ((n0 - DFF) & 127);
            transpose_item(p_wup + (size_t)l * DM * 2 * DFF, DM, 2 * DFF, WSP(bf16, WS_WUP) + (size_t)l * 2 * DFF * DM, kb * 64, n0, drow, scr, F.lane); continue; }
        r -= I_UP;
        { const int kb = r / 64, nb = r % 64;
            transpose_item(p_wdn + (size_t)l * DFF * DM, DFF, DM, WSP(bf16, WS_WDN) + (size_t)l * DM * DFF, kb * 64, nb * 32, nb * 32, scr, F.lane); }
    }
}

__device__ __forceinline__ void norm_phase(Frame& F, int l, int which, bool with_ctx, int nslab) {
    const GAS float* gain = (which ? IN(norm2_g) : IN(norm1_g)) + (size_t)l * DM;
    const GAS float* MOD = WSP(float, WS_MOD) + (size_t)l * 3 * (NMOD * DM);
    const bool first = (l == 0 && which == 0);
    const GAS float* xl = first ? IN(x) : F.out; const GAS float* xc = first ? IN(ctx) : WSP(float, WS_XC);
    GAS bf16* H = WSP(bf16, WS_H);
    const int gw = F.vcu * NWAVES + F.wave, NGW = F.G * NWAVES, nrows = with_ctx ? MT : ML;
    for (int row = gw; row < nrows; row += NGW) {
        const int s = row < SEQ ? 0 : row < ML ? 1 : 2;
        const GAS float* xr = row < ML ? xl + (size_t)row * DM : xc + (size_t)(row - ML) * DM;
        const GAS float* shp = MOD + (size_t)s * (NMOD * DM) + (which ? 3 : 0) * DM; const GAS float* scp = shp + DM;
        f32x4 v[8]; float ss = 0.f;
#pragma unroll
        for (int j = 0; j < 8; ++j) v[j] = *(const GAS f32x4*)(xr + 4 * (F.lane + 64 * j));
        if (row >= ML && nslab > 0) {
            const GAS float* sl = WSP(float, WS_SLAB) + (size_t)(row - ML) * DM; GAS float* xw = WSP(float, WS_XC) + (size_t)(row - ML) * DM;
            for (int ks = 0; ks < nslab; ++ks)
#pragma unroll
                for (int j = 0; j < 8; ++j) v[j] += *(const GAS f32x4*)(sl + (size_t)ks * MC * DM + 4 * (F.lane + 64 * j));
#pragma unroll
            for (int j = 0; j < 8; ++j) *(GAS f32x4*)(xw + 4 * (F.lane + 64 * j)) = v[j];
        }
#pragma unroll
        for (int j = 0; j < 8; ++j) ss += (v[j].x * v[j].x + v[j].y * v[j].y) + (v[j].z * v[j].z + v[j].w * v[j].w);
        const float rstd = 1.0f / sqrtf(wave_sum(ss, F.lane) * (1.0f / DM) + EPS);
        GAS bf16* hr = H + (size_t)row * DM;
#pragma unroll
        for (int j = 0; j < 8; ++j) { const int k = 4 * (F.lane + 64 * j);
            const f32x4 g = *(const GAS f32x4*)(gain + k), sc = *(const GAS f32x4*)(scp + k), sh = *(const GAS f32x4*)(shp + k);
            const f32x4 y = (v[j] * rstd * g) * (1.0f + sc) + sh;
            v2u o; o.x = pk2(y.x, y.y); o.y = pk2(y.z, y.w); *(GAS v2u*)(hr + k) = o; }
    }
}
__device__ __forceinline__ void final_norm_phase(Frame& F) {
    const GAS float* p_g = IN(final_norm_g);
    const int gw = F.vcu * NWAVES + F.wave, NGW = F.G * NWAVES;
    for (int row = gw; row < ML; row += NGW) {
        GAS float* xr = F.out + (size_t)row * DM;
        f32x4 v[8]; float ss = 0.f;
#pragma unroll
        for (int j = 0; j < 8; ++j) { v[j] = *(const GAS f32x4*)(xr + 4 * (F.lane + 64 * j)); ss += (v[j].x * v[j].x + v[j].y * v[j].y) + (v[j].z * v[j].z + v[j].w * v[j].w); }
        const float rstd = 1.0f / sqrtf(wave_sum(ss, F.lane) * (1.0f / DM) + EPS);
#pragma unroll
        for (int j = 0; j < 8; ++j) { const int k = 4 * (F.lane + 64 * j); *(GAS f32x4*)(xr + k) = v[j] * rstd * *(const GAS f32x4*)(p_g + k); }
    }
}

__device__ __forceinline__ void filter_phase(Frame& F, int l, bool with_ctx) {
    LAS float* h1 = (LAS float*)F.lds;
    LAS float* h2 = (LAS float*)(F.lds + 64 * 65 * 4);
    const GAS float* w1 = IN(hy_w1) + (size_t)l * 33 * 64; const GAS float* b1 = IN(hy_b1) + (size_t)l * 64;
    const GAS float* w2 = IN(hy_w2) + (size_t)l * 64 * 64; const GAS float* b2 = IN(hy_b2) + (size_t)l * 64;
    const GAS float* w3 = IN(hy_w3) + (size_t)l * 64 * 2048; const GAS float* fq = IN(hy_freq) + (size_t)l * 64;
    const int nitems = with_ctx ? 260 : 256;
    for (int item = F.vcu; item < nitems; item += F.G) {
        const bool isc = item >= 256; const int Lq = isc ? CTXL : SEQ; const int n0 = (isc ? item - 256 : item) * 64;
        const int p = F.tid & 63, jg = F.wave;
        const float pos = (float)(n0 + p), t = pos / (float)(Lq - 1);
        __syncthreads();
        {
            float zf[33]; zf[0] = t;
#pragma unroll
            for (int i = 0; i < 16; ++i) { const float band = 1e-4f + (float)i * ((15.0f - 1e-4f) / 15.0f); const float ang = band * (6.283185307179586f / (float)Lq) * pos; zf[1 + i] = cosf(ang); zf[17 + i] = -sinf(ang); }
#pragma unroll 1
            for (int jj = 0; jj < 8; ++jj) { const int j = jg * 8 + jj; float a = b1[j];
#pragma unroll
                for (int i = 0; i < 33; ++i) a += zf[i] * w1[i * 64 + j];
                h1[p * 65 + j] = sinf(fq[j] * a); }
        }
        __syncthreads();
#pragma unroll 1
        for (int jj = 0; jj < 8; ++jj) { const int j = jg * 8 + jj; float a = b2[j];
#pragma unroll 8
            for (int i = 0; i < 64; ++i) a += h1[p * 65 + i] * w2[i * 64 + j];
            h2[p * 65 + j] = sinf(fq[j] * a); }
        __syncthreads();
        GAS float* dst = isc ? WSP(float, WS_HFC) : WSP(float, WS_HF);
        LAS float* w3s = (LAS float*)(F.lds + 2 * 64 * 65 * 4);
        for (int ck = 0; ck < 8; ++ck) {
            __syncthreads();
#pragma unroll 4
            for (int i = F.tid; i < 64 * 64; i += NTHR) { const int jr = i >> 6, c4 = (i & 63) * 4; *(LAS f32x4*)(w3s + jr * 256 + c4) = *(const GAS f32x4*)(w3 + (size_t)jr * 2048 + ck * 256 + c4); }
            __syncthreads();
            f32x4 a[8];
#pragma unroll
            for (int q = 0; q < 8; ++q) a[q] = (f32x4){0.f, 0.f, 0.f, 0.f};
#pragma unroll 2
            for (int i = 0; i < 64; ++i) { const float hvi = h2[p * 65 + i]; const LAS f32x4* wr = (const LAS f32x4*)(w3s + i * 256 + jg * 32);
#pragma unroll
                for (int q = 0; q < 8; ++q) a[q] += wr[q] * hvi; }
#pragma unroll
            for (int q = 0; q < 8; ++q)
#pragma unroll
                for (int e = 0; e < 4; ++e) { const int col = ck * 256 + jg * 32 + q * 4 + e, ch = col & 511;
                    const float delta = fabsf(HY_MIN_DECAY + (HY_MAX_DECAY - HY_MIN_DECAY) * ((float)ch / 511.0f));
                    const float val = a[q][e] * __expf(-t * delta); const int n = n0 + p;
                    if (col & 512) dst[(size_t)col * Lq + ((Lq - n) & (Lq - 1))] = n == 0 ? 0.f : val;
                    else dst[(size_t)col * Lq + n] = val; }
        }
    }
}

struct EpiIn {
    static constexpr bool PERM = true, AFTER_DRAIN = false;
    GAS bf16* QK; GAS bf16* VT; GAS float* T32;
    __device__ __forceinline__ void operator()(pg8::f32x4 (&acc)[2][2][4][2], const pg8::Unit& u, int wr_, int wc_, int fr_, int fq_) const {
        int t_ = threadIdx.x; asm volatile("" : "+v"(t_));
        const int fr = t_ & 15, fq = (t_ >> 4) & 3, wc = (t_ >> 6) & 3, wr = t_ >> 8; (void)wr_; (void)wc_; (void)fr_; (void)fq_;
        const int row0 = u.pm * 256 + wr * 64 + fr, col0 = u.pn * 256 + wc * 32 + 8 * fq;
        if (u.type == 0) {
            const float sc = u.pn < 4 ? QSCALE : 1.0f;
#pragma unroll
            for (int ai = 0; ai < 2; ++ai)
#pragma unroll
                for (int m = 0; m < 4; ++m) { GAS bf16* rowp = QK + (size_t)(row0 + ai * 128 + m * 16) * 2048 + col0;
#pragma unroll
                    for (int bj = 0; bj < 2; ++bj) { const pg8::f32x4 v0 = acc[ai][bj][m][0] * sc, v1 = acc[ai][bj][m][1] * sc;
                        v4u w; w.x = pg8::cvt_pk_bf16(v0[0], v0[1]); w.y = pg8::cvt_pk_bf16(v0[2], v0[3]); w.z = pg8::cvt_pk_bf16(v1[0], v1[1]); w.w = pg8::cvt_pk_bf16(v1[2], v1[3]);
                        *(GAS v4u*)(rowp + bj * 128) = w; } }
        } else if (u.pm < 4) {
#pragma unroll
            for (int ai = 0; ai < 2; ++ai)
#pragma unroll
                for (int m = 0; m < 4; ++m) { GAS bf16* rowp = VT + (size_t)(row0 + ai * 128 + m * 16) * MT + col0;
#pragma unroll
                    for (int bj = 0; bj < 2; ++bj) { const pg8::f32x4 v0 = acc[ai][bj][m][0], v1 = acc[ai][bj][m][1];
                        v4u w; w.x = pg8::cvt_pk_bf16(v0[0], v0[1]); w.y = pg8::cvt_pk_bf16(v0[2], v0[3]); w.z = pg8::cvt_pk_bf16(v1[0], v1[1]); w.w = pg8::cvt_pk_bf16(v1[2], v1[3]);
                        *(GAS v4u*)(rowp + bj * 128) = w; } }
        } else {
#pragma unroll
            for (int ai = 0; ai < 2; ++ai)
#pragma unroll
                for (int m = 0; m < 4; ++m) { GAS float* rowp = T32 + (size_t)(row0 - 1024 + ai * 128 + m * 16) * MT + col0;
#pragma unroll
                    for (int bj = 0; bj < 2; ++bj) { *(GAS pg8::f32x4*)(rowp + bj * 128) = acc[ai][bj][m][0]; *(GAS pg8::f32x4*)(rowp + bj * 128 + 4) = acc[ai][bj][m][1]; } }
        }
    }
};
struct EpiRes {
    static constexpr bool PERM = false, AFTER_DRAIN = false;
    const GAS float* base_l; const GAS float* base_c; GAS float* out_l; GAS float* out_c; const GAS float* gate;
    __device__ __forceinline__ void operator()(pg8::f32x4 (&acc)[2][2][4][2], const pg8::Unit& u, int wr_, int wc_, int fr_, int fq_) const {
        int t_ = threadIdx.x; asm volatile("" : "+v"(t_));
        const int fr = t_ & 15, fq = (t_ >> 4) & 3, wc = (t_ >> 6) & 3, wr = t_ >> 8; (void)wr_; (void)wc_; (void)fr_; (void)fq_;
        const int row0 = u.pm * 256 + wr * 64 + fr, col0 = u.pn * 256 + wc * 32 + 4 * fq;
        const int s = u.pm < PML / 2 ? 0 : u.pm < PML ? 1 : 2;
        const GAS float* bs = u.pm < PML ? base_l + (size_t)row0 * DM : base_c + (size_t)(row0 - ML) * DM;
        GAS float* os = u.pm < PML ? out_l + (size_t)row0 * DM : out_c + (size_t)(row0 - ML) * DM;
        pg8::f32x4 gv[2][2];
#pragma unroll
        for (int bj = 0; bj < 2; ++bj)
#pragma unroll
            for (int n = 0; n < 2; ++n) gv[bj][n] = *(const GAS pg8::f32x4*)(gate + (size_t)s * (NMOD * DM) + col0 + bj * 128 + n * 16);
#pragma unroll
        for (int ai = 0; ai < 2; ++ai)
#pragma unroll
            for (int m = 0; m < 4; ++m) { const size_t off = (size_t)(ai * 128 + m * 16) * DM + col0;
#pragma unroll
                for (int bj = 0; bj < 2; ++bj)
#pragma unroll
                    for (int n = 0; n < 2; ++n) { const pg8::f32x4 b = *(const GAS pg8::f32x4*)(bs + off + bj * 128 + n * 16);
                        *(GAS pg8::f32x4*)(os + off + bj * 128 + n * 16) = b + gv[bj][n] * acc[ai][bj][m][n]; }
                asm volatile("" ::: "memory"); }
    }
};
struct EpiSlab {
    static constexpr bool PERM = false, AFTER_DRAIN = false;
    GAS float* slab; const GAS float* gate;
    __device__ __forceinline__ void operator()(pg8::f32x4 (&acc)[2][2][4][2], const pg8::Unit& u, int wr_, int wc_, int fr_, int fq_) const {
        int t_ = threadIdx.x; asm volatile("" : "+v"(t_));
        const int fr = t_ & 15, fq = (t_ >> 4) & 3, wc = (t_ >> 6) & 3, wr = t_ >> 8; (void)wr_; (void)wc_; (void)fr_; (void)fq_;
        const int row0 = u.pm * 256 + wr * 64 + fr - ML, col0 = u.pn * 256 + wc * 32 + 4 * fq;
        pg8::f32x4 gv[2][2];
#pragma unroll
        for (int bj = 0; bj < 2; ++bj)
#pragma unroll
            for (int n = 0; n < 2; ++n) gv[bj][n] = *(const GAS pg8::f32x4*)(gate + (size_t)2 * (NMOD * DM) + col0 + bj * 128 + n * 16);
        GAS float* sb = slab + (size_t)u.type * MC * DM;
#pragma unroll
        for (int ai = 0; ai < 2; ++ai)
#pragma unroll
            for (int m = 0; m < 4; ++m) { GAS float* os = sb + (size_t)(row0 + ai * 128 + m * 16) * DM + col0;
#pragma unroll
                for (int bj = 0; bj < 2; ++bj)
#pragma unroll
                    for (int n = 0; n < 2; ++n) *(GAS pg8::f32x4*)(os + bj * 128 + n * 16) = gv[bj][n] * acc[ai][bj][m][n]; }
    }
};
struct EpiUp {
    static constexpr bool PERM = true, AFTER_DRAIN = false;
    GAS bf16* HID; GAS float* EG; GAS float* EP; GAS float* EU; const GAS float* cw; const GAS float* cb;
    __device__ __forceinline__ void operator()(pg8::f32x4 (&acc)[2][2][4][2], const pg8::Unit& u, int wr_, int wc_, int fr_, int fq_) const {
        int t_ = threadIdx.x; asm volatile("" : "+v"(t_));
        const int fr = t_ & 15, fq = (t_ >> 4) & 3, wc = (t_ >> 6) & 3, wr = t_ >> 8; (void)wr_; (void)wc_; (void)fr_; (void)fq_;
        const int lane = t_ & 63;
        const unsigned hc0 = (unsigned)(u.pn * 128 + wc * 32 + 8 * fq);
        const int src_prev = (lane & 48) | ((fr + 15) & 15), src_next = (lane & 48) | ((fr + 1) & 15);
        const bool e0 = fr == 0, e3 = fr == 15;
        __builtin_amdgcn_sched_barrier(0);
#pragma unroll
        for (int ai = 0; ai < 2; ++ai) {
            const int rbase = u.pm * 256 + ai * 128 + wr * 64;
            const unsigned eb0 = (unsigned)((rbase >> 6) << 1) * (unsigned)DFF, eb3 = eb0 + (unsigned)DFF;
#pragma unroll
            for (int n = 0; n < 2; ++n) {
                const unsigned hc = hc0 + 4u * (unsigned)n;
                const pg8::f32x4 w0 = *(const GAS pg8::f32x4*)&cw[hc], w1 = *(const GAS pg8::f32x4*)&cw[(unsigned)DFF + hc], w2 = *(const GAS pg8::f32x4*)&cw[2u * (unsigned)DFF + hc], bb = *(const GAS pg8::f32x4*)&cb[hc];
                if (e0) { *(GAS pg8::f32x4*)&EG[eb0 + hc] = acc[ai][0][0][n]; *(GAS pg8::f32x4*)&EU[eb0 + hc] = acc[ai][1][0][n]; }
                if (e3) { *(GAS pg8::f32x4*)&EG[eb3 + hc] = acc[ai][0][3][n]; *(GAS pg8::f32x4*)&EU[eb3 + hc] = acc[ai][1][3][n]; }
#pragma unroll
                for (int j = 0; j < 4; ++j) {
                    float pr[4], nx[4], gg[4];
#pragma unroll
                    for (int m = 0; m < 4; ++m) { gg[m] = acc[ai][0][m][n][j]; pr[m] = lane_read(gg[m], src_prev); nx[m] = lane_read(gg[m], src_next); }
#pragma unroll
                    for (int m = 0; m < 4; ++m) {
                        const float pv = fr > 0 ? pr[m] : (m > 0 ? pr[m > 0 ? m - 1 : 0] : 0.f);
                        const float nv = fr < 15 ? nx[m] : (m < 3 ? nx[m < 3 ? m + 1 : 3] : 0.f);
                        const float cv = w0[j] * pv + w1[j] * gg[m] + w2[j] * nv + bb[j];
                        if (m == 0) { if (e0) EP[eb0 + hc + (unsigned)j] = cv; } if (m == 3) { if (e3) EP[eb3 + hc + (unsigned)j] = cv; }
                        acc[ai][0][m][n][j] = gelu_tanh(cv) * acc[ai][1][m][n][j];
                    }
                }
                asm volatile("" ::: "memory"); __builtin_amdgcn_sched_barrier(0);
            }
#pragma unroll
            for (int m = 0; m < 4; ++m) {
                if (!((m == 0 && e0) || (m == 3 && e3))) {
                    const pg8::f32x4 v0 = acc[ai][0][m][0], v1 = acc[ai][0][m][1];
                    v4u w; w.x = pg8::cvt_pk_bf16(v0[0], v0[1]); w.y = pg8::cvt_pk_bf16(v0[2], v0[3]); w.z = pg8::cvt_pk_bf16(v1[0], v1[1]); w.w = pg8::cvt_pk_bf16(v1[2], v1[3]);
                    *(GAS v4u*)&HID[(unsigned)(rbase + m * 16 + fr) * (unsigned)DFF + hc0] = w;
                }
            }
        }
    }
};
__device__ __forceinline__ void edge_fix_phase(Frame& F, int l, bool with_ctx) {
    const GAS float* EG = WSP(float, WS_EDGE); const GAS float* EP = EG + EDGE_ELEMS; const GAS float* EU = EP + EDGE_ELEMS;
    const GAS float* cw = IN(ffn_conv_w) + (size_t)l * 3 * DFF;
    GAS bf16* HID = WSP(bf16, WS_HID);
    const int ne = with_ctx ? NEDGE : ML / 64 * 2, total = ne * (DFF / 4);
    for (int i = F.vcu * NTHR + F.tid; i < total; i += F.G * NTHR) {
        const int e = i / (DFF / 4), c = (i % (DFF / 4)) * 4;
        const int r = (e >> 1) * 64 + (e & 1) * 63;
        f32x4 p = *(const GAS f32x4*)(EP + (size_t)e * DFF + c);
        if (e & 1) { const int nr = r + 1; if (nr != SEQ && nr != ML && nr != ML + CTXL && nr != MT) p += *(const GAS f32x4*)(cw + 2 * DFF + c) * *(const GAS f32x4*)(EG + (size_t)(e + 1) * DFF + c); }
        else { if (r != 0 && r != SEQ && r != ML && r != ML + CTXL) p += *(const GAS f32x4*)(cw + c) * *(const GAS f32x4*)(EG + (size_t)(e - 1) * DFF + c); }
        const f32x4 up = *(const GAS f32x4*)(EU + (size_t)e * DFF + c);
        v2u o; o.x = pk2(gelu_tanh(p.x) * up.x, gelu_tanh(p.y) * up.y); o.y = pk2(gelu_tanh(p.z) * up.z, gelu_tanh(p.w) * up.w);
        *(GAS v2u*)(HID + (size_t)r * DFF + c) = o;
    }
}

#define MFMA16(a, b, c) __builtin_amdgcn_mfma_f32_16x16x32_bf16((a), (b), (c), 0, 0, 0)
struct AttnK { bf16x8 kf[2][4]; };
struct AttnV { bf16x8 vf[8]; };
__device__ __forceinline__ void attn_load_k(AttnK& C, const GAS bf16* kbase  , int q, int g) {
#pragma unroll
    for (int T = 0; T < 2; ++T) { const unsigned koff = (unsigned)((8 * (q >> 2) + 4 * T + (q & 3)) * 2048 + 8 * g);
#pragma unroll
        for (int dc = 0; dc < 4; ++dc) C.kf[T][dc] = *(const GAS bf16x8*)(kbase + koff + 32 * dc); }
}
__device__ __forceinline__ void attn_load_v(AttnV& C, const GAS bf16* vbase  , int q, int g) {
    const unsigned voff = (unsigned)(q * MT + 8 * g);
#pragma unroll
    for (int dt = 0; dt < 8; ++dt) { const GAS bf16* vrow = vbase + (size_t)dt * 16 * MT; C.vf[dt] = *(const GAS bf16x8*)(vrow + voff); }
}
__device__ __forceinline__ void attn_load_k_ctx(AttnK& C, const LAS unsigned char* KC, int cc, int q, int g) {
#pragma unroll
    for (int T = 0; T < 2; ++T) { const int kk = 8 * (q >> 2) + 4 * T + (q & 3);
#pragma unroll
        for (int dc = 0; dc < 4; ++dc) C.kf[T][dc] = *(const LAS bf16x8*)(KC + (32 * cc + kk) * ATT_KC_PITCH + (32 * dc + 8 * g) * 2); }
}
__device__ __forceinline__ void attn_load_v_ctx(AttnV& C, const LAS unsigned char* VC, int cc, int q, int g) {
#pragma unroll
    for (int dt = 0; dt < 8; ++dt) C.vf[dt] = *(const LAS bf16x8*)(VC + (16 * dt + q) * ATT_VC_PITCH + (32 * cc + 8 * g) * 2);
}
__device__ __forceinline__ void attn_compute(const AttnK& C, const AttnV& V, const bf16x8 (&qf)[4], f32x4 (&o)[8], float& mrun, float& lsum, int lane, int g,
                                             bool masked, int keycol0, int cs, const LAS float* brow  , int cq) {
    f32x4 s[2];
#pragma unroll
    for (int T = 0; T < 2; ++T) { s[T] = (f32x4){0.f, 0.f, 0.f, 0.f};
#pragma unroll
        for (int dc = 0; dc < 4; ++dc) s[T] = MFMA16(C.kf[T][dc], qf[dc], s[T]); }
    if (masked) {
#pragma unroll
        for (int T = 0; T < 2; ++T)
#pragma unroll
            for (int i = 0; i < 4; ++i) { const int keycol = keycol0 + 8 * g + 4 * T + i; const bool ok = keycol >= cs && keycol < cs + 16;
                const int dcol = keycol - cq + 15; const float bv = brow[ok ? dcol : 0];
                s[T][i] = ok ? s[T][i] + bv : -1e30f; }
    }
    float cm = fmaxf(fmaxf(fmaxf(s[0][0], s[0][1]), fmaxf(s[0][2], s[0][3])), fmaxf(fmaxf(s[1][0], s[1][1]), fmaxf(s[1][2], s[1][3])));
    cm = fmaxf(cm, lane_read(cm, lane ^ 16)); cm = fmaxf(cm, lane_read(cm, lane ^ 32));
    const float mnew = fmaxf(mrun, cm), alpha = __builtin_amdgcn_exp2f(mrun - mnew);
    mrun = mnew;
    float p[8]; float ps = 0.f;
#pragma unroll
    for (int T = 0; T < 2; ++T)
#pragma unroll
        for (int i = 0; i < 4; ++i) { p[4 * T + i] = __builtin_amdgcn_exp2f(s[T][i] - mnew); ps += p[4 * T + i]; }
    lsum = lsum * alpha + ps;
    v4u pw; pw.x = pg8::cvt_pk_bf16(p[0], p[1]); pw.y = pg8::cvt_pk_bf16(p[2], p[3]); pw.z = pg8::cvt_pk_bf16(p[4], p[5]); pw.w = pg8::cvt_pk_bf16(p[6], p[7]);
    const bf16x8 pf = __builtin_bit_cast(bf16x8, pw);
#pragma unroll
    for (int dt = 0; dt < 8; ++dt) { o[dt] = o[dt] * alpha; o[dt] = MFMA16(V.vf[dt], pf, o[dt]); }
}
__device__ __forceinline__ void attn_tile(Frame& F, bool is_lat, int b, int h, int r, int c0, int qrow0, const LAS float* bias_h) {
    const GAS bf16* QK = WSP(bf16, WS_QK); const GAS bf16* VT = WSP(bf16, WS_VT); GAS bf16* A = WSP(bf16, WS_A);
    const int q = F.lane & 15, g = F.lane >> 4;
    bf16x8 qf[4];
    { const GAS bf16* qp = QK + (size_t)(qrow0 + q) * 2048 + h * 128 + 8 * g;
#pragma unroll
      for (int dc = 0; dc < 4; ++dc) qf[dc] = *(const GAS bf16x8*)(qp + 32 * dc); }
    f32x4 o[8];
#pragma unroll
    for (int dt = 0; dt < 8; ++dt) o[dt] = (f32x4){0.f, 0.f, 0.f, 0.f};
    float mrun = -1e30f, lsum = 0.f;
    const int r0 = min(max(r - 4, 0), GROWS - 8), kc0 = min(max(c0 - 8, 0), 32), cq = c0 + q, cs = min(max(cq - 8, 0), 48);
    const GAS bf16* kh = QK + 1024 + h * 128; const GAS bf16* vh = VT + (size_t)(h * 128) * MT;
#define ATT_TOK(c) ((c) < 8 ? b * SEQ + (r0 + (c)) * GRIDW + kc0 : ML + b * CTXL + 32 * ((c) - 8))
#define ATT_LOADK(C, c) do { if ((c) < 8) { const int tok_ = ATT_TOK(c); attn_load_k(C, kh + (size_t)tok_ * 2048, q, g); } else attn_load_k_ctx(C, F.lds + ATT_KC_OFF, (c) - 8, q, g); } while (0)
#define ATT_LOADV(C, c) do { if ((c) < 8) { const int tok_ = ATT_TOK(c); attn_load_v(C, vh + tok_, q, g); } else attn_load_v_ctx(C, F.lds + ATT_VC_OFF, (c) - 8, q, g); } while (0)
#define ATT_COMP(C, V, c) attn_compute(C, V, qf, o, mrun, lsum, F.lane, g, (c) < 8, kc0, cs, bias_h + (r0 + ((c) < 8 ? (c) : 0) - r + 7) * 31, cq)
    AttnK KA, KB; AttnV VV;
    const int cbeg = is_lat ? 0 : 8;
    ATT_LOADK(KA, cbeg);
    for (int c = cbeg; c < 16; c += 2) {
        ATT_LOADV(VV, c); ATT_LOADK(KB, c + 1); __builtin_amdgcn_sched_barrier(0);
        ATT_COMP(KA, VV, c); __builtin_amdgcn_sched_barrier(0);
        ATT_LOADV(VV, c + 1); if (c + 2 < 16) ATT_LOADK(KA, c + 2);
        __builtin_amdgcn_sched_barrier(0);
        ATT_COMP(KB, VV, c + 1); __builtin_amdgcn_sched_barrier(0);
    }
#undef ATT_TOK
#undef ATT_LOADK
#undef ATT_LOADV
#undef ATT_COMP
    lsum += lane_read(lsum, F.lane ^ 16); lsum += lane_read(lsum, F.lane ^ 32);
    const float inv = 1.0f / lsum;
    GAS bf16* ap = A + (size_t)(qrow0 + q) * 1024 + h * 128 + 4 * g;
#pragma unroll
    for (int dt = 0; dt < 8; ++dt) { v2u w; w.x = pg8::cvt_pk_bf16(o[dt][0] * inv, o[dt][1] * inv); w.y = pg8::cvt_pk_bf16(o[dt][2] * inv, o[dt][3] * inv); *(GAS v2u*)(ap + 16 * dt) = w; }
}
__device__ __forceinline__ void attn_phase(Frame& F, int l, bool with_ctx) {
    LAS float* bias = (LAS float*)(F.lds + ATT_BIAS_OFF);
    const GAS float* p_rpb = IN(na_rpb) + (size_t)l * NHEAD * 465;
    for (int i = F.tid; i < NHEAD * 465; i += NTHR) bias[i] = p_rpb[i] * LOG2E;
    const GAS bf16* QK = WSP(bf16, WS_QK); const GAS bf16* VT = WSP(bf16, WS_VT);
    for (int wgi = F.vcu; wgi < 256; wgi += F.G) {
        const int bh = wgi >> 4, b = bh >> 3, h = bh & 7, sub = wgi & 15;
        __syncthreads();
#pragma unroll 4
        for (int i = F.tid; i < 256 * 16; i += NTHR) { const int row = i >> 4, pc = i & 15;
            *(LAS v4u*)(F.lds + ATT_KC_OFF + row * ATT_KC_PITCH + pc * 16) = *(const GAS v4u*)(QK + (size_t)(ML + b * CTXL + row) * 2048 + 1024 + h * 128 + 8 * pc); }
#pragma unroll 4
        for (int i = F.tid; i < 128 * 32; i += NTHR) { const int row = i >> 5, pc = i & 31;
            *(LAS v4u*)(F.lds + ATT_VC_OFF + row * ATT_VC_PITCH + pc * 16) = *(const GAS v4u*)(VT + (size_t)(h * 128 + row) * MT + ML + b * CTXL + 8 * pc); }
        __syncthreads();
        const int rb = sub * 2 + (F.wave >> 2), c0 = 16 * (F.wave & 3);
        for (int rr = 0; rr < 8; ++rr) { const int r = rb * 8 + rr; attn_tile(F, true, b, h, r, c0, b * SEQ + r * GRIDW + c0, bias + h * 465); }
        if (with_ctx) {
            if ((F.wave & 3) == 0) { const int t = sub; if ((F.wave >> 2) == (t & 1)) attn_tile(F, false, b, h, 0, 0, ML + b * CTXL + 16 * t, bias + h * 465); }
        }
    }
    __syncthreads();
}

constexpr int FFTN = 16384, FFT_PHYS = FFTN + FFTN / 16;
__device__ __forceinline__ int phys(int i) { return i + ((i >> 6) << 2); }
__device__ __forceinline__ f32x2 tw32k(const LAS f32x2* TH, const LAS f32x2* TL, int n) { return cmul(TH[n >> 7], TL[n & 127]); }
template <bool INV> __device__ __forceinline__ void r4(f32x2& x0, f32x2& x1, f32x2& x2, f32x2& x3) {
    const f32x2 a = x0 + x2, c = x0 - x2, b = x1 + x3, e = x1 - x3;
    const f32x2 d = INV ? (f32x2){-e.y, e.x} : (f32x2){e.y, -e.x};
    x0 = a + b; x1 = c + d; x2 = a - b; x3 = c - d;
}
template <bool INV> __device__ __forceinline__ void dft16(f32x2 (&x)[16]) {
#pragma unroll
    for (int b = 0; b < 4; ++b) r4<INV>(x[b], x[4 + b], x[8 + b], x[12 + b]);
    const float sg = INV ? -1.f : 1.f;
    const f32x2 W1 = {0.92387953251f, -0.38268343236f * sg}, W2 = {0.70710678118f, -0.70710678118f * sg}, W3 = {0.38268343236f, -0.92387953251f * sg},
                W4 = {0.f, -1.f * sg}, W6 = {-0.70710678118f, -0.70710678118f * sg}, W9 = {-0.92387953251f, 0.38268343236f * sg};
    x[5] = cmul(x[5], W1); x[9] = cmul(x[9], W2); x[13] = cmul(x[13], W3);
    x[6] = cmul(x[6], W2); x[10] = cmul(x[10], W4); x[14] = cmul(x[14], W6);
    x[7] = cmul(x[7], W3); x[11] = cmul(x[11], W6); x[15] = cmul(x[15], W9);
#pragma unroll
    for (int c = 0; c < 4; ++c) r4<INV>(x[4 * c], x[4 * c + 1], x[4 * c + 2], x[4 * c + 3]);
}
template <bool INV> __device__ __forceinline__ void bfly16(f32x2 (&x)[16], const LAS f32x2* TH, const LAS f32x2* TL, int tw) {
    f32x2 W = tw32k(TH, TL, tw); if (INV) W.y = -W.y;
    if (INV) { f32x2 p = W;
#pragma unroll
        for (int q = 1; q < 16; ++q) { x[q] = cmul(x[q], p); if (q < 15) p = cmul(p, W); } }
    dft16<INV>(x);
    if (!INV) { f32x2 p = W;
#pragma unroll
        for (int r = 1; r < 16; ++r) { x[4 * (r & 3) + (r >> 2)] = cmul(x[4 * (r & 3) + (r >> 2)], p); if (r < 15) p = cmul(p, W); } }
}
template <bool INV> __device__ __forceinline__ void pass16(LAS f32x2* X, const LAS f32x2* TH, const LAS f32x2* TL, int base, int stride, int tw) {
    f32x2 x[16];
#pragma unroll
    for (int q = 0; q < 16; ++q) x[q] = X[base + q * stride];
    bfly16<INV>(x, TH, TL, tw);
#pragma unroll
    for (int c = 0; c < 4; ++c)
#pragma unroll
        for (int d = 0; d < 4; ++d) X[base + (c + 4 * d) * stride] = x[4 * c + d];
}
template <bool INV> __device__ __forceinline__ void pass16_s4(LAS f32x2* X, const LAS f32x2* TH, const LAS f32x2* TL, int blk, int h) {
    LAS f32x4* P = (LAS f32x4*)(X + blk * 68 + 2 * h);
    f32x2 xa[16], xb[16];
#pragma unroll
    for (int q = 0; q < 16; ++q) { const f32x4 v = P[2 * q]; xa[q] = (f32x2){v.x, v.y}; xb[q] = (f32x2){v.z, v.w}; }
    bfly16<INV>(xa, TH, TL, (2 * h) * 512); bfly16<INV>(xb, TH, TL, (2 * h + 1) * 512);
#pragma unroll
    for (int c = 0; c < 4; ++c)
#pragma unroll
        for (int d = 0; d < 4; ++d) P[2 * (c + 4 * d)] = (f32x4){xa[4 * c + d].x, xa[4 * c + d].y, xb[4 * c + d].x, xb[4 * c + d].y};
}
template <bool INV> __device__ __forceinline__ void pass4_s1(LAS f32x2* X, int b) {
    LAS f32x4* P = (LAS f32x4*)(X + 4 * b + ((b >> 4) << 2));
    const f32x4 u = P[0], v = P[1];
    f32x2 x0 = {u.x, u.y}, x1 = {u.z, u.w}, x2 = {v.x, v.y}, x3 = {v.z, v.w};
    r4<INV>(x0, x1, x2, x3);
    P[0] = (f32x4){x0.x, x0.y, x1.x, x1.y}; P[1] = (f32x4){x2.x, x2.y, x3.x, x3.y};
}
__device__ __forceinline__ void fft_fwd(LAS f32x2* X, const LAS f32x2* TH, const LAS f32x2* TL, int tid) {
#pragma unroll 1
    for (int i = 0; i < 2; ++i) { const int j = tid + NTHR * i; pass16<false>(X, TH, TL, j + ((j >> 6) << 2), 1088, 2 * j); }
    __syncthreads();
#pragma unroll 1
    for (int i = 0; i < 2; ++i) { const int b = tid + NTHR * i, j = b & 63, blk = b >> 6; pass16<false>(X, TH, TL, blk * 1088 + j, 68, 32 * j); }
    __syncthreads();
    pass16_s4<false>(X, TH, TL, tid >> 1, tid & 1);
    __syncthreads();
#pragma unroll 2
    for (int i = 0; i < 8; ++i) pass4_s1<false>(X, tid + NTHR * i);
    __syncthreads();
}
__device__ __forceinline__ void fft_inv(LAS f32x2* X, const LAS f32x2* TH, const LAS f32x2* TL, int tid) {
#pragma unroll 2
    for (int i = 0; i < 8; ++i) pass4_s1<true>(X, tid + NTHR * i);
    __syncthreads();
    pass16_s4<true>(X, TH, TL, tid >> 1, tid & 1);
    __syncthreads();
#pragma unroll 1
    for (int i = 0; i < 2; ++i) { const int b = tid + NTHR * i, j = b & 63, blk = b >> 6; pass16<true>(X, TH, TL, blk * 1088 + j, 68, 32 * j); }
    __syncthreads();
#pragma unroll 1
    for (int i = 0; i < 2; ++i) { const int j = tid + NTHR * i; pass16<true>(X, TH, TL, j + ((j >> 6) << 2), 1088, 2 * j); }
    __syncthreads();
}
__device__ __forceinline__ int freq_pos(int k) { return phys(((k & 15) << 10) | (((k >> 4) & 15) << 6) | (((k >> 8) & 15) << 2) | (k >> 12)); }

__device__ __forceinline__ float conv3(const GAS float* p, int n, int Lq, float w0, float w1, float w2, float bb) {
    float a = p[n] * w1 + bb; if (n > 0) a += p[n - 1] * w0; if (n < Lq - 1) a += p[n + 1] * w2; return a;
}
__device__ __forceinline__ f32x4 conv3v(const GAS float* p, int n0, int Lq, float w0, float w1, float w2, float bb) {
    const f32x4 c = *(const GAS f32x4*)(p + n0); const float l = n0 > 0 ? p[n0 - 1] : 0.f, r = n0 + 4 < Lq ? p[n0 + 4] : 0.f;
    return (f32x4){w0 * l + w1 * c.x + w2 * c.y + bb, w0 * c.x + w1 * c.y + w2 * c.z + bb, w0 * c.y + w1 * c.z + w2 * c.w + bb, w0 * c.z + w1 * c.w + w2 * r + bb};
}
__device__ __forceinline__ void tw4(const LAS f32x2* TH, const LAS f32x2* TL, int n0, f32x2 (&w)[4]) {
    const f32x2 th = TH[n0 >> 7]; const LAS f32x4* tl = (const LAS f32x4*)(TL + (n0 & 127)); const f32x4 a = tl[0], b = tl[1];
    w[0] = cmul(th, (f32x2){a.x, a.y}); w[1] = cmul(th, (f32x2){a.z, a.w}); w[2] = cmul(th, (f32x2){b.x, b.y}); w[3] = cmul(th, (f32x2){b.z, b.w});
}

#define LT() ({ int lt_ = tid; asm volatile("" : "+v"(lt_)); lt_; })
__device__ __forceinline__ void hyena_latent(Frame& F, int l, int ch, LAS f32x2* X, const LAS f32x2* TH, const LAS f32x2* TL, GAS f32x2* KS) {
    GAS float* T32 = WSP(float, WS_T32);
    GAS float* hv = T32 + (size_t)(512 + ch) * MT; const GAS float* hx1 = T32 + (size_t)(1024 + ch) * MT; const GAS float* hx2 = T32 + (size_t)(1536 + ch) * MT;
    const GAS float* cw = IN(hy_conv_w) + (size_t)l * 3 * 1536; const GAS float* cb = IN(hy_conv_b) + (size_t)l * 1536;
    const GAS float* HF = WSP(float, WS_HF); const GAS float* p_hb = IN(hy_bias) + (size_t)l * 2 * HYW + ch;
    const int tid = F.tid;
    constexpr int KR = 6;
    GAS f32x4* KS4 = (GAS f32x4*)KS; GAS f32x4* KE4 = KS4 + FFTN / 2;
    f32x4 kreg[2 * KR];
    for (int o = 0; o < 2; ++o) {
        const GAS float* hf = HF + (size_t)(o * 1024 + ch) * SEQ; const GAS float* hbr = HF + (size_t)(o * 1024 + 512 + ch) * SEQ;
        const float bias = p_hb[o * HYW];
        const float vw0 = cw[ch], vw1 = cw[1536 + ch], vw2 = cw[3072 + ch], vbb = cb[ch];
        const GAS float* hx = o == 0 ? hx1 : hx2; const int xo = o == 0 ? 512 : 1024;
        const float xw0 = cw[xo + ch], xw1 = cw[1536 + xo + ch], xw2 = cw[3072 + xo + ch], xbb = cb[xo + ch];
        for (int par = 0; par < 2; ++par) {
#pragma unroll
            for (int i = 0; i < 8; ++i) { const int g = LT() + NTHR * i, n0 = 4 * g; const f32x4 f = *(const GAS f32x4*)(hf + n0), bk = *(const GAS f32x4*)(hbr + n0);
                LAS f32x4* XP = (LAS f32x4*)(X + phys(n0));
                if (par == 0) { XP[0] = (f32x4){f.x + bk.x, 0.f, f.y + bk.y, 0.f}; XP[1] = (f32x4){f.z + bk.z, 0.f, f.w + bk.w, 0.f}; }
                else { f32x2 w[4]; tw4(TH, TL, n0, w); const f32x4 d = f - bk;
                    XP[0] = (f32x4){w[0].x * d.x, w[0].y * d.x, w[1].x * d.y, w[1].y * d.y}; XP[1] = (f32x4){w[2].x * d.z, w[2].y * d.z, w[3].x * d.w, w[3].y * d.w}; } }
            __syncthreads();
            fft_fwd(X, TH, TL, tid);
#pragma unroll
            for (int i = 0; i < 8; ++i) { const int g = LT() + NTHR * i; const LAS f32x4* XP = (const LAS f32x4*)(X + phys(4 * g)); if (i < KR) { kreg[2 * i] = XP[0]; kreg[2 * i + 1] = XP[1]; } else { KS4[2 * g] = XP[0]; KS4[2 * g + 1] = XP[1]; } }
            __syncthreads();
#pragma unroll 2
            for (int i = 0; i < 8; ++i) { const int g = LT() + NTHR * i, n0 = 4 * g;
                f32x4 z0, z1; if (o == 0) { z0 = conv3v(hv, n0, SEQ, vw0, vw1, vw2, vbb); z1 = conv3v(hv + SEQ, n0, SEQ, vw0, vw1, vw2, vbb); } else { z0 = *(const GAS f32x4*)(hv + n0); z1 = *(const GAS f32x4*)(hv + SEQ + n0); }
                LAS f32x4* XP = (LAS f32x4*)(X + phys(n0));
                if (par == 0) { XP[0] = (f32x4){z0.x, z1.x, z0.y, z1.y}; XP[1] = (f32x4){z0.z, z1.z, z0.w, z1.w}; }
                else { f32x2 w[4]; tw4(TH, TL, n0, w);
                    const f32x2 a0 = cmul((f32x2){z0.x, z1.x}, w[0]), a1 = cmul((f32x2){z0.y, z1.y}, w[1]), a2 = cmul((f32x2){z0.z, z1.z}, w[2]), a3 = cmul((f32x2){z0.w, z1.w}, w[3]);
                    XP[0] = (f32x4){a0.x, a0.y, a1.x, a1.y}; XP[1] = (f32x4){a2.x, a2.y, a3.x, a3.y}; } }
            __syncthreads();
#if defined(PROBE_FFTCORE)
            fft_fwd(X, TH, TL, tid); fft_inv(X, TH, TL, tid);
            for (int i = 0; i < 8; ++i) { const int g = LT() + NTHR * i; LAS f32x4* XP = (LAS f32x4*)(X + phys(4 * g)); XP[0] = XP[0] * (1.0f / 16384.0f); XP[1] = XP[1] * (1.0f / 16384.0f); }
            __syncthreads();
#endif
            fft_fwd(X, TH, TL, tid);
#pragma unroll
            for (int i = 0; i < 8; ++i) { const int g = LT() + NTHR * i; LAS f32x4* XP = (LAS f32x4*)(X + phys(4 * g)); f32x4 k0, k1; if (i < KR) { k0 = kreg[2 * i]; k1 = kreg[2 * i + 1]; } else { k0 = KS4[2 * g]; k1 = KS4[2 * g + 1]; } const f32x4 u0 = XP[0], u1 = XP[1];
                const f32x2 a0 = cmul((f32x2){u0.x, u0.y}, (f32x2){k0.x, k0.y}), a1 = cmul((f32x2){u0.z, u0.w}, (f32x2){k0.z, k0.w}), a2 = cmul((f32x2){u1.x, u1.y}, (f32x2){k1.x, k1.y}), a3 = cmul((f32x2){u1.z, u1.w}, (f32x2){k1.z, k1.w});
                XP[0] = (f32x4){a0.x, a0.y, a1.x, a1.y}; XP[1] = (f32x4){a2.x, a2.y, a3.x, a3.y};
                if (i & 1) asm volatile("" ::: "memory"); }
            __syncthreads();
            fft_inv(X, TH, TL, tid);
            if (par == 0) {
#pragma unroll
                for (int i = 0; i < 8; ++i) { const int g = LT() + NTHR * i; const LAS f32x4* XP = (const LAS f32x4*)(X + phys(4 * g)); KE4[2 * g] = XP[0]; KE4[2 * g + 1] = XP[1]; }
                __syncthreads();
            }
        }
#pragma unroll 4
        for (int i = 0; i < 8; ++i) { const int g = LT() + NTHR * i, n0 = 4 * g;
            f32x4 z0, z1; if (o == 0) { z0 = conv3v(hv, n0, SEQ, vw0, vw1, vw2, vbb); z1 = conv3v(hv + SEQ, n0, SEQ, vw0, vw1, vw2, vbb); } else { z0 = *(const GAS f32x4*)(hv + n0); z1 = *(const GAS f32x4*)(hv + SEQ + n0); }
            const f32x4 g0 = conv3v(hx, n0, SEQ, xw0, xw1, xw2, xbb), g1 = conv3v(hx + SEQ, n0, SEQ, xw0, xw1, xw2, xbb);
            const f32x4 e0 = KE4[2 * g], e1 = KE4[2 * g + 1];
            LAS f32x4* XP = (LAS f32x4*)(X + phys(n0)); const f32x4 u0 = XP[0], u1 = XP[1];
            f32x2 w[4]; tw4(TH, TL, n0, w);
            const f32x2 c0 = cmul((f32x2){u0.x, u0.y}, cconj(w[0])), c1 = cmul((f32x2){u0.z, u0.w}, cconj(w[1])), c2 = cmul((f32x2){u1.x, u1.y}, cconj(w[2])), c3 = cmul((f32x2){u1.z, u1.w}, cconj(w[3]));
            const float sc = 1.0f / 32768.0f;
            const f32x2 y0 = ((f32x2){e0.x, e0.y} + c0) * sc + (f32x2){z0.x, z1.x} * bias, y1 = ((f32x2){e0.z, e0.w} + c1) * sc + (f32x2){z0.y, z1.y} * bias,
                        y2 = ((f32x2){e1.x, e1.y} + c2) * sc + (f32x2){z0.z, z1.z} * bias, y3 = ((f32x2){e1.z, e1.w} + c3) * sc + (f32x2){z0.w, z1.w} * bias;
            XP[0] = (f32x4){g0.x * y0.x, g0.y * y1.x, g0.z * y2.x, g0.w * y3.x};
            XP[1] = (f32x4){g1.x * y0.y, g1.y * y1.y, g1.z * y2.y, g1.w * y3.y}; }
        __syncthreads();
#pragma unroll
        for (int i = 0; i < 8; ++i) { const int g = LT() + NTHR * i, n0 = 4 * g; const LAS f32x4* XP = (const LAS f32x4*)(X + phys(n0)); *(GAS f32x4*)(hv + n0) = XP[0]; *(GAS f32x4*)(hv + SEQ + n0) = XP[1]; }
        __syncthreads();
    }
}
__device__ __forceinline__ void fourier_latent(Frame& F, int b, int gq, int m, LAS f32x2* X, const LAS f32x2* TH, const LAS f32x2* TL) {
    GAS float* T32 = WSP(float, WS_T32);
    GAS float* ra = T32 + (size_t)(gq * 128 + m) * MT + b * SEQ; GAS float* rb = T32 + (size_t)(gq * 128 + 64 + m) * MT + b * SEQ;
    const int tid = F.tid;
#pragma unroll
    for (int i = 0; i < 8; ++i) { const int g = LT() + NTHR * i, n0 = 4 * g; const f32x4 a = *(const GAS f32x4*)(ra + n0), c = *(const GAS f32x4*)(rb + n0);
        LAS f32x4* XP = (LAS f32x4*)(X + phys(n0)); XP[0] = (f32x4){a.x, c.x, a.y, c.y}; XP[1] = (f32x4){a.z, c.z, a.w, c.w}; }
    __syncthreads();
    fft_fwd(X, TH, TL, tid);
    const float sc = 6.9053396600248786e-4f;
#pragma unroll 2
    for (int i = 0; i < 8; ++i) { const int g = LT() + NTHR * i, k0 = 4 * g; f32x4 oa, ob;
#pragma unroll
        for (int e = 0; e < 4; ++e) { const int k = k0 + e; const f32x2 u = X[freq_pos(k)], v = X[freq_pos((FFTN - k) & (FFTN - 1))];
            if (m != 0) { oa[e] = u.x * sc; ob[e] = v.x * sc; } else { oa[e] = (u.x + v.x) * (0.5f * sc); ob[e] = (u.y + v.y) * (0.5f * sc); } }
        *(GAS f32x4*)(ra + k0) = oa; *(GAS f32x4*)(rb + k0) = ob; }
    __syncthreads();
}
__device__ __forceinline__ void hyena_ctx(Frame& F, int l, int ch, LAS float* S) {
    GAS float* T32 = WSP(float, WS_T32);
    GAS float* hv = T32 + (size_t)(512 + ch) * MT + ML; const GAS float* hx1 = T32 + (size_t)(1024 + ch) * MT + ML; const GAS float* hx2 = T32 + (size_t)(1536 + ch) * MT + ML;
    const GAS float* cw = IN(hy_conv_w) + (size_t)l * 3 * 1536; const GAS float* cb = IN(hy_conv_b) + (size_t)l * 1536;
    const GAS float* HFC = WSP(float, WS_HFC); const GAS float* p_hb = IN(hy_bias) + (size_t)l * 2 * HYW + ch;
    LAS float* zb = S; LAS float* hfl = S + 512; LAS float* hbl = S + 768;
    const int n = F.tid & 255, b = F.tid >> 8;
    __syncthreads();
    zb[b * 256 + n] = conv3(hv + b * CTXL, n, CTXL, cw[ch], cw[1536 + ch], cw[3072 + ch], cb[ch]);
    for (int o = 0; o < 2; ++o) {
        if (F.tid < 256) hfl[n] = HFC[(size_t)(o * 1024 + ch) * CTXL + n]; else hbl[n] = HFC[(size_t)(o * 1024 + 512 + ch) * CTXL + n];
        __syncthreads();
        float y = 0.f;
        for (int mI = 0; mI < CTXL; ++mI) { const int d = n - mI; y += zb[b * 256 + mI] * (d >= 0 ? hfl[d] : hbl[CTXL + d]); }
        y += p_hb[o * HYW] * zb[b * 256 + n];
        const GAS float* hx = o == 0 ? hx1 : hx2; const int xo = o == 0 ? 512 : 1024;
        const float r = conv3(hx + b * CTXL, n, CTXL, cw[xo + ch], cw[1536 + xo + ch], cw[3072 + xo + ch], cb[xo + ch]) * y;
        __syncthreads();
        if (o == 0) zb[b * 256 + n] = r; else hv[b * CTXL + n] = r;
        __syncthreads();
    }
}
__device__ __forceinline__ void fourier_ctx(Frame& F, int item, LAS float* S) {
    GAS float* T32 = WSP(float, WS_T32);
    const int b = item >> 5, gq = (item >> 3) & 3, m0 = (item & 7) * 8;
    LAS float* cs = S; LAS float* re = S + 256; LAS float* im = S + 256 + 2048;
    __syncthreads();
    if (F.tid < 256) cs[F.tid] = cospif((float)F.tid * (1.0f / 128.0f));
    for (int i = F.tid; i < 8 * 256; i += NTHR) { const int mm = i >> 8, n = i & 255;
        re[i] = T32[(size_t)(gq * 128 + m0 + mm) * MT + ML + b * CTXL + n]; im[i] = T32[(size_t)(gq * 128 + 64 + m0 + mm) * MT + ML + b * CTXL + n]; }
    __syncthreads();
    const int k = F.tid & 255, mh = F.tid >> 8;
    const float sc = 5.5242717280199031e-3f;
    for (int mq = 0; mq < 4; ++mq) { const int mm = mh * 4 + mq, m = m0 + mm;
        float cr = 0.f, ci = 0.f, sr = 0.f, si = 0.f;
        for (int n = 0; n < 256; ++n) { const int ix = (k * n) & 255; const float c = cs[ix], sn = cs[(ix - 64) & 255]; const float a = re[mm * 256 + n], bq = im[mm * 256 + n];
            cr += a * c; ci += bq * c; sr += a * sn; si += bq * sn; }
        float oa, ob;
        if (m != 0) { oa = cr + si; ob = cr - si; } else { oa = cr; ob = ci; }
        T32[(size_t)(gq * 128 + m) * MT + ML + b * CTXL + k] = oa * sc; T32[(size_t)(gq * 128 + 64 + m) * MT + ML + b * CTXL + k] = ob * sc; }
    __syncthreads();
}
__device__ __forceinline__ void fft_phase(Frame& F, int l, bool with_ctx) {
    LAS f32x2* X = (LAS f32x2*)F.lds;
    LAS f32x2* TH = (LAS f32x2*)(F.lds + TW_OFF); LAS f32x2* TL = TH + 128;
    if (F.tid < 256) { const int a = F.tid & 127; const float fr = F.tid < 128 ? (float)(128 * a) * (1.0f / 16384.0f) : (float)a * (1.0f / 16384.0f);
        float sn, cn; sincospif(fr, &sn, &cn); (F.tid < 128 ? TH : TL)[a] = (f32x2){cn, -sn}; }
    __syncthreads();
    for (int ch = F.vcu; ch < HYW; ch += F.G) hyena_latent(F, l, ch, X, TH, TL, WSP(f32x2, WS_KS) + (size_t)F.vcu * 2 * FFTN);
    for (int fu = F.vcu; fu < 512; fu += F.G) fourier_latent(F, fu >> 8, (fu >> 6) & 3, fu & 63, X, TH, TL);
    if (with_ctx) {
        LAS float* S = (LAS float*)F.lds;
        for (int ch = F.vcu; ch < HYW; ch += F.G) hyena_ctx(F, l, ch, S);
        for (int it = F.vcu; it < 64; it += F.G) fourier_ctx(F, it, S);
    }
}

__device__ __forceinline__ void merge_phase(Frame& F, int l, bool with_ctx) {
    const GAS bf16* A = WSP(bf16, WS_A); const GAS float* T32 = WSP(float, WS_T32); GAS bf16* H = WSP(bf16, WS_H);
    const GAS float* gain = IN(mix_norm_g) + (size_t)l * DM;
    LAS float* tile = (LAS float*)F.lds;
    const int TI = with_ctx ? 65 : 64;
    for (int it = F.vcu; it < 512; it += F.G) {
        const int tok0 = it * TI;
        for (int tk = F.wave; tk < TI; tk += NWAVES) {
            const size_t row = (size_t)(tok0 + tk);
            const v4u r0 = *(const GAS v4u*)(A + row * 1024 + 8 * F.lane), r1 = *(const GAS v4u*)(A + row * 1024 + 512 + 8 * F.lane);
            float v[16];
            v[0] = bf2f(r0.x & 0xffff); v[1] = bf2f(r0.x >> 16); v[2] = bf2f(r0.y & 0xffff); v[3] = bf2f(r0.y >> 16); v[4] = bf2f(r0.z & 0xffff); v[5] = bf2f(r0.z >> 16); v[6] = bf2f(r0.w & 0xffff); v[7] = bf2f(r0.w >> 16);
            v[8] = bf2f(r1.x & 0xffff); v[9] = bf2f(r1.x >> 16); v[10] = bf2f(r1.y & 0xffff); v[11] = bf2f(r1.y >> 16); v[12] = bf2f(r1.z & 0xffff); v[13] = bf2f(r1.z >> 16); v[14] = bf2f(r1.w & 0xffff); v[15] = bf2f(r1.w >> 16);
            float ss = 0.f;
#pragma unroll
            for (int j = 0; j < 16; ++j) ss += v[j] * v[j];
            const float rstd = 1.0f / sqrtf(wave_sum(ss, F.lane) * (1.0f / NAW) + EPS);
            const f32x4 g0 = *(const GAS f32x4*)(gain + 8 * F.lane), g1 = *(const GAS f32x4*)(gain + 8 * F.lane + 4), g2 = *(const GAS f32x4*)(gain + 512 + 8 * F.lane), g3 = *(const GAS f32x4*)(gain + 512 + 8 * F.lane + 4);
            v4u o0, o1;
            o0.x = pk2(v[0] * rstd * g0.x, v[1] * rstd * g0.y); o0.y = pk2(v[2] * rstd * g0.z, v[3] * rstd * g0.w); o0.z = pk2(v[4] * rstd * g1.x, v[5] * rstd * g1.y); o0.w = pk2(v[6] * rstd * g1.z, v[7] * rstd * g1.w);
            o1.x = pk2(v[8] * rstd * g2.x, v[9] * rstd * g2.y); o1.y = pk2(v[10] * rstd * g2.z, v[11] * rstd * g2.w); o1.z = pk2(v[12] * rstd * g3.x, v[13] * rstd * g3.y); o1.w = pk2(v[14] * rstd * g3.z, v[15] * rstd * g3.w);
            *(GAS v4u*)(H + row * DM + 8 * F.lane) = o0; *(GAS v4u*)(H + row * DM + 512 + 8 * F.lane) = o1;
        }
        for (int grp = 0; grp < 2; ++grp) {
            __syncthreads();
            for (int c8 = F.wave * 64; c8 < F.wave * 64 + 64; c8 += 8) {
                float v[8], w[8];
#pragma unroll
                for (int u = 0; u < 8; ++u) { const GAS float* src = T32 + (size_t)(grp * 512 + c8 + u) * MT + tok0; v[u] = src[F.lane]; w[u] = (TI > 64 && F.lane == 0) ? src[64] : 0.f; }
#pragma unroll
                for (int u = 0; u < 8; ++u) { tile[(c8 + u) * 65 + F.lane] = v[u]; if (TI > 64 && F.lane == 0) tile[(c8 + u) * 65 + 64] = w[u]; }
            }
            __syncthreads();
            for (int tk = F.wave; tk < TI; tk += NWAVES) {
                float vv[8]; float ss = 0.f;
#pragma unroll
                for (int i = 0; i < 8; ++i) { const int chn = F.lane + 64 * i; int srow = chn;
                    if (grp == 0) { const int cc = chn & 127; srow = (chn & ~127) + (cc <= 64 ? cc : 192 - cc); }
                    vv[i] = tile[srow * 65 + tk]; ss += vv[i] * vv[i]; }
                const float rstd = 1.0f / sqrtf(wave_sum(ss, F.lane) * (1.0f / 512.0f) + EPS);
                GAS bf16* hp = H + (size_t)(tok0 + tk) * DM + NAW + grp * 512;
#pragma unroll
                for (int i = 0; i < 8; ++i) { const int chn = F.lane + 64 * i; hp[chn] = (bf16)f2bf(vv[i] * rstd * gain[NAW + grp * 512 + chn]); }
            }
        }
    }
}

#define REFRESH(F) do { int t_ = threadIdx.x; asm volatile("" : "+v"(t_)); F.tid = t_; F.lane = t_ & 63; F.wave = __builtin_amdgcn_readfirstlane(t_ >> 6); \
    GAS unsigned char* w_ = args.ws; asm volatile("" : "+s"(w_)); F.ws = w_; GAS float* o_ = args.out; asm volatile("" : "+s"(o_)); F.out = o_; } while (0)
#ifndef REP_P1
#define REP_P1 1
#endif
#ifndef REP_P6
#define REP_P6 1
#endif
#ifndef REP_ATT
#define REP_ATT 1
#endif
#ifndef REP_PA
#define REP_PA 1
#endif
#ifndef REP_THIN
#define REP_THIN 1
#endif
__device__ __forceinline__ int opaque_int(int v) { asm volatile("" : "+s"(v)); return v; }
__global__ void __launch_bounds__(NTHR, 2) fwd_kernel(Args args) {
    extern __shared__ __attribute__((aligned(16))) unsigned char lds[];
    Frame F;
    F.lds = (LAS unsigned char*)lds;
    F.tid = threadIdx.x; F.lane = F.tid & 63; F.wave = __builtin_amdgcn_readfirstlane(F.tid >> 6);
    F.G = gridDim.x; { const int bx = blockIdx.x; F.vcu = (F.G % 8 == 0) ? (bx % 8) * (F.G / 8) + bx / 8 : bx; }
    F.ws = args.ws; F.out = args.out;
    volatile LAS unsigned* MISC = (volatile LAS unsigned*)(F.lds + MISC_OFF);
    for (int u = F.tid; u < 64; u += NTHR) MISC[u] = 0u;
    __syncthreads();
    XcdBarrier bar = xcd_barrier_post((unsigned*)(F.ws + WS_CTL) + CW_BAR, MISC + 8);
    LAS unsigned char* ring = F.lds;
#define GRID_BAR() do { unsigned* bp_ = bar.bar; unsigned bx_ = bar.x; asm volatile("" : "+s"(bp_), "+s"(bx_)); XcdBarrier b_ = bar; b_.bar = bp_; b_.x = bx_; xcd_barrier(b_); } while (0)


#if !defined(OFF_PA)
    for (int rep = 0, nrep = opaque_int(REP_PA); rep < nrep; ++rep) { REFRESH(F); pa_adaln(F); __syncthreads(); pa_weights(F); __syncthreads(); pa_ctx_copy(F); }
#endif

    GRID_BAR();

    for (int l = 0; l < DEPTH; ++l) {
        const bool uc = l < DEPTH - 1;
        const int npm = uc ? PMT : PML;
        const GAS float* MODL = WSP(float, WS_MOD) + (size_t)l * 3 * (NMOD * DM);

#if !defined(OFF_P0)
        for (int rep = 0, nrep = opaque_int(REP_THIN); rep < nrep; ++rep) { REFRESH(F); norm_phase(F, l, 0, true, l > 0 ? 4 : 0); __syncthreads();
 REFRESH(F); filter_phase(F, l, uc); __syncthreads(); }
#endif

        GRID_BAR();
        {
            const char* Hb = (const char*)WSP(bf16, WS_H); const char* Wb = (const char*)(WSP(bf16, WS_WIN) + (size_t)l * DIN * DM);
            pg8::Sched2 S; S.n1 = PMT * 8; S.nM1 = PMT; S.nN1 = 8; S.n2 = 12 * PMT; S.nM2 = 12; S.nN2 = PMT; S.G = F.G; S.c = (int)blockIdx.x;
            S.A1 = Hb; S.B1 = Wb; S.A2 = Wb + (size_t)2048 * DM * 2; S.B2 = Hb; S.tstep = (size_t)256 * DM * 2;
            EpiIn E{WSP(bf16, WS_QK), WSP(bf16, WS_VT), WSP(float, WS_T32)};

#if !defined(OFF_P1)
            for (int rep = 0, nrep = opaque_int(REP_P1); rep < nrep; ++rep) { pg8::gemm_phase<EpiIn, pg8::Sched2, true, true>(ring, DM, DM, S, E); __syncthreads(); }
#endif

        }
        GRID_BAR();

#if !defined(OFF_ATT)
        for (int rep = 0, nrep = opaque_int(REP_ATT); rep < nrep; ++rep) { REFRESH(F); attn_phase(F, l, uc); }
#endif
#if !defined(OFF_FFT)
        REFRESH(F); fft_phase(F, l, uc);
#endif

        GRID_BAR();

#if !defined(OFF_P3)
        for (int rep = 0, nrep = opaque_int(REP_THIN); rep < nrep; ++rep) { REFRESH(F); merge_phase(F, l, uc); __syncthreads(); }
#endif

        GRID_BAR();
        {
            pg8::Sched2 S; S.n1 = PML * 8; S.nM1 = PML; S.nN1 = 8; S.n2 = 0; S.nM2 = 1; S.nN2 = 1; S.G = F.G; S.c = (int)blockIdx.x;
            S.A1 = (const char*)WSP(bf16, WS_H); S.B1 = (const char*)(WSP(bf16, WS_WOUT) + (size_t)l * DM * DM); S.A2 = S.A1; S.B2 = S.B1; S.tstep = (size_t)256 * DM * 2;
            EpiRes E{l == 0 ? IN(x) : F.out, WSP(float, WS_XC), F.out, WSP(float, WS_XC), MODL + 2 * DM};
#if !defined(OFF_P4)
            pg8::gemm_phase<EpiRes, pg8::Sched2, true, true>(ring, DM, DM, S, E);
#endif
            if (uc) {
                __syncthreads();
                pg8::SchedK SK; SK.nsub = 16 * 4; SK.nN = 8; SK.ksplit = 4; SK.pm0 = PML; SK.G = F.G; SK.c = (int)blockIdx.x; SK.A = S.A1; SK.B = S.B1; SK.tstep = S.tstep; SK.kbytes = 512 * 2;
                EpiSlab EA{WSP(float, WS_SLAB), MODL + 2 * DM};
#if !defined(OFF_P4)
                pg8::gemm_phase<EpiSlab, pg8::SchedK, true, true>(ring, DM, 512, SK, EA);
#endif
            }
        }
        GRID_BAR();

#if !defined(OFF_P5)
        for (int rep = 0, nrep = opaque_int(REP_THIN); rep < nrep; ++rep) { REFRESH(F); norm_phase(F, l, 1, uc, 4); }
#endif

        GRID_BAR();
        {
            pg8::Sched2 S; S.n1 = npm * 44; S.nM1 = npm; S.nN1 = 44; S.n2 = 0; S.nM2 = 1; S.nN2 = 1; S.G = F.G; S.c = (int)blockIdx.x;
            S.A1 = (const char*)WSP(bf16, WS_H); S.B1 = (const char*)(WSP(bf16, WS_WUP) + (size_t)l * 2 * DFF * DM); S.A2 = S.A1; S.B2 = S.B1; S.tstep = (size_t)256 * DM * 2;
            GAS float* EG = WSP(float, WS_EDGE);
            EpiUp E{WSP(bf16, WS_HID), EG, EG + EDGE_ELEMS, EG + 2 * EDGE_ELEMS, IN(ffn_conv_w) + (size_t)l * 3 * DFF, IN(ffn_conv_b) + (size_t)l * DFF};

#if !defined(OFF_P6)
            for (int rep = 0, nrep = opaque_int(REP_P6); rep < nrep; ++rep) { pg8::gemm_phase<EpiUp, pg8::Sched2, true, true>(ring, DM, DM, S, E); __syncthreads(); }
#endif

        }
        GRID_BAR();

#if !defined(OFF_P6B)
        for (int rep = 0, nrep = opaque_int(REP_THIN); rep < nrep; ++rep) { REFRESH(F); edge_fix_phase(F, l, uc); }
#endif

        GRID_BAR();
        {
            pg8::Sched2 S; S.n1 = PML * 8; S.nM1 = PML; S.nN1 = 8; S.n2 = 0; S.nM2 = 1; S.nN2 = 1; S.G = F.G; S.c = (int)blockIdx.x;
            S.A1 = (const char*)WSP(bf16, WS_HID); S.B1 = (const char*)(WSP(bf16, WS_WDN) + (size_t)l * DM * DFF); S.A2 = S.A1; S.B2 = S.B1; S.tstep = (size_t)256 * DFF * 2;
            EpiRes E{F.out, WSP(float, WS_XC), F.out, WSP(float, WS_XC), MODL + 5 * DM};
#if !defined(OFF_P7)
            pg8::gemm_phase<EpiRes, pg8::Sched2, true, true>(ring, DFF, DFF, S, E);
#endif
            if (uc) {
                __syncthreads();
                pg8::SchedK SK; SK.nsub = 16 * 4; SK.nN = 8; SK.ksplit = 4; SK.pm0 = PML; SK.G = F.G; SK.c = (int)blockIdx.x; SK.A = S.A1; SK.B = S.B1; SK.tstep = S.tstep; SK.kbytes = 1408 * 2;
                EpiSlab EA{WSP(float, WS_SLAB), MODL + 5 * DM};
#if !defined(OFF_P7)
                pg8::gemm_phase<EpiSlab, pg8::SchedK, true, true>(ring, DFF, 1408, SK, EA);
#endif
            }
        }
        GRID_BAR();
    }
    REFRESH(F); final_norm_phase(F);
}

extern "C" void kernel_launch(void* const* d_in, const int* in_sizes, int n_in, void* d_out, int out_size, void* d_ws, size_t ws_size, hipStream_t stream) {
    static int grid = 0;
    if (grid == 0) {
        if (n_in != 26 || in_sizes[0] != ML * DM || out_size != ML * DM || ws_size < WS_END) { fprintf(stderr, "kernel_launch: unexpected shapes (n_in %d, in0 %d, out %d, ws %zu < %zu)\n", n_in, n_in > 0 ? in_sizes[0] : -1, out_size, ws_size, (size_t)WS_END); grid = -1; return; }
        int dev = 0, cus = 0, per_cu = 0;
        if (hipGetDevice(&dev) != hipSuccess || hipDeviceGetAttribute(&cus, hipDeviceAttributeMultiprocessorCount, dev) != hipSuccess) { grid = -1; return; }
        if (hipFuncSetAttribute((const void*)fwd_kernel, hipFuncAttributeMaxDynamicSharedMemorySize, LDS_BYTES) != hipSuccess) { fprintf(stderr, "kernel_launch: hipFuncSetAttribute failed\n"); grid = -1; return; }
        if (hipOccupancyMaxActiveBlocksPerMultiprocessor(&per_cu, (const void*)fwd_kernel, NTHR, LDS_BYTES) != hipSuccess || per_cu < 1) { fprintf(stderr, "kernel_launch: occupancy query reports %d\n", per_cu); }
        (void)hipGetLastError();
        grid = cus;
    }
    if (grid < 0) return;
    if (hipMemsetAsync((char*)d_ws + WS_CTL, 0, CTL_ZERO_BYTES, stream) != hipSuccess) return;
    Args a{};
    for (int i = 0; i < 26; ++i) a.in[i] = (const GAS float*)d_in[i];
    a.out = (GAS float*)d_out; a.ws = (GAS unsigned char*)d_ws;
    hipLaunchKernelGGL(fwd_kernel, dim3(grid), dim3(NTHR), LDS_BYTES, stream, a);
}
```

```cpp
#include <hip/hip_runtime.h>
#include <cstdio>
#include <cstdint>
namespace pg8 {
#define PG8_LAS __attribute__((address_space(3)))
typedef unsigned short bf16_t;
typedef short bf16x8 __attribute__((ext_vector_type(8)));
typedef float f32x4 __attribute__((ext_vector_type(4)));
typedef unsigned u32x4 __attribute__((ext_vector_type(4)));
constexpr int BM = 256, BK = 64, HALF = 128, HTB = HALF * BK * 2  , STAGE_BYTES = 8 * HTB, NXCD = 8, WGM = 8;

__host__ __device__ __forceinline__ int lds_byte(int r, int c) { const int st = (r >> 4) * 2 + (c >> 5), rr = r & 15, cc = c & 31, ob = rr * 64 + cc * 2; return st * 1024 + (ob ^ (((ob >> 9) & 1) << 5)); }
__host__ __device__ __forceinline__ void stage_rc(int b, int& R, int& C) { const int st = b / 1024, sb = b % 1024, swz = sb ^ (((sb >> 9) & 1) << 5); R = (st >> 1) * 16 + swz / 64; C = (st & 1) * 32 + (swz % 64) / 2; }
__host__ __device__ __forceinline__ int perm32(int rho) { const int n = rho >> 4, i = rho & 15; return 8 * (i >> 2) + 4 * n + (i & 3); }

struct Unit { int pm, pn, type; };

__device__ __forceinline__ void map_unit(int w, int nwg, int nM, int nN, Unit& u) {
    { const int q = nwg / NXCD, r = nwg % NXCD, xcd = w % NXCD, off = w / NXCD; w = (xcd < r ? xcd * (q + 1) : r * (q + 1) + (xcd - r) * q) + off; }
    const int nig = WGM * nN, gid = w / nig, fm = gid * WGM, gsz = (nM - fm) < WGM ? (nM - fm) : WGM;
    u.pm = fm + ((w % nig) % gsz); u.pn = (w % nig) / gsz;
}
struct Sched2 {
    int n1, nM1, nN1, n2, nM2, nN2, G, c; const char *A1, *B1, *A2, *B2; size_t tstep;
    __device__ __forceinline__ bool next(int i, Unit& u) const {
        const long L = (long)i * G + c;
        if (L < n1) { map_unit((int)L, n1, nM1, nN1, u); u.type = 0; return true; }
        if (L < n1 + n2) { map_unit((int)L - n1, n2, nM2, nN2, u); u.type = 1; return true; }
        return false;
    }
    __device__ __forceinline__ const char* a_ptr(const Unit& u) const { return (u.type ? A2 : A1) + (size_t)u.pm * tstep; }
    __device__ __forceinline__ const char* b_ptr(const Unit& u) const { return (u.type ? B2 : B1) + (size_t)u.pn * tstep; }
    __device__ __forceinline__ void a_ready(const Unit&) const {}
    __device__ __forceinline__ void done(const Unit&) const {}
};

struct SchedK {
    int nsub, nN, ksplit, pm0, G, c; const char *A, *B; size_t tstep, kbytes;
    __device__ __forceinline__ bool next(int i, Unit& u) const {
        const long L = (long)i * G + c; if (L >= nsub) return false;
        const int j = (int)L / ksplit; u.type = (int)L % ksplit; u.pm = pm0 + j / nN; u.pn = j % nN; return true;
    }
    __device__ __forceinline__ const char* a_ptr(const Unit& u) const { return A + (size_t)u.pm * tstep + (size_t)u.type * kbytes; }
    __device__ __forceinline__ const char* b_ptr(const Unit& u) const { return B + (size_t)u.pn * tstep + (size_t)u.type * kbytes; }
    __device__ __forceinline__ void a_ready(const Unit&) const {}
    __device__ __forceinline__ void done(const Unit&) const {}
};

__device__ __forceinline__ unsigned cvt_pk_bf16(float lo, float hi) { unsigned r; asm volatile("v_cvt_pk_bf16_f32 %0, %1, %2" : "=v"(r) : "v"(lo), "v"(hi)); return r; }
typedef float f32x2 __attribute__((ext_vector_type(2)));

template <class Epi, class Sched, bool ALIGN_EPI = false, bool SP2 = false>
__device__ __forceinline__ void gemm_phase(PG8_LAS unsigned char* lds, const int Kdim  , const int Klen  , const Sched& S, const Epi& E) {
    int tid_ = threadIdx.x; asm volatile("" : "+v"(tid_));
    const int tid = tid_, wid = __builtin_amdgcn_readfirstlane(tid >> 6), lane = tid & 63, wr = wid >> 2, wc = wid & 3, fr = lane & 15, fq = lane >> 4;
    const int K = Kdim, nt = Klen / BK;
    unsigned voffA[2], voffB[2];
#pragma unroll
    for (int i = 0; i < 2; ++i) { int R, C; stage_rc(tid * 16 + i * 8192, R, C); const int Rb = Epi::PERM ? ((R & ~31) + perm32(R & 31)) : R;
        voffA[i] = (unsigned)(R * K + C) * 2u; voffB[i] = (unsigned)(Rb * K + C) * 2u; }
    const size_t kstep = (size_t)(BK * 2);
    const size_t hstep = (size_t)HALF * K * 2;
    const size_t tstep = 2 * hstep;
    const unsigned ldsw = (unsigned)wid * 1024u;
    const int aoff = lds_byte(wr * 64 + fr, fq * 8), boff = lds_byte(wc * 32 + fr, fq * 8);
#define PG8_SA(b, h) (((b) * 2 + (h)) * HTB)
#define PG8_SB(b, h) ((4 + (b) * 2 + (h)) * HTB)
#define PG8_STAGE(bufoff, gbase, voff) do { _Pragma("unroll") for (int _i = 0; _i < 2; ++_i) \
        __builtin_amdgcn_global_load_lds((const unsigned*)((const char*)(gbase) + (voff)[_i]), (PG8_LAS unsigned*)(lds + (bufoff) + ldsw + _i * 8192), 16, 0, 0); } while (0)
#define PG8_LDA(dst, b, h) do { _Pragma("unroll") for (int m = 0; m < 4; ++m) _Pragma("unroll") for (int k = 0; k < 2; ++k) dst[m][k] = *(const PG8_LAS bf16x8*)(lds + PG8_SA(b, h) + aoff + m * 2048 + k * 1024); } while (0)
#define PG8_LDB(dst, b, h) do { _Pragma("unroll") for (int n = 0; n < 2; ++n) _Pragma("unroll") for (int k = 0; k < 2; ++k) dst[n][k] = *(const PG8_LAS bf16x8*)(lds + PG8_SB(b, h) + boff + n * 2048 + k * 1024); } while (0)
#define PG8_MMA(ai, bj, At, Bt) do { __builtin_amdgcn_s_setprio(1); _Pragma("unroll") for (int m = 0; m < 4; ++m) _Pragma("unroll") for (int n = 0; n < 2; ++n) _Pragma("unroll") for (int k = 0; k < 2; ++k) \
        acc[ai][bj][m][n] = __builtin_amdgcn_mfma_f32_16x16x32_bf16(Bt[n][k], At[m][k], acc[ai][bj][m][n], 0, 0, 0); __builtin_amdgcn_s_setprio(0); } while (0)
#define PG8_WAIT_V(n) asm volatile("s_waitcnt vmcnt(" #n ")" ::: "memory")
#define PG8_WAIT_L(n) asm volatile("s_waitcnt lgkmcnt(" #n ")" ::: "memory")
#define PG8_BAR __builtin_amdgcn_s_barrier()
#define PG8_SCHED __builtin_amdgcn_sched_barrier(0)
    Unit cur, nxt; int ui = 0;
    if (!S.next(0, cur)) return;
    f32x4 acc[2][2][4][2];
#pragma unroll
    for (int a = 0; a < 2; ++a)
#pragma unroll
        for (int b = 0; b < 2; ++b)
#pragma unroll
            for (int m = 0; m < 4; ++m)
#pragma unroll
                for (int n = 0; n < 2; ++n) acc[a][b][m][n] = (f32x4){0.f, 0.f, 0.f, 0.f};
    bf16x8 At[4][2], B0[2][2], B1[2][2];
    const char* cA = S.a_ptr(cur); const char* cB = S.b_ptr(cur);
    S.a_ready(cur);
    if constexpr (SP2) {
        PG8_STAGE(PG8_SB(0, 0), cB, voffB); PG8_STAGE(PG8_SB(0, 1), cB + hstep, voffB); PG8_STAGE(PG8_SA(0, 0), cA, voffA); PG8_STAGE(PG8_SA(0, 1), cA + hstep, voffA);
        if (wr == 1) PG8_BAR;
        PG8_WAIT_V(2); PG8_BAR;
        PG8_STAGE(PG8_SB(1, 0), cB + kstep, voffB); PG8_STAGE(PG8_SA(1, 0), cA + kstep, voffA); PG8_STAGE(PG8_SB(1, 1), cB + hstep + kstep, voffB);
        PG8_WAIT_V(6); PG8_BAR;
    } else {
        PG8_STAGE(PG8_SB(0, 0), cB, voffB); PG8_STAGE(PG8_SA(0, 0), cA, voffA); PG8_STAGE(PG8_SB(0, 1), cB + hstep, voffB); PG8_STAGE(PG8_SA(0, 1), cA + hstep, voffA);
        if (wr == 1) PG8_BAR;
        PG8_WAIT_V(4); PG8_BAR;
        PG8_STAGE(PG8_SB(1, 0), cB + kstep, voffB); PG8_STAGE(PG8_SA(1, 0), cA + kstep, voffA); PG8_STAGE(PG8_SB(1, 1), cB + hstep + kstep, voffB);
        PG8_WAIT_V(6); PG8_BAR;
    }
    for (;;) {
        const bool has_next = S.next(ui + 1, nxt);
        const char* nA = has_next ? S.a_ptr(nxt) : cA; const char* nB = has_next ? S.b_ptr(nxt) : cB;
        for (int t = 0; t < nt; t += 2) {
            const bool last = (t == nt - 2);
            const char* a1 = cA + (size_t)(t + 1) * kstep;
            const char* a2 = last ? nA : cA + (size_t)(t + 2) * kstep; const char* b2 = last ? nB : cB + (size_t)(t + 2) * kstep;
            const char* a3 = a2 + kstep; const char* b3 = b2 + kstep;
            if (last && has_next) S.a_ready(nxt);
            if constexpr (SP2) {
            PG8_LDB(B0, 0, 0); PG8_LDB(B1, 0, 1); PG8_SCHED; PG8_LDA(At, 0, 0); PG8_STAGE(PG8_SA(1, 1), a1 + hstep, voffA);
            PG8_WAIT_V(8); PG8_WAIT_L(0); PG8_BAR; PG8_MMA(0, 0, At, B0); PG8_MMA(0, 1, At, B1); PG8_BAR; PG8_SCHED;
            PG8_LDA(At, 0, 1); PG8_STAGE(PG8_SB(0, 0), b2, voffB); PG8_STAGE(PG8_SB(0, 1), b2 + hstep, voffB); PG8_STAGE(PG8_SA(0, 0), a2, voffA);
            PG8_WAIT_V(8); PG8_WAIT_L(0); PG8_BAR; PG8_MMA(1, 0, At, B0); PG8_MMA(1, 1, At, B1); PG8_BAR; PG8_SCHED;
            PG8_LDB(B0, 1, 0); PG8_LDB(B1, 1, 1); PG8_SCHED; PG8_LDA(At, 1, 0); PG8_STAGE(PG8_SA(0, 1), a2 + hstep, voffA);
            PG8_WAIT_V(8); PG8_WAIT_L(0); PG8_BAR; PG8_MMA(0, 0, At, B0); PG8_MMA(0, 1, At, B1); PG8_BAR; PG8_SCHED;
            PG8_LDA(At, 1, 1); PG8_STAGE(PG8_SB(1, 0), b3, voffB); PG8_STAGE(PG8_SB(1, 1), b3 + hstep, voffB); PG8_STAGE(PG8_SA(1, 0), a3, voffA);
            PG8_WAIT_V(8); PG8_WAIT_L(0); PG8_BAR; PG8_MMA(1, 0, At, B0); PG8_MMA(1, 1, At, B1); PG8_BAR; PG8_SCHED;
            } else {
            PG8_LDB(B0, 0, 0); PG8_SCHED; PG8_LDA(At, 0, 0); PG8_STAGE(PG8_SA(1, 1), a1 + hstep, voffA);
            PG8_WAIT_L(8); PG8_BAR; PG8_WAIT_L(0); PG8_MMA(0, 0, At, B0); PG8_BAR; PG8_SCHED;
            PG8_LDB(B1, 0, 1); PG8_STAGE(PG8_SB(0, 0), b2, voffB);
            PG8_BAR; PG8_WAIT_L(0); PG8_MMA(0, 1, At, B1); PG8_BAR;
            PG8_LDA(At, 0, 1); PG8_STAGE(PG8_SA(0, 0), a2, voffA);
            PG8_BAR; PG8_WAIT_L(0); PG8_MMA(1, 0, At, B0); PG8_BAR; PG8_SCHED;
            PG8_STAGE(PG8_SB(0, 1), b2 + hstep, voffB);
            PG8_WAIT_V(6); PG8_BAR; PG8_MMA(1, 1, At, B1); PG8_BAR;
            PG8_LDB(B0, 1, 0); PG8_SCHED; PG8_LDA(At, 1, 0); PG8_STAGE(PG8_SA(0, 1), a2 + hstep, voffA);
            PG8_WAIT_L(8); PG8_BAR; PG8_WAIT_L(0); PG8_MMA(0, 0, At, B0); PG8_BAR; PG8_SCHED;
            PG8_LDB(B1, 1, 1); PG8_STAGE(PG8_SB(1, 0), b3, voffB);
            PG8_BAR; PG8_WAIT_L(0); PG8_MMA(0, 1, At, B1); PG8_BAR;
            PG8_LDA(At, 1, 1); PG8_STAGE(PG8_SA(1, 0), a3, voffA);
            PG8_BAR; PG8_WAIT_L(0); PG8_MMA(1, 0, At, B0); PG8_BAR; PG8_SCHED;
            PG8_STAGE(PG8_SB(1, 1), b3 + hstep, voffB);
            PG8_WAIT_V(6); PG8_BAR; PG8_MMA(1, 1, At, B1); PG8_BAR;
            }
        }
        if constexpr (ALIGN_EPI) { if (wr == 0) PG8_BAR; }
        if constexpr (!Epi::AFTER_DRAIN) { E(acc, cur, wr, wc, fr, fq); S.done(cur); }
        if (!has_next) break;
#pragma unroll
        for (int a = 0; a < 2; ++a)
#pragma unroll
            for (int b = 0; b < 2; ++b)
#pragma unroll
                for (int m = 0; m < 4; ++m)
#pragma unroll
                    for (int n = 0; n < 2; ++n) acc[a][b][m][n] = (f32x4){0.f, 0.f, 0.f, 0.f};
        cur = nxt; cA = nA; cB = nB; ++ui;
        if constexpr (ALIGN_EPI) { if (wr == 1) PG8_BAR; }
    }
    PG8_WAIT_V(0);
    if constexpr (!ALIGN_EPI) { if (wr == 0) PG8_BAR; }
    PG8_BAR;
    if constexpr (Epi::AFTER_DRAIN) { E.fused(acc, cur, wr, wc, fr, fq, lds, wid, lane); S.done(cur); }
#undef PG8_SA
#undef PG8_SB
#undef PG8_STAGE
#undef PG8_LDA
#undef PG8_LDB
#undef PG8_MMA
#undef PG8_WAIT_V
#undef PG8_WAIT_L
#undef PG8_BAR
#undef PG8_SCHED
}
}

constexpr int NWAVES = 8, NTHR = 512;
constexpr int DM = 2048, BATCH = 2, SEQ = 16384, DEPTH = 4, GRIDW = 64, GROWS = 256, CTXL = 256;
constexpr int NAW = 1024, NHEAD = 8, HDIM = 128, FNW = 512, HYW = 512, DFF = 5632, DIN = 5120, NMOD = 6;
constexpr int ML = BATCH * SEQ, MC = BATCH * CTXL, MT = ML + MC;
constexpr int PML = ML / 256, PMT = MT / 256;
constexpr int NEDGE = MT / 64 * 2;
constexpr float EPS = 1e-6f;
constexpr float LOG2E = 1.4426950408889634f;
constexpr float QSCALE = 0.08838834764831845f * LOG2E;
constexpr float HY_MIN_DECAY = -3.0701134573253945f, HY_MAX_DECAY = -15.350567286626973f;

constexpr size_t MiB = 1u << 20;
constexpr size_t WS_CTL = 0, CTL_ZERO_BYTES = 1 * MiB;
constexpr size_t WS_MOD = 1 * MiB;
constexpr size_t WS_XC = 2 * MiB;
constexpr size_t WS_HFC = 6 * MiB;
constexpr size_t WS_HF = 8 * MiB;
constexpr size_t WS_WIN = WS_HF + 128 * MiB;
constexpr size_t WS_WOUT = WS_WIN + 80 * MiB;
constexpr size_t WS_WUP = WS_WOUT + 32 * MiB;
constexpr size_t WS_WDN = WS_WUP + 176 * MiB;
constexpr size_t WS_H = WS_WDN + 88 * MiB;
constexpr size_t WS_QK = WS_H + 130 * MiB;
constexpr size_t WS_VT = WS_QK + 130 * MiB;
constexpr size_t WS_T32 = WS_VT + 65 * MiB;
constexpr size_t WS_A = WS_T32 + 260 * MiB;
constexpr size_t WS_HID = WS_QK;
constexpr size_t WS_EDGE = WS_A + 65 * MiB;
constexpr size_t EDGE_ELEMS = (size_t)NEDGE * DFF;
constexpr size_t WS_KS = WS_EDGE + 68 * MiB;
constexpr size_t WS_SLAB = WS_KS + 64 * MiB;
constexpr size_t WS_END = WS_SLAB + 16 * MiB;
static_assert((size_t)MT * DFF * 2 <= WS_EDGE - WS_QK, "hidden overlay");
static_assert(3 * EDGE_ELEMS * 4 <= 68 * MiB, "edge buffers");
static_assert((size_t)MT * DM * 2 == 130 * MiB && (size_t)1024 * MT * 2 == 65 * MiB && (size_t)2048 * MT * 4 == 260 * MiB, "sizes");
constexpr int CW_BAR = 4096;

constexpr int RING_BYTES = 131072;
constexpr int XTRA_OFF = RING_BYTES, XTRA_BYTES = 28672;
constexpr int MISC_OFF = XTRA_OFF + XTRA_BYTES;
constexpr int TW_OFF = XTRA_OFF + 24576;
constexpr int ATT_KC_OFF = 0, ATT_KC_PITCH = 272, ATT_VC_OFF = 256 * ATT_KC_PITCH, ATT_VC_PITCH = 528, ATT_BIAS_OFF = ATT_VC_OFF + 128 * ATT_VC_PITCH;
static_assert(ATT_BIAS_OFF + 8 * 465 * 4 <= TW_OFF, "attention LDS map");
constexpr int LDS_BYTES = MISC_OFF + 256;

#define GAS __attribute__((address_space(1)))
#define LAS __attribute__((address_space(3)))
typedef unsigned short bf16;
typedef unsigned v4u __attribute__((ext_vector_type(4)));
typedef unsigned v2u __attribute__((ext_vector_type(2)));
typedef float f32x4 __attribute__((ext_vector_type(4)));
typedef float f32x2 __attribute__((ext_vector_type(2)));
typedef short bf16x8 __attribute__((ext_vector_type(8)));
#define LDS_WAIT() asm volatile("s_waitcnt lgkmcnt(0)" ::: "memory")
__device__ __forceinline__ unsigned f2bf(float f) { unsigned u = __builtin_bit_cast(unsigned, f); return (u + 0x7fffu + ((u >> 16) & 1u)) >> 16; }
__device__ __forceinline__ unsigned pk2(float lo, float hi) { return f2bf(lo) | (f2bf(hi) << 16); }
__device__ __forceinline__ float bf2f(unsigned short b) { return __builtin_bit_cast(float, (unsigned)b << 16); }
__device__ __forceinline__ f32x2 cmul(f32x2 a, f32x2 b) { return (f32x2){a.x * b.x - a.y * b.y, a.x * b.y + a.y * b.x}; }
__device__ __forceinline__ f32x2 cconj(f32x2 a) { return (f32x2){a.x, -a.y}; }
__device__ __forceinline__ float lane_read(float v, int src_lane) { return __builtin_bit_cast(float, __builtin_amdgcn_ds_bpermute(src_lane << 2, __builtin_bit_cast(int, v))); }
template <int CTRL> __device__ __forceinline__ float dpp_ror(float v) { return __builtin_bit_cast(float, __builtin_amdgcn_update_dpp(0, __builtin_bit_cast(int, v), CTRL, 0xf, 0xf, false)); }
__device__ __forceinline__ float wave_sum(float v, int lane) {
#pragma unroll
    for (int o = 1; o < 64; o <<= 1) v += lane_read(v, lane ^ o);
    return v;
}
__device__ __forceinline__ float gelu_tanh(float x) {
    const float t = x * (1.0f + 0.044715f * x * x) * (-2.302208198f);
    const float e = __builtin_amdgcn_exp2f(t);
    return x * __builtin_amdgcn_rcpf(1.0f + e);
}
#define XB_LAS_DEFINED
#define XB_TMO      128
#define XB_XCNT(j)  (256  + 64 * (j))
#define XB_XSUB(j)  (1280 + 64 * (j))
#define XB_XGEN(j)  (2304 + 64 * (j))
#define XB_TOP      3328
#define XB_TOPGEN   3392
#define XCD_BAR_WORDS 3456
#define XB_SPIN_CAP (1u << 18)

__device__ __forceinline__ unsigned xb_ld(unsigned* p)              { return __hip_atomic_load(p, __ATOMIC_RELAXED, __HIP_MEMORY_SCOPE_AGENT); }
__device__ __forceinline__ unsigned xb_add(unsigned* p, unsigned v) { return __hip_atomic_fetch_add(p, v, __ATOMIC_RELAXED, __HIP_MEMORY_SCOPE_AGENT); }
__device__ __forceinline__ unsigned xb_xcc_id() { return (unsigned)__builtin_amdgcn_s_getreg((3 << 11) | 20) & 0xFu; }
#define XB_SPIN(cond, bar) do { unsigned _sp = 0; while (cond) { __builtin_amdgcn_s_sleep(1); \
    if ((++_sp & 255u) == 0u) { if (xb_ld(&(bar)[XB_TMO])) break; if (_sp > XB_SPIN_CAP) { atomicAdd(&(bar)[XB_TMO], 1u); break; } } } } while (0)

struct XcdBarrier {
    unsigned* bar; unsigned x;
    volatile LAS unsigned* st;
};

__device__ __forceinline__ XcdBarrier xcd_barrier_post(unsigned* bar, volatile LAS unsigned* st) {
    XcdBarrier b; b.bar = bar; b.x = xb_xcc_id(); b.st = st;
    if (threadIdx.x == 0) (void)xb_add(&bar[XB_XCNT(b.x)], 1u);
    return b;
}
__device__ __forceinline__ void xcd_barrier_complete(unsigned* bar, unsigned x, unsigned& nloc, unsigned& nx) {
    const unsigned G = gridDim.x * gridDim.y * gridDim.z;
    unsigned sum, cnt, mine, sp = 0u;
    for (;;) {
        sum = 0u; cnt = 0u; mine = 0u;
#pragma unroll
        for (unsigned j = 0; j < 16; ++j) { const unsigned c = xb_ld(&bar[XB_XCNT(j)]); sum += c; cnt += (c > 0u) ? 1u : 0u; mine = (j == x) ? c : mine; }
        if (sum == G) break;
        __builtin_amdgcn_s_sleep(1);
        if ((++sp & 255u) == 0u) { if (xb_ld(&bar[XB_TMO])) break; if (sp > XB_SPIN_CAP) { atomicAdd(&bar[XB_TMO], 1u); break; } }
    }
    nloc = mine > 0u ? mine : 1u; nx = cnt > 0u ? cnt : 1u;
}

__device__ __forceinline__ void xcd_barrier(const XcdBarrier& b) {
    asm volatile("s_waitcnt vmcnt(0)" ::: "memory");
    __syncthreads();
    if (threadIdx.x == 0) {
        unsigned* bar = b.bar;
        __builtin_amdgcn_s_waitcnt(0);
        unsigned nloc = b.st[0], nx = b.st[1];
        if (nloc == 0u) { xcd_barrier_complete(bar, b.x, nloc, nx); b.st[0] = nloc; b.st[1] = nx; }
        const unsigned old = xb_add(&bar[XB_XSUB(b.x)], 1u);
        const unsigned gen = old / nloc;
        if (old + 1u == (gen + 1u) * nloc) {
            __builtin_amdgcn_fence(__ATOMIC_RELEASE, "agent");
            asm volatile("s_waitcnt vmcnt(0)" ::: "memory");
            const unsigned og = xb_add(&bar[XB_TOP], 1u);
            const unsigned tg = og / nx;
            if (og + 1u == (tg + 1u) * nx) xb_add(&bar[XB_TOPGEN], 1u);
            else XB_SPIN(xb_ld(&bar[XB_TOPGEN]) == tg, bar);
            __builtin_amdgcn_fence(__ATOMIC_ACQUIRE, "agent");
            xb_add(&bar[XB_XGEN(b.x)], 1u);
            asm volatile("s_waitcnt vmcnt(0)" ::: "memory");
        } else {
            XB_SPIN(xb_ld(&bar[XB_XGEN(b.x)]) == gen, bar);
            __builtin_amdgcn_fence(__ATOMIC_ACQUIRE, "agent");
            asm volatile("s_waitcnt vmcnt(0)" ::: "memory");
        }
    }
    __syncthreads();
}


struct Args { const GAS float* in[26]; GAS float* out; GAS unsigned char* ws; };
struct Frame {
    LAS unsigned char* lds;
    int tid, lane, wave;
    int vcu, G;
    GAS unsigned char* ws;
    GAS float* out;
};
typedef const float* cfptr_t;
__device__ __forceinline__ const GAS float* in_ptr(int k) { asm volatile("" : "+s"(k));
    const __attribute__((address_space(4))) cfptr_t* kp = (const __attribute__((address_space(4))) cfptr_t*)__builtin_amdgcn_kernarg_segment_ptr(); return (const GAS float*)kp[k]; }
enum { I_x, I_c, I_ctx, I_c_ctx, I_ada_w, I_ada_b, I_norm1_g, I_norm2_g, I_w_in, I_na_rpb, I_hy_conv_w, I_hy_conv_b, I_hy_w1, I_hy_b1, I_hy_w2, I_hy_b2, I_hy_w3, I_hy_freq, I_hy_bias,
       I_mix_norm_g, I_w_out, I_ffn_w_up, I_ffn_conv_w, I_ffn_conv_b, I_ffn_w_down, I_final_norm_g };
#define IN(name) in_ptr(I_##name)
#define WSP(T, off) ((GAS T*)(F.ws + (off)))

__device__ __forceinline__ void pa_adaln(Frame& F) {
    LAS float* sv = (LAS float*)F.lds;
    LAS float* red = (LAS float*)(F.lds + 3 * DM * 4);
    const GAS float* p_c = IN(c); const GAS float* p_cc = IN(c_ctx); const GAS float* p_aw = IN(ada_w); const GAS float* p_ab = IN(ada_b);
    for (int i = F.tid; i < 3 * DM; i += NTHR) { const int s = i / DM, k = i % DM; const float v = s < 2 ? p_c[s * DM + k] : p_cc[k]; sv[i] = v / (1.0f + __expf(-v)); }
    __syncthreads();
    GAS float* MOD = WSP(float, WS_MOD);
    const int cg = F.tid & 63, ks = F.tid >> 6;
    for (int item = F.vcu; item < DEPTH * 48; item += F.G) {
        const int l = item / 48, j0 = (item % 48) * 256;
        const GAS float* wp = p_aw + ((size_t)l * DM + ks * 256) * (NMOD * DM) + j0 + 4 * cg;
        f32x4 a0 = {0.f, 0.f, 0.f, 0.f}, a1 = a0, a2 = a0;
#pragma unroll 8
        for (int kk = 0; kk < 256; ++kk) {
            const f32x4 w = *(const GAS f32x4*)(wp + (size_t)kk * (NMOD * DM));
            const float s0 = sv[ks * 256 + kk], s1 = sv[DM + ks * 256 + kk], s2 = sv[2 * DM + ks * 256 + kk];
            a0 += w * s0; a1 += w * s1; a2 += w * s2;
        }
        *(LAS f32x4*)(red + (ks * 3 + 0) * 256 + 4 * cg) = a0; *(LAS f32x4*)(red + (ks * 3 + 1) * 256 + 4 * cg) = a1; *(LAS f32x4*)(red + (ks * 3 + 2) * 256 + 4 * cg) = a2;
        __syncthreads();
        if (F.tid < 192) {
            const int s = F.tid >> 6, cc = F.tid & 63;
            f32x4 t = *(const GAS f32x4*)(p_ab + (size_t)l * (NMOD * DM) + j0 + 4 * cc);
#pragma unroll
            for (int q = 0; q < 8; ++q) t += *(LAS f32x4*)(red + (q * 3 + s) * 256 + 4 * cc);
            *(GAS f32x4*)(MOD + ((size_t)l * 3 + s) * (NMOD * DM) + j0 + 4 * cc) = t;
        }
        __syncthreads();
    }
}
__device__ __forceinline__ void transpose_item(const GAS float* W, int K, int N, GAS bf16* WT, int k0, int n0, int drow0, LAS float* scr, int lane) {
#pragma unroll 8
    for (int i = 0; i < 32; ++i) { const int kk = 2 * i + (lane >> 5); scr[kk * 33 + (lane & 31)] = W[(size_t)(k0 + kk) * N + n0 + (lane & 31)]; }
    LDS_WAIT(); asm volatile("" ::: "memory");
    const int c = lane & 7;
#pragma unroll
    for (int j = 0; j < 4; ++j) { const int n = (lane >> 3) + 8 * j; const LAS float* s = scr + (8 * c) * 33 + n;
        v4u o; o.x = pk2(s[0 * 33], s[1 * 33]); o.y = pk2(s[2 * 33], s[3 * 33]); o.z = pk2(s[4 * 33], s[5 * 33]); o.w = pk2(s[6 * 33], s[7 * 33]);
        *(GAS v4u*)(WT + (size_t)(drow0 + n) * K + k0 + 8 * c) = o; }
    LDS_WAIT(); asm volatile("" ::: "memory");
}
__device__ __forceinline__ void pa_ctx_copy(Frame& F) {
    const GAS f32x4* src = (const GAS f32x4*)IN(ctx); GAS f32x4* dst = WSP(f32x4, WS_XC);
    for (int i = F.vcu * NTHR + F.tid; i < MC * DM / 4; i += F.G * NTHR) dst[i] = src[i];
}
__device__ __forceinline__ void pa_weights(Frame& F) {
    const GAS float* p_win = IN(w_in); const GAS float* p_wout = IN(w_out); const GAS float* p_wup = IN(ffn_w_up); const GAS float* p_wdn = IN(ffn_w_down);
    {
        LAS float* wt = (LAS float*)F.lds;
        LAS float* tab = (LAS float*)(F.lds + 64 * 129 * 4);
        if (F.tid < 128) tab[F.tid] = cospif((float)F.tid * (1.0f / 64.0f));
        for (int item = F.vcu; item < DEPTH * 4 * 32; item += F.G) {
            const int l = item >> 7, g = (item >> 5) & 3, k0 = (item & 31) * 64;
            __syncthreads();
            for (int i = F.tid; i < 64 * 128; i += NTHR) { const int kk = i >> 7, cc = i & 127; wt[kk * 129 + cc] = p_win[((size_t)l * DM + k0 + kk) * DIN + 3072 + g * 128 + cc]; }
            __syncthreads();
            const int kk = F.tid & 63;
            GAS bf16* dst = WSP(bf16, WS_WIN) + ((size_t)l * DIN + 3072 + g * 128) * DM + k0 + kk;
            for (int i = 0; i < 16; ++i) {
                const int mp = (F.tid >> 6) + 8 * i;
                const int mm = mp <= 64 ? mp : mp - 64, sh = mp <= 64 ? 0 : 96;
                float a = 0.f;
                const int add = mp <= 64 ? 0 : 32; (void)sh;
#pragma unroll 8
                for (int cc = 0; cc < 128; ++cc) a += wt[kk * 129 + cc] * tab[(mm * cc + add) & 127];
                dst[(size_t)mp * DM] = (bf16)f2bf(a);
            }
        }
        __syncthreads();
    }
    LAS float* scr = (LAS float*)(F.lds + F.wave * 16384);
    const int gw = F.vcu * NWAVES + F.wave, NGW = F.G * NWAVES;
    constexpr int I_IN = 32 * 144, I_OUT = 32 * 64, I_UP = 32 * 352, I_DN = 88 * 64, I_L = I_IN + I_OUT + I_UP + I_DN;
    for (int it = gw; it < DEPTH * I_L; it += NGW) {
        const int l = it / I_L; int r = it % I_L;
        if (r < I_IN) { const int kb = r / 144; int nb = r % 144; if (nb >= 96) nb += 16;
            transpose_item(p_win + (size_t)l * DM * DIN, DM, DIN, WSP(bf16, WS_WIN) + (size_t)l * DIN * DM, kb * 64, nb * 32, nb * 32, scr, F.lane); continue; }
        r -= I_IN;
        if (r < I_OUT) { const int kb = r / 64, nb = r % 64;
            transpose_item(p_wout + (size_t)l * DM * DM, DM, DM, WSP(bf16, WS_WOUT) + (size_t)l * DM * DM, kb * 64, nb * 32, nb * 32, scr, F.lane); continue; }
        r -= I_OUT;
        if (r < I_UP) { const int kb = r / 352, nb = r % 352; const int n0 = nb * 32;
            const int drow = n0 < DFF ? (n0 >> 7) * 256 + (n0 & 127) : ((n0 - DFF) >> 7) * 256 + 128 + ((n0 - DFF) & 127);
            transpose_item(p_wup + (size_t)l * DM * 2 * DFF, DM, 2 * DFF, WSP(bf16, WS_WUP) + (size_t)l * 2 * DFF * DM, kb * 64, n0, drow, scr, F.lane); continue; }
        r -= I_UP;
        { const int kb = r / 64, nb = r % 64;
            transpose_item(p_wdn + (size_t)l * DFF * DM, DFF, DM, WSP(bf16, WS_WDN) + (size_t)l * DM * DFF, kb * 64, nb * 32, nb * 32, scr, F.lane); }
    }
}

__device__ __forceinline__ void norm_phase(Frame& F, int l, int which, bool with_ctx, int nslab) {
    const GAS float* gain = (which ? IN(norm2_g) : IN(norm1_g)) + (size_t)l * DM;
    const GAS float* MOD = WSP(float, WS_MOD) + (size_t)l * 3 * (NMOD * DM);
    const bool first = (l == 0 && which == 0);
    const GAS float* xl = first ? IN(x) : F.out; const GAS float* xc = first ? IN(ctx) : WSP(float, WS_XC);
    GAS bf16* H = WSP(bf16, WS_H);
    const int gw = F.vcu * NWAVES + F.wave, NGW = F.G * NWAVES, nrows = with_ctx ? MT : ML;
    for (int row = gw; row < nrows; row += NGW) {
        const int s = row < SEQ ? 0 : row < ML ? 1 : 2;
        const GAS float* xr = row < ML ? xl + (size_t)row * DM : xc + (size_t)(row - ML) * DM;
        const GAS float* shp = MOD + (size_t)s * (NMOD * DM) + (which ? 3 : 0) * DM; const GAS float* scp = shp + DM;
        f32x4 v[8]; float ss = 0.f;
#pragma unroll
        for (int j = 0; j < 8; ++j) v[j] = *(const GAS f32x4*)(xr + 4 * (F.lane + 64 * j));
        if (row >= ML && nslab > 0) {
            const GAS float* sl = WSP(float, WS_SLAB) + (size_t)(row - ML) * DM; GAS float* xw = WSP(float, WS_XC) + (size_t)(row - ML) * DM;
            for (int ks = 0; ks < nslab; ++ks)
#pragma unroll
                for (int j = 0; j < 8; ++j) v[j] += *(const GAS f32x4*)(sl + (size_t)ks * MC * DM + 4 * (F.lane + 64 * j));
#pragma unroll
            for (int j = 0; j < 8; ++j) *(GAS f32x4*)(xw + 4 * (F.lane + 64 * j)) = v[j];
        }
#pragma unroll
        for (int j = 0; j < 8; ++j) ss += (v[j].x * v[j].x + v[j].y * v[j].y) + (v[j].z * v[j].z + v[j].w * v[j].w);
        const float rstd = 1.0f / sqrtf(wave_sum(ss, F.lane) * (1.0f / DM) + EPS);
        GAS bf16* hr = H + (size_t)row * DM;
#pragma unroll
        for (int j = 0; j < 8; ++j) { const int k = 4 * (F.lane + 64 * j);
            const f32x4 g = *(const GAS f32x4*)(gain + k), sc = *(const GAS f32x4*)(scp + k), sh = *(const GAS f32x4*)(shp + k);
            const f32x4 y = (v[j] * rstd * g) * (1.0f + sc) + sh;
            v2u o; o.x = pk2(y.x, y.y); o.y = pk2(y.z, y.w); *(GAS v2u*)(hr + k) = o; }
    }
}
__device__ __forceinline__ void final_norm_phase(Frame& F) {
    const GAS float* p_g = IN(final_norm_g);
    const int gw = F.vcu * NWAVES + F.wave, NGW = F.G * NWAVES;
    for (int row = gw; row < ML; row += NGW) {
        GAS float* xr = F.out + (size_t)row * DM;
        f32x4 v[8]; float ss = 0.f;
#pragma unroll
        for (int j = 0; j < 8; ++j) { v[j] = *(const GAS f32x4*)(xr + 4 * (F.lane + 64 * j)); ss += (v[j].x * v[j].x + v[j].y * v[j].y) + (v[j].z * v[j].z + v[j].w * v[j].w); }
        const float rstd = 1.0f / sqrtf(wave_sum(ss, F.lane) * (1.0f / DM) + EPS);
#pragma unroll
        for (int j = 0; j < 8; ++j) { const int k = 4 * (F.lane + 64 * j); *(GAS f32x4*)(xr + k) = v[j] * rstd * *(const GAS f32x4*)(p_g + k); }
    }
}

__device__ __forceinline__ void filter_phase(Frame& F, int l, bool with_ctx) {
    LAS float* h1 = (LAS float*)F.lds;
    LAS float* h2 = (LAS float*)(F.lds + 64 * 65 * 4);
    const GAS float* w1 = IN(hy_w1) + (size_t)l * 33 * 64; const GAS float* b1 = IN(hy_b1) + (size_t)l * 64;
    const GAS float* w2 = IN(hy_w2) + (size_t)l * 64 * 64; const GAS float* b2 = IN(hy_b2) + (size_t)l * 64;
    const GAS float* w3 = IN(hy_w3) + (size_t)l * 64 * 2048; const GAS float* fq = IN(hy_freq) + (size_t)l * 64;
    const int nitems = with_ctx ? 288 : 256;
    for (int item = F.vcu; item < nitems; item += F.G) {
        const bool isc = item >= 256; const int Lq = isc ? CTXL : SEQ; const int n0 = (isc ? (item - 256) >> 3 : item) * 64;
        const int ck_lo = isc ? (item & 7) : 0, ck_hi = isc ? ck_lo + 1 : 8;
        const int p = F.tid & 63, jg = F.wave;
        const float pos = (float)(n0 + p), t = pos / (float)(Lq - 1);
        __syncthreads();
        {
            float zf[33]; zf[0] = t;
#pragma unroll
            for (int i = 0; i < 16; ++i) { const float band = 1e-4f + (float)i * ((15.0f - 1e-4f) / 15.0f); const float ang = band * (6.283185307179586f / (float)Lq) * pos; zf[1 + i] = cosf(ang); zf[17 + i] = -sinf(ang); }
#pragma unroll 1
            for (int jj = 0; jj < 8; ++jj) { const int j = jg * 8 + jj; float a = b1[j];
#pragma unroll
                for (int i = 0; i < 33; ++i) a += zf[i] * w1[i * 64 + j];
                h1[p * 65 + j] = sinf(fq[j] * a); }
        }
        __syncthreads();
#pragma unroll 1
        for (int jj = 0; jj < 8; ++jj) { const int j = jg * 8 + jj; float a = b2[j];
#pragma unroll 8
            for (int i = 0; i < 64; ++i) a += h1[p * 65 + i] * w2[i * 64 + j];
            h2[p * 65 + j] = sinf(fq[j] * a); }
        __syncthreads();
        GAS float* dst = isc ? WSP(float, WS_HFC) : WSP(float, WS_HF);
        LAS float* w3s = (LAS float*)(F.lds + 2 * 64 * 65 * 4);
        for (int ck = ck_lo; ck < ck_hi; ++ck) {
            __syncthreads();
#pragma unroll 4
            for (int i = F.tid; i < 64 * 64; i += NTHR) { const int jr = i >> 6, c4 = (i & 63) * 4; *(LAS f32x4*)(w3s + jr * 256 + c4) = *(const GAS f32x4*)(w3 + (size_t)jr * 2048 + ck * 256 + c4); }
            __syncthreads();
            f32x4 a[8];
#pragma unroll
            for (int q = 0; q < 8; ++q) a[q] = (f32x4){0.f, 0.f, 0.f, 0.f};
#pragma unroll 2
            for (int i = 0; i < 64; ++i) { const float hvi = h2[p * 65 + i]; const LAS f32x4* wr = (const LAS f32x4*)(w3s + i * 256 + jg * 32);
#pragma unroll
                for (int q = 0; q < 8; ++q) a[q] += wr[q] * hvi; }
#pragma unroll
            for (int q = 0; q < 8; ++q)
#pragma unroll
                for (int e = 0; e < 4; ++e) { const int col = ck * 256 + jg * 32 + q * 4 + e, ch = col & 511;
                    const float delta = fabsf(HY_MIN_DECAY + (HY_MAX_DECAY - HY_MIN_DECAY) * ((float)ch / 511.0f));
                    const float val = a[q][e] * __expf(-t * delta); const int n = n0 + p;
                    if (col & 512) dst[(size_t)col * Lq + ((Lq - n) & (Lq - 1))] = n == 0 ? 0.f : val;
                    else dst[(size_t)col * Lq + n] = val; }
        }
    }
}

struct EpiIn {
    static constexpr bool PERM = true, AFTER_DRAIN = false;
    GAS bf16* QK; GAS bf16* VT; GAS float* T32;
    __device__ __forceinline__ void operator()(pg8::f32x4 (&acc)[2][2][4][2], const pg8::Unit& u, int wr_, int wc_, int fr_, int fq_) const {
        int t_ = threadIdx.x; asm volatile("" : "+v"(t_));
        const int fr = t_ & 15, fq = (t_ >> 4) & 3, wc = (t_ >> 6) & 3, wr = t_ >> 8; (void)wr_; (void)wc_; (void)fr_; (void)fq_;
        const int row0 = u.pm * 256 + wr * 64 + fr, col0 = u.pn * 256 + wc * 32 + 8 * fq;
        if (u.type == 0) {
            const float sc = u.pn < 4 ? QSCALE : 1.0f;
#pragma unroll
            for (int ai = 0; ai < 2; ++ai)
#pragma unroll
                for (int m = 0; m < 4; ++m) { GAS bf16* rowp = QK + (size_t)(row0 + ai * 128 + m * 16) * 2048 + col0;
#pragma unroll
                    for (int bj = 0; bj < 2; ++bj) { const pg8::f32x4 v0 = acc[ai][bj][m][0] * sc, v1 = acc[ai][bj][m][1] * sc;
                        v4u w; w.x = pg8::cvt_pk_bf16(v0[0], v0[1]); w.y = pg8::cvt_pk_bf16(v0[2], v0[3]); w.z = pg8::cvt_pk_bf16(v1[0], v1[1]); w.w = pg8::cvt_pk_bf16(v1[2], v1[3]);
                        *(GAS v4u*)(rowp + bj * 128) = w; } }
        } else if (u.pm < 4) {
#pragma unroll
            for (int ai = 0; ai < 2; ++ai)
#pragma unroll
                for (int m = 0; m < 4; ++m) { GAS bf16* rowp = VT + (size_t)(row0 + ai * 128 + m * 16) * MT + col0;
#pragma unroll
                    for (int bj = 0; bj < 2; ++bj) { const pg8::f32x4 v0 = acc[ai][bj][m][0], v1 = acc[ai][bj][m][1];
                        v4u w; w.x = pg8::cvt_pk_bf16(v0[0], v0[1]); w.y = pg8::cvt_pk_bf16(v0[2], v0[3]); w.z = pg8::cvt_pk_bf16(v1[0], v1[1]); w.w = pg8::cvt_pk_bf16(v1[2], v1[3]);
                        *(GAS v4u*)(rowp + bj * 128) = w; } }
        } else {
#pragma unroll
            for (int ai = 0; ai < 2; ++ai)
#pragma unroll
                for (int m = 0; m < 4; ++m) { GAS float* rowp = T32 + (size_t)(row0 - 1024 + ai * 128 + m * 16) * MT + col0;
#pragma unroll
                    for (int bj = 0; bj < 2; ++bj) { *(GAS pg8::f32x4*)(rowp + bj * 128) = acc[ai][bj][m][0]; *(GAS pg8::f32x4*)(rowp + bj * 128 + 4) = acc[ai][bj][m][1]; } }
        }
    }
};
struct EpiRes {
    static constexpr bool PERM = false, AFTER_DRAIN = false;
    const GAS float* base_l; const GAS float* base_c; GAS float* out_l; GAS float* out_c; const GAS float* gate;
    __device__ __forceinline__ void operator()(pg8::f32x4 (&acc)[2][2][4][2], const pg8::Unit& u, int wr_, int wc_, int fr_, int fq_) const {
        int t_ = threadIdx.x; asm volatile("" : "+v"(t_));
        const int fr = t_ & 15, fq = (t_ >> 4) & 3, wc = (t_ >> 6) & 3, wr = t_ >> 8; (void)wr_; (void)wc_; (void)fr_; (void)fq_;
        const int row0 = u.pm * 256 + wr * 64 + fr, col0 = u.pn * 256 + wc * 32 + 4 * fq;
        const int s = u.pm < PML / 2 ? 0 : u.pm < PML ? 1 : 2;
        const GAS float* bs = u.pm < PML ? base_l + (size_t)row0 * DM : base_c + (size_t)(row0 - ML) * DM;
        GAS float* os = u.pm < PML ? out_l + (size_t)row0 * DM : out_c + (size_t)(row0 - ML) * DM;
        pg8::f32x4 gv[2][2];
#pragma unroll
        for (int bj = 0; bj < 2; ++bj)
#pragma unroll
            for (int n = 0; n < 2; ++n) gv[bj][n] = *(const GAS pg8::f32x4*)(gate + (size_t)s * (NMOD * DM) + col0 + bj * 128 + n * 16);
#pragma unroll
        for (int ai = 0; ai < 2; ++ai)
#pragma unroll
            for (int m = 0; m < 4; ++m) { const size_t off = (size_t)(ai * 128 + m * 16) * DM + col0;
#pragma unroll
                for (int bj = 0; bj < 2; ++bj)
#pragma unroll
                    for (int n = 0; n < 2; ++n) { const pg8::f32x4 b = *(const GAS pg8::f32x4*)(bs + off + bj * 128 + n * 16);
                        *(GAS pg8::f32x4*)(os + off + bj * 128 + n * 16) = b + gv[bj][n] * acc[ai][bj][m][n]; }
                asm volatile("" ::: "memory"); }
    }
};
struct EpiSlab {
    static constexpr bool PERM = false, AFTER_DRAIN = false;
    GAS float* slab; const GAS float* gate;
    __device__ __forceinline__ void operator()(pg8::f32x4 (&acc)[2][2][4][2], const pg8::Unit& u, int wr_, int wc_, int fr_, int fq_) const {
        int t_ = threadIdx.x; asm volatile("" : "+v"(t_));
        const int fr = t_ & 15, fq = (t_ >> 4) & 3, wc = (t_ >> 6) & 3, wr = t_ >> 8; (void)wr_; (void)wc_; (void)fr_; (void)fq_;
        const int row0 = u.pm * 256 + wr * 64 + fr - ML, col0 = u.pn * 256 + wc * 32 + 4 * fq;
        pg8::f32x4 gv[2][2];
#pragma unroll
        for (int bj = 0; bj < 2; ++bj)
#pragma unroll
            for (int n = 0; n < 2; ++n) gv[bj][n] = *(const GAS pg8::f32x4*)(gate + (size_t)2 * (NMOD * DM) + col0 + bj * 128 + n * 16);
        GAS float* sb = slab + (size_t)u.type * MC * DM;
#pragma unroll
        for (int ai = 0; ai < 2; ++ai)
#pragma unroll
            for (int m = 0; m < 4; ++m) { GAS float* os = sb + (size_t)(row0 + ai * 128 + m * 16) * DM + col0;
#pragma unroll
                for (int bj = 0; bj < 2; ++bj)
#pragma unroll
                    for (int n = 0; n < 2; ++n) *(GAS pg8::f32x4*)(os + bj * 128 + n * 16) = gv[bj][n] * acc[ai][bj][m][n]; }
    }
};
struct EpiUp {
    static constexpr bool PERM = true, AFTER_DRAIN = false;
    GAS bf16* HID; GAS float* EG; GAS float* EP; GAS float* EU; const GAS float* cw; const GAS float* cb;
    __device__ __forceinline__ void operator()(pg8::f32x4 (&acc)[2][2][4][2], const pg8::Unit& u, int wr_, int wc_, int fr_, int fq_) const {
        int t_ = threadIdx.x; asm volatile("" : "+v"(t_));
        const int fr = t_ & 15, fq = (t_ >> 4) & 3, wc = (t_ >> 6) & 3, wr = t_ >> 8; (void)wr_; (void)wc_; (void)fr_; (void)fq_;
        const unsigned hc0 = (unsigned)(u.pn * 128 + wc * 32 + 8 * fq);
        const bool e0 = fr == 0, e3 = fr == 15;
        __builtin_amdgcn_sched_barrier(0);
#pragma unroll
        for (int ai = 0; ai < 2; ++ai) {
            const int rbase = u.pm * 256 + ai * 128 + wr * 64;
            const unsigned eb0 = (unsigned)((rbase >> 6) << 1) * (unsigned)DFF, eb3 = eb0 + (unsigned)DFF;
#pragma unroll
            for (int n = 0; n < 2; ++n) {
                const unsigned hc = hc0 + 4u * (unsigned)n;
                const pg8::f32x4 w0 = *(const GAS pg8::f32x4*)&cw[hc], w1 = *(const GAS pg8::f32x4*)&cw[(unsigned)DFF + hc], w2 = *(const GAS pg8::f32x4*)&cw[2u * (unsigned)DFF + hc], bb = *(const GAS pg8::f32x4*)&cb[hc];
                if (e0) { *(GAS pg8::f32x4*)&EG[eb0 + hc] = acc[ai][0][0][n]; *(GAS pg8::f32x4*)&EU[eb0 + hc] = acc[ai][1][0][n]; }
                if (e3) { *(GAS pg8::f32x4*)&EG[eb3 + hc] = acc[ai][0][3][n]; *(GAS pg8::f32x4*)&EU[eb3 + hc] = acc[ai][1][3][n]; }
#pragma unroll
                for (int j = 0; j < 4; ++j) {
                    float pr[4], nx[4], gg[4];
#pragma unroll
                    for (int m = 0; m < 4; ++m) { gg[m] = acc[ai][0][m][n][j]; pr[m] = dpp_ror<0x121>(gg[m]); nx[m] = dpp_ror<0x12F>(gg[m]); }
#pragma unroll
                    for (int m = 0; m < 4; ++m) {
                        const float pv = fr > 0 ? pr[m] : (m > 0 ? pr[m > 0 ? m - 1 : 0] : 0.f);
                        const float nv = fr < 15 ? nx[m] : (m < 3 ? nx[m < 3 ? m + 1 : 3] : 0.f);
                        const float cv = w0[j] * pv + w1[j] * gg[m] + w2[j] * nv + bb[j];
                        if (m == 0) { if (e0) EP[eb0 + hc + (unsigned)j] = cv; } if (m == 3) { if (e3) EP[eb3 + hc + (unsigned)j] = cv; }
                        acc[ai][0][m][n][j] = gelu_tanh(cv) * acc[ai][1][m][n][j];
                    }
                }
                asm volatile("" ::: "memory"); __builtin_amdgcn_sched_barrier(0);
            }
#pragma unroll
            for (int m = 0; m < 4; ++m) {
                if (!((m == 0 && e0) || (m == 3 && e3))) {
                    const pg8::f32x4 v0 = acc[ai][0][m][0], v1 = acc[ai][0][m][1];
                    v4u w; w.x = pg8::cvt_pk_bf16(v0[0], v0[1]); w.y = pg8::cvt_pk_bf16(v0[2], v0[3]); w.z = pg8::cvt_pk_bf16(v1[0], v1[1]); w.w = pg8::cvt_pk_bf16(v1[2], v1[3]);
                    *(GAS v4u*)&HID[(unsigned)(rbase + m * 16 + fr) * (unsigned)DFF + hc0] = w;
                }
            }
        }
    }
};
__device__ __forceinline__ void edge_fix_phase(Frame& F, int l, bool with_ctx) {
    const GAS float* EG = WSP(float, WS_EDGE); const GAS float* EP = EG + EDGE_ELEMS; const GAS float* EU = EP + EDGE_ELEMS;
    const GAS float* cw = IN(ffn_conv_w) + (size_t)l * 3 * DFF;
    GAS bf16* HID = WSP(bf16, WS_HID);
    const int ne = with_ctx ? NEDGE : ML / 64 * 2, total = ne * (DFF / 4);
    for (int i = F.vcu * NTHR + F.tid; i < total; i += F.G * NTHR) {
        const int e = i / (DFF / 4), c = (i % (DFF / 4)) * 4;
        const int r = (e >> 1) * 64 + (e & 1) * 63;
        f32x4 p = *(const GAS f32x4*)(EP + (size_t)e * DFF + c);
        if (e & 1) { const int nr = r + 1; if (nr != SEQ && nr != ML && nr != ML + CTXL && nr != MT) p += *(const GAS f32x4*)(cw + 2 * DFF + c) * *(const GAS f32x4*)(EG + (size_t)(e + 1) * DFF + c); }
        else { if (r != 0 && r != SEQ && r != ML && r != ML + CTXL) p += *(const GAS f32x4*)(cw + c) * *(const GAS f32x4*)(EG + (size_t)(e - 1) * DFF + c); }
        const f32x4 up = *(const GAS f32x4*)(EU + (size_t)e * DFF + c);
        v2u o; o.x = pk2(gelu_tanh(p.x) * up.x, gelu_tanh(p.y) * up.y); o.y = pk2(gelu_tanh(p.z) * up.z, gelu_tanh(p.w) * up.w);
        *(GAS v2u*)(HID + (size_t)r * DFF + c) = o;
    }
}

#define MFMA16(a, b, c) __builtin_amdgcn_mfma_f32_16x16x32_bf16((a), (b), (c), 0, 0, 0)
struct AttnK { bf16x8 kf[2][4]; };
struct AttnV { bf16x8 vf[8]; };
__device__ __forceinline__ void attn_load_k(AttnK& C, const GAS bf16* kbase  , int q, int g) {
#pragma unroll
    for (int T = 0; T < 2; ++T) { const unsigned koff = (unsigned)((8 * (q >> 2) + 4 * T + (q & 3)) * 2048 + 8 * g);
#pragma unroll
        for (int dc = 0; dc < 4; ++dc) C.kf[T][dc] = *(const GAS bf16x8*)(kbase + koff + 32 * dc); }
}
__device__ __forceinline__ void attn_load_v(AttnV& C, const GAS bf16* vbase  , int q, int g) {
    const unsigned voff = (unsigned)(q * MT + 8 * g);
#pragma unroll
    for (int dt = 0; dt < 8; ++dt) { const GAS bf16* vrow = vbase + (size_t)dt * 16 * MT; C.vf[dt] = *(const GAS bf16x8*)(vrow + voff); }
}
__device__ __forceinline__ void attn_load_k_ctx(AttnK& C, const LAS unsigned char* KC, int cc, int q, int g) {
#pragma unroll
    for (int T = 0; T < 2; ++T) { const int kk = 8 * (q >> 2) + 4 * T + (q & 3);
#pragma unroll
        for (int dc = 0; dc < 4; ++dc) C.kf[T][dc] = *(const LAS bf16x8*)(KC + (32 * cc + kk) * ATT_KC_PITCH + (32 * dc + 8 * g) * 2); }
}
__device__ __forceinline__ void attn_load_v_ctx(AttnV& C, const LAS unsigned char* VC, int cc, int q, int g) {
#pragma unroll
    for (int dt = 0; dt < 8; ++dt) C.vf[dt] = *(const LAS bf16x8*)(VC + (16 * dt + q) * ATT_VC_PITCH + (32 * cc + 8 * g) * 2);
}
__device__ __forceinline__ void attn_compute(const AttnK& C, const AttnV& V, const bf16x8 (&qf)[4], f32x4 (&o)[8], float& mrun, float& lsum, int lane, int g,
                                             bool masked, int keycol0, int cs, const LAS float* brow  , int cq) {
    f32x4 s[2];
#pragma unroll
    for (int T = 0; T < 2; ++T) { s[T] = (f32x4){0.f, 0.f, 0.f, 0.f};
#pragma unroll
        for (int dc = 0; dc < 4; ++dc) s[T] = MFMA16(C.kf[T][dc], qf[dc], s[T]); }
    if (masked) {
#pragma unroll
        for (int T = 0; T < 2; ++T)
#pragma unroll
            for (int i = 0; i < 4; ++i) { const int keycol = keycol0 + 8 * g + 4 * T + i; const bool ok = keycol >= cs && keycol < cs + 16;
                const int dcol = keycol - cq + 15; const float bv = brow[ok ? dcol : 0];
                s[T][i] = ok ? s[T][i] + bv : -1e30f; }
    }
    float cm = fmaxf(fmaxf(fmaxf(s[0][0], s[0][1]), fmaxf(s[0][2], s[0][3])), fmaxf(fmaxf(s[1][0], s[1][1]), fmaxf(s[1][2], s[1][3])));
    cm = fmaxf(cm, lane_read(cm, lane ^ 16)); cm = fmaxf(cm, lane_read(cm, lane ^ 32));
    const float mnew = fmaxf(mrun, cm), alpha = __builtin_amdgcn_exp2f(mrun - mnew);
    mrun = mnew;
    float p[8]; float ps = 0.f;
#pragma unroll
    for (int T = 0; T < 2; ++T)
#pragma unroll
        for (int i = 0; i < 4; ++i) { p[4 * T + i] = __builtin_amdgcn_exp2f(s[T][i] - mnew); ps += p[4 * T + i]; }
    lsum = lsum * alpha + ps;
    v4u pw; pw.x = pg8::cvt_pk_bf16(p[0], p[1]); pw.y = pg8::cvt_pk_bf16(p[2], p[3]); pw.z = pg8::cvt_pk_bf16(p[4], p[5]); pw.w = pg8::cvt_pk_bf16(p[6], p[7]);
    const bf16x8 pf = __builtin_bit_cast(bf16x8, pw);
#pragma unroll
    for (int dt = 0; dt < 8; ++dt) { o[dt] = o[dt] * alpha; o[dt] = MFMA16(V.vf[dt], pf, o[dt]); }
}
__device__ __forceinline__ void attn_tile(Frame& F, bool is_lat, int b, int h, int r, int c0, int qrow0, const LAS float* bias_h) {
    const GAS bf16* QK = WSP(bf16, WS_QK); const GAS bf16* VT = WSP(bf16, WS_VT); GAS bf16* A = WSP(bf16, WS_A);
    const int q = F.lane & 15, g = F.lane >> 4;
    bf16x8 qf[4];
    { const GAS bf16* qp = QK + (size_t)(qrow0 + q) * 2048 + h * 128 + 8 * g;
#pragma unroll
      for (int dc = 0; dc < 4; ++dc) qf[dc] = *(const GAS bf16x8*)(qp + 32 * dc); }
    f32x4 o[8];
#pragma unroll
    for (int dt = 0; dt < 8; ++dt) o[dt] = (f32x4){0.f, 0.f, 0.f, 0.f};
    float mrun = -1e30f, lsum = 0.f;
    const int r0 = min(max(r - 4, 0), GROWS - 8), kc0 = min(max(c0 - 8, 0), 32), cq = c0 + q, cs = min(max(cq - 8, 0), 48);
    const GAS bf16* kh = QK + 1024 + h * 128; const GAS bf16* vh = VT + (size_t)(h * 128) * MT;
#define ATT_TOK(c) ((c) < 8 ? b * SEQ + (r0 + (c)) * GRIDW + kc0 : ML + b * CTXL + 32 * ((c) - 8))
#define ATT_LOADK(C, c) do { if ((c) < 8) { const int tok_ = ATT_TOK(c); attn_load_k(C, kh + (size_t)tok_ * 2048, q, g); } else attn_load_k_ctx(C, F.lds + ATT_KC_OFF, (c) - 8, q, g); } while (0)
#define ATT_LOADV(C, c) do { if ((c) < 8) { const int tok_ = ATT_TOK(c); attn_load_v(C, vh + tok_, q, g); } else attn_load_v_ctx(C, F.lds + ATT_VC_OFF, (c) - 8, q, g); } while (0)
#define ATT_COMP(C, V, c) attn_compute(C, V, qf, o, mrun, lsum, F.lane, g, (c) < 8, kc0, cs, bias_h + (r0 + ((c) < 8 ? (c) : 0) - r + 7) * 31, cq)
    AttnK KA, KB; AttnV VV;
    const int cbeg = is_lat ? 0 : 8;
    ATT_LOADK(KA, cbeg);
    for (int c = cbeg; c < 16; c += 2) {
        ATT_LOADV(VV, c); ATT_LOADK(KB, c + 1); __builtin_amdgcn_sched_barrier(0);
        ATT_COMP(KA, VV, c); __builtin_amdgcn_sched_barrier(0);
        ATT_LOADV(VV, c + 1); if (c + 2 < 16) ATT_LOADK(KA, c + 2);
        __builtin_amdgcn_sched_barrier(0);
        ATT_COMP(KB, VV, c + 1); __builtin_amdgcn_sched_barrier(0);
    }
#undef ATT_TOK
#undef ATT_LOADK
#undef ATT_LOADV
#undef ATT_COMP
    lsum += lane_read(lsum, F.lane ^ 16); lsum += lane_read(lsum, F.lane ^ 32);
    const float inv = 1.0f / lsum;
    GAS bf16* ap = A + (size_t)(qrow0 + q) * 1024 + h * 128 + 4 * g;
#pragma unroll
    for (int dt = 0; dt < 8; ++dt) { v2u w; w.x = pg8::cvt_pk_bf16(o[dt][0] * inv, o[dt][1] * inv); w.y = pg8::cvt_pk_bf16(o[dt][2] * inv, o[dt][3] * inv); *(GAS v2u*)(ap + 16 * dt) = w; }
}
__device__ __forceinline__ void attn_phase(Frame& F, int l, bool with_ctx) {
    LAS float* bias = (LAS float*)(F.lds + ATT_BIAS_OFF);
    const GAS float* p_rpb = IN(na_rpb) + (size_t)l * NHEAD * 465;
    for (int i = F.tid; i < NHEAD * 465; i += NTHR) bias[i] = p_rpb[i] * LOG2E;
    const GAS bf16* QK = WSP(bf16, WS_QK); const GAS bf16* VT = WSP(bf16, WS_VT);
    for (int wgi = F.vcu; wgi < 256; wgi += F.G) {
        const int bh = wgi >> 4, b = bh >> 3, h = bh & 7, sub = wgi & 15;
        __syncthreads();
#pragma unroll 4
        for (int i = F.tid; i < 256 * 16; i += NTHR) { const int row = i >> 4, pc = i & 15;
            *(LAS v4u*)(F.lds + ATT_KC_OFF + row * ATT_KC_PITCH + pc * 16) = *(const GAS v4u*)(QK + (size_t)(ML + b * CTXL + row) * 2048 + 1024 + h * 128 + 8 * pc); }
#pragma unroll 4
        for (int i = F.tid; i < 128 * 32; i += NTHR) { const int row = i >> 5, pc = i & 31;
            *(LAS v4u*)(F.lds + ATT_VC_OFF + row * ATT_VC_PITCH + pc * 16) = *(const GAS v4u*)(VT + (size_t)(h * 128 + row) * MT + ML + b * CTXL + 8 * pc); }
        __syncthreads();
        const int rb = sub * 2 + (F.wave >> 2), c0 = 16 * (F.wave & 3);
        for (int rr = 0; rr < 8; ++rr) { const int r = rb * 8 + rr; attn_tile(F, true, b, h, r, c0, b * SEQ + r * GRIDW + c0, bias + h * 465); }
        if (with_ctx) {
            if ((F.wave & 3) == 0) { const int t = sub; if ((F.wave >> 2) == (t & 1)) attn_tile(F, false, b, h, 0, 0, ML + b * CTXL + 16 * t, bias + h * 465); }
        }
    }
    __syncthreads();
}

constexpr int FFTN = 16384, FFT_PHYS = FFTN + FFTN / 16;
__device__ __forceinline__ int phys(int i) { return i + ((i >> 6) << 2); }
__device__ __forceinline__ f32x2 tw32k(const LAS f32x2* TH, const LAS f32x2* TL, int n) { return cmul(TH[n >> 7], TL[n & 127]); }
template <bool INV> __device__ __forceinline__ void r4(f32x2& x0, f32x2& x1, f32x2& x2, f32x2& x3) {
    const f32x2 a = x0 + x2, c = x0 - x2, b = x1 + x3, e = x1 - x3;
    const f32x2 d = INV ? (f32x2){-e.y, e.x} : (f32x2){e.y, -e.x};
    x0 = a + b; x1 = c + d; x2 = a - b; x3 = c - d;
}
template <bool INV> __device__ __forceinline__ void dft16(f32x2 (&x)[16]) {
#pragma unroll
    for (int b = 0; b < 4; ++b) r4<INV>(x[b], x[4 + b], x[8 + b], x[12 + b]);
    const float sg = INV ? -1.f : 1.f;
    const f32x2 W1 = {0.92387953251f, -0.38268343236f * sg}, W2 = {0.70710678118f, -0.70710678118f * sg}, W3 = {0.38268343236f, -0.92387953251f * sg},
                W4 = {0.f, -1.f * sg}, W6 = {-0.70710678118f, -0.70710678118f * sg}, W9 = {-0.92387953251f, 0.38268343236f * sg};
    x[5] = cmul(x[5], W1); x[9] = cmul(x[9], W2); x[13] = cmul(x[13], W3);
    x[6] = cmul(x[6], W2); x[10] = cmul(x[10], W4); x[14] = cmul(x[14], W6);
    x[7] = cmul(x[7], W3); x[11] = cmul(x[11], W6); x[15] = cmul(x[15], W9);
#pragma unroll
    for (int c = 0; c < 4; ++c) r4<INV>(x[4 * c], x[4 * c + 1], x[4 * c + 2], x[4 * c + 3]);
}
template <bool INV> __device__ __forceinline__ void bfly16(f32x2 (&x)[16], const LAS f32x2* TH, const LAS f32x2* TL, int tw) {
    f32x2 W = tw32k(TH, TL, tw); if (INV) W.y = -W.y;
    if (INV) { f32x2 p = W;
#pragma unroll
        for (int q = 1; q < 16; ++q) { x[q] = cmul(x[q], p); if (q < 15) p = cmul(p, W); } }
    dft16<INV>(x);
    if (!INV) { f32x2 p = W;
#pragma unroll
        for (int r = 1; r < 16; ++r) { x[4 * (r & 3) + (r >> 2)] = cmul(x[4 * (r & 3) + (r >> 2)], p); if (r < 15) p = cmul(p, W); } }
}
template <bool INV> __device__ __forceinline__ void pass16(LAS f32x2* X, const LAS f32x2* TH, const LAS f32x2* TL, int base, int stride, int tw) {
    f32x2 x[16];
#pragma unroll
    for (int q = 0; q < 16; ++q) x[q] = X[base + q * stride];
    bfly16<INV>(x, TH, TL, tw);
#pragma unroll
    for (int c = 0; c < 4; ++c)
#pragma unroll
        for (int d = 0; d < 4; ++d) X[base + (c + 4 * d) * stride] = x[4 * c + d];
}
template <bool INV> __device__ __forceinline__ void pass16_s4(LAS f32x2* X, const LAS f32x2* TH, const LAS f32x2* TL, int blk, int h) {
    LAS f32x4* P = (LAS f32x4*)(X + blk * 68 + 2 * h);
    f32x2 xa[16], xb[16];
#pragma unroll
    for (int q = 0; q < 16; ++q) { const f32x4 v = P[2 * q]; xa[q] = (f32x2){v.x, v.y}; xb[q] = (f32x2){v.z, v.w}; }
    bfly16<INV>(xa, TH, TL, (2 * h) * 512); bfly16<INV>(xb, TH, TL, (2 * h + 1) * 512);
#pragma unroll
    for (int c = 0; c < 4; ++c)
#pragma unroll
        for (int d = 0; d < 4; ++d) P[2 * (c + 4 * d)] = (f32x4){xa[4 * c + d].x, xa[4 * c + d].y, xb[4 * c + d].x, xb[4 * c + d].y};
}
template <bool INV> __device__ __forceinline__ void pass4_s1(LAS f32x2* X, int b) {
    LAS f32x4* P = (LAS f32x4*)(X + 4 * b + ((b >> 4) << 2));
    const f32x4 u = P[0], v = P[1];
    f32x2 x0 = {u.x, u.y}, x1 = {u.z, u.w}, x2 = {v.x, v.y}, x3 = {v.z, v.w};
    r4<INV>(x0, x1, x2, x3);
    P[0] = (f32x4){x0.x, x0.y, x1.x, x1.y}; P[1] = (f32x4){x2.x, x2.y, x3.x, x3.y};
}
__device__ __forceinline__ void fft_fwd(LAS f32x2* X, const LAS f32x2* TH, const LAS f32x2* TL, int tid) {
#pragma unroll 1
    for (int i = 0; i < 2; ++i) { const int j = tid + NTHR * i; pass16<false>(X, TH, TL, j + ((j >> 6) << 2), 1088, 2 * j); }
    __syncthreads();
#pragma unroll 1
    for (int i = 0; i < 2; ++i) { const int b = tid + NTHR * i, j = b & 63, blk = b >> 6; pass16<false>(X, TH, TL, blk * 1088 + j, 68, 32 * j); }
    __syncthreads();
    pass16_s4<false>(X, TH, TL, tid >> 1, tid & 1);
    __syncthreads();
#pragma unroll 2
    for (int i = 0; i < 8; ++i) pass4_s1<false>(X, tid + NTHR * i);
    __syncthreads();
}
__device__ __forceinline__ void fft_inv(LAS f32x2* X, const LAS f32x2* TH, const LAS f32x2* TL, int tid) {
#pragma unroll 2
    for (int i = 0; i < 8; ++i) pass4_s1<true>(X, tid + NTHR * i);
    __syncthreads();
    pass16_s4<true>(X, TH, TL, tid >> 1, tid & 1);
    __syncthreads();
#pragma unroll 1
    for (int i = 0; i < 2; ++i) { const int b = tid + NTHR * i, j = b & 63, blk = b >> 6; pass16<true>(X, TH, TL, blk * 1088 + j, 68, 32 * j); }
    __syncthreads();
#pragma unroll 1
    for (int i = 0; i < 2; ++i) { const int j = tid + NTHR * i; pass16<true>(X, TH, TL, j + ((j >> 6) << 2), 1088, 2 * j); }
    __syncthreads();
}
__device__ __forceinline__ int freq_pos(int k) { return phys(((k & 15) << 10) | (((k >> 4) & 15) << 6) | (((k >> 8) & 15) << 2) | (k >> 12)); }

__device__ __forceinline__ float conv3(const GAS float* p, int n, int Lq, float w0, float w1, float w2, float bb) {
    float a = p[n] * w1 + bb; if (n > 0) a += p[n - 1] * w0; if (n < Lq - 1) a += p[n + 1] * w2; return a;
}
__device__ __forceinline__ f32x4 conv3v(const GAS float* p, int n0, int Lq, float w0, float w1, float w2, float bb) {
    const f32x4 c = *(const GAS f32x4*)(p + n0); const float l = n0 > 0 ? p[n0 - 1] : 0.f, r = n0 + 4 < Lq ? p[n0 + 4] : 0.f;
    return (f32x4){w0 * l + w1 * c.x + w2 * c.y + bb, w0 * c.x + w1 * c.y + w2 * c.z + bb, w0 * c.y + w1 * c.z + w2 * c.w + bb, w0 * c.z + w1 * c.w + w2 * r + bb};
}
__device__ __forceinline__ void tw4(const LAS f32x2* TH, const LAS f32x2* TL, int n0, f32x2 (&w)[4]) {
    const f32x2 th = TH[n0 >> 7]; const LAS f32x4* tl = (const LAS f32x4*)(TL + (n0 & 127)); const f32x4 a = tl[0], b = tl[1];
    w[0] = cmul(th, (f32x2){a.x, a.y}); w[1] = cmul(th, (f32x2){a.z, a.w}); w[2] = cmul(th, (f32x2){b.x, b.y}); w[3] = cmul(th, (f32x2){b.z, b.w});
}

#define LT() ({ int lt_ = tid; asm volatile("" : "+v"(lt_)); lt_; })
__device__ __forceinline__ void hyena_latent(Frame& F, int l, int ch, LAS f32x2* X, const LAS f32x2* TH, const LAS f32x2* TL, GAS f32x2* KS) {
    GAS float* T32 = WSP(float, WS_T32);
    GAS float* hv = T32 + (size_t)(512 + ch) * MT; const GAS float* hx1 = T32 + (size_t)(1024 + ch) * MT; const GAS float* hx2 = T32 + (size_t)(1536 + ch) * MT;
    const GAS float* cw = IN(hy_conv_w) + (size_t)l * 3 * 1536; const GAS float* cb = IN(hy_conv_b) + (size_t)l * 1536;
    const GAS float* HF = WSP(float, WS_HF); const GAS float* p_hb = IN(hy_bias) + (size_t)l * 2 * HYW + ch;
    const int tid = F.tid;
    constexpr int KR = 6;
    GAS f32x4* KS4 = (GAS f32x4*)KS; GAS f32x4* KE4 = KS4 + FFTN / 2;
    f32x4 kreg[2 * KR];
    for (int o = 0; o < 2; ++o) {
        const GAS float* hf = HF + (size_t)(o * 1024 + ch) * SEQ; const GAS float* hbr = HF + (size_t)(o * 1024 + 512 + ch) * SEQ;
        const float bias = p_hb[o * HYW];
        const float vw0 = cw[ch], vw1 = cw[1536 + ch], vw2 = cw[3072 + ch], vbb = cb[ch];
        const GAS float* hx = o == 0 ? hx1 : hx2; const int xo = o == 0 ? 512 : 1024;
        const float xw0 = cw[xo + ch], xw1 = cw[1536 + xo + ch], xw2 = cw[3072 + xo + ch], xbb = cb[xo + ch];
        for (int par = 0; par < 2; ++par) {
#pragma unroll
            for (int i = 0; i < 8; ++i) { const int g = LT() + NTHR * i, n0 = 4 * g; const f32x4 f = *(const GAS f32x4*)(hf + n0), bk = *(const GAS f32x4*)(hbr + n0);
                LAS f32x4* XP = (LAS f32x4*)(X + phys(n0));
                if (par == 0) { XP[0] = (f32x4){f.x + bk.x, 0.f, f.y + bk.y, 0.f}; XP[1] = (f32x4){f.z + bk.z, 0.f, f.w + bk.w, 0.f}; }
                else { f32x2 w[4]; tw4(TH, TL, n0, w); const f32x4 d = f - bk;
                    XP[0] = (f32x4){w[0].x * d.x, w[0].y * d.x, w[1].x * d.y, w[1].y * d.y}; XP[1] = (f32x4){w[2].x * d.z, w[2].y * d.z, w[3].x * d.w, w[3].y * d.w}; } }
            __syncthreads();
            fft_fwd(X, TH, TL, tid);
#pragma unroll
            for (int i = 0; i < 8; ++i) { const int g = LT() + NTHR * i; const LAS f32x4* XP = (const LAS f32x4*)(X + phys(4 * g)); if (i < KR) { kreg[2 * i] = XP[0]; kreg[2 * i + 1] = XP[1]; } else { KS4[2 * g] = XP[0]; KS4[2 * g + 1] = XP[1]; } }
            __syncthreads();
#pragma unroll 2
            for (int i = 0; i < 8; ++i) { const int g = LT() + NTHR * i, n0 = 4 * g;
                f32x4 z0, z1; if (o == 0) { z0 = conv3v(hv, n0, SEQ, vw0, vw1, vw2, vbb); z1 = conv3v(hv + SEQ, n0, SEQ, vw0, vw1, vw2, vbb); } else { z0 = *(const GAS f32x4*)(hv + n0); z1 = *(const GAS f32x4*)(hv + SEQ + n0); }
                LAS f32x4* XP = (LAS f32x4*)(X + phys(n0));
                if (par == 0) { XP[0] = (f32x4){z0.x, z1.x, z0.y, z1.y}; XP[1] = (f32x4){z0.z, z1.z, z0.w, z1.w}; }
                else { f32x2 w[4]; tw4(TH, TL, n0, w);
                    const f32x2 a0 = cmul((f32x2){z0.x, z1.x}, w[0]), a1 = cmul((f32x2){z0.y, z1.y}, w[1]), a2 = cmul((f32x2){z0.z, z1.z}, w[2]), a3 = cmul((f32x2){z0.w, z1.w}, w[3]);
                    XP[0] = (f32x4){a0.x, a0.y, a1.x, a1.y}; XP[1] = (f32x4){a2.x, a2.y, a3.x, a3.y}; } }
            __syncthreads();
#if defined(PROBE_FFTCORE)
            fft_fwd(X, TH, TL, tid); fft_inv(X, TH, TL, tid);
            for (int i = 0; i < 8; ++i) { const int g = LT() + NTHR * i; LAS f32x4* XP = (LAS f32x4*)(X + phys(4 * g)); XP[0] = XP[0] * (1.0f / 16384.0f); XP[1] = XP[1] * (1.0f / 16384.0f); }
            __syncthreads();
#endif
            fft_fwd(X, TH, TL, tid);
#pragma unroll
            for (int i = 0; i < 8; ++i) { const int g = LT() + NTHR * i; LAS f32x4* XP = (LAS f32x4*)(X + phys(4 * g)); f32x4 k0, k1; if (i < KR) { k0 = kreg[2 * i]; k1 = kreg[2 * i + 1]; } else { k0 = KS4[2 * g]; k1 = KS4[2 * g + 1]; } const f32x4 u0 = XP[0], u1 = XP[1];
                const f32x2 a0 = cmul((f32x2){u0.x, u0.y}, (f32x2){k0.x, k0.y}), a1 = cmul((f32x2){u0.z, u0.w}, (f32x2){k0.z, k0.w}), a2 = cmul((f32x2){u1.x, u1.y}, (f32x2){k1.x, k1.y}), a3 = cmul((f32x2){u1.z, u1.w}, (f32x2){k1.z, k1.w});
                XP[0] = (f32x4){a0.x, a0.y, a1.x, a1.y}; XP[1] = (f32x4){a2.x, a2.y, a3.x, a3.y};
                if (i & 1) asm volatile("" ::: "memory"); }
            __syncthreads();
            fft_inv(X, TH, TL, tid);
            if (par == 0) {
#pragma unroll
                for (int i = 0; i < 8; ++i) { const int g = LT() + NTHR * i; const LAS f32x4* XP = (const LAS f32x4*)(X + phys(4 * g)); KE4[2 * g] = XP[0]; KE4[2 * g + 1] = XP[1]; }
                __syncthreads();
            }
        }
#pragma unroll 4
        for (int i = 0; i < 8; ++i) { const int g = LT() + NTHR * i, n0 = 4 * g;
            f32x4 z0, z1; if (o == 0) { z0 = conv3v(hv, n0, SEQ, vw0, vw1, vw2, vbb); z1 = conv3v(hv + SEQ, n0, SEQ, vw0, vw1, vw2, vbb); } else { z0 = *(const GAS f32x4*)(hv + n0); z1 = *(const GAS f32x4*)(hv + SEQ + n0); }
            const f32x4 g0 = conv3v(hx, n0, SEQ, xw0, xw1, xw2, xbb), g1 = conv3v(hx + SEQ, n0, SEQ, xw0, xw1, xw2, xbb);
            const f32x4 e0 = KE4[2 * g], e1 = KE4[2 * g + 1];
            LAS f32x4* XP = (LAS f32x4*)(X + phys(n0)); const f32x4 u0 = XP[0], u1 = XP[1];
            f32x2 w[4]; tw4(TH, TL, n0, w);
            const f32x2 c0 = cmul((f32x2){u0.x, u0.y}, cconj(w[0])), c1 = cmul((f32x2){u0.z, u0.w}, cconj(w[1])), c2 = cmul((f32x2){u1.x, u1.y}, cconj(w[2])), c3 = cmul((f32x2){u1.z, u1.w}, cconj(w[3]));
            const float sc = 1.0f / 32768.0f;
            const f32x2 y0 = ((f32x2){e0.x, e0.y} + c0) * sc + (f32x2){z0.x, z1.x} * bias, y1 = ((f32x2){e0.z, e0.w} + c1) * sc + (f32x2){z0.y, z1.y} * bias,
                        y2 = ((f32x2){e1.x, e1.y} + c2) * sc + (f32x2){z0.z, z1.z} * bias, y3 = ((f32x2){e1.z, e1.w} + c3) * sc + (f32x2){z0.w, z1.w} * bias;
            XP[0] = (f32x4){g0.x * y0.x, g0.y * y1.x, g0.z * y2.x, g0.w * y3.x};
            XP[1] = (f32x4){g1.x * y0.y, g1.y * y1.y, g1.z * y2.y, g1.w * y3.y}; }
        __syncthreads();
#pragma unroll
        for (int i = 0; i < 8; ++i) { const int g = LT() + NTHR * i, n0 = 4 * g; const LAS f32x4* XP = (const LAS f32x4*)(X + phys(n0)); *(GAS f32x4*)(hv + n0) = XP[0]; *(GAS f32x4*)(hv + SEQ + n0) = XP[1]; }
        __syncthreads();
    }
}
__device__ __forceinline__ void fourier_latent(Frame& F, int b, int gq, int m, LAS f32x2* X, const LAS f32x2* TH, const LAS f32x2* TL) {
    GAS float* T32 = WSP(float, WS_T32);
    GAS float* ra = T32 + (size_t)(gq * 128 + m) * MT + b * SEQ; GAS float* rb = T32 + (size_t)(gq * 128 + 64 + m) * MT + b * SEQ;
    const int tid = F.tid;
#pragma unroll
    for (int i = 0; i < 8; ++i) { const int g = LT() + NTHR * i, n0 = 4 * g; const f32x4 a = *(const GAS f32x4*)(ra + n0), c = *(const GAS f32x4*)(rb + n0);
        LAS f32x4* XP = (LAS f32x4*)(X + phys(n0)); XP[0] = (f32x4){a.x, c.x, a.y, c.y}; XP[1] = (f32x4){a.z, c.z, a.w, c.w}; }
    __syncthreads();
    fft_fwd(X, TH, TL, tid);
    const float sc = 6.9053396600248786e-4f;
#pragma unroll 2
    for (int i = 0; i < 8; ++i) { const int g = LT() + NTHR * i, k0 = 4 * g; f32x4 oa, ob;
#pragma unroll
        for (int e = 0; e < 4; ++e) { const int k = k0 + e; const f32x2 u = X[freq_pos(k)], v = X[freq_pos((FFTN - k) & (FFTN - 1))];
            if (m != 0) { oa[e] = u.x * sc; ob[e] = v.x * sc; } else { oa[e] = (u.x + v.x) * (0.5f * sc); ob[e] = (u.y + v.y) * (0.5f * sc); } }
        *(GAS f32x4*)(ra + k0) = oa; *(GAS f32x4*)(rb + k0) = ob; }
    __syncthreads();
}
__device__ __forceinline__ void hyena_ctx(Frame& F, int l, int ch, LAS float* S) {
    GAS float* T32 = WSP(float, WS_T32);
    GAS float* hv = T32 + (size_t)(512 + ch) * MT + ML; const GAS float* hx1 = T32 + (size_t)(1024 + ch) * MT + ML; const GAS float* hx2 = T32 + (size_t)(1536 + ch) * MT + ML;
    const GAS float* cw = IN(hy_conv_w) + (size_t)l * 3 * 1536; const GAS float* cb = IN(hy_conv_b) + (size_t)l * 1536;
    const GAS float* HFC = WSP(float, WS_HFC); const GAS float* p_hb = IN(hy_bias) + (size_t)l * 2 * HYW + ch;
    LAS float* zb = S; LAS float* hfl = S + 512; LAS float* hbl = S + 768;
    const int n = F.tid & 255, b = F.tid >> 8;
    __syncthreads();
    zb[b * 256 + n] = conv3(hv + b * CTXL, n, CTXL, cw[ch], cw[1536 + ch], cw[3072 + ch], cb[ch]);
    for (int o = 0; o < 2; ++o) {
        if (F.tid < 256) hfl[n] = HFC[(size_t)(o * 1024 + ch) * CTXL + n]; else hbl[n] = HFC[(size_t)(o * 1024 + 512 + ch) * CTXL + n];
        __syncthreads();
        float y = 0.f;
        for (int mI = 0; mI < CTXL; ++mI) { const int d = n - mI; y += zb[b * 256 + mI] * (d >= 0 ? hfl[d] : hbl[CTXL + d]); }
        y += p_hb[o * HYW] * zb[b * 256 + n];
        const GAS float* hx = o == 0 ? hx1 : hx2; const int xo = o == 0 ? 512 : 1024;
        const float r = conv3(hx + b * CTXL, n, CTXL, cw[xo + ch], cw[1536 + xo + ch], cw[3072 + xo + ch], cb[xo + ch]) * y;
        __syncthreads();
        if (o == 0) zb[b * 256 + n] = r; else hv[b * CTXL + n] = r;
        __syncthreads();
    }
}
__device__ __forceinline__ void fourier_ctx(Frame& F, int item, LAS float* S) {
    GAS float* T32 = WSP(float, WS_T32);
    const int b = item >> 5, gq = (item >> 3) & 3, m0 = (item & 7) * 8;
    LAS float* cs = S; LAS float* re = S + 256; LAS float* im = S + 256 + 2048;
    __syncthreads();
    if (F.tid < 256) cs[F.tid] = cospif((float)F.tid * (1.0f / 128.0f));
    for (int i = F.tid; i < 8 * 256; i += NTHR) { const int mm = i >> 8, n = i & 255;
        re[i] = T32[(size_t)(gq * 128 + m0 + mm) * MT + ML + b * CTXL + n]; im[i] = T32[(size_t)(gq * 128 + 64 + m0 + mm) * MT + ML + b * CTXL + n]; }
    __syncthreads();
    const int k = F.tid & 255, mh = F.tid >> 8;
    const float sc = 5.5242717280199031e-3f;
    for (int mq = 0; mq < 4; ++mq) { const int mm = mh * 4 + mq, m = m0 + mm;
        float cr = 0.f, ci = 0.f, sr = 0.f, si = 0.f;
        for (int n = 0; n < 256; ++n) { const int ix = (k * n) & 255; const float c = cs[ix], sn = cs[(ix - 64) & 255]; const float a = re[mm * 256 + n], bq = im[mm * 256 + n];
            cr += a * c; ci += bq * c; sr += a * sn; si += bq * sn; }
        float oa, ob;
        if (m != 0) { oa = cr + si; ob = cr - si; } else { oa = cr; ob = ci; }
        T32[(size_t)(gq * 128 + m) * MT + ML + b * CTXL + k] = oa * sc; T32[(size_t)(gq * 128 + 64 + m) * MT + ML + b * CTXL + k] = ob * sc; }
    __syncthreads();
}
__device__ __forceinline__ void fft_phase(Frame& F, int l, bool with_ctx) {
    LAS f32x2* X = (LAS f32x2*)F.lds;
    LAS f32x2* TH = (LAS f32x2*)(F.lds + TW_OFF); LAS f32x2* TL = TH + 128;
    if (F.tid < 256) { const int a = F.tid & 127; const float fr = F.tid < 128 ? (float)(128 * a) * (1.0f / 16384.0f) : (float)a * (1.0f / 16384.0f);
        float sn, cn; sincospif(fr, &sn, &cn); (F.tid < 128 ? TH : TL)[a] = (f32x2){cn, -sn}; }
    __syncthreads();
    for (int ch = F.vcu; ch < HYW; ch += F.G) hyena_latent(F, l, ch, X, TH, TL, WSP(f32x2, WS_KS) + (size_t)F.vcu * 2 * FFTN);
    for (int fu = F.vcu; fu < 512; fu += F.G) fourier_latent(F, fu >> 8, (fu >> 6) & 3, fu & 63, X, TH, TL);
    if (with_ctx) {
        LAS float* S = (LAS float*)F.lds;
        for (int ch = F.vcu; ch < HYW; ch += F.G) hyena_ctx(F, l, ch, S);
        for (int it = F.vcu; it < 64; it += F.G) fourier_ctx(F, it, S);
    }
}

__device__ __forceinline__ void merge_phase(Frame& F, int l, bool with_ctx) {
    const GAS bf16* A = WSP(bf16, WS_A); const GAS float* T32 = WSP(float, WS_T32); GAS bf16* H = WSP(bf16, WS_H);
    const GAS float* gain = IN(mix_norm_g) + (size_t)l * DM;
    LAS float* tile = (LAS float*)F.lds;
    const int TI = with_ctx ? 65 : 64;
    for (int it = F.vcu; it < 512; it += F.G) {
        const int tok0 = it * TI;
        for (int tk = F.wave; tk < TI; tk += NWAVES) {
            const size_t row = (size_t)(tok0 + tk);
            const v4u r0 = *(const GAS v4u*)(A + row * 1024 + 8 * F.lane), r1 = *(const GAS v4u*)(A + row * 1024 + 512 + 8 * F.lane);
            float v[16];
            v[0] = bf2f(r0.x & 0xffff); v[1] = bf2f(r0.x >> 16); v[2] = bf2f(r0.y & 0xffff); v[3] = bf2f(r0.y >> 16); v[4] = bf2f(r0.z & 0xffff); v[5] = bf2f(r0.z >> 16); v[6] = bf2f(r0.w & 0xffff); v[7] = bf2f(r0.w >> 16);
            v[8] = bf2f(r1.x & 0xffff); v[9] = bf2f(r1.x >> 16); v[10] = bf2f(r1.y & 0xffff); v[11] = bf2f(r1.y >> 16); v[12] = bf2f(r1.z & 0xffff); v[13] = bf2f(r1.z >> 16); v[14] = bf2f(r1.w & 0xffff); v[15] = bf2f(r1.w >> 16);
            float ss = 0.f;
#pragma unroll
            for (int j = 0; j < 16; ++j) ss += v[j] * v[j];
            const float rstd = 1.0f / sqrtf(wave_sum(ss, F.lane) * (1.0f / NAW) + EPS);
            const f32x4 g0 = *(const GAS f32x4*)(gain + 8 * F.lane), g1 = *(const GAS f32x4*)(gain + 8 * F.lane + 4), g2 = *(const GAS f32x4*)(gain + 512 + 8 * F.lane), g3 = *(const GAS f32x4*)(gain + 512 + 8 * F.lane + 4);
            v4u o0, o1;
            o0.x = pk2(v[0] * rstd * g0.x, v[1] * rstd * g0.y); o0.y = pk2(v[2] * rstd * g0.z, v[3] * rstd * g0.w); o0.z = pk2(v[4] * rstd * g1.x, v[5] * rstd * g1.y); o0.w = pk2(v[6] * rstd * g1.z, v[7] * rstd * g1.w);
            o1.x = pk2(v[8] * rstd * g2.x, v[9] * rstd * g2.y); o1.y = pk2(v[10] * rstd * g2.z, v[11] * rstd * g2.w); o1.z = pk2(v[12] * rstd * g3.x, v[13] * rstd * g3.y); o1.w = pk2(v[14] * rstd * g3.z, v[15] * rstd * g3.w);
            *(GAS v4u*)(H + row * DM + 8 * F.lane) = o0; *(GAS v4u*)(H + row * DM + 512 + 8 * F.lane) = o1;
        }
        for (int grp = 0; grp < 2; ++grp) {
            __syncthreads();
            for (int c8 = F.wave * 64; c8 < F.wave * 64 + 64; c8 += 8) {
                float v[8], w[8];
#pragma unroll
                for (int u = 0; u < 8; ++u) { const GAS float* src = T32 + (size_t)(grp * 512 + c8 + u) * MT + tok0; v[u] = src[F.lane]; w[u] = (TI > 64 && F.lane == 0) ? src[64] : 0.f; }
#pragma unroll
                for (int u = 0; u < 8; ++u) { tile[(c8 + u) * 65 + F.lane] = v[u]; if (TI > 64 && F.lane == 0) tile[(c8 + u) * 65 + 64] = w[u]; }
            }
            __syncthreads();
            for (int tk = F.wave; tk < TI; tk += NWAVES) {
                float vv[8]; float ss = 0.f;
#pragma unroll
                for (int i = 0; i < 8; ++i) { const int chn = F.lane + 64 * i; int srow = chn;
                    if (grp == 0) { const int cc = chn & 127; srow = (chn & ~127) + (cc <= 64 ? cc : 192 - cc); }
                    vv[i] = tile[srow * 65 + tk]; ss += vv[i] * vv[i]; }
                const float rstd = 1.0f / sqrtf(wave_sum(ss, F.lane) * (1.0f / 512.0f) + EPS);
                GAS bf16* hp = H + (size_t)(tok0 + tk) * DM + NAW + grp * 512;
#pragma unroll
                for (int i = 0; i < 8; ++i) { const int chn = F.lane + 64 * i; hp[chn] = (bf16)f2bf(vv[i] * rstd * gain[NAW + grp * 512 + chn]); }
            }
        }
    }
}

#define REFRESH(F) do { int t_ = threadIdx.x; asm volatile("" : "+v"(t_)); F.tid = t_; F.lane = t_ & 63; F.wave = __builtin_amdgcn_readfirstlane(t_ >> 6); \
    GAS unsigned char* w_ = args.ws; asm volatile("" : "+s"(w_)); F.ws = w_; GAS float* o_ = args.out; asm volatile("" : "+s"(o_)); F.out = o_; } while (0)
#ifndef REP_P1
#define REP_P1 1
#endif
#ifndef REP_P6
#define REP_P6 1
#endif
#ifndef REP_ATT
#define REP_ATT 1
#endif
#ifndef REP_PA
#define REP_PA 1
#endif
#ifndef REP_THIN
#define REP_THIN 1
#endif
__device__ __forceinline__ int opaque_int(int v) { asm volatile("" : "+s"(v)); return v; }
__global__ void __launch_bounds__(NTHR, 2) fwd_kernel(Args args) {
    extern __shared__ __attribute__((aligned(16))) unsigned char lds[];
    Frame F;
    F.lds = (LAS unsigned char*)lds;
    F.tid = threadIdx.x; F.lane = F.tid & 63; F.wave = __builtin_amdgcn_readfirstlane(F.tid >> 6);
    F.G = gridDim.x; { const int bx = blockIdx.x; F.vcu = (F.G % 8 == 0) ? (bx % 8) * (F.G / 8) + bx / 8 : bx; }
    F.ws = args.ws; F.out = args.out;
    volatile LAS unsigned* MISC = (volatile LAS unsigned*)(F.lds + MISC_OFF);
    for (int u = F.tid; u < 64; u += NTHR) MISC[u] = 0u;
    __syncthreads();
    XcdBarrier bar = xcd_barrier_post((unsigned*)(F.ws + WS_CTL) + CW_BAR, MISC + 8);
    LAS unsigned char* ring = F.lds;
#define GRID_BAR() do { unsigned* bp_ = bar.bar; unsigned bx_ = bar.x; asm volatile("" : "+s"(bp_), "+s"(bx_)); XcdBarrier b_ = bar; b_.bar = bp_; b_.x = bx_; xcd_barrier(b_); } while (0)


#if !defined(OFF_PA)
    for (int rep = 0, nrep = opaque_int(REP_PA); rep < nrep; ++rep) { REFRESH(F); pa_adaln(F); __syncthreads(); pa_weights(F); __syncthreads(); pa_ctx_copy(F); }
#endif

    GRID_BAR();

    for (int l = 0; l < DEPTH; ++l) {
        const bool uc = l < DEPTH - 1;
        const int npm = uc ? PMT : PML;
        const GAS float* MODL = WSP(float, WS_MOD) + (size_t)l * 3 * (NMOD * DM);

#if !defined(OFF_P0)
        for (int rep = 0, nrep = opaque_int(REP_THIN); rep < nrep; ++rep) { REFRESH(F); norm_phase(F, l, 0, true, l > 0 ? 4 : 0); __syncthreads();
 REFRESH(F); filter_phase(F, l, uc); __syncthreads(); }
#endif

        GRID_BAR();
        {
            const char* Hb = (const char*)WSP(bf16, WS_H); const char* Wb = (const char*)(WSP(bf16, WS_WIN) + (size_t)l * DIN * DM);
            pg8::Sched2 S; S.n1 = PMT * 8; S.nM1 = PMT; S.nN1 = 8; S.n2 = 12 * PMT; S.nM2 = 12; S.nN2 = PMT; S.G = F.G; S.c = (int)blockIdx.x;
            S.A1 = Hb; S.B1 = Wb; S.A2 = Wb + (size_t)2048 * DM * 2; S.B2 = Hb; S.tstep = (size_t)256 * DM * 2;
            EpiIn E{WSP(bf16, WS_QK), WSP(bf16, WS_VT), WSP(float, WS_T32)};

#if !defined(OFF_P1)
            for (int rep = 0, nrep = opaque_int(REP_P1); rep < nrep; ++rep) { pg8::gemm_phase<EpiIn, pg8::Sched2, true, true>(ring, DM, DM, S, E); __syncthreads(); }
#endif

        }
        GRID_BAR();

#if !defined(OFF_ATT)
        for (int rep = 0, nrep = opaque_int(REP_ATT); rep < nrep; ++rep) { REFRESH(F); attn_phase(F, l, uc); }
#endif
#if !defined(OFF_FFT)
        REFRESH(F); fft_phase(F, l, uc);
#endif

        GRID_BAR();

#if !defined(OFF_P3)
        for (int rep = 0, nrep = opaque_int(REP_THIN); rep < nrep; ++rep) { REFRESH(F); merge_phase(F, l, uc); __syncthreads(); }
#endif

        GRID_BAR();
        {
            pg8::Sched2 S; S.n1 = PML * 8; S.nM1 = PML; S.nN1 = 8; S.n2 = 0; S.nM2 = 1; S.nN2 = 1; S.G = F.G; S.c = (int)blockIdx.x;
            S.A1 = (const char*)WSP(bf16, WS_H); S.B1 = (const char*)(WSP(bf16, WS_WOUT) + (size_t)l * DM * DM); S.A2 = S.A1; S.B2 = S.B1; S.tstep = (size_t)256 * DM * 2;
            EpiRes E{l == 0 ? IN(x) : F.out, WSP(float, WS_XC), F.out, WSP(float, WS_XC), MODL + 2 * DM};
#if !defined(OFF_P4)
            pg8::gemm_phase<EpiRes, pg8::Sched2, true, true>(ring, DM, DM, S, E);
#endif
            if (uc) {
                __syncthreads();
                pg8::SchedK SK; SK.nsub = 16 * 4; SK.nN = 8; SK.ksplit = 4; SK.pm0 = PML; SK.G = F.G; SK.c = (int)blockIdx.x; SK.A = S.A1; SK.B = S.B1; SK.tstep = S.tstep; SK.kbytes = 512 * 2;
                EpiSlab EA{WSP(float, WS_SLAB), MODL + 2 * DM};
#if !defined(OFF_P4)
                pg8::gemm_phase<EpiSlab, pg8::SchedK, true, true>(ring, DM, 512, SK, EA);
#endif
            }
        }
        GRID_BAR();

#if !defined(OFF_P5)
        for (int rep = 0, nrep = opaque_int(REP_THIN); rep < nrep; ++rep) { REFRESH(F); norm_phase(F, l, 1, uc, 4); }
#endif

        GRID_BAR();
        {
            pg8::Sched2 S; S.n1 = npm * 44; S.nM1 = npm; S.nN1 = 44; S.n2 = 0; S.nM2 = 1; S.nN2 = 1; S.G = F.G; S.c = (int)blockIdx.x;
            S.A1 = (const char*)WSP(bf16, WS_H); S.B1 = (const char*)(WSP(bf16, WS_WUP) + (size_t)l * 2 * DFF * DM); S.A2 = S.A1; S.B2 = S.B1; S.tstep = (size_t)256 * DM * 2;
            GAS float* EG = WSP(float, WS_EDGE);
            EpiUp E{WSP(bf16, WS_HID), EG, EG + EDGE_ELEMS, EG + 2 * EDGE_ELEMS, IN(ffn_conv_w) + (size_t)l * 3 * DFF, IN(ffn_conv_b) + (size_t)l * DFF};

#if !defined(OFF_P6)
            for (int rep = 0, nrep = opaque_int(REP_P6); rep < nrep; ++rep) { pg8::gemm_phase<EpiUp, pg8::Sched2, true, true>(ring, DM, DM, S, E); __syncthreads(); }
#endif

        }
        GRID_BAR();

#if !defined(OFF_P6B)
        for (int rep = 0, nrep = opaque_int(REP_THIN); rep < nrep; ++rep) { REFRESH(F); edge_fix_phase(F, l, uc); }
#endif

        GRID_BAR();
        {
            pg8::Sched2 S; S.n1 = PML * 8; S.nM1 = PML; S.nN1 = 8; S.n2 = 0; S.nM2 = 1; S.nN2 = 1; S.G = F.G; S.c = (int)blockIdx.x;
            S.A1 = (const char*)WSP(bf16, WS_HID); S.B1 = (const char*)(WSP(bf16, WS_WDN) + (size_t)l * DM * DFF); S.A2 = S.A1; S.B2 = S.B1; S.tstep = (size_t)256 * DFF * 2;
            EpiRes E{F.out, WSP(float, WS_XC), F.out, WSP(float, WS_XC), MODL + 5 * DM};
#if !defined(OFF_P7)
            pg8::gemm_phase<EpiRes, pg8::Sched2, true, true>(ring, DFF, DFF, S, E);
#endif
            if (uc) {
                __syncthreads();
                pg8::SchedK SK; SK.nsub = 16 * 4; SK.nN = 8; SK.ksplit = 4; SK.pm0 = PML; SK.G = F.G; SK.c = (int)blockIdx.x; SK.A = S.A1; SK.B = S.B1; SK.tstep = S.tstep; SK.kbytes = 1408 * 2;
                EpiSlab EA{WSP(float, WS_SLAB), MODL + 5 * DM};
#if !defined(OFF_P7)
                pg8::gemm_phase<EpiSlab, pg8::SchedK, true, true>(ring, DFF, 1408, SK, EA);
#endif
            }
        }
        GRID_BAR();
    }
    REFRESH(F); final_norm_phase(F);
}

extern "C" void kernel_launch(void* const* d_in, const int* in_sizes, int n_in, void* d_out, int out_size, void* d_ws, size_t ws_size, hipStream_t stream) {
    static int grid = 0;
    if (grid == 0) {
        if (n_in != 26 || in_sizes[0] != ML * DM || out_size != ML * DM || ws_size < WS_END) { fprintf(stderr, "kernel_launch: unexpected shapes (n_in %d, in0 %d, out %d, ws %zu < %zu)\n", n_in, n_in > 0 ? in_sizes[0] : -1, out_size, ws_size, (size_t)WS_END); grid = -1; return; }
        int dev = 0, cus = 0, per_cu = 0;
        if (hipGetDevice(&dev) != hipSuccess || hipDeviceGetAttribute(&cus, hipDeviceAttributeMultiprocessorCount, dev) != hipSuccess) { grid = -1; return; }
        if (hipFuncSetAttribute((const void*)fwd_kernel, hipFuncAttributeMaxDynamicSharedMemorySize, LDS_BYTES) != hipSuccess) { fprintf(stderr, "kernel_launch: hipFuncSetAttribute failed\n"); grid = -1; return; }
        if (hipOccupancyMaxActiveBlocksPerMultiprocessor(&per_cu, (const void*)fwd_kernel, NTHR, LDS_BYTES) != hipSuccess || per_cu < 1) { fprintf(stderr, "kernel_launch: occupancy query reports %d\n", per_cu); }
        (void)hipGetLastError();
        grid = cus;
    }
    if (grid < 0) return;
    if (hipMemsetAsync((char*)d_ws + WS_CTL, 0, CTL_ZERO_BYTES, stream) != hipSuccess) return;
    Args a{};
    for (int i = 0; i < 26; ++i) a.in[i] = (const GAS float*)d_in[i];
    a.out = (GAS float*)d_out; a.ws = (GAS unsigned char*)d_ws;
    hipLaunchKernelGGL(fwd_kernel, dim3(grid), dim3(NTHR), LDS_BYTES, stream, a);
}
```

```cpp
#include <hip/hip_runtime.h>
#include <cstdio>
#include <cstdint>
namespace pg8 {
#define PG8_LAS __attribute__((address_space(3)))
typedef unsigned short bf16_t;
typedef short bf16x8 __attribute__((ext_vector_type(8)));
typedef float f32x4 __attribute__((ext_vector_type(4)));
typedef unsigned u32x4 __attribute__((ext_vector_type(4)));
constexpr int BM = 256, BK = 64, HALF = 128, HTB = HALF * BK * 2  , STAGE_BYTES = 8 * HTB, NXCD = 8, WGM = 8;

__host__ __device__ __forceinline__ int lds_byte(int r, int c) { const int st = (r >> 4) * 2 + (c >> 5), rr = r & 15, cc = c & 31, ob = rr * 64 + cc * 2; return st * 1024 + (ob ^ (((ob >> 9) & 1) << 5)); }
__host__ __device__ __forceinline__ void stage_rc(int b, int& R, int& C) { const int st = b / 1024, sb = b % 1024, swz = sb ^ (((sb >> 9) & 1) << 5); R = (st >> 1) * 16 + swz / 64; C = (st & 1) * 32 + (swz % 64) / 2; }
__host__ __device__ __forceinline__ int perm32(int rho) { const int n = rho >> 4, i = rho & 15; return 8 * (i >> 2) + 4 * n + (i & 3); }

struct Unit { int pm, pn, type; };

__device__ __forceinline__ void map_unit(int w, int nwg, int nM, int nN, Unit& u) {
    { const int q = nwg / NXCD, r = nwg % NXCD, xcd = w % NXCD, off = w / NXCD; w = (xcd < r ? xcd * (q + 1) : r * (q + 1) + (xcd - r) * q) + off; }
    const int nig = WGM * nN, gid = w / nig, fm = gid * WGM, gsz = (nM - fm) < WGM ? (nM - fm) : WGM;
    u.pm = fm + ((w % nig) % gsz); u.pn = (w % nig) / gsz;
}
struct Sched2 {
    int n1, nM1, nN1, n2, nM2, nN2, G, c; const char *A1, *B1, *A2, *B2; size_t tstep;
    __device__ __forceinline__ bool next(int i, Unit& u) const {
        const long L = (long)i * G + c;
        if (L < n1) { map_unit((int)L, n1, nM1, nN1, u); u.type = 0; return true; }
        if (L < n1 + n2) { map_unit((int)L - n1, n2, nM2, nN2, u); u.type = 1; return true; }
        return false;
    }
    __device__ __forceinline__ const char* a_ptr(const Unit& u) const { return (u.type ? A2 : A1) + (size_t)u.pm * tstep; }
    __device__ __forceinline__ const char* b_ptr(const Unit& u) const { return (u.type ? B2 : B1) + (size_t)u.pn * tstep; }
    __device__ __forceinline__ void a_ready(const Unit&) const {}
    __device__ __forceinline__ void done(const Unit&) const {}
};

struct SchedK {
    int nsub, nN, ksplit, pm0, G, c; const char *A, *B; size_t tstep, kbytes;
    __device__ __forceinline__ bool next(int i, Unit& u) const {
        const long L = (long)i * G + c; if (L >= nsub) return false;
        const int j = (int)L / ksplit; u.type = (int)L % ksplit; u.pm = pm0 + j / nN; u.pn = j % nN; return true;
    }
    __device__ __forceinline__ const char* a_ptr(const Unit& u) const { return A + (size_t)u.pm * tstep + (size_t)u.type * kbytes; }
    __device__ __forceinline__ const char* b_ptr(const Unit& u) const { return B + (size_t)u.pn * tstep + (size_t)u.type * kbytes; }
    __device__ __forceinline__ void a_ready(const Unit&) const {}
    __device__ __forceinline__ void done(const Unit&) const {}
};

__device__ __forceinline__ unsigned cvt_pk_bf16(float lo, float hi) { unsigned r; asm volatile("v_cvt_pk_bf16_f32 %0, %1, %2" : "=v"(r) : "v"(lo), "v"(hi)); return r; }
typedef float f32x2 __attribute__((ext_vector_type(2)));

template <class Epi, class Sched, bool ALIGN_EPI = false, bool SP2 = false>
__device__ __forceinline__ void gemm_phase(PG8_LAS unsigned char* lds, const int Kdim  , const int Klen  , const Sched& S, const Epi& E) {
    int tid_ = threadIdx.x; asm volatile("" : "+v"(tid_));
    const int tid = tid_, wid = __builtin_amdgcn_readfirstlane(tid >> 6), lane = tid & 63, wr = wid >> 2, wc = wid & 3, fr = lane & 15, fq = lane >> 4;
    const int K = Kdim, nt = Klen / BK;
    unsigned voffA[2], voffB[2];
#pragma unroll
    for (int i = 0; i < 2; ++i) { int R, C; stage_rc(tid * 16 + i * 8192, R, C); const int Rb = Epi::PERM ? ((R & ~31) + perm32(R & 31)) : R;
        voffA[i] = (unsigned)(R * K + C) * 2u; voffB[i] = (unsigned)(Rb * K + C) * 2u; }
    const size_t kstep = (size_t)(BK * 2);
    const size_t hstep = (size_t)HALF * K * 2;
    const size_t tstep = 2 * hstep;
    const unsigned ldsw = (unsigned)wid * 1024u;
    const int aoff = lds_byte(wr * 64 + fr, fq * 8), boff = lds_byte(wc * 32 + fr, fq * 8);
#define PG8_SA(b, h) (((b) * 2 + (h)) * HTB)
#define PG8_SB(b, h) ((4 + (b) * 2 + (h)) * HTB)
#define PG8_STAGE(bufoff, gbase, voff) do { _Pragma("unroll") for (int _i = 0; _i < 2; ++_i) \
        __builtin_amdgcn_global_load_lds((const unsigned*)((const char*)(gbase) + (voff)[_i]), (PG8_LAS unsigned*)(lds + (bufoff) + ldsw + _i * 8192), 16, 0, 0); } while (0)
#define PG8_LDA(dst, b, h) do { _Pragma("unroll") for (int m = 0; m < 4; ++m) _Pragma("unroll") for (int k = 0; k < 2; ++k) dst[m][k] = *(const PG8_LAS bf16x8*)(lds + PG8_SA(b, h) + aoff + m * 2048 + k * 1024); } while (0)
#define PG8_LDB(dst, b, h) do { _Pragma("unroll") for (int n = 0; n < 2; ++n) _Pragma("unroll") for (int k = 0; k < 2; ++k) dst[n][k] = *(const PG8_LAS bf16x8*)(lds + PG8_SB(b, h) + boff + n * 2048 + k * 1024); } while (0)
#define PG8_MMA(ai, bj, At, Bt) do { __builtin_amdgcn_s_setprio(1); _Pragma("unroll") for (int m = 0; m < 4; ++m) _Pragma("unroll") for (int n = 0; n < 2; ++n) _Pragma("unroll") for (int k = 0; k < 2; ++k) \
        acc[ai][bj][m][n] = __builtin_amdgcn_mfma_f32_16x16x32_bf16(Bt[n][k], At[m][k], acc[ai][bj][m][n], 0, 0, 0); __builtin_amdgcn_s_setprio(0); } while (0)
#define PG8_WAIT_V(n) asm volatile("s_waitcnt vmcnt(" #n ")" ::: "memory")
#define PG8_WAIT_L(n) asm volatile("s_waitcnt lgkmcnt(" #n ")" ::: "memory")
#define PG8_BAR __builtin_amdgcn_s_barrier()
#define PG8_SCHED __builtin_amdgcn_sched_barrier(0)
    Unit cur, nxt; int ui = 0;
    if (!S.next(0, cur)) return;
    f32x4 acc[2][2][4][2];
#pragma unroll
    for (int a = 0; a < 2; ++a)
#pragma unroll
        for (int b = 0; b < 2; ++b)
#pragma unroll
            for (int m = 0; m < 4; ++m)
#pragma unroll
                for (int n = 0; n < 2; ++n) acc[a][b][m][n] = (f32x4){0.f, 0.f, 0.f, 0.f};
    bf16x8 At[4][2], B0[2][2], B1[2][2];
    const char* cA = S.a_ptr(cur); const char* cB = S.b_ptr(cur);
    S.a_ready(cur);
    if constexpr (SP2) {
        PG8_STAGE(PG8_SB(0, 0), cB, voffB); PG8_STAGE(PG8_SB(0, 1), cB + hstep, voffB); PG8_STAGE(PG8_SA(0, 0), cA, voffA); PG8_STAGE(PG8_SA(0, 1), cA + hstep, voffA);
        if (wr == 1) PG8_BAR;
        PG8_WAIT_V(2); PG8_BAR;
        PG8_STAGE(PG8_SB(1, 0), cB + kstep, voffB); PG8_STAGE(PG8_SA(1, 0), cA + kstep, voffA); PG8_STAGE(PG8_SB(1, 1), cB + hstep + kstep, voffB);
        PG8_WAIT_V(6); PG8_BAR;
    } else {
        PG8_STAGE(PG8_SB(0, 0), cB, voffB); PG8_STAGE(PG8_SA(0, 0), cA, voffA); PG8_STAGE(PG8_SB(0, 1), cB + hstep, voffB); PG8_STAGE(PG8_SA(0, 1), cA + hstep, voffA);
        if (wr == 1) PG8_BAR;
        PG8_WAIT_V(4); PG8_BAR;
        PG8_STAGE(PG8_SB(1, 0), cB + kstep, voffB); PG8_STAGE(PG8_SA(1, 0), cA + kstep, voffA); PG8_STAGE(PG8_SB(1, 1), cB + hstep + kstep, voffB);
        PG8_WAIT_V(6); PG8_BAR;
    }
    for (;;) {
        const bool has_next = S.next(ui + 1, nxt);
        const char* nA = has_next ? S.a_ptr(nxt) : cA; const char* nB = has_next ? S.b_ptr(nxt) : cB;
        for (int t = 0; t < nt; t += 2) {
            const bool last = (t == nt - 2);
            const char* a1 = cA + (size_t)(t + 1) * kstep;
            const char* a2 = last ? nA : cA + (size_t)(t + 2) * kstep; const char* b2 = last ? nB : cB + (size_t)(t + 2) * kstep;
            const char* a3 = a2 + kstep; const char* b3 = b2 + kstep;
            if (last && has_next) S.a_ready(nxt);
            if constexpr (SP2) {
            PG8_LDB(B0, 0, 0); PG8_LDB(B1, 0, 1); PG8_SCHED; PG8_LDA(At, 0, 0); PG8_STAGE(PG8_SA(1, 1), a1 + hstep, voffA);
            PG8_WAIT_V(8); PG8_WAIT_L(0); PG8_BAR; PG8_MMA(0, 0, At, B0); PG8_MMA(0, 1, At, B1); PG8_BAR; PG8_SCHED;
            PG8_LDA(At, 0, 1); PG8_STAGE(PG8_SB(0, 0), b2, voffB); PG8_STAGE(PG8_SB(0, 1), b2 + hstep, voffB); PG8_STAGE(PG8_SA(0, 0), a2, voffA);
            PG8_WAIT_V(8); PG8_WAIT_L(0); PG8_BAR; PG8_MMA(1, 0, At, B0); PG8_MMA(1, 1, At, B1); PG8_BAR; PG8_SCHED;
            PG8_LDB(B0, 1, 0); PG8_LDB(B1, 1, 1); PG8_SCHED; PG8_LDA(At, 1, 0); PG8_STAGE(PG8_SA(0, 1), a2 + hstep, voffA);
            PG8_WAIT_V(8); PG8_WAIT_L(0); PG8_BAR; PG8_MMA(0, 0, At, B0); PG8_MMA(0, 1, At, B1); PG8_BAR; PG8_SCHED;
            PG8_LDA(At, 1, 1); PG8_STAGE(PG8_SB(1, 0), b3, voffB); PG8_STAGE(PG8_SB(1, 1), b3 + hstep, voffB); PG8_STAGE(PG8_SA(1, 0), a3, voffA);
            PG8_WAIT_V(8); PG8_WAIT_L(0); PG8_BAR; PG8_MMA(1, 0, At, B0); PG8_MMA(1, 1, At, B1); PG8_BAR; PG8_SCHED;
            } else {
            PG8_LDB(B0, 0, 0); PG8_SCHED; PG8_LDA(At, 0, 0); PG8_STAGE(PG8_SA(1, 1), a1 + hstep, voffA);
            PG8_WAIT_L(8); PG8_BAR; PG8_WAIT_L(0); PG8_MMA(0, 0, At, B0); PG8_BAR; PG8_SCHED;
            PG8_LDB(B1, 0, 1); PG8_STAGE(PG8_SB(0, 0), b2, voffB);
            PG8_BAR; PG8_WAIT_L(0); PG8_MMA(0, 1, At, B1); PG8_BAR;
            PG8_LDA(At, 0, 1); PG8_STAGE(PG8_SA(0, 0), a2, voffA);
            PG8_BAR; PG8_WAIT_L(0); PG8_MMA(1, 0, At, B0); PG8_BAR; PG8_SCHED;
            PG8_STAGE(PG8_SB(0, 1), b2 + hstep, voffB);
            PG8_WAIT_V(6); PG8_BAR; PG8_MMA(1, 1, At, B1); PG8_BAR;
            PG8_LDB(B0, 1, 0); PG8_SCHED; PG8_LDA(At, 1, 0); PG8_STAGE(PG8_SA(0, 1), a2 + hstep, voffA);
            PG8_WAIT_L(8); PG8_BAR; PG8_WAIT_L(0); PG8_MMA(0, 0, At, B0); PG8_BAR; PG8_SCHED;
            PG8_LDB(B1, 1, 1); PG8_STAGE(PG8_SB(1, 0), b3, voffB);
            PG8_BAR; PG8_WAIT_L(0); PG8_MMA(0, 1, At, B1); PG8_BAR;
            PG8_LDA(At, 1, 1); PG8_STAGE(PG8_SA(1, 0), a3, voffA);
            PG8_BAR; PG8_WAIT_L(0); PG8_MMA(1, 0, At, B0); PG8_BAR; PG8_SCHED;
            PG8_STAGE(PG8_SB(1, 1), b3 + hstep, voffB);
            PG8_WAIT_V(6); PG8_BAR; PG8_MMA(1, 1, At, B1); PG8_BAR;
            }
        }
        if constexpr (ALIGN_EPI) { if (wr == 0) PG8_BAR; }
        if constexpr (!Epi::AFTER_DRAIN) { E(acc, cur, wr, wc, fr, fq); S.done(cur); }
        if (!has_next) break;
#pragma unroll
        for (int a = 0; a < 2; ++a)
#pragma unroll
            for (int b = 0; b < 2; ++b)
#pragma unroll
                for (int m = 0; m < 4; ++m)
#pragma unroll
                    for (int n = 0; n < 2; ++n) acc[a][b][m][n] = (f32x4){0.f, 0.f, 0.f, 0.f};
        cur = nxt; cA = nA; cB = nB; ++ui;
        if constexpr (ALIGN_EPI) { if (wr == 1) PG8_BAR; }
    }
    PG8_WAIT_V(0);
    if constexpr (!ALIGN_EPI) { if (wr == 0) PG8_BAR; }
    PG8_BAR;
    if constexpr (Epi::AFTER_DRAIN) { E.fused(acc, cur, wr, wc, fr, fq, lds, wid, lane); S.done(cur); }
#undef PG8_SA
#undef PG8_SB
#undef PG8_STAGE
#undef PG8_LDA
#undef PG8_LDB
#undef PG8_MMA
#undef PG8_WAIT_V
#undef PG8_WAIT_L
#undef PG8_BAR
#undef PG8_SCHED
}
}

constexpr int NWAVES = 8, NTHR = 512;
constexpr int DM = 2048, BATCH = 2, SEQ = 16384, DEPTH = 4, GRIDW = 64, GROWS = 256, CTXL = 256;
constexpr int NAW = 1024, NHEAD = 8, HDIM = 128, FNW = 512, HYW = 512, DFF = 5632, DIN = 5120, NMOD = 6;
constexpr int ML = BATCH * SEQ, MC = BATCH * CTXL, MT = ML + MC;
constexpr int PML = ML / 256, PMT = MT / 256;
constexpr int NEDGE = MT / 64 * 2;
constexpr float EPS = 1e-6f;
constexpr float LOG2E = 1.4426950408889634f;
constexpr float QSCALE = 0.08838834764831845f * LOG2E;
constexpr float HY_MIN_DECAY = -3.0701134573253945f, HY_MAX_DECAY = -15.350567286626973f;

constexpr size_t MiB = 1u << 20;
constexpr size_t WS_CTL = 0, CTL_ZERO_BYTES = 1 * MiB;
constexpr size_t WS_MOD = 1 * MiB;
constexpr size_t WS_XC = 2 * MiB;
constexpr size_t WS_HFC = 6 * MiB;
constexpr size_t WS_HF = 8 * MiB;
constexpr size_t WS_WIN = WS_HF + 128 * MiB;
constexpr size_t WS_WOUT = WS_WIN + 80 * MiB;
constexpr size_t WS_WUP = WS_WOUT + 32 * MiB;
constexpr size_t WS_WDN = WS_WUP + 176 * MiB;
constexpr size_t WS_H = WS_WDN + 88 * MiB;
constexpr size_t WS_QK = WS_H + 130 * MiB;
constexpr size_t WS_VT = WS_QK + 130 * MiB;
constexpr size_t WS_T32 = WS_VT + 65 * MiB;
constexpr size_t WS_A = WS_T32 + 260 * MiB;
constexpr size_t WS_HID = WS_QK;
constexpr size_t WS_EDGE = WS_A + 65 * MiB;
constexpr size_t EDGE_ELEMS = (size_t)NEDGE * DFF;
constexpr size_t WS_KS = WS_EDGE + 68 * MiB;
constexpr size_t WS_SLAB = WS_KS + 64 * MiB;
constexpr size_t WS_END = WS_SLAB + 16 * MiB;
static_assert((size_t)MT * DFF * 2 <= WS_EDGE - WS_QK, "hidden overlay");
static_assert(3 * EDGE_ELEMS * 4 <= 68 * MiB, "edge buffers");
static_assert((size_t)MT * DM * 2 == 130 * MiB && (size_t)1024 * MT * 2 == 65 * MiB && (size_t)2048 * MT * 4 == 260 * MiB, "sizes");
constexpr int CW_BAR = 4096;

constexpr int RING_BYTES = 131072;
constexpr int XTRA_OFF = RING_BYTES, XTRA_BYTES = 28672;
constexpr int MISC_OFF = XTRA_OFF + XTRA_BYTES;
constexpr int TW_OFF = XTRA_OFF + 24576;
constexpr int ATT_KC_OFF = 0, ATT_KC_PITCH = 272, ATT_VC_OFF = 256 * ATT_KC_PITCH, ATT_VC_PITCH = 528, ATT_BIAS_OFF = ATT_VC_OFF + 128 * ATT_VC_PITCH;
static_assert(ATT_BIAS_OFF + 8 * 465 * 4 <= TW_OFF, "attention LDS map");
constexpr int LDS_BYTES = MISC_OFF + 256;

#define GAS __attribute__((address_space(1)))
#define LAS __attribute__((address_space(3)))
typedef unsigned short bf16;
typedef unsigned v4u __attribute__((ext_vector_type(4)));
typedef unsigned v2u __attribute__((ext_vector_type(2)));
typedef float f32x4 __attribute__((ext_vector_type(4)));
typedef float f32x2 __attribute__((ext_vector_type(2)));
typedef short bf16x8 __attribute__((ext_vector_type(8)));
#define LDS_WAIT() asm volatile("s_waitcnt lgkmcnt(0)" ::: "memory")
__device__ __forceinline__ unsigned f2bf(float f) { unsigned u = __builtin_bit_cast(unsigned, f); return (u + 0x7fffu + ((u >> 16) & 1u)) >> 16; }
__device__ __forceinline__ unsigned pk2(float lo, float hi) { return f2bf(lo) | (f2bf(hi) << 16); }
__device__ __forceinline__ float bf2f(unsigned short b) { return __builtin_bit_cast(float, (unsigned)b << 16); }
__device__ __forceinline__ f32x2 cmul(f32x2 a, f32x2 b) { return (f32x2){a.x * b.x - a.y * b.y, a.x * b.y + a.y * b.x}; }
__device__ __forceinline__ f32x2 cconj(f32x2 a) { return (f32x2){a.x, -a.y}; }
__device__ __forceinline__ float lane_read(float v, int src_lane) { return __builtin_bit_cast(float, __builtin_amdgcn_ds_bpermute(src_lane << 2, __builtin_bit_cast(int, v))); }
template <int CTRL> __device__ __forceinline__ float dpp_ror(float v) { return __builtin_bit_cast(float, __builtin_amdgcn_update_dpp(0, __builtin_bit_cast(int, v), CTRL, 0xf, 0xf, false)); }
__device__ __forceinline__ float wave_sum(float v, int lane) {
#pragma unroll
    for (int o = 1; o < 64; o <<= 1) v += lane_read(v, lane ^ o);
    return v;
}
__device__ __forceinline__ float gelu_tanh(float x) {
    const float t = x * (1.0f + 0.044715f * x * x) * (-2.302208198f);
    const float e = __builtin_amdgcn_exp2f(t);
    return x * __builtin_amdgcn_rcpf(1.0f + e);
}
#define XB_LAS_DEFINED
#define XB_TMO      128
#define XB_XCNT(j)  (256  + 64 * (j))
#define XB_XSUB(j)  (1280 + 64 * (j))
#define XB_XGEN(j)  (2304 + 64 * (j))
#define XB_TOP      3328
#define XB_TOPGEN   3392
#define XCD_BAR_WORDS 3456
#define XB_SPIN_CAP (1u << 18)

__device__ __forceinline__ unsigned xb_ld(unsigned* p)              { return __hip_atomic_load(p, __ATOMIC_RELAXED, __HIP_MEMORY_SCOPE_AGENT); }
__device__ __forceinline__ unsigned xb_add(unsigned* p, unsigned v) { return __hip_atomic_fetch_add(p, v, __ATOMIC_RELAXED, __HIP_MEMORY_SCOPE_AGENT); }
__device__ __forceinline__ unsigned xb_xcc_id() { return (unsigned)__builtin_amdgcn_s_getreg((3 << 11) | 20) & 0xFu; }
#define XB_SPIN(cond, bar) do { unsigned _sp = 0; while (cond) { __builtin_amdgcn_s_sleep(1); \
    if ((++_sp & 255u) == 0u) { if (xb_ld(&(bar)[XB_TMO])) break; if (_sp > XB_SPIN_CAP) { atomicAdd(&(bar)[XB_TMO], 1u); break; } } } } while (0)

struct XcdBarrier {
    unsigned* bar; unsigned x;
    volatile LAS unsigned* st;
};

__device__ __forceinline__ XcdBarrier xcd_barrier_post(unsigned* bar, volatile LAS unsigned* st) {
    XcdBarrier b; b.bar = bar; b.x = xb_xcc_id(); b.st = st;
    if (threadIdx.x == 0) (void)xb_add(&bar[XB_XCNT(b.x)], 1u);
    return b;
}
__device__ __forceinline__ void xcd_barrier_complete(unsigned* bar, unsigned x, unsigned& nloc, unsigned& nx) {
    const unsigned G = gridDim.x * gridDim.y * gridDim.z;
    unsigned sum, cnt, mine, sp = 0u;
    for (;;) {
        sum = 0u; cnt = 0u; mine = 0u;
#pragma unroll
        for (unsigned j = 0; j < 16; ++j) { const unsigned c = xb_ld(&bar[XB_XCNT(j)]); sum += c; cnt += (c > 0u) ? 1u : 0u; mine = (j == x) ? c : mine; }
        if (sum == G) break;
        __builtin_amdgcn_s_sleep(1);
        if ((++sp & 255u) == 0u) { if (xb_ld(&bar[XB_TMO])) break; if (sp > XB_SPIN_CAP) { atomicAdd(&bar[XB_TMO], 1u); break; } }
    }
    nloc = mine > 0u ? mine : 1u; nx = cnt > 0u ? cnt : 1u;
}

__device__ __forceinline__ void xcd_barrier(const XcdBarrier& b) {
    asm volatile("s_waitcnt vmcnt(0)" ::: "memory");
    __syncthreads();
    if (threadIdx.x == 0) {
        unsigned* bar = b.bar;
        __builtin_amdgcn_s_waitcnt(0);
        unsigned nloc = b.st[0], nx = b.st[1];
        if (nloc == 0u) { xcd_barrier_complete(bar, b.x, nloc, nx); b.st[0] = nloc; b.st[1] = nx; }
        const unsigned old = xb_add(&bar[XB_XSUB(b.x)], 1u);
        const unsigned gen = old / nloc;
        if (old + 1u == (gen + 1u) * nloc) {
            __builtin_amdgcn_fence(__ATOMIC_RELEASE, "agent");
            asm volatile("s_waitcnt vmcnt(0)" ::: "memory");
            const unsigned og = xb_add(&bar[XB_TOP], 1u);
            const unsigned tg = og / nx;
            if (og + 1u == (tg + 1u) * nx) xb_add(&bar[XB_TOPGEN], 1u);
            else XB_SPIN(xb_ld(&bar[XB_TOPGEN]) == tg, bar);
            __builtin_amdgcn_fence(__ATOMIC_ACQUIRE, "agent");
            xb_add(&bar[XB_XGEN(b.x)], 1u);
            asm volatile("s_waitcnt vmcnt(0)" ::: "memory");
        } else {
            XB_SPIN(xb_ld(&bar[XB_XGEN(b.x)]) == gen, bar);
            __builtin_amdgcn_fence(__ATOMIC_ACQUIRE, "agent");
            asm volatile("s_waitcnt vmcnt(0)" ::: "memory");
        }
    }
    __syncthreads();
}


struct Args { const GAS float* in[26]; GAS float* out; GAS unsigned char* ws; };
struct Frame {
    LAS unsigned char* lds;
    int tid, lane, wave;
    int vcu, G;
    GAS unsigned char* ws;
    GAS float* out;
};
typedef const float* cfptr_t;
__device__ __forceinline__ const GAS float* in_ptr(int k) { asm volatile("" : "+s"(k));
    const __attribute__((address_space(4))) cfptr_t* kp = (const __attribute__((address_space(4))) cfptr_t*)__builtin_amdgcn_kernarg_segment_ptr(); return (const GAS float*)kp[k]; }
enum { I_x, I_c, I_ctx, I_c_ctx, I_ada_w, I_ada_b, I_norm1_g, I_norm2_g, I_w_in, I_na_rpb, I_hy_conv_w, I_hy_conv_b, I_hy_w1, I_hy_b1, I_hy_w2, I_hy_b2, I_hy_w3, I_hy_freq, I_hy_bias,
       I_mix_norm_g, I_w_out, I_ffn_w_up, I_ffn_conv_w, I_ffn_conv_b, I_ffn_w_down, I_final_norm_g };
#define IN(name) in_ptr(I_##name)
#define WSP(T, off) ((GAS T*)(F.ws + (off)))

__device__ __forceinline__ void pa_adaln(Frame& F) {
    LAS float* sv = (LAS float*)F.lds;
    LAS float* red = (LAS float*)(F.lds + 3 * DM * 4);
    const GAS float* p_c = IN(c); const GAS float* p_cc = IN(c_ctx); const GAS float* p_aw = IN(ada_w); const GAS float* p_ab = IN(ada_b);
    for (int i = F.tid; i < 3 * DM; i += NTHR) { const int s = i / DM, k = i % DM; const float v = s < 2 ? p_c[s * DM + k] : p_cc[k]; sv[i] = v / (1.0f + __expf(-v)); }
    __syncthreads();
    GAS float* MOD = WSP(float, WS_MOD);
    const int cg = F.tid & 63, ks = F.tid >> 6;
    for (int item = F.vcu; item < DEPTH * 48; item += F.G) {
        const int l = item / 48, j0 = (item % 48) * 256;
        const GAS float* wp = p_aw + ((size_t)l * DM + ks * 256) * (NMOD * DM) + j0 + 4 * cg;
        f32x4 a0 = {0.f, 0.f, 0.f, 0.f}, a1 = a0, a2 = a0;
#pragma unroll 8
        for (int kk = 0; kk < 256; ++kk) {
            const f32x4 w = *(const GAS f32x4*)(wp + (size_t)kk * (NMOD * DM));
            const float s0 = sv[ks * 256 + kk], s1 = sv[DM + ks * 256 + kk], s2 = sv[2 * DM + ks * 256 + kk];
            a0 += w * s0; a1 += w * s1; a2 += w * s2;
        }
        *(LAS f32x4*)(red + (ks * 3 + 0) * 256 + 4 * cg) = a0; *(LAS f32x4*)(red + (ks * 3 + 1) * 256 + 4 * cg) = a1; *(LAS f32x4*)(red + (ks * 3 + 2) * 256 + 4 * cg) = a2;
        __syncthreads();
        if (F.tid < 192) {
            const int s = F.tid >> 6, cc = F.tid & 63;
            f32x4 t = *(const GAS f32x4*)(p_ab + (size_t)l * (NMOD * DM) + j0 + 4 * cc);
#pragma unroll
            for (int q = 0; q < 8; ++q) t += *(LAS f32x4*)(red + (q * 3 + s) * 256 + 4 * cc);
            *(GAS f32x4*)(MOD + ((size_t)l * 3 + s) * (NMOD * DM) + j0 + 4 * cc) = t;
        }
        __syncthreads();
    }
}
__device__ __forceinline__ void transpose_item(const GAS float* W, int K, int N, GAS bf16* WT, int k0, int n0, int drow0, LAS float* scr, int lane) {
#pragma unroll 8
    for (int i = 0; i < 32; ++i) { const int kk = 2 * i + (lane >> 5); scr[kk * 33 + (lane & 31)] = W[(size_t)(k0 + kk) * N + n0 + (lane & 31)]; }
    LDS_WAIT(); asm volatile("" ::: "memory");
    const int c = lane & 7;
#pragma unroll
    for (int j = 0; j < 4; ++j) { const int n = (lane >> 3) + 8 * j; const LAS float* s = scr + (8 * c) * 33 + n;
        v4u o; o.x = pk2(s[0 * 33], s[1 * 33]); o.y = pk2(s[2 * 33], s[3 * 33]); o.z = pk2(s[4 * 33], s[5 * 33]); o.w = pk2(s[6 * 33], s[7 * 33]);
        *(GAS v4u*)(WT + (size_t)(drow0 + n) * K + k0 + 8 * c) = o; }
    LDS_WAIT(); asm volatile("" ::: "memory");
}
__device__ __forceinline__ void pa_ctx_copy(Frame& F) {
    const GAS f32x4* src = (const GAS f32x4*)IN(ctx); GAS f32x4* dst = WSP(f32x4, WS_XC);
    for (int i = F.vcu * NTHR + F.tid; i < MC * DM / 4; i += F.G * NTHR) dst[i] = src[i];
}
__device__ __forceinline__ void pa_weights(Frame& F) {
    const GAS float* p_win = IN(w_in); const GAS float* p_wout = IN(w_out); const GAS float* p_wup = IN(ffn_w_up); const GAS float* p_wdn = IN(ffn_w_down);
    {
        LAS float* wt = (LAS float*)F.lds;
        LAS float* tab = (LAS float*)(F.lds + 64 * 129 * 4);
        if (F.tid < 128) tab[F.tid] = cospif((float)F.tid * (1.0f / 64.0f));
        for (int item = F.vcu; item < DEPTH * 4 * 32; item += F.G) {
            const int l = item >> 7, g = (item >> 5) & 3, k0 = (item & 31) * 64;
            __syncthreads();
            for (int i = F.tid; i < 64 * 128; i += NTHR) { const int kk = i >> 7, cc = i & 127; wt[kk * 129 + cc] = p_win[((size_t)l * DM + k0 + kk) * DIN + 3072 + g * 128 + cc]; }
            __syncthreads();
            const int kk = F.tid & 63;
            GAS bf16* dst = WSP(bf16, WS_WIN) + ((size_t)l * DIN + 3072 + g * 128) * DM + k0 + kk;
            for (int i = 0; i < 16; ++i) {
                const int mp = (F.tid >> 6) + 8 * i;
                const int mm = mp <= 64 ? mp : mp - 64, sh = mp <= 64 ? 0 : 96;
                float a = 0.f;
                const int add = mp <= 64 ? 0 : 32; (void)sh;
#pragma unroll 8
                for (int cc = 0; cc < 128; ++cc) a += wt[kk * 129 + cc] * tab[(mm * cc + add) & 127];
                dst[(size_t)mp * DM] = (bf16)f2bf(a);
            }
        }
        __syncthreads();
    }
    LAS float* scr = (LAS float*)(F.lds + F.wave * 16384);
    const int gw = F.vcu * NWAVES + F.wave, NGW = F.G * NWAVES;
    constexpr int I_IN = 32 * 144, I_OUT = 32 * 64, I_UP = 32 * 352, I_DN = 88 * 64, I_L = I_IN + I_OUT + I_UP + I_DN;
    for (int it = gw; it < DEPTH * I_L; it += NGW) {
        const int l = it / I_L; int r = it % I_L;
        if (r < I_IN) { const int kb = r / 144; int nb = r % 144; if (nb >= 96) nb += 16;
            transpose_item(p_win + (size_t)l * DM * DIN, DM, DIN, WSP(bf16, WS_WIN) + (size_t)l * DIN * DM, kb * 64, nb * 32, nb * 32, scr, F.lane); continue; }
        r -= I_IN;
        if (r < I_OUT) { const int kb = r / 64, nb = r % 64;
            transpose_item(p_wout + (size_t)l * DM * DM, DM, DM, WSP(bf16, WS_WOUT) + (size_t)l * DM * DM, kb * 64, nb * 32, nb * 32, scr, F.lane); continue; }
        r -= I_OUT;
        if (r < I_UP) { const int kb = r / 352, nb = r % 352; const int n0 = nb * 32;
            const int drow = n0 < DFF ? (n0 >> 7) * 256 + (n0 & 127) : ((n0 - DFF) >> 7) * 256 + 128 + ((n0 - DFF) & 127);
            transpose_item(p_wup + (size_t)l * DM * 2 * DFF, DM, 2 * DFF, WSP(bf16, WS_WUP) + (size_t)l * 2 * DFF * DM, kb * 64, n0, drow, scr, F.lane); continue; }
        r -= I_UP;
        { const int kb = r / 64, nb = r % 64;
            transpose_item(p_wdn + (size_t)l * DFF * DM, DFF, DM, WSP(bf16, WS_WDN) + (size_t)l * DM * DFF, kb * 64, nb * 32, nb * 32, scr, F.lane); }
    }
}

__device__ __forceinline__ void norm_phase(Frame& F, int l, int which, bool with_ctx, int nslab) {
    const GAS float* gain = (which ? IN(norm2_g) : IN(norm1_g)) + (size_t)l * DM;
    const GAS float* MOD = WSP(float, WS_MOD) + (size_t)l * 3 * (NMOD * DM);
    const bool first = (l == 0 && which == 0);
    const GAS float* xl = first ? IN(x) : F.out; const GAS float* xc = first ? IN(ctx) : WSP(float, WS_XC);
    GAS bf16* H = WSP(bf16, WS_H);
    const int gw = F.vcu * NWAVES + F.wave, NGW = F.G * NWAVES, nrows = with_ctx ? MT : ML;
    for (int row = gw; row < nrows; row += NGW) {
        const int s = row < SEQ ? 0 : row < ML ? 1 : 2;
        const GAS float* xr = row < ML ? xl + (size_t)row * DM : xc + (size_t)(row - ML) * DM;
        const GAS float* shp = MOD + (size_t)s * (NMOD * DM) + (which ? 3 : 0) * DM; const GAS float* scp = shp + DM;
        f32x4 v[8]; float ss = 0.f;
#pragma unroll
        for (int j = 0; j < 8; ++j) v[j] = *(const GAS f32x4*)(xr + 4 * (F.lane + 64 * j));
        if (row >= ML && nslab > 0) {
            const GAS float* sl = WSP(float, WS_SLAB) + (size_t)(row - ML) * DM; GAS float* xw = WSP(float, WS_XC) + (size_t)(row - ML) * DM;
            for (int ks = 0; ks < nslab; ++ks)
#pragma unroll
                for (int j = 0; j < 8; ++j) v[j] += *(const GAS f32x4*)(sl + (size_t)ks * MC * DM + 4 * (F.lane + 64 * j));
#pragma unroll
            for (int j = 0; j < 8; ++j) *(GAS f32x4*)(xw + 4 * (F.lane + 64 * j)) = v[j];
        }
#pragma unroll
        for (int j = 0; j < 8; ++j) ss += (v[j].x * v[j].x + v[j].y * v[j].y) + (v[j].z * v[j].z + v[j].w * v[j].w);
        const float rstd = 1.0f / sqrtf(wave_sum(ss, F.lane) * (1.0f / DM) + EPS);
        GAS bf16* hr = H + (size_t)row * DM;
#pragma unroll
        for (int j = 0; j < 8; ++j) { const int k = 4 * (F.lane + 64 * j);
            const f32x4 g = *(const GAS f32x4*)(gain + k), sc = *(const GAS f32x4*)(scp + k), sh = *(const GAS f32x4*)(shp + k);
            const f32x4 y = (v[j] * rstd * g) * (1.0f + sc) + sh;
            v2u o; o.x = pk2(y.x, y.y); o.y = pk2(y.z, y.w); *(GAS v2u*)(hr + k) = o; }
    }
}
__device__ __forceinline__ void final_norm_phase(Frame& F) {
    const GAS float* p_g = IN(final_norm_g);
    const int gw = F.vcu * NWAVES + F.wave, NGW = F.G * NWAVES;
    for (int row = gw; row < ML; row += NGW) {
        GAS float* xr = F.out + (size_t)row * DM;
        f32x4 v[8]; float ss = 0.f;
#pragma unroll
        for (int j = 0; j < 8; ++j) { v[j] = *(const GAS f32x4*)(xr + 4 * (F.lane + 64 * j)); ss += (v[j].x * v[j].x + v[j].y * v[j].y) + (v[j].z * v[j].z + v[j].w * v[j].w); }
        const float rstd = 1.0f / sqrtf(wave_sum(ss, F.lane) * (1.0f / DM) + EPS);
#pragma unroll
        for (int j = 0; j < 8; ++j) { const int k = 4 * (F.lane + 64 * j); *(GAS f32x4*)(xr + k) = v[j] * rstd * *(const GAS f32x4*)(p_g + k); }
    }
}

__device__ __forceinline__ void filter_phase(Frame& F, int l, bool with_ctx) {
    LAS float* h1 = (LAS float*)F.lds;
    LAS float* h2 = (LAS float*)(F.lds + 64 * 65 * 4);
    const GAS float* w1 = IN(hy_w1) + (size_t)l * 33 * 64; const GAS float* b1 = IN(hy_b1) + (size_t)l * 64;
    const GAS float* w2 = IN(hy_w2) + (size_t)l * 64 * 64; const GAS float* b2 = IN(hy_b2) + (size_t)l * 64;
    const GAS float* w3 = IN(hy_w3) + (size_t)l * 64 * 2048; const GAS float* fq = IN(hy_freq) + (size_t)l * 64;
    const int nitems = with_ctx ? 288 : 256;
    for (int item = F.vcu; item < nitems; item += F.G) {
        const bool isc = item >= 256; const int Lq = isc ? CTXL : SEQ; const int n0 = (isc ? (item - 256) >> 3 : item) * 64;
        const int ck_lo = isc ? (item & 7) : 0, ck_hi = isc ? ck_lo + 1 : 8;
        const int p = F.tid & 63, jg = F.wave;
        const float pos = (float)(n0 + p), t = pos / (float)(Lq - 1);
        __syncthreads();
        {
            float zf[33]; zf[0] = t;
#pragma unroll
            for (int i = 0; i < 16; ++i) { const float band = 1e-4f + (float)i * ((15.0f - 1e-4f) / 15.0f); const float ang = band * (6.283185307179586f / (float)Lq) * pos; zf[1 + i] = cosf(ang); zf[17 + i] = -sinf(ang); }
#pragma unroll 1
            for (int jj = 0; jj < 8; ++jj) { const int j = jg * 8 + jj; float a = b1[j];
#pragma unroll
                for (int i = 0; i < 33; ++i) a += zf[i] * w1[i * 64 + j];
                h1[p * 65 + j] = sinf(fq[j] * a); }
        }
        __syncthreads();
#pragma unroll 1
        for (int jj = 0; jj < 8; ++jj) { const int j = jg * 8 + jj; float a = b2[j];
#pragma unroll 8
            for (int i = 0; i < 64; ++i) a += h1[p * 65 + i] * w2[i * 64 + j];
            h2[p * 65 + j] = sinf(fq[j] * a); }
        __syncthreads();
        GAS float* dst = isc ? WSP(float, WS_HFC) : WSP(float, WS_HF);
        LAS float* w3s = (LAS float*)(F.lds + 2 * 64 * 65 * 4);
        for (int ck = ck_lo; ck < ck_hi; ++ck) {
            __syncthreads();
#pragma unroll 4
            for (int i = F.tid; i < 64 * 64; i += NTHR) { const int jr = i >> 6, c4 = (i & 63) * 4; *(LAS f32x4*)(w3s + jr * 256 + c4) = *(const GAS f32x4*)(w3 + (size_t)jr * 2048 + ck * 256 + c4); }
            __syncthreads();
            f32x4 a[8];
#pragma unroll
            for (int q = 0; q < 8; ++q) a[q] = (f32x4){0.f, 0.f, 0.f, 0.f};
#pragma unroll 2
            for (int i = 0; i < 64; ++i) { const float hvi = h2[p * 65 + i]; const LAS f32x4* wr = (const LAS f32x4*)(w3s + i * 256 + jg * 32);
#pragma unroll
                for (int q = 0; q < 8; ++q) a[q] += wr[q] * hvi; }
#pragma unroll
            for (int q = 0; q < 8; ++q)
#pragma unroll
                for (int e = 0; e < 4; ++e) { const int col = ck * 256 + jg * 32 + q * 4 + e, ch = col & 511;
                    const float delta = fabsf(HY_MIN_DECAY + (HY_MAX_DECAY - HY_MIN_DECAY) * ((float)ch / 511.0f));
                    const float val = a[q][e] * __expf(-t * delta); const int n = n0 + p;
                    if (col & 512) dst[(size_t)col * Lq + ((Lq - n) & (Lq - 1))] = n == 0 ? 0.f : val;
                    else dst[(size_t)col * Lq + n] = val; }
        }
    }
}

struct EpiIn {
    static constexpr bool PERM = true, AFTER_DRAIN = false;
    GAS bf16* QK; GAS bf16* VT; GAS float* T32;
    __device__ __forceinline__ void operator()(pg8::f32x4 (&acc)[2][2][4][2], const pg8::Unit& u, int wr_, int wc_, int fr_, int fq_) const {
        int t_ = threadIdx.x; asm volatile("" : "+v"(t_));
        const int fr = t_ & 15, fq = (t_ >> 4) & 3, wc = (t_ >> 6) & 3, wr = t_ >> 8; (void)wr_; (void)wc_; (void)fr_; (void)fq_;
        const int row0 = u.pm * 256 + wr * 64 + fr, col0 = u.pn * 256 + wc * 32 + 8 * fq;
        if (u.type == 0) {
            const float sc = u.pn < 4 ? QSCALE : 1.0f;
#pragma unroll
            for (int ai = 0; ai < 2; ++ai)
#pragma unroll
                for (int m = 0; m < 4; ++m) { GAS bf16* rowp = QK + (size_t)(row0 + ai * 128 + m * 16) * 2048 + col0;
#pragma unroll
                    for (int bj = 0; bj < 2; ++bj) { const pg8::f32x4 v0 = acc[ai][bj][m][0] * sc, v1 = acc[ai][bj][m][1] * sc;
                        v4u w; w.x = pg8::cvt_pk_bf16(v0[0], v0[1]); w.y = pg8::cvt_pk_bf16(v0[2], v0[3]); w.z = pg8::cvt_pk_bf16(v1[0], v1[1]); w.w = pg8::cvt_pk_bf16(v1[2], v1[3]);
                        *(GAS v4u*)(rowp + bj * 128) = w; } }
        } else if (u.pm < 4) {
#pragma unroll
            for (int ai = 0; ai < 2; ++ai)
#pragma unroll
                for (int m = 0; m < 4; ++m) { GAS bf16* rowp = VT + (size_t)(row0 + ai * 128 + m * 16) * MT + col0;
#pragma unroll
                    for (int bj = 0; bj < 2; ++bj) { const pg8::f32x4 v0 = acc[ai][bj][m][0], v1 = acc[ai][bj][m][1];
                        v4u w; w.x = pg8::cvt_pk_bf16(v0[0], v0[1]); w.y = pg8::cvt_pk_bf16(v0[2], v0[3]); w.z = pg8::cvt_pk_bf16(v1[0], v1[1]); w.w = pg8::cvt_pk_bf16(v1[2], v1[3]);
                        *(GAS v4u*)(rowp + bj * 128) = w; } }
        } else {
#pragma unroll
            for (int ai = 0; ai < 2; ++ai)
#pragma unroll
                for (int m = 0; m < 4; ++m) { GAS float* rowp = T32 + (size_t)(row0 - 1024 + ai * 128 + m * 16) * MT + col0;
#pragma unroll
                    for (int bj = 0; bj < 2; ++bj) { *(GAS pg8::f32x4*)(rowp + bj * 128) = acc[ai][bj][m][0]; *(GAS pg8::f32x4*)(rowp + bj * 128 + 4) = acc[ai][bj][m][1]; } }
        }
    }
};
struct EpiRes {
    static constexpr bool PERM = false, AFTER_DRAIN = false;
    const GAS float* base_l; const GAS float* base_c; GAS float* out_l; GAS float* out_c; const GAS float* gate;
    __device__ __forceinline__ void operator()(pg8::f32x4 (&acc)[2][2][4][2], const pg8::Unit& u, int wr_, int wc_, int fr_, int fq_) const {
        int t_ = threadIdx.x; asm volatile("" : "+v"(t_));
        const int fr = t_ & 15, fq = (t_ >> 4) & 3, wc = (t_ >> 6) & 3, wr = t_ >> 8; (void)wr_; (void)wc_; (void)fr_; (void)fq_;
        const int row0 = u.pm * 256 + wr * 64 + fr, col0 = u.pn * 256 + wc * 32 + 4 * fq;
        const int s = u.pm < PML / 2 ? 0 : u.pm < PML ? 1 : 2;
        const GAS float* bs = u.pm < PML ? base_l + (size_t)row0 * DM : base_c + (size_t)(row0 - ML) * DM;
        GAS float* os = u.pm < PML ? out_l + (size_t)row0 * DM : out_c + (size_t)(row0 - ML) * DM;
        pg8::f32x4 gv[2][2];
#pragma unroll
        for (int bj = 0; bj < 2; ++bj)
#pragma unroll
            for (int n = 0; n < 2; ++n) gv[bj][n] = *(const GAS pg8::f32x4*)(gate + (size_t)s * (NMOD * DM) + col0 + bj * 128 + n * 16);
#pragma unroll
        for (int ai = 0; ai < 2; ++ai)
#pragma unroll
            for (int m = 0; m < 4; ++m) { const size_t off = (size_t)(ai * 128 + m * 16) * DM + col0;
#pragma unroll
                for (int bj = 0; bj < 2; ++bj)
#pragma unroll
                    for (int n = 0; n < 2; ++n) { const pg8::f32x4 b = *(const GAS pg8::f32x4*)(bs + off + bj * 128 + n * 16);
                        *(GAS pg8::f32x4*)(os + off + bj * 128 + n * 16) = b + gv[bj][n] * acc[ai][bj][m][n]; }
                asm volatile("" ::: "memory"); }
    }
};
struct EpiSlab {
    static constexpr bool PERM = false, AFTER_DRAIN = false;
    GAS float* slab; const GAS float* gate;
    __device__ __forceinline__ void operator()(pg8::f32x4 (&acc)[2][2][4][2], const pg8::Unit& u, int wr_, int wc_, int fr_, int fq_) const {
        int t_ = threadIdx.x; asm volatile("" : "+v"(t_));
        const int fr = t_ & 15, fq = (t_ >> 4) & 3, wc = (t_ >> 6) & 3, wr = t_ >> 8; (void)wr_; (void)wc_; (void)fr_; (void)fq_;
        const int row0 = u.pm * 256 + wr * 64 + fr - ML, col0 = u.pn * 256 + wc * 32 + 4 * fq;
        pg8::f32x4 gv[2][2];
#pragma unroll
        for (int bj = 0; bj < 2; ++bj)
#pragma unroll
            for (int n = 0; n < 2; ++n) gv[bj][n] = *(const GAS pg8::f32x4*)(gate + (size_t)2 * (NMOD * DM) + col0 + bj * 128 + n * 16);
        GAS float* sb = slab + (size_t)u.type * MC * DM;
#pragma unroll
        for (int ai = 0; ai < 2; ++ai)
#pragma unroll
            for (int m = 0; m < 4; ++m) { GAS float* os = sb + (size_t)(row0 + ai * 128 + m * 16) * DM + col0;
#pragma unroll
                for (int bj = 0; bj < 2; ++bj)
#pragma unroll
                    for (int n = 0; n < 2; ++n) *(GAS pg8::f32x4*)(os + bj * 128 + n * 16) = gv[bj][n] * acc[ai][bj][m][n]; }
    }
};
struct EpiUp {
    static constexpr bool PERM = true, AFTER_DRAIN = false;
    GAS bf16* HID; GAS float* EG; GAS float* EP; GAS float* EU; const GAS float* cw; const GAS float* cb;
    __device__ __forceinline__ void operator()(pg8::f32x4 (&acc)[2][2][4][2], const pg8::Unit& u, int wr_, int wc_, int fr_, int fq_) const {
        int t_ = threadIdx.x; asm volatile("" : "+v"(t_));
        const int fr = t_ & 15, fq = (t_ >> 4) & 3, wc = (t_ >> 6) & 3, wr = t_ >> 8; (void)wr_; (void)wc_; (void)fr_; (void)fq_;
        const unsigned hc0 = (unsigned)(u.pn * 128 + wc * 32 + 8 * fq);
        const bool e0 = fr == 0, e3 = fr == 15;
        __builtin_amdgcn_sched_barrier(0);
#pragma unroll
        for (int ai = 0; ai < 2; ++ai) {
            const int rbase = u.pm * 256 + ai * 128 + wr * 64;
            const unsigned eb0 = (unsigned)((rbase >> 6) << 1) * (unsigned)DFF, eb3 = eb0 + (unsigned)DFF;
#pragma unroll
            for (int n = 0; n < 2; ++n) {
                const unsigned hc = hc0 + 4u * (unsigned)n;
                const pg8::f32x4 w0 = *(const GAS pg8::f32x4*)&cw[hc], w1 = *(const GAS pg8::f32x4*)&cw[(unsigned)DFF + hc], w2 = *(const GAS pg8::f32x4*)&cw[2u * (unsigned)DFF + hc], bb = *(const GAS pg8::f32x4*)&cb[hc];
                if (e0) { *(GAS pg8::f32x4*)&EG[eb0 + hc] = acc[ai][0][0][n]; *(GAS pg8::f32x4*)&EU[eb0 + hc] = acc[ai][1][0][n]; }
                if (e3) { *(GAS pg8::f32x4*)&EG[eb3 + hc] = acc[ai][0][3][n]; *(GAS pg8::f32x4*)&EU[eb3 + hc] = acc[ai][1][3][n]; }
#pragma unroll
                for (int j = 0; j < 4; ++j) {
                    float pr[4], nx[4], gg[4];
#pragma unroll
                    for (int m = 0; m < 4; ++m) { gg[m] = acc[ai][0][m][n][j]; pr[m] = dpp_ror<0x121>(gg[m]); nx[m] = dpp_ror<0x12F>(gg[m]); }
#pragma unroll
                    for (int m = 0; m < 4; ++m) {
                        const float pv = fr > 0 ? pr[m] : (m > 0 ? pr[m > 0 ? m - 1 : 0] : 0.f);
                        const float nv = fr < 15 ? nx[m] : (m < 3 ? nx[m < 3 ? m + 1 : 3] : 0.f);
                        const float cv = w0[j] * pv + w1[j] * gg[m] + w2[j] * nv + bb[j];
                        if (m == 0) { if (e0) EP[eb0 + hc + (unsigned)j] = cv; } if (m == 3) { if (e3) EP[eb3 + hc + (unsigned)j] = cv; }
                        acc[ai][0][m][n][j] = gelu_tanh(cv) * acc[ai][1][m][n][j];
                    }
                }
                asm volatile("" ::: "memory"); __builtin_amdgcn_sched_barrier(0);
            }
#pragma unroll
            for (int m = 0; m < 4; ++m) {
                if (!((m == 0 && e0) || (m == 3 && e3))) {
                    const pg8::f32x4 v0 = acc[ai][0][m][0], v1 = acc[ai][0][m][1];
                    v4u w; w.x = pg8::cvt_pk_bf16(v0[0], v0[1]); w.y = pg8::cvt_pk_bf16(v0[2], v0[3]); w.z = pg8::cvt_pk_bf16(v1[0], v1[1]); w.w = pg8::cvt_pk_bf16(v1[2], v1[3]);
                    *(GAS v4u*)&HID[(unsigned)(rbase + m * 16 + fr) * (unsigned)DFF + hc0] = w;
                }
            }
        }
    }
};
__device__ __forceinline__ void edge_fix_phase(Frame& F, int l, bool with_ctx) {
    const GAS float* EG = WSP(float, WS_EDGE); const GAS float* EP = EG + EDGE_ELEMS; const GAS float* EU = EP + EDGE_ELEMS;
    const GAS float* cw = IN(ffn_conv_w) + (size_t)l * 3 * DFF;
    GAS bf16* HID = WSP(bf16, WS_HID);
    const int ne = with_ctx ? NEDGE : ML / 64 * 2, total = ne * (DFF / 4);
    for (int i = F.vcu * NTHR + F.tid; i < total; i += F.G * NTHR) {
        const int e = i / (DFF / 4), c = (i % (DFF / 4)) * 4;
        const int r = (e >> 1) * 64 + (e & 1) * 63;
        f32x4 p = *(const GAS f32x4*)(EP + (size_t)e * DFF + c);
        if (e & 1) { const int nr = r + 1; if (nr != SEQ && nr != ML && nr != ML + CTXL && nr != MT) p += *(const GAS f32x4*)(cw + 2 * DFF + c) * *(const GAS f32x4*)(EG + (size_t)(e + 1) * DFF + c); }
        else { if (r != 0 && r != SEQ && r != ML && r != ML + CTXL) p += *(const GAS f32x4*)(cw + c) * *(const GAS f32x4*)(EG + (size_t)(e - 1) * DFF + c); }
        const f32x4 up = *(const GAS f32x4*)(EU + (size_t)e * DFF + c);
        v2u o; o.x = pk2(gelu_tanh(p.x) * up.x, gelu_tanh(p.y) * up.y); o.y = pk2(gelu_tanh(p.z) * up.z, gelu_tanh(p.w) * up.w);
        *(GAS v2u*)(HID + (size_t)r * DFF + c) = o;
    }
}

#define MFMA16(a, b, c) __builtin_amdgcn_mfma_f32_16x16x32_bf16((a), (b), (c), 0, 0, 0)
struct AttnK { bf16x8 kf[2][4]; };
struct AttnV { bf16x8 vf[8]; };
__device__ __forceinline__ void attn_load_k(AttnK& C, const GAS bf16* kbase  , int q, int g) {
#pragma unroll
    for (int T = 0; T < 2; ++T) { const unsigned koff = (unsigned)((8 * (q >> 2) + 4 * T + (q & 3)) * 2048 + 8 * g);
#pragma unroll
        for (int dc = 0; dc < 4; ++dc) C.kf[T][dc] = *(const GAS bf16x8*)(kbase + koff + 32 * dc); }
}
__device__ __forceinline__ void attn_load_v(AttnV& C, const GAS bf16* vbase  , int q, int g) {
    const unsigned voff = (unsigned)(q * MT + 8 * g);
#pragma unroll
    for (int dt = 0; dt < 8; ++dt) { const GAS bf16* vrow = vbase + (size_t)dt * 16 * MT; C.vf[dt] = *(const GAS bf16x8*)(vrow + voff); }
}
__device__ __forceinline__ void attn_load_k_ctx(AttnK& C, const LAS unsigned char* KC, int cc, int q, int g) {
#pragma unroll
    for (int T = 0; T < 2; ++T) { const int kk = 8 * (q >> 2) + 4 * T + (q & 3);
#pragma unroll
        for (int dc = 0; dc < 4; ++dc) C.kf[T][dc] = *(const LAS bf16x8*)(KC + (32 * cc + kk) * ATT_KC_PITCH + (32 * dc + 8 * g) * 2); }
}
__device__ __forceinline__ void attn_load_v_ctx(AttnV& C, const LAS unsigned char* VC, int cc, int q, int g) {
#pragma unroll
    for (int dt = 0; dt < 8; ++dt) C.vf[dt] = *(const LAS bf16x8*)(VC + (16 * dt + q) * ATT_VC_PITCH + (32 * cc + 8 * g) * 2);
}
__device__ __forceinline__ void attn_compute(const AttnK& C, const AttnV& V, const bf16x8 (&qf)[4], f32x4 (&o)[8], float& mrun, float& lsum, int lane, int g,
                                             bool masked, int keycol0, int cs, const LAS float* brow  , int cq) {
    f32x4 s[2];
#pragma unroll
    for (int T = 0; T < 2; ++T) { s[T] = (f32x4){0.f, 0.f, 0.f, 0.f};
#pragma unroll
        for (int dc = 0; dc < 4; ++dc) s[T] = MFMA16(C.kf[T][dc], qf[dc], s[T]); }
    if (masked) {
#pragma unroll
        for (int T = 0; T < 2; ++T)
#pragma unroll
            for (int i = 0; i < 4; ++i) { const int keycol = keycol0 + 8 * g + 4 * T + i; const bool ok = keycol >= cs && keycol < cs + 16;
                const int dcol = keycol - cq + 15; const float bv = brow[ok ? dcol : 0];
                s[T][i] = ok ? s[T][i] + bv : -1e30f; }
    }
    float cm = fmaxf(fmaxf(fmaxf(s[0][0], s[0][1]), fmaxf(s[0][2], s[0][3])), fmaxf(fmaxf(s[1][0], s[1][1]), fmaxf(s[1][2], s[1][3])));
    cm = fmaxf(cm, lane_read(cm, lane ^ 16)); cm = fmaxf(cm, lane_read(cm, lane ^ 32));
    const float mnew = fmaxf(mrun, cm), alpha = __builtin_amdgcn_exp2f(mrun - mnew);
    mrun = mnew;
    float p[8]; float ps = 0.f;
#pragma unroll
    for (int T = 0; T < 2; ++T)
#pragma unroll
        for (int i = 0; i < 4; ++i) { p[4 * T + i] = __builtin_amdgcn_exp2f(s[T][i] - mnew); ps += p[4 * T + i]; }
    lsum = lsum * alpha + ps;
    v4u pw; pw.x = pg8::cvt_pk_bf16(p[0], p[1]); pw.y = pg8::cvt_pk_bf16(p[2], p[3]); pw.z = pg8::cvt_pk_bf16(p[4], p[5]); pw.w = pg8::cvt_pk_bf16(p[6], p[7]);
    const bf16x8 pf = __builtin_bit_cast(bf16x8, pw);
#pragma unroll
    for (int dt = 0; dt < 8; ++dt) { o[dt] = o[dt] * alpha; o[dt] = MFMA16(V.vf[dt], pf, o[dt]); }
}
__device__ __forceinline__ void attn_tile(Frame& F, bool is_lat, int b, int h, int r, int c0, int qrow0, const LAS float* bias_h) {
    const GAS bf16* QK = WSP(bf16, WS_QK); const GAS bf16* VT = WSP(bf16, WS_VT); GAS bf16* A = WSP(bf16, WS_A);
    const int q = F.lane & 15, g = F.lane >> 4;
    bf16x8 qf[4];
    { const GAS bf16* qp = QK + (size_t)(qrow0 + q) * 2048 + h * 128 + 8 * g;
#pragma unroll
      for (int dc = 0; dc < 4; ++dc) qf[dc] = *(const GAS bf16x8*)(qp + 32 * dc); }
    f32x4 o[8];
#pragma unroll
    for (int dt = 0; dt < 8; ++dt) o[dt] = (f32x4){0.f, 0.f, 0.f, 0.f};
    float mrun = -1e30f, lsum = 0.f;
    const int r0 = min(max(r - 4, 0), GROWS - 8), kc0 = min(max(c0 - 8, 0), 32), cq = c0 + q, cs = min(max(cq - 8, 0), 48);
    const GAS bf16* kh = QK + 1024 + h * 128; const GAS bf16* vh = VT + (size_t)(h * 128) * MT;
#define ATT_TOK(c) ((c) < 8 ? b * SEQ + (r0 + (c)) * GRIDW + kc0 : ML + b * CTXL + 32 * ((c) - 8))
#define ATT_LOADK(C, c) do { if ((c) < 8) { const int tok_ = ATT_TOK(c); attn_load_k(C, kh + (size_t)tok_ * 2048, q, g); } else attn_load_k_ctx(C, F.lds + ATT_KC_OFF, (c) - 8, q, g); } while (0)
#define ATT_LOADV(C, c) do { if ((c) < 8) { const int tok_ = ATT_TOK(c); attn_load_v(C, vh + tok_, q, g); } else attn_load_v_ctx(C, F.lds + ATT_VC_OFF, (c) - 8, q, g); } while (0)
#define ATT_COMP(C, V, c) attn_compute(C, V, qf, o, mrun, lsum, F.lane, g, (c) < 8, kc0, cs, bias_h + (r0 + ((c) < 8 ? (c) : 0) - r + 7) * 31, cq)
    AttnK KA, KB; AttnV VV;
    const int cbeg = is_lat ? 0 : 8;
    ATT_LOADK(KA, cbeg);
    for (int c = cbeg; c < 16; c += 2) {
        ATT_LOADV(VV, c); ATT_LOADK(KB, c + 1); __builtin_amdgcn_sched_barrier(0);
        ATT_COMP(KA, VV, c); __builtin_amdgcn_sched_barrier(0);
        ATT_LOADV(VV, c + 1); if (c + 2 < 16) ATT_LOADK(KA, c + 2);
        __builtin_amdgcn_sched_barrier(0);
        ATT_COMP(KB, VV, c + 1); __builtin_amdgcn_sched_barrier(0);
    }
#undef ATT_TOK
#undef ATT_LOADK
#undef ATT_LOADV
#undef ATT_COMP
    lsum += lane_read(lsum, F.lane ^ 16); lsum += lane_read(lsum, F.lane ^ 32);
    const float inv = 1.0f / lsum;
    GAS bf16* ap = A + (size_t)(qrow0 + q) * 1024 + h * 128 + 4 * g;
#pragma unroll
    for (int dt = 0; dt < 8; ++dt) { v2u w; w.x = pg8::cvt_pk_bf16(o[dt][0] * inv, o[dt][1] * inv); w.y = pg8::cvt_pk_bf16(o[dt][2] * inv, o[dt][3] * inv); *(GAS v2u*)(ap + 16 * dt) = w; }
}
__device__ __forceinline__ void attn_phase(Frame& F, int l, bool with_ctx) {
    LAS float* bias = (LAS float*)(F.lds + ATT_BIAS_OFF);
    const GAS float* p_rpb = IN(na_rpb) + (size_t)l * NHEAD * 465;
    for (int i = F.tid; i < NHEAD * 465; i += NTHR) bias[i] = p_rpb[i] * LOG2E;
    const GAS bf16* QK = WSP(bf16, WS_QK); const GAS bf16* VT = WSP(bf16, WS_VT);
    for (int wgi = F.vcu; wgi < 256; wgi += F.G) {
        const int bh = wgi >> 4, b = bh >> 3, h = bh & 7, sub = wgi & 15;
        __syncthreads();
#pragma unroll 4
        for (int i = F.tid; i < 256 * 16; i += NTHR) { const int row = i >> 4, pc = i & 15;
            *(LAS v4u*)(F.lds + ATT_KC_OFF + row * ATT_KC_PITCH + pc * 16) = *(const GAS v4u*)(QK + (size_t)(ML + b * CTXL + row) * 2048 + 1024 + h * 128 + 8 * pc); }
#pragma unroll 4
        for (int i = F.tid; i < 128 * 32; i += NTHR) { const int row = i >> 5, pc = i & 31;
            *(LAS v4u*)(F.lds + ATT_VC_OFF + row * ATT_VC_PITCH + pc * 16) = *(const GAS v4u*)(VT + (size_t)(h * 128 + row) * MT + ML + b * CTXL + 8 * pc); }
        __syncthreads();
        const int rb = sub * 2 + (F.wave >> 2), c0 = 16 * (F.wave & 3);
        for (int rr = 0; rr < 8; ++rr) { const int r = rb * 8 + rr; attn_tile(F, true, b, h, r, c0, b * SEQ + r * GRIDW + c0, bias + h * 465); }
        if (with_ctx) {
            if ((F.wave & 3) == 0) { const int t = sub; if ((F.wave >> 2) == (t & 1)) attn_tile(F, false, b, h, 0, 0, ML + b * CTXL + 16 * t, bias + h * 465); }
        }
    }
    __syncthreads();
}

constexpr int FFTN = 16384, FFT_PHYS = FFTN + FFTN / 16;
__device__ __forceinline__ int phys(int i) { return i + ((i >> 6) << 2); }
__device__ __forceinline__ f32x2 tw32k(const LAS f32x2* TH, const LAS f32x2* TL, int n) { return cmul(TH[n >> 7], TL[n & 127]); }
template <bool INV> __device__ __forceinline__ void r4(f32x2& x0, f32x2& x1, f32x2& x2, f32x2& x3) {
    const f32x2 a = x0 + x2, c = x0 - x2, b = x1 + x3, e = x1 - x3;
    const f32x2 d = INV ? (f32x2){-e.y, e.x} : (f32x2){e.y, -e.x};
    x0 = a + b; x1 = c + d; x2 = a - b; x3 = c - d;
}
template <bool INV> __device__ __forceinline__ void dft16(f32x2 (&x)[16]) {
#pragma unroll
    for (int b = 0; b < 4; ++b) r4<INV>(x[b], x[4 + b], x[8 + b], x[12 + b]);
    const float sg = INV ? -1.f : 1.f;
    const f32x2 W1 = {0.92387953251f, -0.38268343236f * sg}, W2 = {0.70710678118f, -0.70710678118f * sg}, W3 = {0.38268343236f, -0.92387953251f * sg},
                W4 = {0.f, -1.f * sg}, W6 = {-0.70710678118f, -0.70710678118f * sg}, W9 = {-0.92387953251f, 0.38268343236f * sg};
    x[5] = cmul(x[5], W1); x[9] = cmul(x[9], W2); x[13] = cmul(x[13], W3);
    x[6] = cmul(x[6], W2); x[10] = cmul(x[10], W4); x[14] = cmul(x[14], W6);
    x[7] = cmul(x[7], W3); x[11] = cmul(x[11], W6); x[15] = cmul(x[15], W9);
#pragma unroll
    for (int c = 0; c < 4; ++c) r4<INV>(x[4 * c], x[4 * c + 1], x[4 * c + 2], x[4 * c + 3]);
}
template <bool INV> __device__ __forceinline__ void bfly16(f32x2 (&x)[16], const LAS f32x2* TH, const LAS f32x2* TL, int tw) {
    f32x2 W = tw32k(TH, TL, tw); if (INV) W.y = -W.y;
    if (INV) { f32x2 p = W;
#pragma unroll
        for (int q = 1; q < 16; ++q) { x[q] = cmul(x[q], p); if (q < 15) p = cmul(p, W); } }
    dft16<INV>(x);
    if (!INV) { f32x2 p = W;
#pragma unroll
        for (int r = 1; r < 16; ++r) { x[4 * (r & 3) + (r >> 2)] = cmul(x[4 * (r & 3) + (r >> 2)], p); if (r < 15) p = cmul(p, W); } }
}
template <bool INV> __device__ __forceinline__ void pass16(LAS f32x2* X, const LAS f32x2* TH, const LAS f32x2* TL, int base, int stride, int tw) {
    f32x2 x[16];
#pragma unroll
    for (int q = 0; q < 16; ++q) x[q] = X[base + q * stride];
    bfly16<INV>(x, TH, TL, tw);
#pragma unroll
    for (int c = 0; c < 4; ++c)
#pragma unroll
        for (int d = 0; d < 4; ++d) X[base + (c + 4 * d) * stride] = x[4 * c + d];
}
template <bool INV> __device__ __forceinline__ void pass16_s4(LAS f32x2* X, const LAS f32x2* TH, const LAS f32x2* TL, int blk, int h) {
    LAS f32x4* P = (LAS f32x4*)(X + blk * 68 + 2 * h);
    f32x2 xa[16], xb[16];
#pragma unroll
    for (int q = 0; q < 16; ++q) { const f32x4 v = P[2 * q]; xa[q] = (f32x2){v.x, v.y}; xb[q] = (f32x2){v.z, v.w}; }
    bfly16<INV>(xa, TH, TL, (2 * h) * 512); bfly16<INV>(xb, TH, TL, (2 * h + 1) * 512);
#pragma unroll
    for (int c = 0; c < 4; ++c)
#pragma unroll
        for (int d = 0; d < 4; ++d) P[2 * (c + 4 * d)] = (f32x4){xa[4 * c + d].x, xa[4 * c + d].y, xb[4 * c + d].x, xb[4 * c + d].y};
}
template <bool INV> __device__ __forceinline__ void pass4_s1(LAS f32x2* X, int b) {
    LAS f32x4* P = (LAS f32x4*)(X + 4 * b + ((b >> 4) << 2));
    const f32x4 u = P[0], v = P[1];
    f32x2 x0 = {u.x, u.y}, x1 = {u.z, u.w}, x2 = {v.x, v.y}, x3 = {v.z, v.w};
    r4<INV>(x0, x1, x2, x3);
    P[0] = (f32x4){x0.x, x0.y, x1.x, x1.y}; P[1] = (f32x4){x2.x, x2.y, x3.x, x3.y};
}
__device__ __forceinline__ void fft_fwd(LAS f32x2* X, const LAS f32x2* TH, const LAS f32x2* TL, int tid) {
#pragma unroll 1
    for (int i = 0; i < 2; ++i) { const int j = tid + NTHR * i; pass16<false>(X, TH, TL, j + ((j >> 6) << 2), 1088, 2 * j); }
    __syncthreads();
#pragma unroll 1
    for (int i = 0; i < 2; ++i) { const int b = tid + NTHR * i, j = b & 63, blk = b >> 6; pass16<false>(X, TH, TL, blk * 1088 + j, 68, 32 * j); }
    __syncthreads();
    pass16_s4<false>(X, TH, TL, tid >> 1, tid & 1);
    __syncthreads();
#pragma unroll 2
    for (int i = 0; i < 8; ++i) pass4_s1<false>(X, tid + NTHR * i);
    __syncthreads();
}
__device__ __forceinline__ void fft_inv(LAS f32x2* X, const LAS f32x2* TH, const LAS f32x2* TL, int tid) {
#pragma unroll 2
    for (int i = 0; i < 8; ++i) pass4_s1<true>(X, tid + NTHR * i);
    __syncthreads();
    pass16_s4<true>(X, TH, TL, tid >> 1, tid & 1);
    __syncthreads();
#pragma unroll 1
    for (int i = 0; i < 2; ++i) { const int b = tid + NTHR * i, j = b & 63, blk = b >> 6; pass16<true>(X, TH, TL, blk * 1088 + j, 68, 32 * j); }
    __syncthreads();
#pragma unroll 1
    for (int i = 0; i < 2; ++i) { const int j = tid + NTHR * i; pass16<true>(X, TH, TL, j + ((j >> 6) << 2), 1088, 2 * j); }
    __syncthreads();
}
__device__ __forceinline__ int freq_pos(int k) { return phys(((k & 15) << 10) | (((k >> 4) & 15) << 6) | (((k >> 8) & 15) << 2) | (k >> 12)); }

__device__ __forceinline__ float conv3(const GAS float* p, int n, int Lq, float w0, float w1, float w2, float bb) {
    float a = p[n] * w1 + bb; if (n > 0) a += p[n - 1] * w0; if (n < Lq - 1) a += p[n + 1] * w2; return a;
}
__device__ __forceinline__ f32x4 conv3v(const GAS float* p, int n0, int Lq, float w0, float w1, float w2, float bb) {
    const f32x4 c = *(const GAS f32x4*)(p + n0); const float l = n0 > 0 ? p[n0 - 1] : 0.f, r = n0 + 4 < Lq ? p[n0 + 4] : 0.f;
    return (f32x4){w0 * l + w1 * c.x + w2 * c.y + bb, w0 * c.x + w1 * c.y + w2 * c.z + bb, w0 * c.y + w1 * c.z + w2 * c.w + bb, w0 * c.z + w1 * c.w + w2 * r + bb};
}
__device__ __forceinline__ void tw4(const LAS f32x2* TH, const LAS f32x2* TL, int n0, f32x2 (&w)[4]) {
    const f32x2 th = TH[n0 >> 7]; const LAS f32x4* tl = (const LAS f32x4*)(TL + (n0 & 127)); const f32x4 a = tl[0], b = tl[1];
    w[0] = cmul(th, (f32x2){a.x, a.y}); w[1] = cmul(th, (f32x2){a.z, a.w}); w[2] = cmul(th, (f32x2){b.x, b.y}); w[3] = cmul(th, (f32x2){b.z, b.w});
}

#define LT() ({ int lt_ = tid; asm volatile("" : "+v"(lt_)); lt_; })
__device__ __forceinline__ void hyena_latent(Frame& F, int l, int ch, LAS f32x2* X, const LAS f32x2* TH, const LAS f32x2* TL, GAS f32x2* KS) {
    GAS float* T32 = WSP(float, WS_T32);
    GAS float* hv = T32 + (size_t)(512 + ch) * MT; const GAS float* hx1 = T32 + (size_t)(1024 + ch) * MT; const GAS float* hx2 = T32 + (size_t)(1536 + ch) * MT;
    const GAS float* cw = IN(hy_conv_w) + (size_t)l * 3 * 1536; const GAS float* cb = IN(hy_conv_b) + (size_t)l * 1536;
    const GAS float* HF = WSP(float, WS_HF); const GAS float* p_hb = IN(hy_bias) + (size_t)l * 2 * HYW + ch;
    const int tid = F.tid;
    constexpr int KR = 6;
    GAS f32x4* KS4 = (GAS f32x4*)KS; GAS f32x4* KE4 = KS4 + FFTN / 2;
    f32x4 kreg[2 * KR];
    for (int o = 0; o < 2; ++o) {
        const GAS float* hf = HF + (size_t)(o * 1024 + ch) * SEQ; const GAS float* hbr = HF + (size_t)(o * 1024 + 512 + ch) * SEQ;
        const float bias = p_hb[o * HYW];
        const float vw0 = cw[ch], vw1 = cw[1536 + ch], vw2 = cw[3072 + ch], vbb = cb[ch];
        const GAS float* hx = o == 0 ? hx1 : hx2; const int xo = o == 0 ? 512 : 1024;
        const float xw0 = cw[xo + ch], xw1 = cw[1536 + xo + ch], xw2 = cw[3072 + xo + ch], xbb = cb[xo + ch];
        for (int par = 0; par < 2; ++par) {
#pragma unroll
            for (int i = 0; i < 8; ++i) { const int g = LT() + NTHR * i, n0 = 4 * g; const f32x4 f = *(const GAS f32x4*)(hf + n0), bk = *(const GAS f32x4*)(hbr + n0);
                LAS f32x4* XP = (LAS f32x4*)(X + phys(n0));
                if (par == 0) { XP[0] = (f32x4){f.x + bk.x, 0.f, f.y + bk.y, 0.f}; XP[1] = (f32x4){f.z + bk.z, 0.f, f.w + bk.w, 0.f}; }
                else { f32x2 w[4]; tw4(TH, TL, n0, w); const f32x4 d = f - bk;
                    XP[0] = (f32x4){w[0].x * d.x, w[0].y * d.x, w[1].x * d.y, w[1].y * d.y}; XP[1] = (f32x4){w[2].x * d.z, w[2].y * d.z, w[3].x * d.w, w[3].y * d.w}; } }
            __syncthreads();
            fft_fwd(X, TH, TL, tid);
#pragma unroll
            for (int i = 0; i < 8; ++i) { const int g = LT() + NTHR * i; const LAS f32x4* XP = (const LAS f32x4*)(X + phys(4 * g)); if (i < KR) { kreg[2 * i] = XP[0]; kreg[2 * i + 1] = XP[1]; } else { KS4[2 * g] = XP[0]; KS4[2 * g + 1] = XP[1]; } }
            __syncthreads();
#pragma unroll 2
            for (int i = 0; i < 8; ++i) { const int g = LT() + NTHR * i, n0 = 4 * g;
                f32x4 z0, z1; if (o == 0) { z0 = conv3v(hv, n0, SEQ, vw0, vw1, vw2, vbb); z1 = conv3v(hv + SEQ, n0, SEQ, vw0, vw1, vw2, vbb); } else { z0 = *(const GAS f32x4*)(hv + n0); z1 = *(const GAS f32x4*)(hv + SEQ + n0); }
                LAS f32x4* XP = (LAS f32x4*)(X + phys(n0));
                if (par == 0) { XP[0] = (f32x4){z0.x, z1.x, z0.y, z1.y}; XP[1] = (f32x4){z0.z, z1.z, z0.w, z1.w}; }
                else { f32x2 w[4]; tw4(TH, TL, n0, w);
                    const f32x2 a0 = cmul((f32x2){z0.x, z1.x}, w[0]), a1 = cmul((f32x2){z0.y, z1.y}, w[1]), a2 = cmul((f32x2){z0.z, z1.z}, w[2]), a3 = cmul((f32x2){z0.w, z1.w}, w[3]);
                    XP[0] = (f32x4){a0.x, a0.y, a1.x, a1.y}; XP[1] = (f32x4){a2.x, a2.y, a3.x, a3.y}; } }
            __syncthreads();
#if defined(PROBE_FFTCORE)
            fft_fwd(X, TH, TL, tid); fft_inv(X, TH, TL, tid);
            for (int i = 0; i < 8; ++i) { const int g = LT() + NTHR * i; LAS f32x4* XP = (LAS f32x4*)(X + phys(4 * g)); XP[0] = XP[0] * (1.0f / 16384.0f); XP[1] = XP[1] * (1.0f / 16384.0f); }
            __syncthreads();
#endif
            fft_fwd(X, TH, TL, tid);
#pragma unroll
            for (int i = 0; i < 8; ++i) { const int g = LT() + NTHR * i; LAS f32x4* XP = (LAS f32x4*)(X + phys(4 * g)); f32x4 k0, k1; if (i < KR) { k0 = kreg[2 * i]; k1 = kreg[2 * i + 1]; } else { k0 = KS4[2 * g]; k1 = KS4[2 * g + 1]; } const f32x4 u0 = XP[0], u1 = XP[1];
                const f32x2 a0 = cmul((f32x2){u0.x, u0.y}, (f32x2){k0.x, k0.y}), a1 = cmul((f32x2){u0.z, u0.w}, (f32x2){k0.z, k0.w}), a2 = cmul((f32x2){u1.x, u1.y}, (f32x2){k1.x, k1.y}), a3 = cmul((f32x2){u1.z, u1.w}, (f32x2){k1.z, k1.w});
                XP[0] = (f32x4){a0.x, a0.y, a1.x, a1.y}; XP[1] = (f32x4){a2.x, a2.y, a3.x, a3.y};
                if (i & 1) asm volatile("" ::: "memory"); }
            __syncthreads();
            fft_inv(X, TH, TL, tid);
            if (par == 0) {
#pragma unroll
                for (int i = 0; i < 8; ++i) { const int g = LT() + NTHR * i; const LAS f32x4* XP = (const LAS f32x4*)(X + phys(4 * g)); KE4[2 * g] = XP[0]; KE4[2 * g + 1] = XP[1]; }
                __syncthreads();
            }
        }
#pragma unroll 4
        for (int i = 0; i < 8; ++i) { const int g = LT() + NTHR * i, n0 = 4 * g;
            f32x4 z0, z1; if (o == 0) { z0 = conv3v(hv, n0, SEQ, vw0, vw1, vw2, vbb); z1 = conv3v(hv + SEQ, n0, SEQ, vw0, vw1, vw2, vbb); } else { z0 = *(const GAS f32x4*)(hv + n0); z1 = *(const GAS f32x4*)(hv + SEQ + n0); }
            const f32x4 g0 = conv3v(hx, n0, SEQ, xw0, xw1, xw2, xbb), g1 = conv3v(hx + SEQ, n0, SEQ, xw0, xw1, xw2, xbb);
            const f32x4 e0 = KE4[2 * g], e1 = KE4[2 * g + 1];
            LAS f32x4* XP = (LAS f32x4*)(X + phys(n0)); const f32x4 u0 = XP[0], u1 = XP[1];
            f32x2 w[4]; tw4(TH, TL, n0, w);
            const f32x2 c0 = cmul((f32x2){u0.x, u0.y}, cconj(w[0])), c1 = cmul((f32x2){u0.z, u0.w}, cconj(w[1])), c2 = cmul((f32x2){u1.x, u1.y}, cconj(w[2])), c3 = cmul((f32x2){u1.z, u1.w}, cconj(w[3]));
            const float sc = 1.0f / 32768.0f;
            const f32x2 y0 = ((f32x2){e0.x, e0.y} + c0) * sc + (f32x2){z0.x, z1.x} * bias, y1 = ((f32x2){e0.z, e0.w} + c1) * sc + (f32x2){z0.y, z1.y} * bias,
                        y2 = ((f32x2){e1.x, e1.y} + c2) * sc + (f32x2){z0.z, z1.z} * bias, y3 = ((f32x2){e1.z, e1.w} + c3) * sc + (f32x2){z0.w, z1.w} * bias;
            XP[0] = (f32x4){g0.x * y0.x, g0.y * y1.x, g0.z * y2.x, g0.w * y3.x};
            XP[1] = (f32x4){g1.x * y0.y, g1.y * y1.y, g1.z * y2.y, g1.w * y3.y}; }
        __syncthreads();
#pragma unroll
        for (int i = 0; i < 8; ++i) { const int g = LT() + NTHR * i, n0 = 4 * g; const LAS f32x4* XP = (const LAS f32x4*)(X + phys(n0)); *(GAS f32x4*)(hv + n0) = XP[0]; *(GAS f32x4*)(hv + SEQ + n0) = XP[1]; }
        __syncthreads();
    }
}
__device__ __forceinline__ void fourier_latent(Frame& F, int b, int gq, int m, LAS f32x2* X, const LAS f32x2* TH, const LAS f32x2* TL) {
    GAS float* T32 = WSP(float, WS_T32);
    GAS float* ra = T32 + (size_t)(gq * 128 + m) * MT + b * SEQ; GAS float* rb = T32 + (size_t)(gq * 128 + 64 + m) * MT + b * SEQ;
    const int tid = F.tid;
#pragma unroll
    for (int i = 0; i < 8; ++i) { const int g = LT() + NTHR * i, n0 = 4 * g; const f32x4 a = *(const GAS f32x4*)(ra + n0), c = *(const GAS f32x4*)(rb + n0);
        LAS f32x4* XP = (LAS f32x4*)(X + phys(n0)); XP[0] = (f32x4){a.x, c.x, a.y, c.y}; XP[1] = (f32x4){a.z, c.z, a.w, c.w}; }
    __syncthreads();
    fft_fwd(X, TH, TL, tid);
    const float sc = 6.9053396600248786e-4f;
#pragma unroll 2
    for (int i = 0; i < 8; ++i) { const int g = LT() + NTHR * i, k0 = 4 * g; f32x4 oa, ob;
#pragma unroll
        for (int e = 0; e < 4; ++e) { const int k = k0 + e; const f32x2 u = X[freq_pos(k)], v = X[freq_pos((FFTN - k) & (FFTN - 1))];
            if (m != 0) { oa[e] = u.x * sc; ob[e] = v.x * sc; } else { oa[e] = (u.x + v.x) * (0.5f * sc); ob[e] = (u.y + v.y) * (0.5f * sc); } }
        *(GAS f32x4*)(ra + k0) = oa; *(GAS f32x4*)(rb + k0) = ob; }
    __syncthreads();
}
__device__ __forceinline__ void hyena_ctx(Frame& F, int l, int ch, LAS float* S) {
    GAS float* T32 = WSP(float, WS_T32);
    GAS float* hv = T32 + (size_t)(512 + ch) * MT + ML; const GAS float* hx1 = T32 + (size_t)(1024 + ch) * MT + ML; const GAS float* hx2 = T32 + (size_t)(1536 + ch) * MT + ML;
    const GAS float* cw = IN(hy_conv_w) + (size_t)l * 3 * 1536; const GAS float* cb = IN(hy_conv_b) + (size_t)l * 1536;
    const GAS float* HFC = WSP(float, WS_HFC); const GAS float* p_hb = IN(hy_bias) + (size_t)l * 2 * HYW + ch;
    LAS float* zb = S; LAS float* hfl = S + 512; LAS float* hbl = S + 768;
    const int n = F.tid & 255, b = F.tid >> 8;
    __syncthreads();
    zb[b * 256 + n] = conv3(hv + b * CTXL, n, CTXL, cw[ch], cw[1536 + ch], cw[3072 + ch], cb[ch]);
    for (int o = 0; o < 2; ++o) {
        if (F.tid < 256) hfl[n] = HFC[(size_t)(o * 1024 + ch) * CTXL + n]; else hbl[n] = HFC[(size_t)(o * 1024 + 512 + ch) * CTXL + n];
        __syncthreads();
        float y = 0.f;
        for (int mI = 0; mI < CTXL; ++mI) { const int d = n - mI; y += zb[b * 256 + mI] * (d >= 0 ? hfl[d] : hbl[CTXL + d]); }
        y += p_hb[o * HYW] * zb[b * 256 + n];
        const GAS float* hx = o == 0 ? hx1 : hx2; const int xo = o == 0 ? 512 : 1024;
        const float r = conv3(hx + b * CTXL, n, CTXL, cw[xo + ch], cw[1536 + xo + ch], cw[3072 + xo + ch], cb[xo + ch]) * y;
        __syncthreads();
        if (o == 0) zb[b * 256 + n] = r; else hv[b * CTXL + n] = r;
        __syncthreads();
    }
}
__device__ __forceinline__ void fourier_ctx(Frame& F, int item, LAS float* S) {
    GAS float* T32 = WSP(float, WS_T32);
    const int b = item >> 7, gq = (item >> 5) & 3, m0 = (item & 31) * 2;
    LAS float* cs = S; LAS float* re = S + 256; LAS float* im = S + 256 + 512;
    __syncthreads();
    if (F.tid < 256) cs[F.tid] = cospif((float)F.tid * (1.0f / 128.0f));
    { const int mm = F.tid >> 8, n = F.tid & 255;
      re[F.tid] = T32[(size_t)(gq * 128 + m0 + mm) * MT + ML + b * CTXL + n]; im[F.tid] = T32[(size_t)(gq * 128 + 64 + m0 + mm) * MT + ML + b * CTXL + n]; }
    __syncthreads();
    const int k = F.tid & 255, mm = F.tid >> 8, m = m0 + mm;
    const float sc = 5.5242717280199031e-3f;
    float cr = 0.f, ci = 0.f, sr = 0.f, si = 0.f;
#pragma unroll 4
    for (int n = 0; n < 256; ++n) { const int ix = (k * n) & 255; const float c = cs[ix], sn = cs[(ix - 64) & 255]; const float a = re[mm * 256 + n], bq = im[mm * 256 + n];
        cr += a * c; ci += bq * c; sr += a * sn; si += bq * sn; }
    float oa, ob;
    if (m != 0) { oa = cr + si; ob = cr - si; } else { oa = cr; ob = ci; }
    T32[(size_t)(gq * 128 + m) * MT + ML + b * CTXL + k] = oa * sc; T32[(size_t)(gq * 128 + 64 + m) * MT + ML + b * CTXL + k] = ob * sc;
    __syncthreads();
}
__device__ __forceinline__ void fft_phase(Frame& F, int l, bool with_ctx) {
    LAS f32x2* X = (LAS f32x2*)F.lds;
    LAS f32x2* TH = (LAS f32x2*)(F.lds + TW_OFF); LAS f32x2* TL = TH + 128;
    if (F.tid < 256) { const int a = F.tid & 127; const float fr = F.tid < 128 ? (float)(128 * a) * (1.0f / 16384.0f) : (float)a * (1.0f / 16384.0f);
        float sn, cn; sincospif(fr, &sn, &cn); (F.tid < 128 ? TH : TL)[a] = (f32x2){cn, -sn}; }
    __syncthreads();
    for (int ch = F.vcu; ch < HYW; ch += F.G) hyena_latent(F, l, ch, X, TH, TL, WSP(f32x2, WS_KS) + (size_t)F.vcu * 2 * FFTN);
    for (int fu = F.vcu; fu < 512; fu += F.G) fourier_latent(F, fu >> 8, (fu >> 6) & 3, fu & 63, X, TH, TL);
    if (with_ctx) {
        LAS float* S = (LAS float*)F.lds;
        for (int ch = F.vcu; ch < HYW; ch += F.G) hyena_ctx(F, l, ch, S);
        for (int it = F.vcu; it < 256; it += F.G) fourier_ctx(F, it, S);
    }
}

__device__ __forceinline__ void merge_phase(Frame& F, int l, bool with_ctx) {
    const GAS bf16* A = WSP(bf16, WS_A); const GAS float* T32 = WSP(float, WS_T32); GAS bf16* H = WSP(bf16, WS_H);
    const GAS float* gain = IN(mix_norm_g) + (size_t)l * DM;
    LAS float* tile = (LAS float*)F.lds;
    const int TI = with_ctx ? 65 : 64;
    for (int it = F.vcu; it < 512; it += F.G) {
        const int tok0 = it * TI;
        for (int tk = F.wave; tk < TI; tk += NWAVES) {
            const size_t row = (size_t)(tok0 + tk);
            const v4u r0 = *(const GAS v4u*)(A + row * 1024 + 8 * F.lane), r1 = *(const GAS v4u*)(A + row * 1024 + 512 + 8 * F.lane);
            float v[16];
            v[0] = bf2f(r0.x & 0xffff); v[1] = bf2f(r0.x >> 16); v[2] = bf2f(r0.y & 0xffff); v[3] = bf2f(r0.y >> 16); v[4] = bf2f(r0.z & 0xffff); v[5] = bf2f(r0.z >> 16); v[6] = bf2f(r0.w & 0xffff); v[7] = bf2f(r0.w >> 16);
            v[8] = bf2f(r1.x & 0xffff); v[9] = bf2f(r1.x >> 16); v[10] = bf2f(r1.y & 0xffff); v[11] = bf2f(r1.y >> 16); v[12] = bf2f(r1.z & 0xffff); v[13] = bf2f(r1.z >> 16); v[14] = bf2f(r1.w & 0xffff); v[15] = bf2f(r1.w >> 16);
            float ss = 0.f;
#pragma unroll
            for (int j = 0; j < 16; ++j) ss += v[j] * v[j];
            const float rstd = 1.0f / sqrtf(wave_sum(ss, F.lane) * (1.0f / NAW) + EPS);
            const f32x4 g0 = *(const GAS f32x4*)(gain + 8 * F.lane), g1 = *(const GAS f32x4*)(gain + 8 * F.lane + 4), g2 = *(const GAS f32x4*)(gain + 512 + 8 * F.lane), g3 = *(const GAS f32x4*)(gain + 512 + 8 * F.lane + 4);
            v4u o0, o1;
            o0.x = pk2(v[0] * rstd * g0.x, v[1] * rstd * g0.y); o0.y = pk2(v[2] * rstd * g0.z, v[3] * rstd * g0.w); o0.z = pk2(v[4] * rstd * g1.x, v[5] * rstd * g1.y); o0.w = pk2(v[6] * rstd * g1.z, v[7] * rstd * g1.w);
            o1.x = pk2(v[8] * rstd * g2.x, v[9] * rstd * g2.y); o1.y = pk2(v[10] * rstd * g2.z, v[11] * rstd * g2.w); o1.z = pk2(v[12] * rstd * g3.x, v[13] * rstd * g3.y); o1.w = pk2(v[14] * rstd * g3.z, v[15] * rstd * g3.w);
            *(GAS v4u*)(H + row * DM + 8 * F.lane) = o0; *(GAS v4u*)(H + row * DM + 512 + 8 * F.lane) = o1;
        }
        for (int grp = 0; grp < 2; ++grp) {
            __syncthreads();
            for (int c8 = F.wave * 64; c8 < F.wave * 64 + 64; c8 += 8) {
                float v[8], w[8];
#pragma unroll
                for (int u = 0; u < 8; ++u) { const GAS float* src = T32 + (size_t)(grp * 512 + c8 + u) * MT + tok0; v[u] = src[F.lane]; w[u] = (TI > 64 && F.lane == 0) ? src[64] : 0.f; }
#pragma unroll
                for (int u = 0; u < 8; ++u) { tile[(c8 + u) * 65 + F.lane] = v[u]; if (TI > 64 && F.lane == 0) tile[(c8 + u) * 65 + 64] = w[u]; }
            }
            __syncthreads();
            for (int tk = F.wave; tk < TI; tk += NWAVES) {
                float vv[8]; float ss = 0.f;
#pragma unroll
                for (int i = 0; i < 8; ++i) { const int chn = F.lane + 64 * i; int srow = chn;
                    if (grp == 0) { const int cc = chn & 127; srow = (chn & ~127) + (cc <= 64 ? cc : 192 - cc); }
                    vv[i] = tile[srow * 65 + tk]; ss += vv[i] * vv[i]; }
                const float rstd = 1.0f / sqrtf(wave_sum(ss, F.lane) * (1.0f / 512.0f) + EPS);
                GAS bf16* hp = H + (size_t)(tok0 + tk) * DM + NAW + grp * 512;
#pragma unroll
                for (int i = 0; i < 8; ++i) { const int chn = F.lane + 64 * i; hp[chn] = (bf16)f2bf(vv[i] * rstd * gain[NAW + grp * 512 + chn]); }
            }
        }
    }
}

#define REFRESH(F) do { int t_ = threadIdx.x; asm volatile("" : "+v"(t_)); F.tid = t_; F.lane = t_ & 63; F.wave = __builtin_amdgcn_readfirstlane(t_ >> 6); \
    GAS unsigned char* w_ = args.ws; asm volatile("" : "+s"(w_)); F.ws = w_; GAS float* o_ = args.out; asm volatile("" : "+s"(o_)); F.out = o_; } while (0)
#ifndef REP_P1
#define REP_P1 1
#endif
#ifndef REP_P6
#define REP_P6 1
#endif
#ifndef REP_ATT
#define REP_ATT 1
#endif
#ifndef REP_PA
#define REP_PA 1
#endif
#ifndef REP_THIN
#define REP_THIN 1
#endif
__device__ __forceinline__ int opaque_int(int v) { asm volatile("" : "+s"(v)); return v; }
__global__ void __launch_bounds__(NTHR, 2) fwd_kernel(Args args) {
    extern __shared__ __attribute__((aligned(16))) unsigned char lds[];
    Frame F;
    F.lds = (LAS unsigned char*)lds;
    F.tid = threadIdx.x; F.lane = F.tid & 63; F.wave = __builtin_amdgcn_readfirstlane(F.tid >> 6);
    F.G = gridDim.x; { const int bx = blockIdx.x; F.vcu = (F.G % 8 == 0) ? (bx % 8) * (F.G / 8) + bx / 8 : bx; }
    F.ws = args.ws; F.out = args.out;
    volatile LAS unsigned* MISC = (volatile LAS unsigned*)(F.lds + MISC_OFF);
    for (int u = F.tid; u < 64; u += NTHR) MISC[u] = 0u;
    __syncthreads();
    XcdBarrier bar = xcd_barrier_post((unsigned*)(F.ws + WS_CTL) + CW_BAR, MISC + 8);
    LAS unsigned char* ring = F.lds;
#define GRID_BAR() do { unsigned* bp_ = bar.bar; unsigned bx_ = bar.x; asm volatile("" : "+s"(bp_), "+s"(bx_)); XcdBarrier b_ = bar; b_.bar = bp_; b_.x = bx_; xcd_barrier(b_); } while (0)


#if !defined(OFF_PA)
    for (int rep = 0, nrep = opaque_int(REP_PA); rep < nrep; ++rep) { REFRESH(F); pa_adaln(F); __syncthreads(); pa_weights(F); __syncthreads(); pa_ctx_copy(F); }
#endif

    GRID_BAR();

    for (int l = 0; l < DEPTH; ++l) {
        const bool uc = l < DEPTH - 1;
        const int npm = uc ? PMT : PML;
        const GAS float* MODL = WSP(float, WS_MOD) + (size_t)l * 3 * (NMOD * DM);

#if !defined(OFF_P0)
        for (int rep = 0, nrep = opaque_int(REP_THIN); rep < nrep; ++rep) { REFRESH(F); norm_phase(F, l, 0, true, l > 0 ? 4 : 0); __syncthreads();
 REFRESH(F); filter_phase(F, l, uc); __syncthreads(); }
#endif

        GRID_BAR();
        {
            const char* Hb = (const char*)WSP(bf16, WS_H); const char* Wb = (const char*)(WSP(bf16, WS_WIN) + (size_t)l * DIN * DM);
            pg8::Sched2 S; S.n1 = PMT * 8; S.nM1 = PMT; S.nN1 = 8; S.n2 = 12 * PMT; S.nM2 = 12; S.nN2 = PMT; S.G = F.G; S.c = (int)blockIdx.x;
            S.A1 = Hb; S.B1 = Wb; S.A2 = Wb + (size_t)2048 * DM * 2; S.B2 = Hb; S.tstep = (size_t)256 * DM * 2;
            EpiIn E{WSP(bf16, WS_QK), WSP(bf16, WS_VT), WSP(float, WS_T32)};

#if !defined(OFF_P1)
            for (int rep = 0, nrep = opaque_int(REP_P1); rep < nrep; ++rep) { pg8::gemm_phase<EpiIn, pg8::Sched2, true, true>(ring, DM, DM, S, E); __syncthreads(); }
#endif

        }
        GRID_BAR();

#if !defined(OFF_ATT)
        for (int rep = 0, nrep = opaque_int(REP_ATT); rep < nrep; ++rep) { REFRESH(F); attn_phase(F, l, uc); }
#endif
#if !defined(OFF_FFT)
        REFRESH(F); fft_phase(F, l, uc);
#endif

        GRID_BAR();

#if !defined(OFF_P3)
        for (int rep = 0, nrep = opaque_int(REP_THIN); rep < nrep; ++rep) { REFRESH(F); merge_phase(F, l, uc); __syncthreads(); }
#endif

        GRID_BAR();
        {
            pg8::Sched2 S; S.n1 = PML * 8; S.nM1 = PML; S.nN1 = 8; S.n2 = 0; S.nM2 = 1; S.nN2 = 1; S.G = F.G; S.c = (int)blockIdx.x;
            S.A1 = (const char*)WSP(bf16, WS_H); S.B1 = (const char*)(WSP(bf16, WS_WOUT) + (size_t)l * DM * DM); S.A2 = S.A1; S.B2 = S.B1; S.tstep = (size_t)256 * DM * 2;
            EpiRes E{l == 0 ? IN(x) : F.out, WSP(float, WS_XC), F.out, WSP(float, WS_XC), MODL + 2 * DM};
#if !defined(OFF_P4)
            pg8::gemm_phase<EpiRes, pg8::Sched2, true, true>(ring, DM, DM, S, E);
#endif
            if (uc) {
                __syncthreads();
                pg8::SchedK SK; SK.nsub = 16 * 4; SK.nN = 8; SK.ksplit = 4; SK.pm0 = PML; SK.G = F.G; SK.c = (int)blockIdx.x; SK.A = S.A1; SK.B = S.B1; SK.tstep = S.tstep; SK.kbytes = 512 * 2;
                EpiSlab EA{WSP(float, WS_SLAB), MODL + 2 * DM};
#if !defined(OFF_P4)
                pg8::gemm_phase<EpiSlab, pg8::SchedK, true, true>(ring, DM, 512, SK, EA);
#endif
            }
        }
        GRID_BAR();

#if !defined(OFF_P5)
        for (int rep = 0, nrep = opaque_int(REP_THIN); rep < nrep; ++rep) { REFRESH(F); norm_phase(F, l, 1, uc, 4); }
#endif

        GRID_BAR();
        {
            pg8::Sched2 S; S.n1 = npm * 44; S.nM1 = npm; S.nN1 = 44; S.n2 = 0; S.nM2 = 1; S.nN2 = 1; S.G = F.G; S.c = (int)blockIdx.x;
            S.A1 = (const char*)WSP(bf16, WS_H); S.B1 = (const char*)(WSP(bf16, WS_WUP) + (size_t)l * 2 * DFF * DM); S.A2 = S.A1; S.B2 = S.B1; S.tstep = (size_t)256 * DM * 2;
            GAS float* EG = WSP(float, WS_EDGE);
            EpiUp E{WSP(bf16, WS_HID), EG, EG + EDGE_ELEMS, EG + 2 * EDGE_ELEMS, IN(ffn_conv_w) + (size_t)l * 3 * DFF, IN(ffn_conv_b) + (size_t)l * DFF};

#if !defined(OFF_P6)
            for (int rep = 0, nrep = opaque_int(REP_P6); rep < nrep; ++rep) { pg8::gemm_phase<EpiUp, pg8::Sched2, true, true>(ring, DM, DM, S, E); __syncthreads(); }
#endif

        }
        GRID_BAR();

#if !defined(OFF_P6B)
        for (int rep = 0, nrep = opaque_int(REP_THIN); rep < nrep; ++rep) { REFRESH(F); edge_fix_phase(F, l, uc); }
#endif

        GRID_BAR();
        {
            pg8::Sched2 S; S.n1 = PML * 8; S.nM1 = PML; S.nN1 = 8; S.n2 = 0; S.nM2 = 1; S.nN2 = 1; S.G = F.G; S.c = (int)blockIdx.x;
            S.A1 = (const char*)WSP(bf16, WS_HID); S.B1 = (const char*)(WSP(bf16, WS_WDN) + (size_t)l * DM * DFF); S.A2 = S.A1; S.B2 = S.B1; S.tstep = (size_t)256 * DFF * 2;
            EpiRes E{F.out, WSP(float, WS_XC), F.out, WSP(float, WS_XC), MODL + 5 * DM};
#if !defined(OFF_P7)
            pg8::gemm_phase<EpiRes, pg8::Sched2, true, true>(ring, DFF, DFF, S, E);
#endif
            if (uc) {
                __syncthreads();
                pg8::SchedK SK; SK.nsub = 16 * 4; SK.nN = 8; SK.ksplit = 4; SK.pm0 = PML; SK.G = F.G; SK.c = (int)blockIdx.x; SK.A = S.A1; SK.B = S.B1; SK.tstep = S.tstep; SK.kbytes = 1408 * 2;
                EpiSlab EA{WSP(float, WS_SLAB), MODL + 5 * DM};
#if !defined(OFF_P7)
                pg8::gemm_phase<EpiSlab, pg8::SchedK, true, true>(ring, DFF, 1408, SK, EA);
#endif
            }
        }
        GRID_BAR();
    }
    REFRESH(F); final_norm_phase(F);
}

extern "C" void kernel_launch(void* const* d_in, const int* in_sizes, int n_in, void* d_out, int out_size, void* d_ws, size_t ws_size, hipStream_t stream) {
    static int grid = 0;
    if (grid == 0) {
        if (n_in != 26 || in_sizes[0] != ML * DM || out_size != ML * DM || ws_size < WS_END) { fprintf(stderr, "kernel_launch: unexpected shapes (n_in %d, in0 %d, out %d, ws %zu < %zu)\n", n_in, n_in > 0 ? in_sizes[0] : -1, out_size, ws_size, (size_t)WS_END); grid = -1; return; }
        int dev = 0, cus = 0, per_cu = 0;
        if (hipGetDevice(&dev) != hipSuccess || hipDeviceGetAttribute(&cus, hipDeviceAttributeMultiprocessorCount, dev) != hipSuccess) { grid = -1; return; }
        if (hipFuncSetAttribute((const void*)fwd_kernel, hipFuncAttributeMaxDynamicSharedMemorySize, LDS_BYTES) != hipSuccess) { fprintf(stderr, "kernel_launch: hipFuncSetAttribute failed\n"); grid = -1; return; }
        if (hipOccupancyMaxActiveBlocksPerMultiprocessor(&per_cu, (const void*)fwd_kernel, NTHR, LDS_BYTES) != hipSuccess || per_cu < 1) { fprintf(stderr, "kernel_launch: occupancy query reports %d\n", per_cu); }
        (void)hipGetLastError();
        grid = cus;
    }
    if (grid < 0) return;
    if (hipMemsetAsync((char*)d_ws + WS_CTL, 0, CTL_ZERO_BYTES, stream) != hipSuccess) return;
    Args a{};
    for (int i = 0; i < 26; ++i) a.in[i] = (const GAS float*)d_in[i];
    a.out = (GAS float*)d_out; a.ws = (GAS unsigned char*)d_ws;
    hipLaunchKernelGGL(fwd_kernel, dim3(grid), dim3(NTHR), LDS_BYTES, stream, a);
}
```

```cpp
#include <hip/hip_runtime.h>
#include <cstdio>
#include <cstdint>
namespace pg8 {
#define PG8_LAS __attribute__((address_space(3)))
typedef unsigned short bf16_t;
typedef short bf16x8 __attribute__((ext_vector_type(8)));
typedef float f32x4 __attribute__((ext_vector_type(4)));
typedef unsigned u32x4 __attribute__((ext_vector_type(4)));
constexpr int BM = 256, BK = 64, HALF = 128, HTB = HALF * BK * 2  , STAGE_BYTES = 8 * HTB, NXCD = 8, WGM = 8;

__host__ __device__ __forceinline__ int lds_byte(int r, int c) { const int st = (r >> 4) * 2 + (c >> 5), rr = r & 15, cc = c & 31, ob = rr * 64 + cc * 2; return st * 1024 + (ob ^ (((ob >> 9) & 1) << 5)); }
__host__ __device__ __forceinline__ void stage_rc(int b, int& R, int& C) { const int st = b / 1024, sb = b % 1024, swz = sb ^ (((sb >> 9) & 1) << 5); R = (st >> 1) * 16 + swz / 64; C = (st & 1) * 32 + (swz % 64) / 2; }
__host__ __device__ __forceinline__ int perm32(int rho) { const int n = rho >> 4, i = rho & 15; return 8 * (i >> 2) + 4 * n + (i & 3); }

struct Unit { int pm, pn, type; };

__device__ __forceinline__ void map_unit(int w, int nwg, int nM, int nN, Unit& u) {
    { const int q = nwg / NXCD, r = nwg % NXCD, xcd = w % NXCD, off = w / NXCD; w = (xcd < r ? xcd * (q + 1) : r * (q + 1) + (xcd - r) * q) + off; }
    const int nig = WGM * nN, gid = w / nig, fm = gid * WGM, gsz = (nM - fm) < WGM ? (nM - fm) : WGM;
    u.pm = fm + ((w % nig) % gsz); u.pn = (w % nig) / gsz;
}
struct Sched2 {
    int n1, nM1, nN1, n2, nM2, nN2, G, c; const char *A1, *B1, *A2, *B2; size_t tstep;
    __device__ __forceinline__ bool next(int i, Unit& u) const {
        const long L = (long)i * G + c;
        if (L < n1) { map_unit((int)L, n1, nM1, nN1, u); u.type = 0; return true; }
        if (L < n1 + n2) { map_unit((int)L - n1, n2, nM2, nN2, u); u.type = 1; return true; }
        return false;
    }
    __device__ __forceinline__ const char* a_ptr(const Unit& u) const { return (u.type ? A2 : A1) + (size_t)u.pm * tstep; }
    __device__ __forceinline__ const char* b_ptr(const Unit& u) const { return (u.type ? B2 : B1) + (size_t)u.pn * tstep; }
    __device__ __forceinline__ void a_ready(const Unit&) const {}
    __device__ __forceinline__ void done(const Unit&) const {}
};

struct SchedK {
    int nsub, nN, ksplit, pm0, G, c; const char *A, *B; size_t tstep, kbytes;
    __device__ __forceinline__ bool next(int i, Unit& u) const {
        const long L = (long)i * G + c; if (L >= nsub) return false;
        const int j = (int)L / ksplit; u.type = (int)L % ksplit; u.pm = pm0 + j / nN; u.pn = j % nN; return true;
    }
    __device__ __forceinline__ const char* a_ptr(const Unit& u) const { return A + (size_t)u.pm * tstep + (size_t)u.type * kbytes; }
    __device__ __forceinline__ const char* b_ptr(const Unit& u) const { return B + (size_t)u.pn * tstep + (size_t)u.type * kbytes; }
    __device__ __forceinline__ void a_ready(const Unit&) const {}
    __device__ __forceinline__ void done(const Unit&) const {}
};

__device__ __forceinline__ unsigned cvt_pk_bf16(float lo, float hi) { unsigned r; asm volatile("v_cvt_pk_bf16_f32 %0, %1, %2" : "=v"(r) : "v"(lo), "v"(hi)); return r; }
typedef float f32x2 __attribute__((ext_vector_type(2)));

template <class Epi, class Sched, bool ALIGN_EPI = false, bool SP2 = false>
__device__ __forceinline__ void gemm_phase(PG8_LAS unsigned char* lds, const int Kdim  , const int Klen  , const Sched& S, const Epi& E) {
    int tid_ = threadIdx.x; asm volatile("" : "+v"(tid_));
    const int tid = tid_, wid = __builtin_amdgcn_readfirstlane(tid >> 6), lane = tid & 63, wr = wid >> 2, wc = wid & 3, fr = lane & 15, fq = lane >> 4;
    const int K = Kdim, nt = Klen / BK;
    unsigned voffA[2], voffB[2];
#pragma unroll
    for (int i = 0; i < 2; ++i) { int R, C; stage_rc(tid * 16 + i * 8192, R, C); const int Rb = Epi::PERM ? ((R & ~31) + perm32(R & 31)) : R;
        voffA[i] = (unsigned)(R * K + C) * 2u; voffB[i] = (unsigned)(Rb * K + C) * 2u; }
    const size_t kstep = (size_t)(BK * 2);
    const size_t hstep = (size_t)HALF * K * 2;
    const size_t tstep = 2 * hstep;
    const unsigned ldsw = (unsigned)wid * 1024u;
    const int aoff = lds_byte(wr * 64 + fr, fq * 8), boff = lds_byte(wc * 32 + fr, fq * 8);
#define PG8_SA(b, h) (((b) * 2 + (h)) * HTB)
#define PG8_SB(b, h) ((4 + (b) * 2 + (h)) * HTB)
#define PG8_STAGE(bufoff, gbase, voff) do { _Pragma("unroll") for (int _i = 0; _i < 2; ++_i) \
        __builtin_amdgcn_global_load_lds((const unsigned*)((const char*)(gbase) + (voff)[_i]), (PG8_LAS unsigned*)(lds + (bufoff) + ldsw + _i * 8192), 16, 0, 0); } while (0)
#define PG8_LDA(dst, b, h) do { _Pragma("unroll") for (int m = 0; m < 4; ++m) _Pragma("unroll") for (int k = 0; k < 2; ++k) dst[m][k] = *(const PG8_LAS bf16x8*)(lds + PG8_SA(b, h) + aoff + m * 2048 + k * 1024); } while (0)
#define PG8_LDB(dst, b, h) do { _Pragma("unroll") for (int n = 0; n < 2; ++n) _Pragma("unroll") for (int k = 0; k < 2; ++k) dst[n][k] = *(const PG8_LAS bf16x8*)(lds + PG8_SB(b, h) + boff + n * 2048 + k * 1024); } while (0)
#define PG8_MMA(ai, bj, At, Bt) do { __builtin_amdgcn_s_setprio(1); _Pragma("unroll") for (int m = 0; m < 4; ++m) _Pragma("unroll") for (int n = 0; n < 2; ++n) _Pragma("unroll") for (int k = 0; k < 2; ++k) \
        acc[ai][bj][m][n] = __builtin_amdgcn_mfma_f32_16x16x32_bf16(Bt[n][k], At[m][k], acc[ai][bj][m][n], 0, 0, 0); __builtin_amdgcn_s_setprio(0); } while (0)
#define PG8_WAIT_V(n) asm volatile("s_waitcnt vmcnt(" #n ")" ::: "memory")
#define PG8_WAIT_L(n) asm volatile("s_waitcnt lgkmcnt(" #n ")" ::: "memory")
#define PG8_BAR __builtin_amdgcn_s_barrier()
#define PG8_SCHED __builtin_amdgcn_sched_barrier(0)
    Unit cur, nxt; int ui = 0;
    if (!S.next(0, cur)) return;
    f32x4 acc[2][2][4][2];
#pragma unroll
    for (int a = 0; a < 2; ++a)
#pragma unroll
        for (int b = 0; b < 2; ++b)
#pragma unroll
            for (int m = 0; m < 4; ++m)
#pragma unroll
                for (int n = 0; n < 2; ++n) acc[a][b][m][n] = (f32x4){0.f, 0.f, 0.f, 0.f};
    bf16x8 At[4][2], B0[2][2], B1[2][2];
    const char* cA = S.a_ptr(cur); const char* cB = S.b_ptr(cur);
    S.a_ready(cur);
    if constexpr (SP2) {
        PG8_STAGE(PG8_SB(0, 0), cB, voffB); PG8_STAGE(PG8_SB(0, 1), cB + hstep, voffB); PG8_STAGE(PG8_SA(0, 0), cA, voffA); PG8_STAGE(PG8_SA(0, 1), cA + hstep, voffA);
        if (wr == 1) PG8_BAR;
        PG8_WAIT_V(2); PG8_BAR;
        PG8_STAGE(PG8_SB(1, 0), cB + kstep, voffB); PG8_STAGE(PG8_SA(1, 0), cA + kstep, voffA); PG8_STAGE(PG8_SB(1, 1), cB + hstep + kstep, voffB);
        PG8_WAIT_V(6); PG8_BAR;
    } else {
        PG8_STAGE(PG8_SB(0, 0), cB, voffB); PG8_STAGE(PG8_SA(0, 0), cA, voffA); PG8_STAGE(PG8_SB(0, 1), cB + hstep, voffB); PG8_STAGE(PG8_SA(0, 1), cA + hstep, voffA);
        if (wr == 1) PG8_BAR;
        PG8_WAIT_V(4); PG8_BAR;
        PG8_STAGE(PG8_SB(1, 0), cB + kstep, voffB); PG8_STAGE(PG8_SA(1, 0), cA + kstep, voffA); PG8_STAGE(PG8_SB(1, 1), cB + hstep + kstep, voffB);
        PG8_WAIT_V(6); PG8_BAR;
    }
    for (;;) {
        const bool has_next = S.next(ui + 1, nxt);
        const char* nA = has_next ? S.a_ptr(nxt) : cA; const char* nB = has_next ? S.b_ptr(nxt) : cB;
        for (int t = 0; t < nt; t += 2) {
            const bool last = (t == nt - 2);
            const char* a1 = cA + (size_t)(t + 1) * kstep;
            const char* a2 = last ? nA : cA + (size_t)(t + 2) * kstep; const char* b2 = last ? nB : cB + (size_t)(t + 2) * kstep;
            const char* a3 = a2 + kstep; const char* b3 = b2 + kstep;
            if (last && has_next) S.a_ready(nxt);
            if constexpr (SP2) {
            PG8_LDB(B0, 0, 0); PG8_LDB(B1, 0, 1); PG8_SCHED; PG8_LDA(At, 0, 0); PG8_STAGE(PG8_SA(1, 1), a1 + hstep, voffA);
            PG8_WAIT_V(8); PG8_WAIT_L(0); PG8_BAR; PG8_MMA(0, 0, At, B0); PG8_MMA(0, 1, At, B1); PG8_BAR; PG8_SCHED;
            PG8_LDA(At, 0, 1); PG8_STAGE(PG8_SB(0, 0), b2, voffB); PG8_STAGE(PG8_SB(0, 1), b2 + hstep, voffB); PG8_STAGE(PG8_SA(0, 0), a2, voffA);
            PG8_WAIT_V(8); PG8_WAIT_L(0); PG8_BAR; PG8_MMA(1, 0, At, B0); PG8_MMA(1, 1, At, B1); PG8_BAR; PG8_SCHED;
            PG8_LDB(B0, 1, 0); PG8_LDB(B1, 1, 1); PG8_SCHED; PG8_LDA(At, 1, 0); PG8_STAGE(PG8_SA(0, 1), a2 + hstep, voffA);
            PG8_WAIT_V(8); PG8_WAIT_L(0); PG8_BAR; PG8_MMA(0, 0, At, B0); PG8_MMA(0, 1, At, B1); PG8_BAR; PG8_SCHED;
            PG8_LDA(At, 1, 1); PG8_STAGE(PG8_SB(1, 0), b3, voffB); PG8_STAGE(PG8_SB(1, 1), b3 + hstep, voffB); PG8_STAGE(PG8_SA(1, 0), a3, voffA);
            PG8_WAIT_V(8); PG8_WAIT_L(0); PG8_BAR; PG8_MMA(1, 0, At, B0); PG8_MMA(1, 1, At, B1); PG8_BAR; PG8_SCHED;
            } else {
            PG8_LDB(B0, 0, 0); PG8_SCHED; PG8_LDA(At, 0, 0); PG8_STAGE(PG8_SA(1, 1), a1 + hstep, voffA);
            PG8_WAIT_L(8); PG8_BAR; PG8_WAIT_L(0); PG8_MMA(0, 0, At, B0); PG8_BAR; PG8_SCHED;
            PG8_LDB(B1, 0, 1); PG8_STAGE(PG8_SB(0, 0), b2, voffB);
            PG8_BAR; PG8_WAIT_L(0); PG8_MMA(0, 1, At, B1); PG8_BAR;
            PG8_LDA(At, 0, 1); PG8_STAGE(PG8_SA(0, 0), a2, voffA);
            PG8_BAR; PG8_WAIT_L(0); PG8_MMA(1, 0, At, B0); PG8_BAR; PG8_SCHED;
            PG8_STAGE(PG8_SB(0, 1), b2 + hstep, voffB);
            PG8_WAIT_V(6); PG8_BAR; PG8_MMA(1, 1, At, B1); PG8_BAR;
            PG8_LDB(B0, 1, 0); PG8_SCHED; PG8_LDA(At, 1, 0); PG8_STAGE(PG8_SA(0, 1), a2 + hstep, voffA);
            PG8_WAIT_L(8); PG8_BAR; PG8_WAIT_L(0); PG8_MMA(0, 0, At, B0); PG8_BAR; PG8_SCHED;
            PG8_LDB(B1, 1, 1); PG8_STAGE(PG8_SB(1, 0), b3, voffB);
            PG8_BAR; PG8_WAIT_L(0); PG8_MMA(0, 1, At, B1); PG8_BAR;
            PG8_LDA(At, 1, 1); PG8_STAGE(PG8_SA(1, 0), a3, voffA);
            PG8_BAR; PG8_WAIT_L(0); PG8_MMA(1, 0, At, B0); PG8_BAR; PG8_SCHED;
            PG8_STAGE(PG8_SB(1, 1), b3 + hstep, voffB);
            PG8_WAIT_V(6); PG8_BAR; PG8_MMA(1, 1, At, B1); PG8_BAR;
            }
        }
        if constexpr (ALIGN_EPI) { if (wr == 0) PG8_BAR; }
        if constexpr (!Epi::AFTER_DRAIN) { E(acc, cur, wr, wc, fr, fq); S.done(cur); }
        if (!has_next) break;
#pragma unroll
        for (int a = 0; a < 2; ++a)
#pragma unroll
            for (int b = 0; b < 2; ++b)
#pragma unroll
                for (int m = 0; m < 4; ++m)
#pragma unroll
                    for (int n = 0; n < 2; ++n) acc[a][b][m][n] = (f32x4){0.f, 0.f, 0.f, 0.f};
        cur = nxt; cA = nA; cB = nB; ++ui;
        if constexpr (ALIGN_EPI) { if (wr == 1) PG8_BAR; }
    }
    PG8_WAIT_V(0);
    if constexpr (!ALIGN_EPI) { if (wr == 0) PG8_BAR; }
    PG8_BAR;
    if constexpr (Epi::AFTER_DRAIN) { E.fused(acc, cur, wr, wc, fr, fq, lds, wid, lane); S.done(cur); }
#undef PG8_SA
#undef PG8_SB
#undef PG8_STAGE
#undef PG8_LDA
#undef PG8_LDB
#undef PG8_MMA
#undef PG8_WAIT_V
#undef PG8_WAIT_L
#undef PG8_BAR
#undef PG8_SCHED
}
}

constexpr int NWAVES = 8, NTHR = 512;
constexpr int DM = 2048, BATCH = 2, SEQ = 16384, DEPTH = 4, GRIDW = 64, GROWS = 256, CTXL = 256;
constexpr int NAW = 1024, NHEAD = 8, HDIM = 128, FNW = 512, HYW = 512, DFF = 5632, DIN = 5120, NMOD = 6;
constexpr int ML = BATCH * SEQ, MC = BATCH * CTXL, MT = ML + MC;
constexpr int PML = ML / 256, PMT = MT / 256;
constexpr int NEDGE = MT / 64 * 2;
constexpr float EPS = 1e-6f;
constexpr float LOG2E = 1.4426950408889634f;
constexpr float QSCALE = 0.08838834764831845f * LOG2E;
constexpr float HY_MIN_DECAY = -3.0701134573253945f, HY_MAX_DECAY = -15.350567286626973f;

constexpr size_t MiB = 1u << 20;
constexpr size_t WS_CTL = 0, CTL_ZERO_BYTES = 1 * MiB;
constexpr size_t WS_MOD = 1 * MiB;
constexpr size_t WS_XC = 2 * MiB;
constexpr size_t WS_HFC = 6 * MiB;
constexpr size_t WS_HF = 8 * MiB;
constexpr size_t WS_WIN = WS_HF + 128 * MiB;
constexpr size_t WS_WOUT = WS_WIN + 80 * MiB;
constexpr size_t WS_WUP = WS_WOUT + 32 * MiB;
constexpr size_t WS_WDN = WS_WUP + 176 * MiB;
constexpr size_t WS_H = WS_WDN + 88 * MiB;
constexpr size_t WS_QK = WS_H + 130 * MiB;
constexpr size_t WS_VT = WS_QK + 130 * MiB;
constexpr size_t WS_T32 = WS_VT + 65 * MiB;
constexpr size_t WS_A = WS_T32 + 260 * MiB;
constexpr size_t WS_HID = WS_QK;
constexpr size_t WS_EDGE = WS_A + 65 * MiB;
constexpr size_t EDGE_ELEMS = (size_t)NEDGE * DFF;
constexpr size_t WS_KS = WS_EDGE + 68 * MiB;
constexpr size_t WS_SLAB = WS_KS + 64 * MiB;
constexpr size_t WS_END = WS_SLAB + 16 * MiB;
static_assert((size_t)MT * DFF * 2 <= WS_EDGE - WS_QK, "hidden overlay");
static_assert(3 * EDGE_ELEMS * 4 <= 68 * MiB, "edge buffers");
static_assert((size_t)MT * DM * 2 == 130 * MiB && (size_t)1024 * MT * 2 == 65 * MiB && (size_t)2048 * MT * 4 == 260 * MiB, "sizes");
constexpr int CW_BAR = 4096;

constexpr int RING_BYTES = 131072;
constexpr int XTRA_OFF = RING_BYTES, XTRA_BYTES = 28672;
constexpr int MISC_OFF = XTRA_OFF + XTRA_BYTES;
constexpr int TW_OFF = XTRA_OFF + 24576;
constexpr int ATT_KC_OFF = 0, ATT_KC_PITCH = 272, ATT_VC_OFF = 256 * ATT_KC_PITCH, ATT_VC_PITCH = 528, ATT_BIAS_OFF = ATT_VC_OFF + 128 * ATT_VC_PITCH;
static_assert(ATT_BIAS_OFF + 8 * 465 * 4 <= TW_OFF, "attention LDS map");
constexpr int LDS_BYTES = MISC_OFF + 256;

#define GAS __attribute__((address_space(1)))
#define LAS __attribute__((address_space(3)))
typedef unsigned short bf16;
typedef unsigned v4u __attribute__((ext_vector_type(4)));
typedef unsigned v2u __attribute__((ext_vector_type(2)));
typedef float f32x4 __attribute__((ext_vector_type(4)));
typedef float f32x2 __attribute__((ext_vector_type(2)));
typedef short bf16x8 __attribute__((ext_vector_type(8)));
#define LDS_WAIT() asm volatile("s_waitcnt lgkmcnt(0)" ::: "memory")
__device__ __forceinline__ unsigned f2bf(float f) { unsigned u = __builtin_bit_cast(unsigned, f); return (u + 0x7fffu + ((u >> 16) & 1u)) >> 16; }
__device__ __forceinline__ unsigned pk2(float lo, float hi) { return f2bf(lo) | (f2bf(hi) << 16); }
__device__ __forceinline__ float bf2f(unsigned short b) { return __builtin_bit_cast(float, (unsigned)b << 16); }
__device__ __forceinline__ f32x2 cmul(f32x2 a, f32x2 b) { return (f32x2){a.x * b.x - a.y * b.y, a.x * b.y + a.y * b.x}; }
__device__ __forceinline__ f32x2 cconj(f32x2 a) { return (f32x2){a.x, -a.y}; }
__device__ __forceinline__ float lane_read(float v, int src_lane) { return __builtin_bit_cast(float, __builtin_amdgcn_ds_bpermute(src_lane << 2, __builtin_bit_cast(int, v))); }
template <int CTRL> __device__ __forceinline__ float dpp_ror(float v) { return __builtin_bit_cast(float, __builtin_amdgcn_update_dpp(0, __builtin_bit_cast(int, v), CTRL, 0xf, 0xf, false)); }
__device__ __forceinline__ float wave_sum(float v, int lane) {
#pragma unroll
    for (int o = 1; o < 64; o <<= 1) v += lane_read(v, lane ^ o);
    return v;
}
__device__ __forceinline__ int opaque_int(int v) { asm volatile("" : "+s"(v)); return v; }
__device__ __forceinline__ float gelu_tanh(float x) {
    const float t = x * (1.0f + 0.044715f * x * x) * (-2.302208198f);
    const float e = __builtin_amdgcn_exp2f(t);
    return x * __builtin_amdgcn_rcpf(1.0f + e);
}
#define XB_LAS_DEFINED
#define XB_TMO      128
#define XB_XCNT(j)  (256  + 64 * (j))
#define XB_XSUB(j)  (1280 + 64 * (j))
#define XB_XGEN(j)  (2304 + 64 * (j))
#define XB_TOP      3328
#define XB_TOPGEN   3392
#define XCD_BAR_WORDS 3456
#define XB_SPIN_CAP (1u << 18)

__device__ __forceinline__ unsigned xb_ld(unsigned* p)              { return __hip_atomic_load(p, __ATOMIC_RELAXED, __HIP_MEMORY_SCOPE_AGENT); }
__device__ __forceinline__ unsigned xb_add(unsigned* p, unsigned v) { return __hip_atomic_fetch_add(p, v, __ATOMIC_RELAXED, __HIP_MEMORY_SCOPE_AGENT); }
__device__ __forceinline__ unsigned xb_xcc_id() { return (unsigned)__builtin_amdgcn_s_getreg((3 << 11) | 20) & 0xFu; }
#define XB_SPIN(cond, bar) do { unsigned _sp = 0; while (cond) { __builtin_amdgcn_s_sleep(1); \
    if ((++_sp & 255u) == 0u) { if (xb_ld(&(bar)[XB_TMO])) break; if (_sp > XB_SPIN_CAP) { atomicAdd(&(bar)[XB_TMO], 1u); break; } } } } while (0)

struct XcdBarrier {
    unsigned* bar; unsigned x;
    volatile LAS unsigned* st;
};

__device__ __forceinline__ XcdBarrier xcd_barrier_post(unsigned* bar, volatile LAS unsigned* st) {
    XcdBarrier b; b.bar = bar; b.x = xb_xcc_id(); b.st = st;
    if (threadIdx.x == 0) (void)xb_add(&bar[XB_XCNT(b.x)], 1u);
    return b;
}
__device__ __forceinline__ void xcd_barrier_complete(unsigned* bar, unsigned x, unsigned& nloc, unsigned& nx) {
    const unsigned G = gridDim.x * gridDim.y * gridDim.z;
    unsigned sum, cnt, mine, sp = 0u;
    for (;;) {
        sum = 0u; cnt = 0u; mine = 0u;
#pragma unroll
        for (unsigned j = 0; j < 16; ++j) { const unsigned c = xb_ld(&bar[XB_XCNT(j)]); sum += c; cnt += (c > 0u) ? 1u : 0u; mine = (j == x) ? c : mine; }
        if (sum == G) break;
        __builtin_amdgcn_s_sleep(1);
        if ((++sp & 255u) == 0u) { if (xb_ld(&bar[XB_TMO])) break; if (sp > XB_SPIN_CAP) { atomicAdd(&bar[XB_TMO], 1u); break; } }
    }
    nloc = mine > 0u ? mine : 1u; nx = cnt > 0u ? cnt : 1u;
}

__device__ __forceinline__ void xcd_barrier(const XcdBarrier& b) {
    asm volatile("s_waitcnt vmcnt(0)" ::: "memory");
    __syncthreads();
    if (threadIdx.x == 0) {
        unsigned* bar = b.bar;
        __builtin_amdgcn_s_waitcnt(0);
        unsigned nloc = b.st[0], nx = b.st[1];
        if (nloc == 0u) { xcd_barrier_complete(bar, b.x, nloc, nx); b.st[0] = nloc; b.st[1] = nx; }
        const unsigned old = xb_add(&bar[XB_XSUB(b.x)], 1u);
        const unsigned gen = old / nloc;
        if (old + 1u == (gen + 1u) * nloc) {
            __builtin_amdgcn_fence(__ATOMIC_RELEASE, "agent");
            asm volatile("s_waitcnt vmcnt(0)" ::: "memory");
            const unsigned og = xb_add(&bar[XB_TOP], 1u);
            const unsigned tg = og / nx;
            if (og + 1u == (tg + 1u) * nx) xb_add(&bar[XB_TOPGEN], 1u);
            else XB_SPIN(xb_ld(&bar[XB_TOPGEN]) == tg, bar);
            __builtin_amdgcn_fence(__ATOMIC_ACQUIRE, "agent");
            xb_add(&bar[XB_XGEN(b.x)], 1u);
            asm volatile("s_waitcnt vmcnt(0)" ::: "memory");
        } else {
            XB_SPIN(xb_ld(&bar[XB_XGEN(b.x)]) == gen, bar);
            __builtin_amdgcn_fence(__ATOMIC_ACQUIRE, "agent");
            asm volatile("s_waitcnt vmcnt(0)" ::: "memory");
        }
    }
    __syncthreads();
}


struct Args { const GAS float* in[26]; GAS float* out; GAS unsigned char* ws; };
struct Frame {
    LAS unsigned char* lds;
    int tid, lane, wave;
    int vcu, G;
    GAS unsigned char* ws;
    GAS float* out;
};
typedef const float* cfptr_t;
__device__ __forceinline__ const GAS float* in_ptr(int k) { asm volatile("" : "+s"(k));
    const __attribute__((address_space(4))) cfptr_t* kp = (const __attribute__((address_space(4))) cfptr_t*)__builtin_amdgcn_kernarg_segment_ptr(); return (const GAS float*)kp[k]; }
enum { I_x, I_c, I_ctx, I_c_ctx, I_ada_w, I_ada_b, I_norm1_g, I_norm2_g, I_w_in, I_na_rpb, I_hy_conv_w, I_hy_conv_b, I_hy_w1, I_hy_b1, I_hy_w2, I_hy_b2, I_hy_w3, I_hy_freq, I_hy_bias,
       I_mix_norm_g, I_w_out, I_ffn_w_up, I_ffn_conv_w, I_ffn_conv_b, I_ffn_w_down, I_final_norm_g };
#define IN(name) in_ptr(I_##name)
#define WSP(T, off) ((GAS T*)(F.ws + (off)))

__device__ __forceinline__ void pa_adaln(Frame& F) {
    LAS float* sv = (LAS float*)F.lds;
    LAS float* red = (LAS float*)(F.lds + 3 * DM * 4);
    const GAS float* p_c = IN(c); const GAS float* p_cc = IN(c_ctx); const GAS float* p_aw = IN(ada_w); const GAS float* p_ab = IN(ada_b);
    for (int i = F.tid; i < 3 * DM; i += NTHR) { const int s = i / DM, k = i % DM; const float v = s < 2 ? p_c[s * DM + k] : p_cc[k]; sv[i] = v / (1.0f + __expf(-v)); }
    __syncthreads();
    GAS float* MOD = WSP(float, WS_MOD);
    const int cg = F.tid & 63, ks = F.tid >> 6;
    for (int item = F.vcu; item < DEPTH * 48; item += F.G) {
        const int l = item / 48, j0 = (item % 48) * 256;
        const GAS float* wp = p_aw + ((size_t)l * DM + ks * 256) * (NMOD * DM) + j0 + 4 * cg;
        f32x4 a0 = {0.f, 0.f, 0.f, 0.f}, a1 = a0, a2 = a0;
#pragma unroll 8
        for (int kk = 0; kk < 256; ++kk) {
            const f32x4 w = *(const GAS f32x4*)(wp + (size_t)kk * (NMOD * DM));
            const float s0 = sv[ks * 256 + kk], s1 = sv[DM + ks * 256 + kk], s2 = sv[2 * DM + ks * 256 + kk];
            a0 += w * s0; a1 += w * s1; a2 += w * s2;
        }
        *(LAS f32x4*)(red + (ks * 3 + 0) * 256 + 4 * cg) = a0; *(LAS f32x4*)(red + (ks * 3 + 1) * 256 + 4 * cg) = a1; *(LAS f32x4*)(red + (ks * 3 + 2) * 256 + 4 * cg) = a2;
        __syncthreads();
        if (F.tid < 192) {
            const int s = F.tid >> 6, cc = F.tid & 63;
            f32x4 t = *(const GAS f32x4*)(p_ab + (size_t)l * (NMOD * DM) + j0 + 4 * cc);
#pragma unroll
            for (int q = 0; q < 8; ++q) t += *(LAS f32x4*)(red + (q * 3 + s) * 256 + 4 * cc);
            *(GAS f32x4*)(MOD + ((size_t)l * 3 + s) * (NMOD * DM) + j0 + 4 * cc) = t;
        }
        __syncthreads();
    }
}
__device__ __forceinline__ void transpose_item(const GAS float* W, int K, int N, GAS bf16* WT, int k0, int n0, int drow0, LAS float* scr, int lane) {
#pragma unroll 8
    for (int i = 0; i < 32; ++i) { const int kk = 2 * i + (lane >> 5); scr[kk * 33 + (lane & 31)] = W[(size_t)(k0 + kk) * N + n0 + (lane & 31)]; }
    LDS_WAIT(); asm volatile("" ::: "memory");
    const int c = lane & 7;
#pragma unroll
    for (int j = 0; j < 4; ++j) { const int n = (lane >> 3) + 8 * j; const LAS float* s = scr + (8 * c) * 33 + n;
        v4u o; o.x = pk2(s[0 * 33], s[1 * 33]); o.y = pk2(s[2 * 33], s[3 * 33]); o.z = pk2(s[4 * 33], s[5 * 33]); o.w = pk2(s[6 * 33], s[7 * 33]);
        *(GAS v4u*)(WT + (size_t)(drow0 + n) * K + k0 + 8 * c) = o; }
    LDS_WAIT(); asm volatile("" ::: "memory");
}
__device__ __forceinline__ void pa_ctx_copy(Frame& F) {
    const GAS f32x4* src = (const GAS f32x4*)IN(ctx); GAS f32x4* dst = WSP(f32x4, WS_XC);
    for (int i = F.vcu * NTHR + F.tid; i < MC * DM / 4; i += F.G * NTHR) dst[i] = src[i];
}
__device__ __forceinline__ void pa_weights(Frame& F) {
    const GAS float* p_win = IN(w_in); const GAS float* p_wout = IN(w_out); const GAS float* p_wup = IN(ffn_w_up); const GAS float* p_wdn = IN(ffn_w_down);
    {
        LAS float* wt = (LAS float*)F.lds;
        LAS float* tab = (LAS float*)(F.lds + 64 * 129 * 4);
        if (F.tid < 128) tab[F.tid] = cospif((float)F.tid * (1.0f / 64.0f));
        for (int item = F.vcu; item < DEPTH * 4 * 32; item += F.G) {
            const int l = item >> 7, g = (item >> 5) & 3, k0 = (item & 31) * 64;
            __syncthreads();
            for (int i = F.tid; i < 64 * 128; i += NTHR) { const int kk = i >> 7, cc = i & 127; wt[kk * 129 + cc] = p_win[((size_t)l * DM + k0 + kk) * DIN + 3072 + g * 128 + cc]; }
            __syncthreads();
            const int kk = F.tid & 63;
            GAS bf16* dst = WSP(bf16, WS_WIN) + ((size_t)l * DIN + 3072 + g * 128) * DM + k0 + kk;
            for (int i = 0; i < 16; ++i) {
                const int mp = (F.tid >> 6) + 8 * i;
                const int mm = mp <= 64 ? mp : mp - 64, sh = mp <= 64 ? 0 : 96;
                float a = 0.f;
                const int add = mp <= 64 ? 0 : 32; (void)sh;
#pragma unroll 8
                for (int cc = 0; cc < 128; ++cc) a += wt[kk * 129 + cc] * tab[(mm * cc + add) & 127];
                dst[(size_t)mp * DM] = (bf16)f2bf(a);
            }
        }
        __syncthreads();
    }
    LAS float* scr = (LAS float*)(F.lds + F.wave * 16384);
    const int gw = F.vcu * NWAVES + F.wave, NGW = F.G * NWAVES;
    constexpr int I_IN = 32 * 144, I_OUT = 32 * 64, I_UP = 32 * 352, I_DN = 88 * 64, I_L = I_IN + I_OUT + I_UP + I_DN;
    for (int it = gw; it < DEPTH * I_L; it += NGW) {
        const int l = it / I_L; int r = it % I_L;
        if (r < I_IN) { const int kb = r / 144; int nb = r % 144; if (nb >= 96) nb += 16;
            transpose_item(p_win + (size_t)l * DM * DIN, DM, DIN, WSP(bf16, WS_WIN) + (size_t)l * DIN * DM, kb * 64, nb * 32, nb * 32, scr, F.lane); continue; }
        r -= I_IN;
        if (r < I_OUT) { const int kb = r / 64, nb = r % 64;
            transpose_item(p_wout + (size_t)l * DM * DM, DM, DM, WSP(bf16, WS_WOUT) + (size_t)l * DM * DM, kb * 64, nb * 32, nb * 32, scr, F.lane); continue; }
        r -= I_OUT;
        if (r < I_UP) { const int kb = r / 352, nb = r % 352; const int n0 = nb * 32;
            const int drow = n0 < DFF ? (n0 >> 7) * 256 + (n0 & 127) : ((n0 - DFF) >> 7) * 256 + 128 + ((n0 - DFF) & 127);
            transpose_item(p_wup + (size_t)l * DM * 2 * DFF, DM, 2 * DFF, WSP(bf16, WS_WUP) + (size_t)l * 2 * DFF * DM, kb * 64, n0, drow, scr, F.lane); continue; }
        r -= I_UP;
        { const int kb = r / 64, nb = r % 64;
            transpose_item(p_wdn + (size_t)l * DFF * DM, DFF, DM, WSP(bf16, WS_WDN) + (size_t)l * DM * DFF, kb * 64, nb * 32, nb * 32, scr, F.lane); }
    }
}

__device__ __forceinline__ void norm_phase(Frame& F, int l, int which, bool with_ctx, int nslab) {
    const GAS float* gain = (which ? IN(norm2_g) : IN(norm1_g)) + (size_t)l * DM;
    const GAS float* MOD = WSP(float, WS_MOD) + (size_t)l * 3 * (NMOD * DM);
    const bool first = (l == 0 && which == 0);
    const GAS float* xl = first ? IN(x) : F.out; const GAS float* xc = first ? IN(ctx) : WSP(float, WS_XC);
    GAS bf16* H = WSP(bf16, WS_H);
    const int gw = F.vcu * NWAVES + F.wave, NGW = F.G * NWAVES, nrows = with_ctx ? MT : ML;
    for (int row = gw; row < nrows; row += NGW) {
        const int s = row < SEQ ? 0 : row < ML ? 1 : 2;
        const GAS float* xr = row < ML ? xl + (size_t)row * DM : xc + (size_t)(row - ML) * DM;
        const GAS float* shp = MOD + (size_t)s * (NMOD * DM) + (which ? 3 : 0) * DM; const GAS float* scp = shp + DM;
        f32x4 v[8]; float ss = 0.f;
#pragma unroll
        for (int j = 0; j < 8; ++j) v[j] = *(const GAS f32x4*)(xr + 4 * (F.lane + 64 * j));
        if (row >= ML && nslab > 0) {
            const GAS float* sl = WSP(float, WS_SLAB) + (size_t)(row - ML) * DM; GAS float* xw = WSP(float, WS_XC) + (size_t)(row - ML) * DM;
            for (int ks = 0; ks < nslab; ++ks)
#pragma unroll
                for (int j = 0; j < 8; ++j) v[j] += *(const GAS f32x4*)(sl + (size_t)ks * MC * DM + 4 * (F.lane + 64 * j));
#pragma unroll
            for (int j = 0; j < 8; ++j) *(GAS f32x4*)(xw + 4 * (F.lane + 64 * j)) = v[j];
        }
#pragma unroll
        for (int j = 0; j < 8; ++j) ss += (v[j].x * v[j].x + v[j].y * v[j].y) + (v[j].z * v[j].z + v[j].w * v[j].w);
        const float rstd = 1.0f / sqrtf(wave_sum(ss, F.lane) * (1.0f / DM) + EPS);
        GAS bf16* hr = H + (size_t)row * DM;
#pragma unroll
        for (int j = 0; j < 8; ++j) { const int k = 4 * (F.lane + 64 * j);
            const f32x4 g = *(const GAS f32x4*)(gain + k), sc = *(const GAS f32x4*)(scp + k), sh = *(const GAS f32x4*)(shp + k);
            const f32x4 y = (v[j] * rstd * g) * (1.0f + sc) + sh;
            v2u o; o.x = pk2(y.x, y.y); o.y = pk2(y.z, y.w); *(GAS v2u*)(hr + k) = o; }
    }
}
__device__ __forceinline__ void final_norm_phase(Frame& F) {
    const GAS float* p_g = IN(final_norm_g);
    const int gw = F.vcu * NWAVES + F.wave, NGW = F.G * NWAVES;
    for (int row = gw; row < ML; row += NGW) {
        GAS float* xr = F.out + (size_t)row * DM;
        f32x4 v[8]; float ss = 0.f;
#pragma unroll
        for (int j = 0; j < 8; ++j) { v[j] = *(const GAS f32x4*)(xr + 4 * (F.lane + 64 * j)); ss += (v[j].x * v[j].x + v[j].y * v[j].y) + (v[j].z * v[j].z + v[j].w * v[j].w); }
        const float rstd = 1.0f / sqrtf(wave_sum(ss, F.lane) * (1.0f / DM) + EPS);
#pragma unroll
        for (int j = 0; j < 8; ++j) { const int k = 4 * (F.lane + 64 * j); *(GAS f32x4*)(xr + k) = v[j] * rstd * *(const GAS f32x4*)(p_g + k); }
    }
}

__device__ __forceinline__ void filter_phase(Frame& F, int l, bool with_ctx) {
    LAS float* h1 = (LAS float*)F.lds;
    LAS float* h2 = (LAS float*)(F.lds + 64 * 65 * 4);
    const GAS float* w1 = IN(hy_w1) + (size_t)l * 33 * 64; const GAS float* b1 = IN(hy_b1) + (size_t)l * 64;
    const GAS float* w2 = IN(hy_w2) + (size_t)l * 64 * 64; const GAS float* b2 = IN(hy_b2) + (size_t)l * 64;
    const GAS float* w3 = IN(hy_w3) + (size_t)l * 64 * 2048; const GAS float* fq = IN(hy_freq) + (size_t)l * 64;
    const int nitems = with_ctx ? 288 : 256;
    for (int item = F.vcu; item < nitems; item += F.G) {
        const bool isc = item >= 256; const int Lq = isc ? CTXL : SEQ; const int n0 = (isc ? (item - 256) >> 3 : item) * 64;
        const int ck_lo = isc ? (item & 7) : 0, ck_hi = isc ? ck_lo + 1 : 8;
        const int p = F.tid & 63, jg = F.wave;
        const float pos = (float)(n0 + p), t = pos / (float)(Lq - 1);
        __syncthreads();
        {
            float zf[33]; zf[0] = t;
#pragma unroll
            for (int i = 0; i < 16; ++i) { const float band = 1e-4f + (float)i * ((15.0f - 1e-4f) / 15.0f); const float ang = band * (6.283185307179586f / (float)Lq) * pos; zf[1 + i] = cosf(ang); zf[17 + i] = -sinf(ang); }
#pragma unroll 1
            for (int jj = 0; jj < 8; ++jj) { const int j = jg * 8 + jj; float a = b1[j];
#pragma unroll
                for (int i = 0; i < 33; ++i) a += zf[i] * w1[i * 64 + j];
                h1[p * 65 + j] = sinf(fq[j] * a); }
        }
        __syncthreads();
#pragma unroll 1
        for (int jj = 0; jj < 8; ++jj) { const int j = jg * 8 + jj; float a = b2[j];
#pragma unroll 8
            for (int i = 0; i < 64; ++i) a += h1[p * 65 + i] * w2[i * 64 + j];
            h2[p * 65 + j] = sinf(fq[j] * a); }
        __syncthreads();
        GAS float* dst = isc ? WSP(float, WS_HFC) : WSP(float, WS_HF);
        LAS float* w3s = (LAS float*)(F.lds + 2 * 64 * 65 * 4);
        for (int ck = ck_lo; ck < ck_hi; ++ck) {
            __syncthreads();
#pragma unroll 4
            for (int i = F.tid; i < 64 * 64; i += NTHR) { const int jr = i >> 6, c4 = (i & 63) * 4; *(LAS f32x4*)(w3s + jr * 256 + c4) = *(const GAS f32x4*)(w3 + (size_t)jr * 2048 + ck * 256 + c4); }
            __syncthreads();
            f32x4 a[8];
#pragma unroll
            for (int q = 0; q < 8; ++q) a[q] = (f32x4){0.f, 0.f, 0.f, 0.f};
#pragma unroll 2
            for (int i = 0; i < 64; ++i) { const float hvi = h2[p * 65 + i]; const LAS f32x4* wr = (const LAS f32x4*)(w3s + i * 256 + jg * 32);
#pragma unroll
                for (int q = 0; q < 8; ++q) a[q] += wr[q] * hvi; }
#pragma unroll
            for (int q = 0; q < 8; ++q)
#pragma unroll
                for (int e = 0; e < 4; ++e) { const int col = ck * 256 + jg * 32 + q * 4 + e, ch = col & 511;
                    const float delta = fabsf(HY_MIN_DECAY + (HY_MAX_DECAY - HY_MIN_DECAY) * ((float)ch / 511.0f));
                    const float val = a[q][e] * __expf(-t * delta); const int n = n0 + p;
                    if (col & 512) dst[(size_t)col * Lq + ((Lq - n) & (Lq - 1))] = n == 0 ? 0.f : val;
                    else dst[(size_t)col * Lq + n] = val; }
        }
    }
}

struct EpiIn {
    static constexpr bool PERM = true, AFTER_DRAIN = false;
    GAS bf16* QK; GAS bf16* VT; GAS float* T32;
    __device__ __forceinline__ void operator()(pg8::f32x4 (&acc)[2][2][4][2], const pg8::Unit& u, int wr_, int wc_, int fr_, int fq_) const {
        int t_ = threadIdx.x; asm volatile("" : "+v"(t_));
        const int fr = t_ & 15, fq = (t_ >> 4) & 3, wc = (t_ >> 6) & 3, wr = t_ >> 8; (void)wr_; (void)wc_; (void)fr_; (void)fq_;
        const int row0 = u.pm * 256 + wr * 64 + fr, col0 = u.pn * 256 + wc * 32 + 8 * fq;
        if (u.type == 0) {
            const float sc = u.pn < 4 ? QSCALE : 1.0f;
#pragma unroll
            for (int ai = 0; ai < 2; ++ai)
#pragma unroll
                for (int m = 0; m < 4; ++m) { GAS bf16* rowp = QK + (size_t)(row0 + ai * 128 + m * 16) * 2048 + col0;
#pragma unroll
                    for (int bj = 0; bj < 2; ++bj) { const pg8::f32x4 v0 = acc[ai][bj][m][0] * sc, v1 = acc[ai][bj][m][1] * sc;
                        v4u w; w.x = pg8::cvt_pk_bf16(v0[0], v0[1]); w.y = pg8::cvt_pk_bf16(v0[2], v0[3]); w.z = pg8::cvt_pk_bf16(v1[0], v1[1]); w.w = pg8::cvt_pk_bf16(v1[2], v1[3]);
                        *(GAS v4u*)(rowp + bj * 128) = w; } }
        } else if (u.pm < 4) {
#pragma unroll
            for (int ai = 0; ai < 2; ++ai)
#pragma unroll
                for (int m = 0; m < 4; ++m) { GAS bf16* rowp = VT + (size_t)(row0 + ai * 128 + m * 16) * MT + col0;
#pragma unroll
                    for (int bj = 0; bj < 2; ++bj) { const pg8::f32x4 v0 = acc[ai][bj][m][0], v1 = acc[ai][bj][m][1];
                        v4u w; w.x = pg8::cvt_pk_bf16(v0[0], v0[1]); w.y = pg8::cvt_pk_bf16(v0[2], v0[3]); w.z = pg8::cvt_pk_bf16(v1[0], v1[1]); w.w = pg8::cvt_pk_bf16(v1[2], v1[3]);
                        *(GAS v4u*)(rowp + bj * 128) = w; } }
        } else {
#pragma unroll
            for (int ai = 0; ai < 2; ++ai)
#pragma unroll
                for (int m = 0; m < 4; ++m) { GAS float* rowp = T32 + (size_t)(row0 - 1024 + ai * 128 + m * 16) * MT + col0;
#pragma unroll
                    for (int bj = 0; bj < 2; ++bj) { *(GAS pg8::f32x4*)(rowp + bj * 128) = acc[ai][bj][m][0]; *(GAS pg8::f32x4*)(rowp + bj * 128 + 4) = acc[ai][bj][m][1]; } }
        }
    }
};
template <bool DRY = false> struct EpiResT {
    static constexpr bool PERM = false, AFTER_DRAIN = false;
    const GAS float* base_l; const GAS float* base_c; GAS float* out_l; GAS float* out_c; const GAS float* gate; int never;
    __device__ __forceinline__ void operator()(pg8::f32x4 (&acc)[2][2][4][2], const pg8::Unit& u, int wr_, int wc_, int fr_, int fq_) const {
        int t_ = threadIdx.x; asm volatile("" : "+v"(t_));
        const int fr = t_ & 15, fq = (t_ >> 4) & 3, wc = (t_ >> 6) & 3, wr = t_ >> 8; (void)wr_; (void)wc_; (void)fr_; (void)fq_;
        const int row0 = u.pm * 256 + wr * 64 + fr, col0 = u.pn * 256 + wc * 32 + 4 * fq;
        const int s = u.pm < PML / 2 ? 0 : u.pm < PML ? 1 : 2;
        const GAS float* bs = u.pm < PML ? base_l + (size_t)row0 * DM : base_c + (size_t)(row0 - ML) * DM;
        GAS float* os = u.pm < PML ? out_l + (size_t)row0 * DM : out_c + (size_t)(row0 - ML) * DM;
        pg8::f32x4 gv[2][2];
#pragma unroll
        for (int bj = 0; bj < 2; ++bj)
#pragma unroll
            for (int n = 0; n < 2; ++n) gv[bj][n] = *(const GAS pg8::f32x4*)(gate + (size_t)s * (NMOD * DM) + col0 + bj * 128 + n * 16);
#pragma unroll
        for (int ai = 0; ai < 2; ++ai)
#pragma unroll
            for (int m = 0; m < 4; ++m) { const size_t off = (size_t)(ai * 128 + m * 16) * DM + col0;
#pragma unroll
                for (int bj = 0; bj < 2; ++bj)
#pragma unroll
                    for (int n = 0; n < 2; ++n) { const pg8::f32x4 b = *(const GAS pg8::f32x4*)(bs + off + bj * 128 + n * 16);
                        if (!DRY || never) *(GAS pg8::f32x4*)(os + off + bj * 128 + n * 16) = b + gv[bj][n] * acc[ai][bj][m][n]; }
                asm volatile("" ::: "memory"); }
    }
};
struct EpiSlab {
    static constexpr bool PERM = false, AFTER_DRAIN = false;
    GAS float* slab; const GAS float* gate;
    __device__ __forceinline__ void operator()(pg8::f32x4 (&acc)[2][2][4][2], const pg8::Unit& u, int wr_, int wc_, int fr_, int fq_) const {
        int t_ = threadIdx.x; asm volatile("" : "+v"(t_));
        const int fr = t_ & 15, fq = (t_ >> 4) & 3, wc = (t_ >> 6) & 3, wr = t_ >> 8; (void)wr_; (void)wc_; (void)fr_; (void)fq_;
        const int row0 = u.pm * 256 + wr * 64 + fr - ML, col0 = u.pn * 256 + wc * 32 + 4 * fq;
        pg8::f32x4 gv[2][2];
#pragma unroll
        for (int bj = 0; bj < 2; ++bj)
#pragma unroll
            for (int n = 0; n < 2; ++n) gv[bj][n] = *(const GAS pg8::f32x4*)(gate + (size_t)2 * (NMOD * DM) + col0 + bj * 128 + n * 16);
        GAS float* sb = slab + (size_t)u.type * MC * DM;
#pragma unroll
        for (int ai = 0; ai < 2; ++ai)
#pragma unroll
            for (int m = 0; m < 4; ++m) { GAS float* os = sb + (size_t)(row0 + ai * 128 + m * 16) * DM + col0;
#pragma unroll
                for (int bj = 0; bj < 2; ++bj)
#pragma unroll
                    for (int n = 0; n < 2; ++n) *(GAS pg8::f32x4*)(os + bj * 128 + n * 16) = gv[bj][n] * acc[ai][bj][m][n]; }
    }
};
typedef EpiResT<false> EpiRes;
struct EpiUp {
    static constexpr bool PERM = true, AFTER_DRAIN = false;
    GAS bf16* HID; GAS float* EG; GAS float* EP; GAS float* EU; const GAS float* cw; const GAS float* cb;
    __device__ __forceinline__ void operator()(pg8::f32x4 (&acc)[2][2][4][2], const pg8::Unit& u, int wr_, int wc_, int fr_, int fq_) const {
        int t_ = threadIdx.x; asm volatile("" : "+v"(t_));
        const int fr = t_ & 15, fq = (t_ >> 4) & 3, wc = (t_ >> 6) & 3, wr = t_ >> 8; (void)wr_; (void)wc_; (void)fr_; (void)fq_;
        const unsigned hc0 = (unsigned)(u.pn * 128 + wc * 32 + 8 * fq);
        const bool e0 = fr == 0, e3 = fr == 15;
        __builtin_amdgcn_sched_barrier(0);
#pragma unroll
        for (int ai = 0; ai < 2; ++ai) {
            const int rbase = u.pm * 256 + ai * 128 + wr * 64;
            const unsigned eb0 = (unsigned)((rbase >> 6) << 1) * (unsigned)DFF, eb3 = eb0 + (unsigned)DFF;
#pragma unroll
            for (int n = 0; n < 2; ++n) {
                const unsigned hc = hc0 + 4u * (unsigned)n;
                const pg8::f32x4 w0 = *(const GAS pg8::f32x4*)&cw[hc], w1 = *(const GAS pg8::f32x4*)&cw[(unsigned)DFF + hc], w2 = *(const GAS pg8::f32x4*)&cw[2u * (unsigned)DFF + hc], bb = *(const GAS pg8::f32x4*)&cb[hc];
                if (e0) { *(GAS pg8::f32x4*)&EG[eb0 + hc] = acc[ai][0][0][n]; *(GAS pg8::f32x4*)&EU[eb0 + hc] = acc[ai][1][0][n]; }
                if (e3) { *(GAS pg8::f32x4*)&EG[eb3 + hc] = acc[ai][0][3][n]; *(GAS pg8::f32x4*)&EU[eb3 + hc] = acc[ai][1][3][n]; }
#pragma unroll
                for (int j = 0; j < 4; ++j) {
                    float pr[4], nx[4], gg[4];
#pragma unroll
                    for (int m = 0; m < 4; ++m) { gg[m] = acc[ai][0][m][n][j]; pr[m] = dpp_ror<0x121>(gg[m]); nx[m] = dpp_ror<0x12F>(gg[m]); }
#pragma unroll
                    for (int m = 0; m < 4; ++m) {
                        const float pv = fr > 0 ? pr[m] : (m > 0 ? pr[m > 0 ? m - 1 : 0] : 0.f);
                        const float nv = fr < 15 ? nx[m] : (m < 3 ? nx[m < 3 ? m + 1 : 3] : 0.f);
                        const float cv = w0[j] * pv + w1[j] * gg[m] + w2[j] * nv + bb[j];
                        if (m == 0) { if (e0) EP[eb0 + hc + (unsigned)j] = cv; } if (m == 3) { if (e3) EP[eb3 + hc + (unsigned)j] = cv; }
                        acc[ai][0][m][n][j] = gelu_tanh(cv) * acc[ai][1][m][n][j];
                    }
                }
                asm volatile("" ::: "memory"); __builtin_amdgcn_sched_barrier(0);
            }
#pragma unroll
            for (int m = 0; m < 4; ++m) {
                if (!((m == 0 && e0) || (m == 3 && e3))) {
                    const pg8::f32x4 v0 = acc[ai][0][m][0], v1 = acc[ai][0][m][1];
                    v4u w; w.x = pg8::cvt_pk_bf16(v0[0], v0[1]); w.y = pg8::cvt_pk_bf16(v0[2], v0[3]); w.z = pg8::cvt_pk_bf16(v1[0], v1[1]); w.w = pg8::cvt_pk_bf16(v1[2], v1[3]);
                    *(GAS v4u*)&HID[(unsigned)(rbase + m * 16 + fr) * (unsigned)DFF + hc0] = w;
                }
            }
        }
    }
};
__device__ __forceinline__ void edge_fix_phase(Frame& F, int l, bool with_ctx) {
    const GAS float* EG = WSP(float, WS_EDGE); const GAS float* EP = EG + EDGE_ELEMS; const GAS float* EU = EP + EDGE_ELEMS;
    const GAS float* cw = IN(ffn_conv_w) + (size_t)l * 3 * DFF;
    GAS bf16* HID = WSP(bf16, WS_HID);
    const int ne = with_ctx ? NEDGE : ML / 64 * 2, total = ne * (DFF / 4);
    for (int i = F.vcu * NTHR + F.tid; i < total; i += F.G * NTHR) {
        const int e = i / (DFF / 4), c = (i % (DFF / 4)) * 4;
        const int r = (e >> 1) * 64 + (e & 1) * 63;
        f32x4 p = *(const GAS f32x4*)(EP + (size_t)e * DFF + c);
        if (e & 1) { const int nr = r + 1; if (nr != SEQ && nr != ML && nr != ML + CTXL && nr != MT) p += *(const GAS f32x4*)(cw + 2 * DFF + c) * *(const GAS f32x4*)(EG + (size_t)(e + 1) * DFF + c); }
        else { if (r != 0 && r != SEQ && r != ML && r != ML + CTXL) p += *(const GAS f32x4*)(cw + c) * *(const GAS f32x4*)(EG + (size_t)(e - 1) * DFF + c); }
        const f32x4 up = *(const GAS f32x4*)(EU + (size_t)e * DFF + c);
        v2u o; o.x = pk2(gelu_tanh(p.x) * up.x, gelu_tanh(p.y) * up.y); o.y = pk2(gelu_tanh(p.z) * up.z, gelu_tanh(p.w) * up.w);
        *(GAS v2u*)(HID + (size_t)r * DFF + c) = o;
    }
}

#define MFMA16(a, b, c) __builtin_amdgcn_mfma_f32_16x16x32_bf16((a), (b), (c), 0, 0, 0)
struct AttnK { bf16x8 kf[2][4]; };
struct AttnV { bf16x8 vf[8]; };
__device__ __forceinline__ void attn_load_k(AttnK& C, const GAS bf16* kbase  , int q, int g) {
#pragma unroll
    for (int T = 0; T < 2; ++T) { const unsigned koff = (unsigned)((8 * (q >> 2) + 4 * T + (q & 3)) * 2048 + 8 * g);
#pragma unroll
        for (int dc = 0; dc < 4; ++dc) C.kf[T][dc] = *(const GAS bf16x8*)(kbase + koff + 32 * dc); }
}
__device__ __forceinline__ void attn_load_v(AttnV& C, const GAS bf16* vbase  , int q, int g) {
    const unsigned voff = (unsigned)(q * MT + 8 * g);
#pragma unroll
    for (int dt = 0; dt < 8; ++dt) { const GAS bf16* vrow = vbase + (size_t)dt * 16 * MT; C.vf[dt] = *(const GAS bf16x8*)(vrow + voff); }
}
__device__ __forceinline__ void attn_load_k_ctx(AttnK& C, const LAS unsigned char* KC, int cc, int q, int g) {
#pragma unroll
    for (int T = 0; T < 2; ++T) { const int kk = 8 * (q >> 2) + 4 * T + (q & 3);
#pragma unroll
        for (int dc = 0; dc < 4; ++dc) C.kf[T][dc] = *(const LAS bf16x8*)(KC + (32 * cc + kk) * ATT_KC_PITCH + (32 * dc + 8 * g) * 2); }
}
__device__ __forceinline__ void attn_load_v_ctx(AttnV& C, const LAS unsigned char* VC, int cc, int q, int g) {
#pragma unroll
    for (int dt = 0; dt < 8; ++dt) C.vf[dt] = *(const LAS bf16x8*)(VC + (16 * dt + q) * ATT_VC_PITCH + (32 * cc + 8 * g) * 2);
}
__device__ __forceinline__ void attn_compute(const AttnK& C, const AttnV& V, const bf16x8 (&qf)[4], f32x4 (&o)[8], float& mrun, float& lsum, int lane, int g,
                                             bool masked, int keycol0, int cs, const LAS float* brow  , int cq) {
    f32x4 s[2];
#pragma unroll
    for (int T = 0; T < 2; ++T) { s[T] = (f32x4){0.f, 0.f, 0.f, 0.f};
#pragma unroll
        for (int dc = 0; dc < 4; ++dc) s[T] = MFMA16(C.kf[T][dc], qf[dc], s[T]); }
    if (masked) {
#pragma unroll
        for (int T = 0; T < 2; ++T)
#pragma unroll
            for (int i = 0; i < 4; ++i) { const int keycol = keycol0 + 8 * g + 4 * T + i; const bool ok = keycol >= cs && keycol < cs + 16;
                const int dcol = keycol - cq + 15; const float bv = brow[ok ? dcol : 0];
                s[T][i] = ok ? s[T][i] + bv : -1e30f; }
    }
    float cm = fmaxf(fmaxf(fmaxf(s[0][0], s[0][1]), fmaxf(s[0][2], s[0][3])), fmaxf(fmaxf(s[1][0], s[1][1]), fmaxf(s[1][2], s[1][3])));
    cm = fmaxf(cm, lane_read(cm, lane ^ 16)); cm = fmaxf(cm, lane_read(cm, lane ^ 32));
    const float mnew = fmaxf(mrun, cm), alpha = __builtin_amdgcn_exp2f(mrun - mnew);
    mrun = mnew;
    float p[8]; float ps = 0.f;
#pragma unroll
    for (int T = 0; T < 2; ++T)
#pragma unroll
        for (int i = 0; i < 4; ++i) { p[4 * T + i] = __builtin_amdgcn_exp2f(s[T][i] - mnew); ps += p[4 * T + i]; }
    lsum = lsum * alpha + ps;
    v4u pw; pw.x = pg8::cvt_pk_bf16(p[0], p[1]); pw.y = pg8::cvt_pk_bf16(p[2], p[3]); pw.z = pg8::cvt_pk_bf16(p[4], p[5]); pw.w = pg8::cvt_pk_bf16(p[6], p[7]);
    const bf16x8 pf = __builtin_bit_cast(bf16x8, pw);
#pragma unroll
    for (int dt = 0; dt < 8; ++dt) { o[dt] = o[dt] * alpha; o[dt] = MFMA16(V.vf[dt], pf, o[dt]); }
}
__device__ __forceinline__ void attn_tile(Frame& F, bool is_lat, int b, int h, int r, int c0, int qrow0, const LAS float* bias_h) {
    const GAS bf16* QK = WSP(bf16, WS_QK); const GAS bf16* VT = WSP(bf16, WS_VT); GAS bf16* A = WSP(bf16, WS_A);
    const int q = F.lane & 15, g = F.lane >> 4;
    bf16x8 qf[4];
    { const GAS bf16* qp = QK + (size_t)(qrow0 + q) * 2048 + h * 128 + 8 * g;
#pragma unroll
      for (int dc = 0; dc < 4; ++dc) qf[dc] = *(const GAS bf16x8*)(qp + 32 * dc); }
    f32x4 o[8];
#pragma unroll
    for (int dt = 0; dt < 8; ++dt) o[dt] = (f32x4){0.f, 0.f, 0.f, 0.f};
    float mrun = -1e30f, lsum = 0.f;
    const int r0 = min(max(r - 4, 0), GROWS - 8), kc0 = min(max(c0 - 8, 0), 32), cq = c0 + q, cs = min(max(cq - 8, 0), 48);
    const GAS bf16* kh = QK + 1024 + h * 128; const GAS bf16* vh = VT + (size_t)(h * 128) * MT;
#define ATT_TOK(c) ((c) < 8 ? b * SEQ + (r0 + (c)) * GRIDW + kc0 : ML + b * CTXL + 32 * ((c) - 8))
#define ATT_LOADK(C, c) do { if ((c) < 8) { const int tok_ = ATT_TOK(c); attn_load_k(C, kh + (size_t)tok_ * 2048, q, g); } else attn_load_k_ctx(C, F.lds + ATT_KC_OFF, (c) - 8, q, g); } while (0)
#define ATT_LOADV(C, c) do { if ((c) < 8) { const int tok_ = ATT_TOK(c); attn_load_v(C, vh + tok_, q, g); } else attn_load_v_ctx(C, F.lds + ATT_VC_OFF, (c) - 8, q, g); } while (0)
#define ATT_COMP(C, V, c) attn_compute(C, V, qf, o, mrun, lsum, F.lane, g, (c) < 8, kc0, cs, bias_h + (r0 + ((c) < 8 ? (c) : 0) - r + 7) * 31, cq)
    AttnK KA, KB; AttnV VV;
    const int cbeg = is_lat ? 0 : 8;
    ATT_LOADK(KA, cbeg);
    for (int c = cbeg; c < 16; c += 2) {
        ATT_LOADV(VV, c); ATT_LOADK(KB, c + 1); __builtin_amdgcn_sched_barrier(0);
        ATT_COMP(KA, VV, c); __builtin_amdgcn_sched_barrier(0);
        ATT_LOADV(VV, c + 1); if (c + 2 < 16) ATT_LOADK(KA, c + 2);
        __builtin_amdgcn_sched_barrier(0);
        ATT_COMP(KB, VV, c + 1); __builtin_amdgcn_sched_barrier(0);
    }
#undef ATT_TOK
#undef ATT_LOADK
#undef ATT_LOADV
#undef ATT_COMP
    lsum += lane_read(lsum, F.lane ^ 16); lsum += lane_read(lsum, F.lane ^ 32);
    const float inv = 1.0f / lsum;
    GAS bf16* ap = A + (size_t)(qrow0 + q) * 1024 + h * 128 + 4 * g;
#pragma unroll
    for (int dt = 0; dt < 8; ++dt) { v2u w; w.x = pg8::cvt_pk_bf16(o[dt][0] * inv, o[dt][1] * inv); w.y = pg8::cvt_pk_bf16(o[dt][2] * inv, o[dt][3] * inv); *(GAS v2u*)(ap + 16 * dt) = w; }
}
__device__ __forceinline__ void attn_pair(Frame& F, int b, int h, int r, int c0, const LAS float* bias_h) {
    const GAS bf16* QK = WSP(bf16, WS_QK); const GAS bf16* VT = WSP(bf16, WS_VT); GAS bf16* A = WSP(bf16, WS_A);
    const int q = F.lane & 15, g = F.lane >> 4;
    const int qrowA = b * SEQ + r * GRIDW + c0, qrowB = qrowA + GRIDW;
    bf16x8 qfA[4], qfB[4];
    { const GAS bf16* qp = QK + (size_t)(qrowA + q) * 2048 + h * 128 + 8 * g;
#pragma unroll
      for (int dc = 0; dc < 4; ++dc) { qfA[dc] = *(const GAS bf16x8*)(qp + 32 * dc); qfB[dc] = *(const GAS bf16x8*)(qp + (size_t)GRIDW * 2048 + 32 * dc); } }
    f32x4 oA[8], oB[8];
#pragma unroll
    for (int dt = 0; dt < 8; ++dt) { oA[dt] = (f32x4){0.f, 0.f, 0.f, 0.f}; oB[dt] = oA[dt]; }
    float mA = -1e30f, lA = 0.f, mB = -1e30f, lB = 0.f;
    const int r0A = min(max(r - 4, 0), GROWS - 8), r0B = min(max(r - 3, 0), GROWS - 8), kc0 = min(max(c0 - 8, 0), 32), cq = c0 + q, cs = min(max(cq - 8, 0), 48);
    const GAS bf16* kh = QK + 1024 + h * 128; const GAS bf16* vh = VT + (size_t)(h * 128) * MT;
    AttnK KK; AttnV VV;
    for (int kr = r0A; kr < r0B + 8; ++kr) {
        const int tok = b * SEQ + kr * GRIDW + kc0;
        attn_load_k(KK, kh + (size_t)tok * 2048, q, g); attn_load_v(VV, vh + tok, q, g);
        if (kr < r0A + 8) attn_compute(KK, VV, qfA, oA, mA, lA, F.lane, g, true, kc0, cs, bias_h + (kr - r + 7) * 31, cq);
        if (kr >= r0B)    attn_compute(KK, VV, qfB, oB, mB, lB, F.lane, g, true, kc0, cs, bias_h + (kr - r + 6) * 31, cq);
    }
    for (int cc = 0; cc < 8; ++cc) {
        attn_load_k_ctx(KK, F.lds + ATT_KC_OFF, cc, q, g); attn_load_v_ctx(VV, F.lds + ATT_VC_OFF, cc, q, g);
        attn_compute(KK, VV, qfA, oA, mA, lA, F.lane, g, false, 0, 0, bias_h, 0);
        attn_compute(KK, VV, qfB, oB, mB, lB, F.lane, g, false, 0, 0, bias_h, 0);
    }
    lA += lane_read(lA, F.lane ^ 16); lA += lane_read(lA, F.lane ^ 32); lB += lane_read(lB, F.lane ^ 16); lB += lane_read(lB, F.lane ^ 32);
    const float iA = 1.0f / lA, iB = 1.0f / lB;
    GAS bf16* ap = A + (size_t)(qrowA + q) * 1024 + h * 128 + 4 * g;
#pragma unroll
    for (int dt = 0; dt < 8; ++dt) { v2u w; w.x = pg8::cvt_pk_bf16(oA[dt][0] * iA, oA[dt][1] * iA); w.y = pg8::cvt_pk_bf16(oA[dt][2] * iA, oA[dt][3] * iA); *(GAS v2u*)(ap + 16 * dt) = w;
        v2u x; x.x = pg8::cvt_pk_bf16(oB[dt][0] * iB, oB[dt][1] * iB); x.y = pg8::cvt_pk_bf16(oB[dt][2] * iB, oB[dt][3] * iB); *(GAS v2u*)(ap + (size_t)GRIDW * 1024 + 16 * dt) = x; }
}
__device__ __forceinline__ void attn_phase(Frame& F, int l, bool with_ctx) {
    LAS float* bias = (LAS float*)(F.lds + ATT_BIAS_OFF);
    const GAS float* p_rpb = IN(na_rpb) + (size_t)l * NHEAD * 465;
    for (int i = F.tid; i < NHEAD * 465; i += NTHR) bias[i] = p_rpb[i] * LOG2E;
    const GAS bf16* QK = WSP(bf16, WS_QK); const GAS bf16* VT = WSP(bf16, WS_VT);
    for (int wgi = F.vcu; wgi < 256; wgi += F.G) {
        const int bh = wgi >> 4, b = bh >> 3, h = bh & 7, sub = wgi & 15;
        __syncthreads();
#pragma unroll 4
        for (int i = F.tid; i < 256 * 16; i += NTHR) { const int row = i >> 4, pc = i & 15;
            *(LAS v4u*)(F.lds + ATT_KC_OFF + row * ATT_KC_PITCH + pc * 16) = *(const GAS v4u*)(QK + (size_t)(ML + b * CTXL + row) * 2048 + 1024 + h * 128 + 8 * pc); }
#pragma unroll 4
        for (int i = F.tid; i < 128 * 32; i += NTHR) { const int row = i >> 5, pc = i & 31;
            *(LAS v4u*)(F.lds + ATT_VC_OFF + row * ATT_VC_PITCH + pc * 16) = *(const GAS v4u*)(VT + (size_t)(h * 128 + row) * MT + ML + b * CTXL + 8 * pc); }
        __syncthreads();
        const int rb = sub * 2 + (F.wave >> 2), c0 = 16 * (F.wave & 3);
#if defined(ATT_SINGLE)
        for (int rr = 0; rr < 8; ++rr) { const int r = rb * 8 + rr; attn_tile(F, true, b, h, r, c0, b * SEQ + r * GRIDW + c0, bias + h * 465); }
#else
        for (int rr = 0; rr < 8; rr += 2) attn_pair(F, b, h, rb * 8 + rr, c0, bias + h * 465);
#endif
        if (with_ctx) {
            if ((F.wave & 3) == 0) { const int t = sub; if ((F.wave >> 2) == (t & 1)) attn_tile(F, false, b, h, 0, 0, ML + b * CTXL + 16 * t, bias + h * 465); }
        }
    }
    __syncthreads();
}

constexpr int FFTN = 16384, FFT_PHYS = FFTN + FFTN / 16;
__device__ __forceinline__ int phys(int i) { return i + ((i >> 6) << 2); }
__device__ __forceinline__ f32x2 tw32k(const LAS f32x2* TH, const LAS f32x2* TL, int n) { return cmul(TH[n >> 7], TL[n & 127]); }
template <bool INV> __device__ __forceinline__ void r4(f32x2& x0, f32x2& x1, f32x2& x2, f32x2& x3) {
    const f32x2 a = x0 + x2, c = x0 - x2, b = x1 + x3, e = x1 - x3;
    const f32x2 d = INV ? (f32x2){-e.y, e.x} : (f32x2){e.y, -e.x};
    x0 = a + b; x1 = c + d; x2 = a - b; x3 = c - d;
}
template <bool INV> __device__ __forceinline__ void dft16(f32x2 (&x)[16]) {
#pragma unroll
    for (int b = 0; b < 4; ++b) r4<INV>(x[b], x[4 + b], x[8 + b], x[12 + b]);
    const float sg = INV ? -1.f : 1.f;
    const f32x2 W1 = {0.92387953251f, -0.38268343236f * sg}, W2 = {0.70710678118f, -0.70710678118f * sg}, W3 = {0.38268343236f, -0.92387953251f * sg},
                W4 = {0.f, -1.f * sg}, W6 = {-0.70710678118f, -0.70710678118f * sg}, W9 = {-0.92387953251f, 0.38268343236f * sg};
    x[5] = cmul(x[5], W1); x[9] = cmul(x[9], W2); x[13] = cmul(x[13], W3);
    x[6] = cmul(x[6], W2); x[10] = cmul(x[10], W4); x[14] = cmul(x[14], W6);
    x[7] = cmul(x[7], W3); x[11] = cmul(x[11], W6); x[15] = cmul(x[15], W9);
#pragma unroll
    for (int c = 0; c < 4; ++c) r4<INV>(x[4 * c], x[4 * c + 1], x[4 * c + 2], x[4 * c + 3]);
}
template <bool INV> __device__ __forceinline__ void bfly16(f32x2 (&x)[16], const LAS f32x2* TH, const LAS f32x2* TL, int tw) {
    f32x2 W = tw32k(TH, TL, tw); if (INV) W.y = -W.y;
    if (INV) { f32x2 p = W;
#pragma unroll
        for (int q = 1; q < 16; ++q) { x[q] = cmul(x[q], p); if (q < 15) p = cmul(p, W); } }
    dft16<INV>(x);
    if (!INV) { f32x2 p = W;
#pragma unroll
        for (int r = 1; r < 16; ++r) { x[4 * (r & 3) + (r >> 2)] = cmul(x[4 * (r & 3) + (r >> 2)], p); if (r < 15) p = cmul(p, W); } }
}
template <bool INV> __device__ __forceinline__ void pass16(LAS f32x2* X, const LAS f32x2* TH, const LAS f32x2* TL, int base, int stride, int tw) {
    f32x2 x[16];
#pragma unroll
    for (int q = 0; q < 16; ++q) x[q] = X[base + q * stride];
    bfly16<INV>(x, TH, TL, tw);
#pragma unroll
    for (int c = 0; c < 4; ++c)
#pragma unroll
        for (int d = 0; d < 4; ++d) X[base + (c + 4 * d) * stride] = x[4 * c + d];
}
template <bool INV> __device__ __forceinline__ void pass16_s4(LAS f32x2* X, const LAS f32x2* TH, const LAS f32x2* TL, int blk, int h) {
#pragma unroll 1
    for (int s = 0; s < 2; ++s) {
        LAS f32x2* P = X + blk * 68 + 2 * h + s;
        f32x2 x[16];
#pragma unroll
        for (int q = 0; q < 16; ++q) x[q] = P[4 * q];
        bfly16<INV>(x, TH, TL, (2 * h + s) * 512);
#pragma unroll
        for (int c = 0; c < 4; ++c)
#pragma unroll
            for (int d = 0; d < 4; ++d) P[4 * (c + 4 * d)] = x[4 * c + d];
    }
}
template <bool INV> __device__ __forceinline__ void pass4_s1(LAS f32x2* X, int b) {
    LAS f32x4* P = (LAS f32x4*)(X + 4 * b + ((b >> 4) << 2));
    const f32x4 u = P[0], v = P[1];
    f32x2 x0 = {u.x, u.y}, x1 = {u.z, u.w}, x2 = {v.x, v.y}, x3 = {v.z, v.w};
    r4<INV>(x0, x1, x2, x3);
    P[0] = (f32x4){x0.x, x0.y, x1.x, x1.y}; P[1] = (f32x4){x2.x, x2.y, x3.x, x3.y};
}
__device__ __forceinline__ void fft_fwd_head(LAS f32x2* X, const LAS f32x2* TH, const LAS f32x2* TL, int tid) {
#pragma unroll 1
    for (int i = 0; i < 2; ++i) { const int j = tid + NTHR * i; pass16<false>(X, TH, TL, j + ((j >> 6) << 2), 1088, 2 * j); }
    __syncthreads();
#pragma unroll 1
    for (int i = 0; i < 2; ++i) { const int b = tid + NTHR * i, j = b & 63, blk = b >> 6; pass16<false>(X, TH, TL, blk * 1088 + j, 68, 32 * j); }
    __syncthreads();
    pass16_s4<false>(X, TH, TL, tid >> 1, tid & 1);
    __syncthreads();
}
__device__ __forceinline__ void fft_fwd(LAS f32x2* X, const LAS f32x2* TH, const LAS f32x2* TL, int tid) {
    fft_fwd_head(X, TH, TL, tid);
#pragma unroll 2
    for (int i = 0; i < 8; ++i) pass4_s1<false>(X, tid + NTHR * i);
    __syncthreads();
}
__device__ __forceinline__ void fft_inv_tail(LAS f32x2* X, const LAS f32x2* TH, const LAS f32x2* TL, int tid) {
    pass16_s4<true>(X, TH, TL, tid >> 1, tid & 1);
    __syncthreads();
#pragma unroll 1
    for (int i = 0; i < 2; ++i) { const int b = tid + NTHR * i, j = b & 63, blk = b >> 6; pass16<true>(X, TH, TL, blk * 1088 + j, 68, 32 * j); }
    __syncthreads();
#pragma unroll 1
    for (int i = 0; i < 2; ++i) { const int j = tid + NTHR * i; pass16<true>(X, TH, TL, j + ((j >> 6) << 2), 1088, 2 * j); }
    __syncthreads();
}
__device__ __forceinline__ void fft_inv(LAS f32x2* X, const LAS f32x2* TH, const LAS f32x2* TL, int tid) {
#pragma unroll 2
    for (int i = 0; i < 8; ++i) pass4_s1<true>(X, tid + NTHR * i);
    __syncthreads();
    fft_inv_tail(X, TH, TL, tid);
}
__device__ __forceinline__ int freq_pos(int k) { return phys(((k & 15) << 10) | (((k >> 4) & 15) << 6) | (((k >> 8) & 15) << 2) | (k >> 12)); }

__device__ __forceinline__ float conv3(const GAS float* p, int n, int Lq, float w0, float w1, float w2, float bb) {
    float a = p[n] * w1 + bb; if (n > 0) a += p[n - 1] * w0; if (n < Lq - 1) a += p[n + 1] * w2; return a;
}
__device__ __forceinline__ f32x4 conv3v(const GAS float* p, int n0, int Lq, float w0, float w1, float w2, float bb) {
    const f32x4 c = *(const GAS f32x4*)(p + n0); const float l = n0 > 0 ? p[n0 - 1] : 0.f, r = n0 + 4 < Lq ? p[n0 + 4] : 0.f;
    return (f32x4){w0 * l + w1 * c.x + w2 * c.y + bb, w0 * c.x + w1 * c.y + w2 * c.z + bb, w0 * c.y + w1 * c.z + w2 * c.w + bb, w0 * c.z + w1 * c.w + w2 * r + bb};
}
__device__ __forceinline__ void tw4(const LAS f32x2* TH, const LAS f32x2* TL, int n0, f32x2 (&w)[4]) {
    const f32x2 th = TH[n0 >> 7]; const LAS f32x4* tl = (const LAS f32x4*)(TL + (n0 & 127)); const f32x4 a = tl[0], b = tl[1];
    w[0] = cmul(th, (f32x2){a.x, a.y}); w[1] = cmul(th, (f32x2){a.z, a.w}); w[2] = cmul(th, (f32x2){b.x, b.y}); w[3] = cmul(th, (f32x2){b.z, b.w});
}

#define LT() ({ int lt_ = tid; asm volatile("" : "+v"(lt_)); lt_; })
__device__ __forceinline__ void hyena_latent(Frame& F, int l, int ch, LAS f32x2* X, const LAS f32x2* TH, const LAS f32x2* TL, GAS f32x2* KS, bool wr = true) {
    GAS float* T32 = WSP(float, WS_T32);
    GAS float* hv = T32 + (size_t)(512 + ch) * MT; const GAS float* hx1 = T32 + (size_t)(1024 + ch) * MT; const GAS float* hx2 = T32 + (size_t)(1536 + ch) * MT;
    const GAS float* cw = IN(hy_conv_w) + (size_t)l * 3 * 1536; const GAS float* cb = IN(hy_conv_b) + (size_t)l * 1536;
    const GAS float* HF = WSP(float, WS_HF); const GAS float* p_hb = IN(hy_bias) + (size_t)l * 2 * HYW + ch;
    const int tid = F.tid;
    GAS f32x4* KE4 = (GAS f32x4*)KS;
    f32x4 kreg[16];
    for (int o = 0; o < 2; ++o) {
        const GAS float* hf = HF + (size_t)(o * 1024 + ch) * SEQ; const GAS float* hbr = HF + (size_t)(o * 1024 + 512 + ch) * SEQ;
        const float bias = p_hb[o * HYW];
        const float vw0 = cw[ch], vw1 = cw[1536 + ch], vw2 = cw[3072 + ch], vbb = cb[ch];
        const GAS float* hx = o == 0 ? hx1 : hx2; const int xo = o == 0 ? 512 : 1024;
        const float xw0 = cw[xo + ch], xw1 = cw[1536 + xo + ch], xw2 = cw[3072 + xo + ch], xbb = cb[xo + ch];
        for (int par = 0; par < 2; ++par) {
#if defined(PROBE_ELEM)
            for (int rep_ = 0; rep_ < 2; ++rep_)
#endif
#pragma unroll
            for (int i = 0; i < 8; ++i) { const int g = LT() + NTHR * i, n0 = 4 * g; const f32x4 f = *(const GAS f32x4*)(hf + n0), bk = *(const GAS f32x4*)(hbr + n0);
                LAS f32x4* XP = (LAS f32x4*)(X + phys(n0));
                if (par == 0) { XP[0] = (f32x4){f.x + bk.x, 0.f, f.y + bk.y, 0.f}; XP[1] = (f32x4){f.z + bk.z, 0.f, f.w + bk.w, 0.f}; }
                else { f32x2 w[4]; tw4(TH, TL, n0, w); const f32x4 d = f - bk;
                    XP[0] = (f32x4){w[0].x * d.x, w[0].y * d.x, w[1].x * d.y, w[1].y * d.y}; XP[1] = (f32x4){w[2].x * d.z, w[2].y * d.z, w[3].x * d.w, w[3].y * d.w}; } }
            __syncthreads();
            fft_fwd_head(X, TH, TL, tid);
#pragma unroll
            for (int i = 0; i < 8; ++i) { const int b = LT() + NTHR * i; const LAS f32x4* P = (const LAS f32x4*)(X + 4 * b + ((b >> 4) << 2)); const f32x4 u = P[0], v = P[1];
                f32x2 x0 = {u.x, u.y}, x1 = {u.z, u.w}, x2 = {v.x, v.y}, x3 = {v.z, v.w}; r4<false>(x0, x1, x2, x3);
                kreg[2 * i] = (f32x4){x0.x, x0.y, x1.x, x1.y}; kreg[2 * i + 1] = (f32x4){x2.x, x2.y, x3.x, x3.y}; }
            __syncthreads();
#if defined(PROBE_ELEM)
            for (int rep_ = 0; rep_ < 2; ++rep_)
#endif
#pragma unroll 2
            for (int i = 0; i < 8; ++i) { const int g = LT() + NTHR * i, n0 = 4 * g;
                f32x4 z0, z1; if (o == 0) { z0 = conv3v(hv, n0, SEQ, vw0, vw1, vw2, vbb); z1 = conv3v(hv + SEQ, n0, SEQ, vw0, vw1, vw2, vbb); } else { z0 = *(const GAS f32x4*)(hv + n0); z1 = *(const GAS f32x4*)(hv + SEQ + n0); }
                LAS f32x4* XP = (LAS f32x4*)(X + phys(n0));
                if (par == 0) { XP[0] = (f32x4){z0.x, z1.x, z0.y, z1.y}; XP[1] = (f32x4){z0.z, z1.z, z0.w, z1.w}; }
                else { f32x2 w[4]; tw4(TH, TL, n0, w);
                    const f32x2 a0 = cmul((f32x2){z0.x, z1.x}, w[0]), a1 = cmul((f32x2){z0.y, z1.y}, w[1]), a2 = cmul((f32x2){z0.z, z1.z}, w[2]), a3 = cmul((f32x2){z0.w, z1.w}, w[3]);
                    XP[0] = (f32x4){a0.x, a0.y, a1.x, a1.y}; XP[1] = (f32x4){a2.x, a2.y, a3.x, a3.y}; } }
            __syncthreads();
#if defined(PROBE_FFTCORE)
            fft_fwd(X, TH, TL, tid); fft_inv(X, TH, TL, tid);
            for (int i = 0; i < 8; ++i) { const int g = LT() + NTHR * i; LAS f32x4* XP = (LAS f32x4*)(X + phys(4 * g)); XP[0] = XP[0] * (1.0f / 16384.0f); XP[1] = XP[1] * (1.0f / 16384.0f); }
            __syncthreads();
#endif
            fft_fwd_head(X, TH, TL, tid);
#pragma unroll
            for (int i = 0; i < 8; ++i) { const int b = LT() + NTHR * i; LAS f32x4* P = (LAS f32x4*)(X + 4 * b + ((b >> 4) << 2)); const f32x4 u = P[0], v = P[1], k0 = kreg[2 * i], k1 = kreg[2 * i + 1];
                f32x2 x0 = {u.x, u.y}, x1 = {u.z, u.w}, x2 = {v.x, v.y}, x3 = {v.z, v.w}; r4<false>(x0, x1, x2, x3);
                x0 = cmul(x0, (f32x2){k0.x, k0.y}); x1 = cmul(x1, (f32x2){k0.z, k0.w}); x2 = cmul(x2, (f32x2){k1.x, k1.y}); x3 = cmul(x3, (f32x2){k1.z, k1.w});
                r4<true>(x0, x1, x2, x3);
                P[0] = (f32x4){x0.x, x0.y, x1.x, x1.y}; P[1] = (f32x4){x2.x, x2.y, x3.x, x3.y};
                if (i & 1) asm volatile("" ::: "memory"); }
            __syncthreads();
            fft_inv_tail(X, TH, TL, tid);
            if (par == 0) {
#pragma unroll
                for (int i = 0; i < 8; ++i) { const int g = LT() + NTHR * i; const LAS f32x4* XP = (const LAS f32x4*)(X + phys(4 * g)); KE4[2 * g] = XP[0]; KE4[2 * g + 1] = XP[1]; }
                __syncthreads();
            }
        }
#pragma unroll 4
        for (int i = 0; i < 8; ++i) { const int g = LT() + NTHR * i, n0 = 4 * g;
            f32x4 z0, z1; if (o == 0) { z0 = conv3v(hv, n0, SEQ, vw0, vw1, vw2, vbb); z1 = conv3v(hv + SEQ, n0, SEQ, vw0, vw1, vw2, vbb); } else { z0 = *(const GAS f32x4*)(hv + n0); z1 = *(const GAS f32x4*)(hv + SEQ + n0); }
            const f32x4 g0 = conv3v(hx, n0, SEQ, xw0, xw1, xw2, xbb), g1 = conv3v(hx + SEQ, n0, SEQ, xw0, xw1, xw2, xbb);
            const f32x4 e0 = KE4[2 * g], e1 = KE4[2 * g + 1];
            LAS f32x4* XP = (LAS f32x4*)(X + phys(n0)); const f32x4 u0 = XP[0], u1 = XP[1];
            f32x2 w[4]; tw4(TH, TL, n0, w);
            const f32x2 c0 = cmul((f32x2){u0.x, u0.y}, cconj(w[0])), c1 = cmul((f32x2){u0.z, u0.w}, cconj(w[1])), c2 = cmul((f32x2){u1.x, u1.y}, cconj(w[2])), c3 = cmul((f32x2){u1.z, u1.w}, cconj(w[3]));
            const float sc = 1.0f / 32768.0f;
            const f32x2 y0 = ((f32x2){e0.x, e0.y} + c0) * sc + (f32x2){z0.x, z1.x} * bias, y1 = ((f32x2){e0.z, e0.w} + c1) * sc + (f32x2){z0.y, z1.y} * bias,
                        y2 = ((f32x2){e1.x, e1.y} + c2) * sc + (f32x2){z0.z, z1.z} * bias, y3 = ((f32x2){e1.z, e1.w} + c3) * sc + (f32x2){z0.w, z1.w} * bias;
            XP[0] = (f32x4){g0.x * y0.x, g0.y * y1.x, g0.z * y2.x, g0.w * y3.x};
            XP[1] = (f32x4){g1.x * y0.y, g1.y * y1.y, g1.z * y2.y, g1.w * y3.y}; }
        __syncthreads();
#pragma unroll
        for (int i = 0; i < 8; ++i) { const int g = LT() + NTHR * i, n0 = 4 * g; const LAS f32x4* XP = (const LAS f32x4*)(X + phys(n0)); if (wr) { *(GAS f32x4*)(hv + n0) = XP[0]; *(GAS f32x4*)(hv + SEQ + n0) = XP[1]; } }
        __syncthreads();
    }
}
__device__ __forceinline__ void fourier_latent(Frame& F, int b, int gq, int m, LAS f32x2* X, const LAS f32x2* TH, const LAS f32x2* TL, bool wr = true) {
    GAS float* T32 = WSP(float, WS_T32);
    GAS float* ra = T32 + (size_t)(gq * 128 + m) * MT + b * SEQ; GAS float* rb = T32 + (size_t)(gq * 128 + 64 + m) * MT + b * SEQ;
    const int tid = F.tid;
#pragma unroll
    for (int i = 0; i < 8; ++i) { const int g = LT() + NTHR * i, n0 = 4 * g; const f32x4 a = *(const GAS f32x4*)(ra + n0), c = *(const GAS f32x4*)(rb + n0);
        LAS f32x4* XP = (LAS f32x4*)(X + phys(n0)); XP[0] = (f32x4){a.x, c.x, a.y, c.y}; XP[1] = (f32x4){a.z, c.z, a.w, c.w}; }
    __syncthreads();
    fft_fwd(X, TH, TL, tid);
    const float sc = 6.9053396600248786e-4f;
#pragma unroll 2
    for (int i = 0; i < 8; ++i) { const int g = LT() + NTHR * i, k0 = 4 * g; f32x4 oa, ob;
#pragma unroll
        for (int e = 0; e < 4; ++e) { const int k = k0 + e; const f32x2 u = X[freq_pos(k)], v = X[freq_pos((FFTN - k) & (FFTN - 1))];
            if (m != 0) { oa[e] = u.x * sc; ob[e] = v.x * sc; } else { oa[e] = (u.x + v.x) * (0.5f * sc); ob[e] = (u.y + v.y) * (0.5f * sc); } }
        if (wr) { *(GAS f32x4*)(ra + k0) = oa; *(GAS f32x4*)(rb + k0) = ob; } }
    __syncthreads();
}
__device__ __forceinline__ void hyena_ctx(Frame& F, int l, int ch, LAS float* S, bool wr = true) {
    GAS float* T32 = WSP(float, WS_T32);
    GAS float* hv = T32 + (size_t)(512 + ch) * MT + ML; const GAS float* hx1 = T32 + (size_t)(1024 + ch) * MT + ML; const GAS float* hx2 = T32 + (size_t)(1536 + ch) * MT + ML;
    const GAS float* cw = IN(hy_conv_w) + (size_t)l * 3 * 1536; const GAS float* cb = IN(hy_conv_b) + (size_t)l * 1536;
    const GAS float* HFC = WSP(float, WS_HFC); const GAS float* p_hb = IN(hy_bias) + (size_t)l * 2 * HYW + ch;
    LAS float* zb = S; LAS float* hfl = S + 512; LAS float* hbl = S + 768;
    const int n = F.tid & 255, b = F.tid >> 8;
    __syncthreads();
    zb[b * 256 + n] = conv3(hv + b * CTXL, n, CTXL, cw[ch], cw[1536 + ch], cw[3072 + ch], cb[ch]);
    for (int o = 0; o < 2; ++o) {
        if (F.tid < 256) hfl[n] = HFC[(size_t)(o * 1024 + ch) * CTXL + n]; else hbl[n] = HFC[(size_t)(o * 1024 + 512 + ch) * CTXL + n];
        __syncthreads();
        float y = 0.f;
        for (int mI = 0; mI < CTXL; ++mI) { const int d = n - mI; y += zb[b * 256 + mI] * (d >= 0 ? hfl[d] : hbl[CTXL + d]); }
        y += p_hb[o * HYW] * zb[b * 256 + n];
        const GAS float* hx = o == 0 ? hx1 : hx2; const int xo = o == 0 ? 512 : 1024;
        const float r = conv3(hx + b * CTXL, n, CTXL, cw[xo + ch], cw[1536 + xo + ch], cw[3072 + xo + ch], cb[xo + ch]) * y;
        __syncthreads();
        if (o == 0) zb[b * 256 + n] = r; else if (wr) hv[b * CTXL + n] = r;
        __syncthreads();
    }
}
__device__ __forceinline__ void fourier_ctx(Frame& F, int item, LAS float* S, bool wr = true) {
    GAS float* T32 = WSP(float, WS_T32);
    const int b = item >> 7, gq = (item >> 5) & 3, m0 = (item & 31) * 2;
    LAS float* cs = S; LAS float* re = S + 256; LAS float* im = S + 256 + 512;
    __syncthreads();
    if (F.tid < 256) cs[F.tid] = cospif((float)F.tid * (1.0f / 128.0f));
    { const int mm = F.tid >> 8, n = F.tid & 255;
      re[F.tid] = T32[(size_t)(gq * 128 + m0 + mm) * MT + ML + b * CTXL + n]; im[F.tid] = T32[(size_t)(gq * 128 + 64 + m0 + mm) * MT + ML + b * CTXL + n]; }
    __syncthreads();
    const int k = F.tid & 255, mm = F.tid >> 8, m = m0 + mm;
    const float sc = 5.5242717280199031e-3f;
    float cr = 0.f, ci = 0.f, sr = 0.f, si = 0.f;
#pragma unroll 4
    for (int n = 0; n < 256; ++n) { const int ix = (k * n) & 255; const float c = cs[ix], sn = cs[(ix - 64) & 255]; const float a = re[mm * 256 + n], bq = im[mm * 256 + n];
        cr += a * c; ci += bq * c; sr += a * sn; si += bq * sn; }
    float oa, ob;
    if (m != 0) { oa = cr + si; ob = cr - si; } else { oa = cr; ob = ci; }
    if (wr) { T32[(size_t)(gq * 128 + m) * MT + ML + b * CTXL + k] = oa * sc; T32[(size_t)(gq * 128 + 64 + m) * MT + ML + b * CTXL + k] = ob * sc; }
    __syncthreads();
}
__device__ __forceinline__ void fft_phase(Frame& F, int l, bool with_ctx) {
    LAS f32x2* X = (LAS f32x2*)F.lds;
    LAS f32x2* TH = (LAS f32x2*)(F.lds + TW_OFF); LAS f32x2* TL = TH + 128;
    if (F.tid < 256) { const int a = F.tid & 127; const float fr = F.tid < 128 ? (float)(128 * a) * (1.0f / 16384.0f) : (float)a * (1.0f / 16384.0f);
        float sn, cn; sincospif(fr, &sn, &cn); (F.tid < 128 ? TH : TL)[a] = (f32x2){cn, -sn}; }
    __syncthreads();
#if defined(PROBE_HYENA)
    { const bool wr0 = opaque_int(0) != 0; for (int ch = F.vcu; ch < HYW; ch += F.G) hyena_latent(F, l, ch, X, TH, TL, WSP(f32x2, WS_KS) + (size_t)F.vcu * 2 * FFTN, wr0); }
#endif
    for (int ch = F.vcu; ch < HYW; ch += F.G) hyena_latent(F, l, ch, X, TH, TL, WSP(f32x2, WS_KS) + (size_t)F.vcu * 2 * FFTN);
#if defined(PROBE_FOUR)
    { const bool wr0 = opaque_int(0) != 0; for (int fu = F.vcu; fu < 512; fu += F.G) fourier_latent(F, fu >> 8, (fu >> 6) & 3, fu & 63, X, TH, TL, wr0); }
#endif
    for (int fu = F.vcu; fu < 512; fu += F.G) fourier_latent(F, fu >> 8, (fu >> 6) & 3, fu & 63, X, TH, TL);
    if (with_ctx) {
        LAS float* S = (LAS float*)F.lds;
#if defined(PROBE_CTX)
        { const bool wr0 = opaque_int(0) != 0; for (int ch = F.vcu; ch < HYW; ch += F.G) hyena_ctx(F, l, ch, S, wr0); for (int it = F.vcu; it < 256; it += F.G) fourier_ctx(F, it, S, wr0); }
#endif
        for (int ch = F.vcu; ch < HYW; ch += F.G) hyena_ctx(F, l, ch, S);
        for (int it = F.vcu; it < 256; it += F.G) fourier_ctx(F, it, S);
    }
}

__device__ __forceinline__ void merge_phase(Frame& F, int l, bool with_ctx) {
    const GAS bf16* A = WSP(bf16, WS_A); const GAS float* T32 = WSP(float, WS_T32); GAS bf16* H = WSP(bf16, WS_H);
    const GAS float* gain = IN(mix_norm_g) + (size_t)l * DM;
    LAS float* tile = (LAS float*)F.lds;
    const int TI = with_ctx ? 65 : 64;
    for (int it = F.vcu; it < 512; it += F.G) {
        const int tok0 = it * TI;
        for (int tk = F.wave; tk < TI; tk += NWAVES) {
            const size_t row = (size_t)(tok0 + tk);
            const v4u r0 = *(const GAS v4u*)(A + row * 1024 + 8 * F.lane), r1 = *(const GAS v4u*)(A + row * 1024 + 512 + 8 * F.lane);
            float v[16];
            v[0] = bf2f(r0.x & 0xffff); v[1] = bf2f(r0.x >> 16); v[2] = bf2f(r0.y & 0xffff); v[3] = bf2f(r0.y >> 16); v[4] = bf2f(r0.z & 0xffff); v[5] = bf2f(r0.z >> 16); v[6] = bf2f(r0.w & 0xffff); v[7] = bf2f(r0.w >> 16);
            v[8] = bf2f(r1.x & 0xffff); v[9] = bf2f(r1.x >> 16); v[10] = bf2f(r1.y & 0xffff); v[11] = bf2f(r1.y >> 16); v[12] = bf2f(r1.z & 0xffff); v[13] = bf2f(r1.z >> 16); v[14] = bf2f(r1.w & 0xffff); v[15] = bf2f(r1.w >> 16);
            float ss = 0.f;
#pragma unroll
            for (int j = 0; j < 16; ++j) ss += v[j] * v[j];
            const float rstd = 1.0f / sqrtf(wave_sum(ss, F.lane) * (1.0f / NAW) + EPS);
            const f32x4 g0 = *(const GAS f32x4*)(gain + 8 * F.lane), g1 = *(const GAS f32x4*)(gain + 8 * F.lane + 4), g2 = *(const GAS f32x4*)(gain + 512 + 8 * F.lane), g3 = *(const GAS f32x4*)(gain + 512 + 8 * F.lane + 4);
            v4u o0, o1;
            o0.x = pk2(v[0] * rstd * g0.x, v[1] * rstd * g0.y); o0.y = pk2(v[2] * rstd * g0.z, v[3] * rstd * g0.w); o0.z = pk2(v[4] * rstd * g1.x, v[5] * rstd * g1.y); o0.w = pk2(v[6] * rstd * g1.z, v[7] * rstd * g1.w);
            o1.x = pk2(v[8] * rstd * g2.x, v[9] * rstd * g2.y); o1.y = pk2(v[10] * rstd * g2.z, v[11] * rstd * g2.w); o1.z = pk2(v[12] * rstd * g3.x, v[13] * rstd * g3.y); o1.w = pk2(v[14] * rstd * g3.z, v[15] * rstd * g3.w);
            *(GAS v4u*)(H + row * DM + 8 * F.lane) = o0; *(GAS v4u*)(H + row * DM + 512 + 8 * F.lane) = o1;
        }
        for (int grp = 0; grp < 2; ++grp) {
            __syncthreads();
            for (int c8 = F.wave * 64; c8 < F.wave * 64 + 64; c8 += 8) {
                float v[8], w[8];
#pragma unroll
                for (int u = 0; u < 8; ++u) { const GAS float* src = T32 + (size_t)(grp * 512 + c8 + u) * MT + tok0; v[u] = src[F.lane]; w[u] = (TI > 64 && F.lane == 0) ? src[64] : 0.f; }
#pragma unroll
                for (int u = 0; u < 8; ++u) { tile[(c8 + u) * 65 + F.lane] = v[u]; if (TI > 64 && F.lane == 0) tile[(c8 + u) * 65 + 64] = w[u]; }
            }
            __syncthreads();
            for (int tk = F.wave; tk < TI; tk += NWAVES) {
                float vv[8]; float ss = 0.f;
#pragma unroll
                for (int i = 0; i < 8; ++i) { const int chn = F.lane + 64 * i; int srow = chn;
                    if (grp == 0) { const int cc = chn & 127; srow = (chn & ~127) + (cc <= 64 ? cc : 192 - cc); }
                    vv[i] = tile[srow * 65 + tk]; ss += vv[i] * vv[i]; }
                const float rstd = 1.0f / sqrtf(wave_sum(ss, F.lane) * (1.0f / 512.0f) + EPS);
                GAS bf16* hp = H + (size_t)(tok0 + tk) * DM + NAW + grp * 512;
#pragma unroll
                for (int i = 0; i < 8; ++i) { const int chn = F.lane + 64 * i; hp[chn] = (bf16)f2bf(vv[i] * rstd * gain[NAW + grp * 512 + chn]); }
            }
        }
    }
}

#define REFRESH(F) do { int t_ = threadIdx.x; asm volatile("" : "+v"(t_)); F.tid = t_; F.lane = t_ & 63; F.wave = __builtin_amdgcn_readfirstlane(t_ >> 6); \
    GAS unsigned char* w_ = args.ws; asm volatile("" : "+s"(w_)); F.ws = w_; GAS float* o_ = args.out; asm volatile("" : "+s"(o_)); F.out = o_; } while (0)
#ifndef REP_P1
#define REP_P1 1
#endif
#ifndef REP_P6
#define REP_P6 1
#endif
#ifndef REP_ATT
#define REP_ATT 1
#endif
#ifndef REP_PA
#define REP_PA 1
#endif
#ifndef REP_NORM
#define REP_NORM 1
#endif
#ifndef REP_FILT
#define REP_FILT 1
#endif
#ifndef REP_MERGE
#define REP_MERGE 1
#endif
#ifndef REP_EDGE
#define REP_EDGE 1
#endif
__global__ void __launch_bounds__(NTHR, 2) fwd_kernel(Args args) {
    extern __shared__ __attribute__((aligned(16))) unsigned char lds[];
    Frame F;
    F.lds = (LAS unsigned char*)lds;
    F.tid = threadIdx.x; F.lane = F.tid & 63; F.wave = __builtin_amdgcn_readfirstlane(F.tid >> 6);
    F.G = gridDim.x; { const int bx = blockIdx.x; F.vcu = (F.G % 8 == 0) ? (bx % 8) * (F.G / 8) + bx / 8 : bx; }
    F.ws = args.ws; F.out = args.out;
    volatile LAS unsigned* MISC = (volatile LAS unsigned*)(F.lds + MISC_OFF);
    for (int u = F.tid; u < 64; u += NTHR) MISC[u] = 0u;
    __syncthreads();
    XcdBarrier bar = xcd_barrier_post((unsigned*)(F.ws + WS_CTL) + CW_BAR, MISC + 8);
    LAS unsigned char* ring = F.lds;
#define GRID_BAR() do { unsigned* bp_ = bar.bar; unsigned bx_ = bar.x; asm volatile("" : "+s"(bp_), "+s"(bx_)); XcdBarrier b_ = bar; b_.bar = bp_; b_.x = bx_; xcd_barrier(b_); } while (0)


#if !defined(OFF_PA)
    for (int rep = 0, nrep = opaque_int(REP_PA); rep < nrep; ++rep) { REFRESH(F); pa_adaln(F); __syncthreads(); pa_weights(F); __syncthreads(); pa_ctx_copy(F); }
#endif

    GRID_BAR();

    for (int l = 0; l < DEPTH; ++l) {
        const bool uc = l < DEPTH - 1;
        const int npm = uc ? PMT : PML;
        const GAS float* MODL = WSP(float, WS_MOD) + (size_t)l * 3 * (NMOD * DM);

#if !defined(OFF_P0)
        for (int rep = 0, nrep = opaque_int(REP_NORM); rep < nrep; ++rep) { REFRESH(F); norm_phase(F, l, 0, true, (l > 0 && rep == 0) ? 4 : 0); __syncthreads(); }
        for (int rep = 0, nrep = opaque_int(REP_FILT); rep < nrep; ++rep) { REFRESH(F); filter_phase(F, l, uc); __syncthreads(); }
#endif

        GRID_BAR();
        {
            const char* Hb = (const char*)WSP(bf16, WS_H); const char* Wb = (const char*)(WSP(bf16, WS_WIN) + (size_t)l * DIN * DM);
            pg8::Sched2 S; S.n1 = PMT * 8; S.nM1 = PMT; S.nN1 = 8; S.n2 = 12 * PMT; S.nM2 = 12; S.nN2 = PMT; S.G = F.G; S.c = (int)blockIdx.x;
            S.A1 = Hb; S.B1 = Wb; S.A2 = Wb + (size_t)2048 * DM * 2; S.B2 = Hb; S.tstep = (size_t)256 * DM * 2;
            EpiIn E{WSP(bf16, WS_QK), WSP(bf16, WS_VT), WSP(float, WS_T32)};

#if !defined(OFF_P1)
            for (int rep = 0, nrep = opaque_int(REP_P1); rep < nrep; ++rep) { pg8::gemm_phase<EpiIn, pg8::Sched2, true, true>(ring, DM, DM, S, E); __syncthreads(); }
#endif

        }
        GRID_BAR();

#if !defined(OFF_ATT)
        for (int rep = 0, nrep = opaque_int(REP_ATT); rep < nrep; ++rep) { REFRESH(F); attn_phase(F, l, uc); }
#endif
#if !defined(OFF_FFT)
        REFRESH(F); fft_phase(F, l, uc);
#endif

        GRID_BAR();

#if !defined(OFF_P3)
        for (int rep = 0, nrep = opaque_int(REP_MERGE); rep < nrep; ++rep) { REFRESH(F); merge_phase(F, l, uc); __syncthreads(); }
#endif

        GRID_BAR();
        {
            pg8::Sched2 S; S.n1 = PML * 8; S.nM1 = PML; S.nN1 = 8; S.n2 = 0; S.nM2 = 1; S.nN2 = 1; S.G = F.G; S.c = (int)blockIdx.x;
            S.A1 = (const char*)WSP(bf16, WS_H); S.B1 = (const char*)(WSP(bf16, WS_WOUT) + (size_t)l * DM * DM); S.A2 = S.A1; S.B2 = S.B1; S.tstep = (size_t)256 * DM * 2;
            EpiRes E{l == 0 ? IN(x) : F.out, WSP(float, WS_XC), F.out, WSP(float, WS_XC), MODL + 2 * DM, 0};
#if defined(PROBE_P4)
            { EpiResT<true> E0{E.base_l, E.base_c, E.out_l, E.out_c, E.gate, opaque_int(0)}; pg8::gemm_phase<EpiResT<true>, pg8::Sched2, true, true>(ring, DM, DM, S, E0); __syncthreads(); }
#endif
#if !defined(OFF_P4)
            pg8::gemm_phase<EpiRes, pg8::Sched2, true, true>(ring, DM, DM, S, E);
#endif
            if (uc) {
                __syncthreads();
                pg8::SchedK SK; SK.nsub = 16 * 4; SK.nN = 8; SK.ksplit = 4; SK.pm0 = PML; SK.G = F.G; SK.c = (int)blockIdx.x; SK.A = S.A1; SK.B = S.B1; SK.tstep = S.tstep; SK.kbytes = 512 * 2;
                EpiSlab EA{WSP(float, WS_SLAB), MODL + 2 * DM};
#if !defined(OFF_P4)
                pg8::gemm_phase<EpiSlab, pg8::SchedK, true, true>(ring, DM, 512, SK, EA);
#endif
            }
        }
        GRID_BAR();

#if !defined(OFF_P5)
        for (int rep = 0, nrep = opaque_int(REP_NORM); rep < nrep; ++rep) { REFRESH(F); norm_phase(F, l, 1, uc, rep == 0 ? 4 : 0); }
#endif

        GRID_BAR();
        {
            pg8::Sched2 S; S.n1 = npm * 44; S.nM1 = npm; S.nN1 = 44; S.n2 = 0; S.nM2 = 1; S.nN2 = 1; S.G = F.G; S.c = (int)blockIdx.x;
            S.A1 = (const char*)WSP(bf16, WS_H); S.B1 = (const char*)(WSP(bf16, WS_WUP) + (size_t)l * 2 * DFF * DM); S.A2 = S.A1; S.B2 = S.B1; S.tstep = (size_t)256 * DM * 2;
            GAS float* EG = WSP(float, WS_EDGE);
            EpiUp E{WSP(bf16, WS_HID), EG, EG + EDGE_ELEMS, EG + 2 * EDGE_ELEMS, IN(ffn_conv_w) + (size_t)l * 3 * DFF, IN(ffn_conv_b) + (size_t)l * DFF};

#if !defined(OFF_P6)
            for (int rep = 0, nrep = opaque_int(REP_P6); rep < nrep; ++rep) { pg8::gemm_phase<EpiUp, pg8::Sched2, true, true>(ring, DM, DM, S, E); __syncthreads(); }
#endif

        }
        GRID_BAR();

#if !defined(OFF_P6B)
        for (int rep = 0, nrep = opaque_int(REP_EDGE); rep < nrep; ++rep) { REFRESH(F); edge_fix_phase(F, l, uc); }
#endif

        GRID_BAR();
        {
            pg8::Sched2 S; S.n1 = PML * 8; S.nM1 = PML; S.nN1 = 8; S.n2 = 0; S.nM2 = 1; S.nN2 = 1; S.G = F.G; S.c = (int)blockIdx.x;
            S.A1 = (const char*)WSP(bf16, WS_HID); S.B1 = (const char*)(WSP(bf16, WS_WDN) + (size_t)l * DM * DFF); S.A2 = S.A1; S.B2 = S.B1; S.tstep = (size_t)256 * DFF * 2;
            EpiRes E{F.out, WSP(float, WS_XC), F.out, WSP(float, WS_XC), MODL + 5 * DM, 0};
#if defined(PROBE_P7)
            { EpiResT<true> E0{E.base_l, E.base_c, E.out_l, E.out_c, E.gate, opaque_int(0)}; pg8::gemm_phase<EpiResT<true>, pg8::Sched2, true, true>(ring, DFF, DFF, S, E0); __syncthreads(); }
#endif
#if !defined(OFF_P7)
            pg8::gemm_phase<EpiRes, pg8::Sched2, true, true>(ring, DFF, DFF, S, E);
#endif
            if (uc) {
                __syncthreads();
                pg8::SchedK SK; SK.nsub = 16 * 4; SK.nN = 8; SK.ksplit = 4; SK.pm0 = PML; SK.G = F.G; SK.c = (int)blockIdx.x; SK.A = S.A1; SK.B = S.B1; SK.tstep = S.tstep; SK.kbytes = 1408 * 2;
                EpiSlab EA{WSP(float, WS_SLAB), MODL + 5 * DM};
#if !defined(OFF_P7)
                pg8::gemm_phase<EpiSlab, pg8::SchedK, true, true>(ring, DFF, 1408, SK, EA);
#endif
            }
        }
        GRID_BAR();
    }
    REFRESH(F); final_norm_phase(F);
}

extern "C" void kernel_launch(void* const* d_in, const int* in_sizes, int n_in, void* d_out, int out_size, void* d_ws, size_t ws_size, hipStream_t stream) {
    static int grid = 0;
    if (grid == 0) {
        if (n_in != 26 || in_sizes[0] != ML * DM || out_size != ML * DM || ws_size < WS_END) { fprintf(stderr, "kernel_launch: unexpected shapes (n_in %d, in0 %d, out %d, ws %zu < %zu)\n", n_in, n_in > 0 ? in_sizes[0] : -1, out_size, ws_size, (size_t)WS_END); grid = -1; return; }
        int dev = 0, cus = 0, per_cu = 0;
        if (hipGetDevice(&dev) != hipSuccess || hipDeviceGetAttribute(&cus, hipDeviceAttributeMultiprocessorCount, dev) != hipSuccess) { grid = -1; return; }
        if (hipFuncSetAttribute((const void*)fwd_kernel, hipFuncAttributeMaxDynamicSharedMemorySize, LDS_BYTES) != hipSuccess) { fprintf(stderr, "kernel_launch: hipFuncSetAttribute failed\n"); grid = -1; return; }
        if (hipOccupancyMaxActiveBlocksPerMultiprocessor(&per_cu, (const void*)fwd_kernel, NTHR, LDS_BYTES) != hipSuccess || per_cu < 1) { fprintf(stderr, "kernel_launch: occupancy query reports %d\n", per_cu); }
        (void)hipGetLastError();
        grid = cus;
    }
    if (grid < 0) return;
    if (hipMemsetAsync((char*)d_ws + WS_CTL, 0, CTL_ZERO_BYTES, stream) != hipSuccess) return;
    Args a{};
    for (int i = 0; i < 26; ++i) a.in[i] = (const GAS float*)d_in[i];
    a.out = (GAS float*)d_out; a.ws = (GAS unsigned char*)d_ws;
    hipLaunchKernelGGL(fwd_kernel, dim3(grid), dim3(NTHR), LDS_BYTES, stream, a);
}
```

```cpp
#include <hip/hip_runtime.h>
#include <cstdio>
#include <cstdint>
namespace pg8 {
#define PG8_LAS __attribute__((address_space(3)))
typedef unsigned short bf16_t;
typedef short bf16x8 __attribute__((ext_vector_type(8)));
typedef float f32x4 __attribute__((ext_vector_type(4)));
typedef unsigned u32x4 __attribute__((ext_vector_type(4)));
constexpr int BM = 256, BK = 64, HALF = 128, HTB = HALF * BK * 2  , STAGE_BYTES = 8 * HTB, NXCD = 8, WGM = 8;

__host__ __device__ __forceinline__ int lds_byte(int r, int c) { const int st = (r >> 4) * 2 + (c >> 5), rr = r & 15, cc = c & 31, ob = rr * 64 + cc * 2; return st * 1024 + (ob ^ (((ob >> 9) & 1) << 5)); }
__host__ __device__ __forceinline__ void stage_rc(int b, int& R, int& C) { const int st = b / 1024, sb = b % 1024, swz = sb ^ (((sb >> 9) & 1) << 5); R = (st >> 1) * 16 + swz / 64; C = (st & 1) * 32 + (swz % 64) / 2; }
__host__ __device__ __forceinline__ int perm32(int rho) { const int n = rho >> 4, i = rho & 15; return 8 * (i >> 2) + 4 * n + (i & 3); }

struct Unit { int pm, pn, type; };

__device__ __forceinline__ void map_unit(int w, int nwg, int nM, int nN, Unit& u) {
    { const int q = nwg / NXCD, r = nwg % NXCD, xcd = w % NXCD, off = w / NXCD; w = (xcd < r ? xcd * (q + 1) : r * (q + 1) + (xcd - r) * q) + off; }
    const int nig = WGM * nN, gid = w / nig, fm = gid * WGM, gsz = (nM - fm) < WGM ? (nM - fm) : WGM;
    u.pm = fm + ((w % nig) % gsz); u.pn = (w % nig) / gsz;
}
struct Sched2 {
    int n1, nM1, nN1, n2, nM2, nN2, G, c; const char *A1, *B1, *A2, *B2; size_t tstep;
    __device__ __forceinline__ bool next(int i, Unit& u) const {
        const long L = (long)i * G + c;
        if (L < n1) { map_unit((int)L, n1, nM1, nN1, u); u.type = 0; return true; }
        if (L < n1 + n2) { map_unit((int)L - n1, n2, nM2, nN2, u); u.type = 1; return true; }
        return false;
    }
    __device__ __forceinline__ const char* a_ptr(const Unit& u) const { return (u.type ? A2 : A1) + (size_t)u.pm * tstep; }
    __device__ __forceinline__ const char* b_ptr(const Unit& u) const { return (u.type ? B2 : B1) + (size_t)u.pn * tstep; }
    __device__ __forceinline__ void a_ready(const Unit&) const {}
    __device__ __forceinline__ void done(const Unit&) const {}
};

struct SchedK {
    int nsub, nN, ksplit, pm0, G, c; const char *A, *B; size_t tstep, kbytes;
    __device__ __forceinline__ bool next(int i, Unit& u) const {
        const long L = (long)i * G + c; if (L >= nsub) return false;
        const int j = (int)L / ksplit; u.type = (int)L % ksplit; u.pm = pm0 + j / nN; u.pn = j % nN; return true;
    }
    __device__ __forceinline__ const char* a_ptr(const Unit& u) const { return A + (size_t)u.pm * tstep + (size_t)u.type * kbytes; }
    __device__ __forceinline__ const char* b_ptr(const Unit& u) const { return B + (size_t)u.pn * tstep + (size_t)u.type * kbytes; }
    __device__ __forceinline__ void a_ready(const Unit&) const {}
    __device__ __forceinline__ void done(const Unit&) const {}
};

__device__ __forceinline__ unsigned cvt_pk_bf16(float lo, float hi) { unsigned r; asm volatile("v_cvt_pk_bf16_f32 %0, %1, %2" : "=v"(r) : "v"(lo), "v"(hi)); return r; }
typedef float f32x2 __attribute__((ext_vector_type(2)));

template <class Epi, class Sched, bool ALIGN_EPI = false, bool SP2 = false>
__device__ __forceinline__ void gemm_phase(PG8_LAS unsigned char* lds, const int Kdim  , const int Klen  , const Sched& S, const Epi& E) {
    int tid_ = threadIdx.x; asm volatile("" : "+v"(tid_));
    const int tid = tid_, wid = __builtin_amdgcn_readfirstlane(tid >> 6), lane = tid & 63, wr = wid >> 2, wc = wid & 3, fr = lane & 15, fq = lane >> 4;
    const int K = Kdim, nt = Klen / BK;
    unsigned voffA[2], voffB[2];
#pragma unroll
    for (int i = 0; i < 2; ++i) { int R, C; stage_rc(tid * 16 + i * 8192, R, C); const int Rb = Epi::PERM ? ((R & ~31) + perm32(R & 31)) : R;
        voffA[i] = (unsigned)(R * K + C) * 2u; voffB[i] = (unsigned)(Rb * K + C) * 2u; }
    const size_t kstep = (size_t)(BK * 2);
    const size_t hstep = (size_t)HALF * K * 2;
    const size_t tstep = 2 * hstep;
    const unsigned ldsw = (unsigned)wid * 1024u;
    const int aoff = lds_byte(wr * 64 + fr, fq * 8), boff = lds_byte(wc * 32 + fr, fq * 8);
#define PG8_SA(b, h) (((b) * 2 + (h)) * HTB)
#define PG8_SB(b, h) ((4 + (b) * 2 + (h)) * HTB)
#define PG8_STAGE(bufoff, gbase, voff) do { _Pragma("unroll") for (int _i = 0; _i < 2; ++_i) \
        __builtin_amdgcn_global_load_lds((const unsigned*)((const char*)(gbase) + (voff)[_i]), (PG8_LAS unsigned*)(lds + (bufoff) + ldsw + _i * 8192), 16, 0, 0); } while (0)
#define PG8_LDA(dst, b, h) do { _Pragma("unroll") for (int m = 0; m < 4; ++m) _Pragma("unroll") for (int k = 0; k < 2; ++k) dst[m][k] = *(const PG8_LAS bf16x8*)(lds + PG8_SA(b, h) + aoff + m * 2048 + k * 1024); } while (0)
#define PG8_LDB(dst, b, h) do { _Pragma("unroll") for (int n = 0; n < 2; ++n) _Pragma("unroll") for (int k = 0; k < 2; ++k) dst[n][k] = *(const PG8_LAS bf16x8*)(lds + PG8_SB(b, h) + boff + n * 2048 + k * 1024); } while (0)
#define PG8_MMA(ai, bj, At, Bt) do { __builtin_amdgcn_s_setprio(1); _Pragma("unroll") for (int m = 0; m < 4; ++m) _Pragma("unroll") for (int n = 0; n < 2; ++n) _Pragma("unroll") for (int k = 0; k < 2; ++k) \
        acc[ai][bj][m][n] = __builtin_amdgcn_mfma_f32_16x16x32_bf16(Bt[n][k], At[m][k], acc[ai][bj][m][n], 0, 0, 0); __builtin_amdgcn_s_setprio(0); } while (0)
#define PG8_WAIT_V(n) asm volatile("s_waitcnt vmcnt(" #n ")" ::: "memory")
#define PG8_WAIT_L(n) asm volatile("s_waitcnt lgkmcnt(" #n ")" ::: "memory")
#define PG8_BAR __builtin_amdgcn_s_barrier()
#define PG8_SCHED __builtin_amdgcn_sched_barrier(0)
    Unit cur, nxt; int ui = 0;
    if (!S.next(0, cur)) return;
    f32x4 acc[2][2][4][2];
#pragma unroll
    for (int a = 0; a < 2; ++a)
#pragma unroll
        for (int b = 0; b < 2; ++b)
#pragma unroll
            for (int m = 0; m < 4; ++m)
#pragma unroll
                for (int n = 0; n < 2; ++n) acc[a][b][m][n] = (f32x4){0.f, 0.f, 0.f, 0.f};
    bf16x8 At[4][2], B0[2][2], B1[2][2];
    const char* cA = S.a_ptr(cur); const char* cB = S.b_ptr(cur);
    S.a_ready(cur);
    if constexpr (SP2) {
        PG8_STAGE(PG8_SB(0, 0), cB, voffB); PG8_STAGE(PG8_SB(0, 1), cB + hstep, voffB); PG8_STAGE(PG8_SA(0, 0), cA, voffA); PG8_STAGE(PG8_SA(0, 1), cA + hstep, voffA);
        if (wr == 1) PG8_BAR;
        PG8_WAIT_V(2); PG8_BAR;
        PG8_STAGE(PG8_SB(1, 0), cB + kstep, voffB); PG8_STAGE(PG8_SA(1, 0), cA + kstep, voffA); PG8_STAGE(PG8_SB(1, 1), cB + hstep + kstep, voffB);
        PG8_WAIT_V(6); PG8_BAR;
    } else {
        PG8_STAGE(PG8_SB(0, 0), cB, voffB); PG8_STAGE(PG8_SA(0, 0), cA, voffA); PG8_STAGE(PG8_SB(0, 1), cB + hstep, voffB); PG8_STAGE(PG8_SA(0, 1), cA + hstep, voffA);
        if (wr == 1) PG8_BAR;
        PG8_WAIT_V(4); PG8_BAR;
        PG8_STAGE(PG8_SB(1, 0), cB + kstep, voffB); PG8_STAGE(PG8_SA(1, 0), cA + kstep, voffA); PG8_STAGE(PG8_SB(1, 1), cB + hstep + kstep, voffB);
        PG8_WAIT_V(6); PG8_BAR;
    }
    for (;;) {
        const bool has_next = S.next(ui + 1, nxt);
        const char* nA = has_next ? S.a_ptr(nxt) : cA; const char* nB = has_next ? S.b_ptr(nxt) : cB;
        for (int t = 0; t < nt; t += 2) {
            const bool last = (t == nt - 2);
            const char* a1 = cA + (size_t)(t + 1) * kstep;
            const char* a2 = last ? nA : cA + (size_t)(t + 2) * kstep; const char* b2 = last ? nB : cB + (size_t)(t + 2) * kstep;
            const char* a3 = a2 + kstep; const char* b3 = b2 + kstep;
            if (last && has_next) S.a_ready(nxt);
            if constexpr (SP2) {
            PG8_LDB(B0, 0, 0); PG8_LDB(B1, 0, 1); PG8_SCHED; PG8_LDA(At, 0, 0); PG8_STAGE(PG8_SA(1, 1), a1 + hstep, voffA);
            PG8_WAIT_V(8); PG8_WAIT_L(0); PG8_BAR; PG8_MMA(0, 0, At, B0); PG8_MMA(0, 1, At, B1); PG8_BAR; PG8_SCHED;
            PG8_LDA(At, 0, 1); PG8_STAGE(PG8_SB(0, 0), b2, voffB); PG8_STAGE(PG8_SB(0, 1), b2 + hstep, voffB); PG8_STAGE(PG8_SA(0, 0), a2, voffA);
            PG8_WAIT_V(8); PG8_WAIT_L(0); PG8_BAR; PG8_MMA(1, 0, At, B0); PG8_MMA(1, 1, At, B1); PG8_BAR; PG8_SCHED;
            PG8_LDB(B0, 1, 0); PG8_LDB(B1, 1, 1); PG8_SCHED; PG8_LDA(At, 1, 0); PG8_STAGE(PG8_SA(0, 1), a2 + hstep, voffA);
            PG8_WAIT_V(8); PG8_WAIT_L(0); PG8_BAR; PG8_MMA(0, 0, At, B0); PG8_MMA(0, 1, At, B1); PG8_BAR; PG8_SCHED;
            PG8_LDA(At, 1, 1); PG8_STAGE(PG8_SB(1, 0), b3, voffB); PG8_STAGE(PG8_SB(1, 1), b3 + hstep, voffB); PG8_STAGE(PG8_SA(1, 0), a3, voffA);
            PG8_WAIT_V(8); PG8_WAIT_L(0); PG8_BAR; PG8_MMA(1, 0, At, B0); PG8_MMA(1, 1, At, B1); PG8_BAR; PG8_SCHED;
            } else {
            PG8_LDB(B0, 0, 0); PG8_SCHED; PG8_LDA(At, 0, 0); PG8_STAGE(PG8_SA(1, 1), a1 + hstep, voffA);
            PG8_WAIT_L(8); PG8_BAR; PG8_WAIT_L(0); PG8_MMA(0, 0, At, B0); PG8_BAR; PG8_SCHED;
            PG8_LDB(B1, 0, 1); PG8_STAGE(PG8_SB(0, 0), b2, voffB);
            PG8_BAR; PG8_WAIT_L(0); PG8_MMA(0, 1, At, B1); PG8_BAR;
            PG8_LDA(At, 0, 1); PG8_STAGE(PG8_SA(0, 0), a2, voffA);
            PG8_BAR; PG8_WAIT_L(0); PG8_MMA(1, 0, At, B0); PG8_BAR; PG8_SCHED;
            PG8_STAGE(PG8_SB(0, 1), b2 + hstep, voffB);
            PG8_WAIT_V(6); PG8_BAR; PG8_MMA(1, 1, At, B1); PG8_BAR;
            PG8_LDB(B0, 1, 0); PG8_SCHED; PG8_LDA(At, 1, 0); PG8_STAGE(PG8_SA(0, 1), a2 + hstep, voffA);
            PG8_WAIT_L(8); PG8_BAR; PG8_WAIT_L(0); PG8_MMA(0, 0, At, B0); PG8_BAR; PG8_SCHED;
            PG8_LDB(B1, 1, 1); PG8_STAGE(PG8_SB(1, 0), b3, voffB);
            PG8_BAR; PG8_WAIT_L(0); PG8_MMA(0, 1, At, B1); PG8_BAR;
            PG8_LDA(At, 1, 1); PG8_STAGE(PG8_SA(1, 0), a3, voffA);
            PG8_BAR; PG8_WAIT_L(0); PG8_MMA(1, 0, At, B0); PG8_BAR; PG8_SCHED;
            PG8_STAGE(PG8_SB(1, 1), b3 + hstep, voffB);
            PG8_WAIT_V(6); PG8_BAR; PG8_MMA(1, 1, At, B1); PG8_BAR;
            }
        }
        if constexpr (ALIGN_EPI) { if (wr == 0) PG8_BAR; }
        if constexpr (!Epi::AFTER_DRAIN) { E(acc, cur, wr, wc, fr, fq); S.done(cur); }
        if (!has_next) break;
#pragma unroll
        for (int a = 0; a < 2; ++a)
#pragma unroll
            for (int b = 0; b < 2; ++b)
#pragma unroll
                for (int m = 0; m < 4; ++m)
#pragma unroll
                    for (int n = 0; n < 2; ++n) acc[a][b][m][n] = (f32x4){0.f, 0.f, 0.f, 0.f};
        cur = nxt; cA = nA; cB = nB; ++ui;
        if constexpr (ALIGN_EPI) { if (wr == 1) PG8_BAR; }
    }
    PG8_WAIT_V(0);
    if constexpr (!ALIGN_EPI) { if (wr == 0) PG8_BAR; }
    PG8_BAR;
    if constexpr (Epi::AFTER_DRAIN) { E.fused(acc, cur, wr, wc, fr, fq, lds, wid, lane); S.done(cur); }
#undef PG8_SA
#undef PG8_SB
#undef PG8_STAGE
#undef PG8_LDA
#undef PG8_LDB
#undef PG8_MMA
#undef PG8_WAIT_V
#undef PG8_WAIT_L
#undef PG8_BAR
#undef PG8_SCHED
}
}

constexpr int NWAVES = 8, NTHR = 512;
constexpr int DM = 2048, BATCH = 2, SEQ = 16384, DEPTH = 4, GRIDW = 64, GROWS = 256, CTXL = 256;
constexpr int NAW = 1024, NHEAD = 8, HDIM = 128, FNW = 512, HYW = 512, DFF = 5632, DIN = 5120, NMOD = 6;
constexpr int ML = BATCH * SEQ, MC = BATCH * CTXL, MT = ML + MC;
constexpr int PML = ML / 256, PMT = MT / 256;
constexpr int NEDGE = MT / 64 * 2;
constexpr float EPS = 1e-6f;
constexpr float LOG2E = 1.4426950408889634f;
constexpr float QSCALE = 0.08838834764831845f * LOG2E;
constexpr float HY_MIN_DECAY = -3.0701134573253945f, HY_MAX_DECAY = -15.350567286626973f;

constexpr size_t MiB = 1u << 20;
constexpr size_t WS_CTL = 0, CTL_ZERO_BYTES = 1 * MiB;
constexpr size_t WS_MOD = 1 * MiB;
constexpr size_t WS_XC = 2 * MiB;
constexpr size_t WS_HFC = 6 * MiB;
constexpr size_t WS_HF = 8 * MiB;
constexpr size_t WS_WIN = WS_HF + 128 * MiB;
constexpr size_t WS_WOUT = WS_WIN + 80 * MiB;
constexpr size_t WS_WUP = WS_WOUT + 32 * MiB;
constexpr size_t WS_WDN = WS_WUP + 176 * MiB;
constexpr size_t WS_H = WS_WDN + 88 * MiB;
constexpr size_t WS_QK = WS_H + 130 * MiB;
constexpr size_t WS_VT = WS_QK + 130 * MiB;
constexpr size_t WS_T32 = WS_VT + 65 * MiB;
constexpr size_t WS_A = WS_T32 + 260 * MiB;
constexpr size_t WS_HID = WS_QK;
constexpr size_t WS_EDGE = WS_A + 65 * MiB;
constexpr size_t EDGE_ELEMS = (size_t)NEDGE * DFF;
constexpr size_t WS_KS = WS_EDGE + 68 * MiB;
constexpr size_t WS_SLAB = WS_KS + 64 * MiB;
constexpr size_t WS_END = WS_SLAB + 16 * MiB;
static_assert((size_t)MT * DFF * 2 <= WS_EDGE - WS_QK, "hidden overlay");
static_assert(3 * EDGE_ELEMS * 4 <= 68 * MiB, "edge buffers");
static_assert((size_t)MT * DM * 2 == 130 * MiB && (size_t)1024 * MT * 2 == 65 * MiB && (size_t)2048 * MT * 4 == 260 * MiB, "sizes");
constexpr int CW_BAR = 4096;

constexpr int RING_BYTES = 131072;
constexpr int XTRA_OFF = RING_BYTES, XTRA_BYTES = 28672;
constexpr int MISC_OFF = XTRA_OFF + XTRA_BYTES;
constexpr int TW_OFF = XTRA_OFF + 24576;
constexpr int ATT_KC_OFF = 0, ATT_KC_PITCH = 272, ATT_VC_OFF = 256 * ATT_KC_PITCH, ATT_VC_PITCH = 528, ATT_BIAS_OFF = ATT_VC_OFF + 128 * ATT_VC_PITCH;
static_assert(ATT_BIAS_OFF + 8 * 465 * 4 <= TW_OFF, "attention LDS map");
constexpr int LDS_BYTES = MISC_OFF + 256;

#define GAS __attribute__((address_space(1)))
#define LAS __attribute__((address_space(3)))
typedef unsigned short bf16;
typedef unsigned v4u __attribute__((ext_vector_type(4)));
typedef unsigned v2u __attribute__((ext_vector_type(2)));
typedef float f32x4 __attribute__((ext_vector_type(4)));
typedef float f32x2 __attribute__((ext_vector_type(2)));
typedef short bf16x8 __attribute__((ext_vector_type(8)));
#define LDS_WAIT() asm volatile("s_waitcnt lgkmcnt(0)" ::: "memory")
__device__ __forceinline__ unsigned f2bf(float f) { unsigned u = __builtin_bit_cast(unsigned, f); return (u + 0x7fffu + ((u >> 16) & 1u)) >> 16; }
__device__ __forceinline__ unsigned pk2(float lo, float hi) { return f2bf(lo) | (f2bf(hi) << 16); }
__device__ __forceinline__ float bf2f(unsigned short b) { return __builtin_bit_cast(float, (unsigned)b << 16); }
__device__ __forceinline__ f32x2 cmul(f32x2 a, f32x2 b) { return (f32x2){a.x * b.x - a.y * b.y, a.x * b.y + a.y * b.x}; }
__device__ __forceinline__ f32x2 cconj(f32x2 a) { return (f32x2){a.x, -a.y}; }
__device__ __forceinline__ float lane_read(float v, int src_lane) { return __builtin_bit_cast(float, __builtin_amdgcn_ds_bpermute(src_lane << 2, __builtin_bit_cast(int, v))); }
template <int CTRL> __device__ __forceinline__ float dpp_ror(float v) { return __builtin_bit_cast(float, __builtin_amdgcn_update_dpp(0, __builtin_bit_cast(int, v), CTRL, 0xf, 0xf, false)); }
__device__ __forceinline__ float wave_sum(float v, int lane) {
#pragma unroll
    for (int o = 1; o < 64; o <<= 1) v += lane_read(v, lane ^ o);
    return v;
}
__device__ __forceinline__ int opaque_int(int v) { asm volatile("" : "+s"(v)); return v; }
__device__ __forceinline__ float gelu_tanh(float x) {
    const float t = x * (1.0f + 0.044715f * x * x) * (-2.302208198f);
    const float e = __builtin_amdgcn_exp2f(t);
    return x * __builtin_amdgcn_rcpf(1.0f + e);
}
#define XB_LAS_DEFINED
#define XB_TMO      128
#define XB_XCNT(j)  (256  + 64 * (j))
#define XB_XSUB(j)  (1280 + 64 * (j))
#define XB_XGEN(j)  (2304 + 64 * (j))
#define XB_TOP      3328
#define XB_TOPGEN   3392
#define XCD_BAR_WORDS 3456
#define XB_SPIN_CAP (1u << 18)

__device__ __forceinline__ unsigned xb_ld(unsigned* p)              { return __hip_atomic_load(p, __ATOMIC_RELAXED, __HIP_MEMORY_SCOPE_AGENT); }
__device__ __forceinline__ unsigned xb_add(unsigned* p, unsigned v) { return __hip_atomic_fetch_add(p, v, __ATOMIC_RELAXED, __HIP_MEMORY_SCOPE_AGENT); }
__device__ __forceinline__ unsigned xb_xcc_id() { return (unsigned)__builtin_amdgcn_s_getreg((3 << 11) | 20) & 0xFu; }
#define XB_SPIN(cond, bar) do { unsigned _sp = 0; while (cond) { __builtin_amdgcn_s_sleep(1); \
    if ((++_sp & 255u) == 0u) { if (xb_ld(&(bar)[XB_TMO])) break; if (_sp > XB_SPIN_CAP) { atomicAdd(&(bar)[XB_TMO], 1u); break; } } } } while (0)

struct XcdBarrier {
    unsigned* bar; unsigned x;
    volatile LAS unsigned* st;
};

__device__ __forceinline__ XcdBarrier xcd_barrier_post(unsigned* bar, volatile LAS unsigned* st) {
    XcdBarrier b; b.bar = bar; b.x = xb_xcc_id(); b.st = st;
    if (threadIdx.x == 0) (void)xb_add(&bar[XB_XCNT(b.x)], 1u);
    return b;
}
__device__ __forceinline__ void xcd_barrier_complete(unsigned* bar, unsigned x, unsigned& nloc, unsigned& nx) {
    const unsigned G = gridDim.x * gridDim.y * gridDim.z;
    unsigned sum, cnt, mine, sp = 0u;
    for (;;) {
        sum = 0u; cnt = 0u; mine = 0u;
#pragma unroll
        for (unsigned j = 0; j < 16; ++j) { const unsigned c = xb_ld(&bar[XB_XCNT(j)]); sum += c; cnt += (c > 0u) ? 1u : 0u; mine = (j == x) ? c : mine; }
        if (sum == G) break;
        __builtin_amdgcn_s_sleep(1);
        if ((++sp & 255u) == 0u) { if (xb_ld(&bar[XB_TMO])) break; if (sp > XB_SPIN_CAP) { atomicAdd(&bar[XB_TMO], 1u); break; } }
    }
    nloc = mine > 0u ? mine : 1u; nx = cnt > 0u ? cnt : 1u;
}

__device__ __forceinline__ void xcd_barrier(const XcdBarrier& b) {
    asm volatile("s_waitcnt vmcnt(0)" ::: "memory");
    __syncthreads();
    if (threadIdx.x == 0) {
        unsigned* bar = b.bar;
        __builtin_amdgcn_s_waitcnt(0);
        unsigned nloc = b.st[0], nx = b.st[1];
        if (nloc == 0u) { xcd_barrier_complete(bar, b.x, nloc, nx); b.st[0] = nloc; b.st[1] = nx; }
        const unsigned old = xb_add(&bar[XB_XSUB(b.x)], 1u);
        const unsigned gen = old / nloc;
        if (old + 1u == (gen + 1u) * nloc) {
            __builtin_amdgcn_fence(__ATOMIC_RELEASE, "agent");
            asm volatile("s_waitcnt vmcnt(0)" ::: "memory");
            const unsigned og = xb_add(&bar[XB_TOP], 1u);
            const unsigned tg = og / nx;
            if (og + 1u == (tg + 1u) * nx) xb_add(&bar[XB_TOPGEN], 1u);
            else XB_SPIN(xb_ld(&bar[XB_TOPGEN]) == tg, bar);
            __builtin_amdgcn_fence(__ATOMIC_ACQUIRE, "agent");
            xb_add(&bar[XB_XGEN(b.x)], 1u);
            asm volatile("s_waitcnt vmcnt(0)" ::: "memory");
        } else {
            XB_SPIN(xb_ld(&bar[XB_XGEN(b.x)]) == gen, bar);
            __builtin_amdgcn_fence(__ATOMIC_ACQUIRE, "agent");
            asm volatile("s_waitcnt vmcnt(0)" ::: "memory");
        }
    }
    __syncthreads();
}


struct Args { const GAS float* in[26]; GAS float* out; GAS unsigned char* ws; };
struct Frame {
    LAS unsigned char* lds;
    int tid, lane, wave;
    int vcu, G;
    GAS unsigned char* ws;
    GAS float* out;
};
typedef const float* cfptr_t;
__device__ __forceinline__ const GAS float* in_ptr(int k) { asm volatile("" : "+s"(k));
    const __attribute__((address_space(4))) cfptr_t* kp = (const __attribute__((address_space(4))) cfptr_t*)__builtin_amdgcn_kernarg_segment_ptr(); return (const GAS float*)kp[k]; }
enum { I_x, I_c, I_ctx, I_c_ctx, I_ada_w, I_ada_b, I_norm1_g, I_norm2_g, I_w_in, I_na_rpb, I_hy_conv_w, I_hy_conv_b, I_hy_w1, I_hy_b1, I_hy_w2, I_hy_b2, I_hy_w3, I_hy_freq, I_hy_bias,
       I_mix_norm_g, I_w_out, I_ffn_w_up, I_ffn_conv_w, I_ffn_conv_b, I_ffn_w_down, I_final_norm_g };
#define IN(name) in_ptr(I_##name)
#define WSP(T, off) ((GAS T*)(F.ws + (off)))

__device__ __forceinline__ void pa_adaln(Frame& F) {
    LAS float* sv = (LAS float*)F.lds;
    LAS float* red = (LAS float*)(F.lds + 3 * DM * 4);
    const GAS float* p_c = IN(c); const GAS float* p_cc = IN(c_ctx); const GAS float* p_aw = IN(ada_w); const GAS float* p_ab = IN(ada_b);
    for (int i = F.tid; i < 3 * DM; i += NTHR) { const int s = i / DM, k = i % DM; const float v = s < 2 ? p_c[s * DM + k] : p_cc[k]; sv[i] = v / (1.0f + __expf(-v)); }
    __syncthreads();
    GAS float* MOD = WSP(float, WS_MOD);
    const int cg = F.tid & 63, ks = F.tid >> 6;
    for (int item = F.vcu; item < DEPTH * 48; item += F.G) {
        const int l = item / 48, j0 = (item % 48) * 256;
        const GAS float* wp = p_aw + ((size_t)l * DM + ks * 256) * (NMOD * DM) + j0 + 4 * cg;
        f32x4 a0 = {0.f, 0.f, 0.f, 0.f}, a1 = a0, a2 = a0;
#pragma unroll 8
        for (int kk = 0; kk < 256; ++kk) {
            const f32x4 w = *(const GAS f32x4*)(wp + (size_t)kk * (NMOD * DM));
            const float s0 = sv[ks * 256 + kk], s1 = sv[DM + ks * 256 + kk], s2 = sv[2 * DM + ks * 256 + kk];
            a0 += w * s0; a1 += w * s1; a2 += w * s2;
        }
        *(LAS f32x4*)(red + (ks * 3 + 0) * 256 + 4 * cg) = a0; *(LAS f32x4*)(red + (ks * 3 + 1) * 256 + 4 * cg) = a1; *(LAS f32x4*)(red + (ks * 3 + 2) * 256 + 4 * cg) = a2;
        __syncthreads();
        if (F.tid < 192) {
            const int s = F.tid >> 6, cc = F.tid & 63;
            f32x4 t = *(const GAS f32x4*)(p_ab + (size_t)l * (NMOD * DM) + j0 + 4 * cc);
#pragma unroll
            for (int q = 0; q < 8; ++q) t += *(LAS f32x4*)(red + (q * 3 + s) * 256 + 4 * cc);
            *(GAS f32x4*)(MOD + ((size_t)l * 3 + s) * (NMOD * DM) + j0 + 4 * cc) = t;
        }
        __syncthreads();
    }
}
__device__ __forceinline__ void transpose_item(const GAS float* W, int K, int N, GAS bf16* WT, int k0, int n0, int drow0, LAS float* scr, int lane) {
#pragma unroll 8
    for (int i = 0; i < 32; ++i) { const int kk = 2 * i + (lane >> 5); scr[kk * 33 + (lane & 31)] = W[(size_t)(k0 + kk) * N + n0 + (lane & 31)]; }
    LDS_WAIT(); asm volatile("" ::: "memory");
    const int c = lane & 7;
#pragma unroll
    for (int j = 0; j < 4; ++j) { const int n = (lane >> 3) + 8 * j; const LAS float* s = scr + (8 * c) * 33 + n;
        v4u o; o.x = pk2(s[0 * 33], s[1 * 33]); o.y = pk2(s[2 * 33], s[3 * 33]); o.z = pk2(s[4 * 33], s[5 * 33]); o.w = pk2(s[6 * 33], s[7 * 33]);
        *(GAS v4u*)(WT + (size_t)(drow0 + n) * K + k0 + 8 * c) = o; }
    LDS_WAIT(); asm volatile("" ::: "memory");
}
__device__ __forceinline__ void pa_ctx_copy(Frame& F) {
    const GAS f32x4* src = (const GAS f32x4*)IN(ctx); GAS f32x4* dst = WSP(f32x4, WS_XC);
    for (int i = F.vcu * NTHR + F.tid; i < MC * DM / 4; i += F.G * NTHR) dst[i] = src[i];
}
__device__ __forceinline__ void pa_weights(Frame& F) {
    const GAS float* p_win = IN(w_in); const GAS float* p_wout = IN(w_out); const GAS float* p_wup = IN(ffn_w_up); const GAS float* p_wdn = IN(ffn_w_down);
    {
        LAS float* wt = (LAS float*)F.lds;
        LAS float* tab = (LAS float*)(F.lds + 64 * 129 * 4);
        if (F.tid < 128) tab[F.tid] = cospif((float)F.tid * (1.0f / 64.0f));
        for (int item = F.vcu; item < DEPTH * 4 * 32; item += F.G) {
            const int l = item >> 7, g = (item >> 5) & 3, k0 = (item & 31) * 64;
            __syncthreads();
            for (int i = F.tid; i < 64 * 128; i += NTHR) { const int kk = i >> 7, cc = i & 127; wt[kk * 129 + cc] = p_win[((size_t)l * DM + k0 + kk) * DIN + 3072 + g * 128 + cc]; }
            __syncthreads();
            const int kk = F.tid & 63;
            GAS bf16* dst = WSP(bf16, WS_WIN) + ((size_t)l * DIN + 3072 + g * 128) * DM + k0 + kk;
            for (int i = 0; i < 16; ++i) {
                const int mp = (F.tid >> 6) + 8 * i;
                const int mm = mp <= 64 ? mp : mp - 64, sh = mp <= 64 ? 0 : 96;
                float a = 0.f;
                const int add = mp <= 64 ? 0 : 32; (void)sh;
#pragma unroll 8
                for (int cc = 0; cc < 128; ++cc) a += wt[kk * 129 + cc] * tab[(mm * cc + add) & 127];
                dst[(size_t)mp * DM] = (bf16)f2bf(a);
            }
        }
        __syncthreads();
    }
    LAS float* scr = (LAS float*)(F.lds + F.wave * 16384);
    const int gw = F.vcu * NWAVES + F.wave, NGW = F.G * NWAVES;
    constexpr int I_IN = 32 * 144, I_OUT = 32 * 64, I_UP = 32 * 352, I_DN = 88 * 64, I_L = I_IN + I_OUT + I_UP + I_DN;
    for (int it = gw; it < DEPTH * I_L; it += NGW) {
        const int l = it / I_L; int r = it % I_L;
        if (r < I_IN) { const int kb = r / 144; int nb = r % 144; if (nb >= 96) nb += 16;
            transpose_item(p_win + (size_t)l * DM * DIN, DM, DIN, WSP(bf16, WS_WIN) + (size_t)l * DIN * DM, kb * 64, nb * 32, nb * 32, scr, F.lane); continue; }
        r -= I_IN;
        if (r < I_OUT) { const int kb = r / 64, nb = r % 64;
            transpose_item(p_wout + (size_t)l * DM * DM, DM, DM, WSP(bf16, WS_WOUT) + (size_t)l * DM * DM, kb * 64, nb * 32, nb * 32, scr, F.lane); continue; }
        r -= I_OUT;
        if (r < I_UP) { const int kb = r / 352, nb = r % 352; const int n0 = nb * 32;
            const int drow = n0 < DFF ? (n0 >> 7) * 256 + (n0 & 127) : ((n0 - DFF) >> 7) * 256 + 128 + ((n0 - DFF) & 127);
            transpose_item(p_wup + (size_t)l * DM * 2 * DFF, DM, 2 * DFF, WSP(bf16, WS_WUP) + (size_t)l * 2 * DFF * DM, kb * 64, n0, drow, scr, F.lane); continue; }
        r -= I_UP;
        { const int kb = r / 64, nb = r % 64;
            transpose_item(p_wdn + (size_t)l * DFF * DM, DFF, DM, WSP(bf16, WS_WDN) + (size_t)l * DM * DFF, kb * 64, nb * 32, nb * 32, scr, F.lane); }
    }
}

__device__ __forceinline__ void norm_phase(Frame& F, int l, int which, bool with_ctx, int nslab) {
    const GAS float* gain = (which ? IN(norm2_g) : IN(norm1_g)) + (size_t)l * DM;
    const GAS float* MOD = WSP(float, WS_MOD) + (size_t)l * 3 * (NMOD * DM);
    const bool first = (l == 0 && which == 0);
    const GAS float* xl = first ? IN(x) : F.out; const GAS float* xc = first ? IN(ctx) : WSP(float, WS_XC);
    GAS bf16* H = WSP(bf16, WS_H);
    const int gw = F.vcu * NWAVES + F.wave, NGW = F.G * NWAVES, nrows = with_ctx ? MT : ML;
    for (int row = gw; row < nrows; row += NGW) {
        const int s = row < SEQ ? 0 : row < ML ? 1 : 2;
        const GAS float* xr = row < ML ? xl + (size_t)row * DM : xc + (size_t)(row - ML) * DM;
        const GAS float* shp = MOD + (size_t)s * (NMOD * DM) + (which ? 3 : 0) * DM; const GAS float* scp = shp + DM;
        f32x4 v[8]; float ss = 0.f;
#pragma unroll
        for (int j = 0; j < 8; ++j) v[j] = *(const GAS f32x4*)(xr + 4 * (F.lane + 64 * j));
        if (row >= ML && nslab > 0) {
            const GAS float* sl = WSP(float, WS_SLAB) + (size_t)(row - ML) * DM; GAS float* xw = WSP(float, WS_XC) + (size_t)(row - ML) * DM;
            for (int ks = 0; ks < nslab; ++ks)
#pragma unroll
                for (int j = 0; j < 8; ++j) v[j] += *(const GAS f32x4*)(sl + (size_t)ks * MC * DM + 4 * (F.lane + 64 * j));
#pragma unroll
            for (int j = 0; j < 8; ++j) *(GAS f32x4*)(xw + 4 * (F.lane + 64 * j)) = v[j];
        }
#pragma unroll
        for (int j = 0; j < 8; ++j) ss += (v[j].x * v[j].x + v[j].y * v[j].y) + (v[j].z * v[j].z + v[j].w * v[j].w);
        const float rstd = 1.0f / sqrtf(wave_sum(ss, F.lane) * (1.0f / DM) + EPS);
        GAS bf16* hr = H + (size_t)row * DM;
#pragma unroll
        for (int j = 0; j < 8; ++j) { const int k = 4 * (F.lane + 64 * j);
            const f32x4 g = *(const GAS f32x4*)(gain + k), sc = *(const GAS f32x4*)(scp + k), sh = *(const GAS f32x4*)(shp + k);
            const f32x4 y = (v[j] * rstd * g) * (1.0f + sc) + sh;
            v2u o; o.x = pk2(y.x, y.y); o.y = pk2(y.z, y.w); *(GAS v2u*)(hr + k) = o; }
    }
}
__device__ __forceinline__ void final_norm_phase(Frame& F) {
    const GAS float* p_g = IN(final_norm_g);
    const int gw = F.vcu * NWAVES + F.wave, NGW = F.G * NWAVES;
    for (int row = gw; row < ML; row += NGW) {
        GAS float* xr = F.out + (size_t)row * DM;
        f32x4 v[8]; float ss = 0.f;
#pragma unroll
        for (int j = 0; j < 8; ++j) { v[j] = *(const GAS f32x4*)(xr + 4 * (F.lane + 64 * j)); ss += (v[j].x * v[j].x + v[j].y * v[j].y) + (v[j].z * v[j].z + v[j].w * v[j].w); }
        const float rstd = 1.0f / sqrtf(wave_sum(ss, F.lane) * (1.0f / DM) + EPS);
#pragma unroll
        for (int j = 0; j < 8; ++j) { const int k = 4 * (F.lane + 64 * j); *(GAS f32x4*)(xr + k) = v[j] * rstd * *(const GAS f32x4*)(p_g + k); }
    }
}

__device__ __forceinline__ void filter_phase(Frame& F, int l, bool with_ctx) {
    LAS float* h1 = (LAS float*)F.lds;
    LAS float* h2 = (LAS float*)(F.lds + 64 * 65 * 4);
    const GAS float* w1 = IN(hy_w1) + (size_t)l * 33 * 64; const GAS float* b1 = IN(hy_b1) + (size_t)l * 64;
    const GAS float* w2 = IN(hy_w2) + (size_t)l * 64 * 64; const GAS float* b2 = IN(hy_b2) + (size_t)l * 64;
    const GAS float* w3 = IN(hy_w3) + (size_t)l * 64 * 2048; const GAS float* fq = IN(hy_freq) + (size_t)l * 64;
    const int nitems = with_ctx ? 288 : 256;
    for (int item = F.vcu; item < nitems; item += F.G) {
        const bool isc = item >= 256; const int Lq = isc ? CTXL : SEQ; const int n0 = (isc ? (item - 256) >> 3 : item) * 64;
        const int ck_lo = isc ? (item & 7) : 0, ck_hi = isc ? ck_lo + 1 : 8;
        const int p = F.tid & 63, jg = F.wave;
        const float pos = (float)(n0 + p), t = pos / (float)(Lq - 1);
        __syncthreads();
        {
            float zf[33]; zf[0] = t;
#pragma unroll
            for (int i = 0; i < 16; ++i) { const float band = 1e-4f + (float)i * ((15.0f - 1e-4f) / 15.0f); const float ang = band * (6.283185307179586f / (float)Lq) * pos; zf[1 + i] = cosf(ang); zf[17 + i] = -sinf(ang); }
#pragma unroll 1
            for (int jj = 0; jj < 8; ++jj) { const int j = jg * 8 + jj; float a = b1[j];
#pragma unroll
                for (int i = 0; i < 33; ++i) a += zf[i] * w1[i * 64 + j];
                h1[p * 65 + j] = sinf(fq[j] * a); }
        }
        __syncthreads();
#pragma unroll 1
        for (int jj = 0; jj < 8; ++jj) { const int j = jg * 8 + jj; float a = b2[j];
#pragma unroll 8
            for (int i = 0; i < 64; ++i) a += h1[p * 65 + i] * w2[i * 64 + j];
            h2[p * 65 + j] = sinf(fq[j] * a); }
        __syncthreads();
        GAS float* dst = isc ? WSP(float, WS_HFC) : WSP(float, WS_HF);
        LAS float* w3s = (LAS float*)(F.lds + 2 * 64 * 65 * 4);
        const int lq = F.lane & 15, lg = F.lane >> 4;
        float hb4[16][4];
#pragma unroll
        for (int ks = 0; ks < 16; ++ks)
#pragma unroll
            for (int pt = 0; pt < 4; ++pt) hb4[ks][pt] = h2[(16 * pt + lq) * 65 + 4 * ks + lg];
        for (int ck = ck_lo; ck < ck_hi; ++ck) {
            __syncthreads();
#pragma unroll 4
            for (int i = F.tid; i < 64 * 64; i += NTHR) { const int jr = i >> 6, c4 = (i & 63) * 4; *(LAS f32x4*)(w3s + jr * 272 + c4) = *(const GAS f32x4*)(w3 + (size_t)jr * 2048 + ck * 256 + c4); }
            __syncthreads();
            f32x4 acc[2][4];
#pragma unroll
            for (int ct = 0; ct < 2; ++ct)
#pragma unroll
                for (int pt = 0; pt < 4; ++pt) acc[ct][pt] = (f32x4){0.f, 0.f, 0.f, 0.f};
#pragma unroll
            for (int ks = 0; ks < 16; ++ks) {
                const float a0 = w3s[(4 * ks + lg) * 272 + jg * 32 + lq], a1 = w3s[(4 * ks + lg) * 272 + jg * 32 + 16 + lq];
#pragma unroll
                for (int pt = 0; pt < 4; ++pt) { acc[0][pt] = __builtin_amdgcn_mfma_f32_16x16x4f32(a0, hb4[ks][pt], acc[0][pt], 0, 0, 0); acc[1][pt] = __builtin_amdgcn_mfma_f32_16x16x4f32(a1, hb4[ks][pt], acc[1][pt], 0, 0, 0); }
            }
#pragma unroll
            for (int pt = 0; pt < 4; ++pt) { const int n = n0 + 16 * pt + lq; const float tn = (float)n / (float)(Lq - 1);
#pragma unroll
                for (int ct = 0; ct < 2; ++ct)
#pragma unroll
                    for (int r = 0; r < 4; ++r) { const int col = ck * 256 + jg * 32 + 16 * ct + 4 * lg + r, ch = col & 511;
                        const float delta = fabsf(HY_MIN_DECAY + (HY_MAX_DECAY - HY_MIN_DECAY) * ((float)ch / 511.0f));
                        const float val = acc[ct][pt][r] * __expf(-tn * delta);
                        if (col & 512) dst[(size_t)col * Lq + ((Lq - n) & (Lq - 1))] = n == 0 ? 0.f : val;
                        else dst[(size_t)col * Lq + n] = val; } }
        }
    }
}

struct EpiIn {
    static constexpr bool PERM = true, AFTER_DRAIN = false;
    GAS bf16* QK; GAS bf16* VT; GAS float* T32;
    __device__ __forceinline__ void operator()(pg8::f32x4 (&acc)[2][2][4][2], const pg8::Unit& u, int wr_, int wc_, int fr_, int fq_) const {
        int t_ = threadIdx.x; asm volatile("" : "+v"(t_));
        const int fr = t_ & 15, fq = (t_ >> 4) & 3, wc = (t_ >> 6) & 3, wr = t_ >> 8; (void)wr_; (void)wc_; (void)fr_; (void)fq_;
        const int row0 = u.pm * 256 + wr * 64 + fr, col0 = u.pn * 256 + wc * 32 + 8 * fq;
        if (u.type == 0) {
            const float sc = u.pn < 4 ? QSCALE : 1.0f;
#pragma unroll
            for (int ai = 0; ai < 2; ++ai)
#pragma unroll
                for (int m = 0; m < 4; ++m) { GAS bf16* rowp = QK + (size_t)(row0 + ai * 128 + m * 16) * 2048 + col0;
#pragma unroll
                    for (int bj = 0; bj < 2; ++bj) { const pg8::f32x4 v0 = acc[ai][bj][m][0] * sc, v1 = acc[ai][bj][m][1] * sc;
                        v4u w; w.x = pg8::cvt_pk_bf16(v0[0], v0[1]); w.y = pg8::cvt_pk_bf16(v0[2], v0[3]); w.z = pg8::cvt_pk_bf16(v1[0], v1[1]); w.w = pg8::cvt_pk_bf16(v1[2], v1[3]);
                        *(GAS v4u*)(rowp + bj * 128) = w; } }
        } else if (u.pm < 4) {
#pragma unroll
            for (int ai = 0; ai < 2; ++ai)
#pragma unroll
                for (int m = 0; m < 4; ++m) { GAS bf16* rowp = VT + (size_t)(row0 + ai * 128 + m * 16) * MT + col0;
#pragma unroll
                    for (int bj = 0; bj < 2; ++bj) { const pg8::f32x4 v0 = acc[ai][bj][m][0], v1 = acc[ai][bj][m][1];
                        v4u w; w.x = pg8::cvt_pk_bf16(v0[0], v0[1]); w.y = pg8::cvt_pk_bf16(v0[2], v0[3]); w.z = pg8::cvt_pk_bf16(v1[0], v1[1]); w.w = pg8::cvt_pk_bf16(v1[2], v1[3]);
                        *(GAS v4u*)(rowp + bj * 128) = w; } }
        } else {
#pragma unroll
            for (int ai = 0; ai < 2; ++ai)
#pragma unroll
                for (int m = 0; m < 4; ++m) { GAS float* rowp = T32 + (size_t)(row0 - 1024 + ai * 128 + m * 16) * MT + col0;
#pragma unroll
                    for (int bj = 0; bj < 2; ++bj) { *(GAS pg8::f32x4*)(rowp + bj * 128) = acc[ai][bj][m][0]; *(GAS pg8::f32x4*)(rowp + bj * 128 + 4) = acc[ai][bj][m][1]; } }
        }
    }
};
template <bool DRY = false> struct EpiResT {
    static constexpr bool PERM = false, AFTER_DRAIN = false;
    const GAS float* base_l; const GAS float* base_c; GAS float* out_l; GAS float* out_c; const GAS float* gate; int never;
    __device__ __forceinline__ void operator()(pg8::f32x4 (&acc)[2][2][4][2], const pg8::Unit& u, int wr_, int wc_, int fr_, int fq_) const {
        int t_ = threadIdx.x; asm volatile("" : "+v"(t_));
        const int fr = t_ & 15, fq = (t_ >> 4) & 3, wc = (t_ >> 6) & 3, wr = t_ >> 8; (void)wr_; (void)wc_; (void)fr_; (void)fq_;
        const int row0 = u.pm * 256 + wr * 64 + fr, col0 = u.pn * 256 + wc * 32 + 4 * fq;
        const int s = u.pm < PML / 2 ? 0 : u.pm < PML ? 1 : 2;
        const GAS float* bs = u.pm < PML ? base_l + (size_t)row0 * DM : base_c + (size_t)(row0 - ML) * DM;
        GAS float* os = u.pm < PML ? out_l + (size_t)row0 * DM : out_c + (size_t)(row0 - ML) * DM;
        pg8::f32x4 gv[2][2];
#pragma unroll
        for (int bj = 0; bj < 2; ++bj)
#pragma unroll
            for (int n = 0; n < 2; ++n) gv[bj][n] = *(const GAS pg8::f32x4*)(gate + (size_t)s * (NMOD * DM) + col0 + bj * 128 + n * 16);
#pragma unroll
        for (int ai = 0; ai < 2; ++ai)
#pragma unroll
            for (int m = 0; m < 4; ++m) { const size_t off = (size_t)(ai * 128 + m * 16) * DM + col0;
#pragma unroll
                for (int bj = 0; bj < 2; ++bj)
#pragma unroll
                    for (int n = 0; n < 2; ++n) { const pg8::f32x4 b = *(const GAS pg8::f32x4*)(bs + off + bj * 128 + n * 16);
                        if (!DRY || never) *(GAS pg8::f32x4*)(os + off + bj * 128 + n * 16) = b + gv[bj][n] * acc[ai][bj][m][n]; }
                asm volatile("" ::: "memory"); }
    }
};
struct EpiSlab {
    static constexpr bool PERM = false, AFTER_DRAIN = false;
    GAS float* slab; const GAS float* gate;
    __device__ __forceinline__ void operator()(pg8::f32x4 (&acc)[2][2][4][2], const pg8::Unit& u, int wr_, int wc_, int fr_, int fq_) const {
        int t_ = threadIdx.x; asm volatile("" : "+v"(t_));
        const int fr = t_ & 15, fq = (t_ >> 4) & 3, wc = (t_ >> 6) & 3, wr = t_ >> 8; (void)wr_; (void)wc_; (void)fr_; (void)fq_;
        const int row0 = u.pm * 256 + wr * 64 + fr - ML, col0 = u.pn * 256 + wc * 32 + 4 * fq;
        pg8::f32x4 gv[2][2];
#pragma unroll
        for (int bj = 0; bj < 2; ++bj)
#pragma unroll
            for (int n = 0; n < 2; ++n) gv[bj][n] = *(const GAS pg8::f32x4*)(gate + (size_t)2 * (NMOD * DM) + col0 + bj * 128 + n * 16);
        GAS float* sb = slab + (size_t)u.type * MC * DM;
#pragma unroll
        for (int ai = 0; ai < 2; ++ai)
#pragma unroll
            for (int m = 0; m < 4; ++m) { GAS float* os = sb + (size_t)(row0 + ai * 128 + m * 16) * DM + col0;
#pragma unroll
                for (int bj = 0; bj < 2; ++bj)
#pragma unroll
                    for (int n = 0; n < 2; ++n) *(GAS pg8::f32x4*)(os + bj * 128 + n * 16) = gv[bj][n] * acc[ai][bj][m][n]; }
    }
};
typedef EpiResT<false> EpiRes;
struct EpiUp {
    static constexpr bool PERM = true, AFTER_DRAIN = false;
    GAS bf16* HID; GAS float* EG; GAS float* EP; GAS float* EU; const GAS float* cw; const GAS float* cb;
    __device__ __forceinline__ void operator()(pg8::f32x4 (&acc)[2][2][4][2], const pg8::Unit& u, int wr_, int wc_, int fr_, int fq_) const {
        int t_ = threadIdx.x; asm volatile("" : "+v"(t_));
        const int fr = t_ & 15, fq = (t_ >> 4) & 3, wc = (t_ >> 6) & 3, wr = t_ >> 8; (void)wr_; (void)wc_; (void)fr_; (void)fq_;
        const unsigned hc0 = (unsigned)(u.pn * 128 + wc * 32 + 8 * fq);
        const bool e0 = fr == 0, e3 = fr == 15;
        __builtin_amdgcn_sched_barrier(0);
#pragma unroll
        for (int ai = 0; ai < 2; ++ai) {
            const int rbase = u.pm * 256 + ai * 128 + wr * 64;
            const unsigned eb0 = (unsigned)((rbase >> 6) << 1) * (unsigned)DFF, eb3 = eb0 + (unsigned)DFF;
#pragma unroll
            for (int n = 0; n < 2; ++n) {
                const unsigned hc = hc0 + 4u * (unsigned)n;
                const pg8::f32x4 w0 = *(const GAS pg8::f32x4*)&cw[hc], w1 = *(const GAS pg8::f32x4*)&cw[(unsigned)DFF + hc], w2 = *(const GAS pg8::f32x4*)&cw[2u * (unsigned)DFF + hc], bb = *(const GAS pg8::f32x4*)&cb[hc];
                if (e0) { *(GAS pg8::f32x4*)&EG[eb0 + hc] = acc[ai][0][0][n]; *(GAS pg8::f32x4*)&EU[eb0 + hc] = acc[ai][1][0][n]; }
                if (e3) { *(GAS pg8::f32x4*)&EG[eb3 + hc] = acc[ai][0][3][n]; *(GAS pg8::f32x4*)&EU[eb3 + hc] = acc[ai][1][3][n]; }
#pragma unroll
                for (int j = 0; j < 4; ++j) {
                    float pr[4], nx[4], gg[4];
#pragma unroll
                    for (int m = 0; m < 4; ++m) { gg[m] = acc[ai][0][m][n][j]; pr[m] = dpp_ror<0x121>(gg[m]); nx[m] = dpp_ror<0x12F>(gg[m]); }
#pragma unroll
                    for (int m = 0; m < 4; ++m) {
                        const float pv = fr > 0 ? pr[m] : (m > 0 ? pr[m > 0 ? m - 1 : 0] : 0.f);
                        const float nv = fr < 15 ? nx[m] : (m < 3 ? nx[m < 3 ? m + 1 : 3] : 0.f);
                        const float cv = w0[j] * pv + w1[j] * gg[m] + w2[j] * nv + bb[j];
                        if (m == 0) { if (e0) EP[eb0 + hc + (unsigned)j] = cv; } if (m == 3) { if (e3) EP[eb3 + hc + (unsigned)j] = cv; }
                        acc[ai][0][m][n][j] = gelu_tanh(cv) * acc[ai][1][m][n][j];
                    }
                }
                asm volatile("" ::: "memory"); __builtin_amdgcn_sched_barrier(0);
            }
#pragma unroll
            for (int m = 0; m < 4; ++m) {
                if (!((m == 0 && e0) || (m == 3 && e3))) {
                    const pg8::f32x4 v0 = acc[ai][0][m][0], v1 = acc[ai][0][m][1];
                    v4u w; w.x = pg8::cvt_pk_bf16(v0[0], v0[1]); w.y = pg8::cvt_pk_bf16(v0[2], v0[3]); w.z = pg8::cvt_pk_bf16(v1[0], v1[1]); w.w = pg8::cvt_pk_bf16(v1[2], v1[3]);
                    *(GAS v4u*)&HID[(unsigned)(rbase + m * 16 + fr) * (unsigned)DFF + hc0] = w;
                }
            }
        }
    }
};
__device__ __forceinline__ void edge_fix_phase(Frame& F, int l, bool with_ctx) {
    const GAS float* EG = WSP(float, WS_EDGE); const GAS float* EP = EG + EDGE_ELEMS; const GAS float* EU = EP + EDGE_ELEMS;
    const GAS float* cw = IN(ffn_conv_w) + (size_t)l * 3 * DFF;
    GAS bf16* HID = WSP(bf16, WS_HID);
    const int ne = with_ctx ? NEDGE : ML / 64 * 2, total = ne * (DFF / 4);
    for (int i = F.vcu * NTHR + F.tid; i < total; i += F.G * NTHR) {
        const int e = i / (DFF / 4), c = (i % (DFF / 4)) * 4;
        const int r = (e >> 1) * 64 + (e & 1) * 63;
        f32x4 p = *(const GAS f32x4*)(EP + (size_t)e * DFF + c);
        if (e & 1) { const int nr = r + 1; if (nr != SEQ && nr != ML && nr != ML + CTXL && nr != MT) p += *(const GAS f32x4*)(cw + 2 * DFF + c) * *(const GAS f32x4*)(EG + (size_t)(e + 1) * DFF + c); }
        else { if (r != 0 && r != SEQ && r != ML && r != ML + CTXL) p += *(const GAS f32x4*)(cw + c) * *(const GAS f32x4*)(EG + (size_t)(e - 1) * DFF + c); }
        const f32x4 up = *(const GAS f32x4*)(EU + (size_t)e * DFF + c);
        v2u o; o.x = pk2(gelu_tanh(p.x) * up.x, gelu_tanh(p.y) * up.y); o.y = pk2(gelu_tanh(p.z) * up.z, gelu_tanh(p.w) * up.w);
        *(GAS v2u*)(HID + (size_t)r * DFF + c) = o;
    }
}

#define MFMA16(a, b, c) __builtin_amdgcn_mfma_f32_16x16x32_bf16((a), (b), (c), 0, 0, 0)
struct AttnK { bf16x8 kf[2][4]; };
struct AttnV { bf16x8 vf[8]; };
__device__ __forceinline__ void attn_load_k(AttnK& C, const GAS bf16* kbase  , int q, int g) {
#pragma unroll
    for (int T = 0; T < 2; ++T) { const unsigned koff = (unsigned)((8 * (q >> 2) + 4 * T + (q & 3)) * 2048 + 8 * g);
#pragma unroll
        for (int dc = 0; dc < 4; ++dc) C.kf[T][dc] = *(const GAS bf16x8*)(kbase + koff + 32 * dc); }
}
__device__ __forceinline__ void attn_load_v(AttnV& C, const GAS bf16* vbase  , int q, int g) {
    const unsigned voff = (unsigned)(q * MT + 8 * g);
#pragma unroll
    for (int dt = 0; dt < 8; ++dt) { const GAS bf16* vrow = vbase + (size_t)dt * 16 * MT; C.vf[dt] = *(const GAS bf16x8*)(vrow + voff); }
}
__device__ __forceinline__ void attn_load_k_ctx(AttnK& C, const LAS unsigned char* KC, int cc, int q, int g) {
#pragma unroll
    for (int T = 0; T < 2; ++T) { const int kk = 8 * (q >> 2) + 4 * T + (q & 3);
#pragma unroll
        for (int dc = 0; dc < 4; ++dc) C.kf[T][dc] = *(const LAS bf16x8*)(KC + (32 * cc + kk) * ATT_KC_PITCH + (32 * dc + 8 * g) * 2); }
}
__device__ __forceinline__ void attn_load_v_ctx(AttnV& C, const LAS unsigned char* VC, int cc, int q, int g) {
#pragma unroll
    for (int dt = 0; dt < 8; ++dt) C.vf[dt] = *(const LAS bf16x8*)(VC + (16 * dt + q) * ATT_VC_PITCH + (32 * cc + 8 * g) * 2);
}
__device__ __forceinline__ void attn_compute(const AttnK& C, const AttnV& V, const bf16x8 (&qf)[4], f32x4 (&o)[8], float& mrun, float& lsum, int lane, int g,
                                             bool masked, int keycol0, int cs, const LAS float* brow  , int cq) {
    f32x4 s[2];
#pragma unroll
    for (int T = 0; T < 2; ++T) { s[T] = (f32x4){0.f, 0.f, 0.f, 0.f};
#pragma unroll
        for (int dc = 0; dc < 4; ++dc) s[T] = MFMA16(C.kf[T][dc], qf[dc], s[T]); }
    if (masked) {
#pragma unroll
        for (int T = 0; T < 2; ++T)
#pragma unroll
            for (int i = 0; i < 4; ++i) { const int keycol = keycol0 + 8 * g + 4 * T + i; const bool ok = keycol >= cs && keycol < cs + 16;
                const int dcol = keycol - cq + 15; const float bv = brow[ok ? dcol : 0];
                s[T][i] = ok ? s[T][i] + bv : -1e30f; }
    }
    float cm = fmaxf(fmaxf(fmaxf(s[0][0], s[0][1]), fmaxf(s[0][2], s[0][3])), fmaxf(fmaxf(s[1][0], s[1][1]), fmaxf(s[1][2], s[1][3])));
    cm = fmaxf(cm, lane_read(cm, lane ^ 16)); cm = fmaxf(cm, lane_read(cm, lane ^ 32));
    const float mnew = fmaxf(mrun, cm), alpha = __builtin_amdgcn_exp2f(mrun - mnew);
    mrun = mnew;
    float p[8]; float ps = 0.f;
#pragma unroll
    for (int T = 0; T < 2; ++T)
#pragma unroll
        for (int i = 0; i < 4; ++i) { p[4 * T + i] = __builtin_amdgcn_exp2f(s[T][i] - mnew); ps += p[4 * T + i]; }
    lsum = lsum * alpha + ps;
    v4u pw; pw.x = pg8::cvt_pk_bf16(p[0], p[1]); pw.y = pg8::cvt_pk_bf16(p[2], p[3]); pw.z = pg8::cvt_pk_bf16(p[4], p[5]); pw.w = pg8::cvt_pk_bf16(p[6], p[7]);
    const bf16x8 pf = __builtin_bit_cast(bf16x8, pw);
#pragma unroll
    for (int dt = 0; dt < 8; ++dt) { o[dt] = o[dt] * alpha; o[dt] = MFMA16(V.vf[dt], pf, o[dt]); }
}
__device__ __forceinline__ void attn_tile(Frame& F, bool is_lat, int b, int h, int r, int c0, int qrow0, const LAS float* bias_h) {
    const GAS bf16* QK = WSP(bf16, WS_QK); const GAS bf16* VT = WSP(bf16, WS_VT); GAS bf16* A = WSP(bf16, WS_A);
    const int q = F.lane & 15, g = F.lane >> 4;
    bf16x8 qf[4];
    { const GAS bf16* qp = QK + (size_t)(qrow0 + q) * 2048 + h * 128 + 8 * g;
#pragma unroll
      for (int dc = 0; dc < 4; ++dc) qf[dc] = *(const GAS bf16x8*)(qp + 32 * dc); }
    f32x4 o[8];
#pragma unroll
    for (int dt = 0; dt < 8; ++dt) o[dt] = (f32x4){0.f, 0.f, 0.f, 0.f};
    float mrun = -1e30f, lsum = 0.f;
    const int r0 = min(max(r - 4, 0), GROWS - 8), kc0 = min(max(c0 - 8, 0), 32), cq = c0 + q, cs = min(max(cq - 8, 0), 48);
    const GAS bf16* kh = QK + 1024 + h * 128; const GAS bf16* vh = VT + (size_t)(h * 128) * MT;
#define ATT_TOK(c) ((c) < 8 ? b * SEQ + (r0 + (c)) * GRIDW + kc0 : ML + b * CTXL + 32 * ((c) - 8))
#define ATT_LOADK(C, c) do { if ((c) < 8) { const int tok_ = ATT_TOK(c); attn_load_k(C, kh + (size_t)tok_ * 2048, q, g); } else attn_load_k_ctx(C, F.lds + ATT_KC_OFF, (c) - 8, q, g); } while (0)
#define ATT_LOADV(C, c) do { if ((c) < 8) { const int tok_ = ATT_TOK(c); attn_load_v(C, vh + tok_, q, g); } else attn_load_v_ctx(C, F.lds + ATT_VC_OFF, (c) - 8, q, g); } while (0)
#define ATT_COMP(C, V, c) attn_compute(C, V, qf, o, mrun, lsum, F.lane, g, (c) < 8, kc0, cs, bias_h + (r0 + ((c) < 8 ? (c) : 0) - r + 7) * 31, cq)
    AttnK KA, KB; AttnV VV;
    const int cbeg = is_lat ? 0 : 8;
    ATT_LOADK(KA, cbeg);
    for (int c = cbeg; c < 16; c += 2) {
        ATT_LOADV(VV, c); ATT_LOADK(KB, c + 1); __builtin_amdgcn_sched_barrier(0);
        ATT_COMP(KA, VV, c); __builtin_amdgcn_sched_barrier(0);
        ATT_LOADV(VV, c + 1); if (c + 2 < 16) ATT_LOADK(KA, c + 2);
        __builtin_amdgcn_sched_barrier(0);
        ATT_COMP(KB, VV, c + 1); __builtin_amdgcn_sched_barrier(0);
    }
#undef ATT_TOK
#undef ATT_LOADK
#undef ATT_LOADV
#undef ATT_COMP
    lsum += lane_read(lsum, F.lane ^ 16); lsum += lane_read(lsum, F.lane ^ 32);
    const float inv = 1.0f / lsum;
    GAS bf16* ap = A + (size_t)(qrow0 + q) * 1024 + h * 128 + 4 * g;
#pragma unroll
    for (int dt = 0; dt < 8; ++dt) { v2u w; w.x = pg8::cvt_pk_bf16(o[dt][0] * inv, o[dt][1] * inv); w.y = pg8::cvt_pk_bf16(o[dt][2] * inv, o[dt][3] * inv); *(GAS v2u*)(ap + 16 * dt) = w; }
}
__device__ __forceinline__ void attn_pair(Frame& F, int b, int h, int r, int c0, const LAS float* bias_h) {
    const GAS bf16* QK = WSP(bf16, WS_QK); const GAS bf16* VT = WSP(bf16, WS_VT); GAS bf16* A = WSP(bf16, WS_A);
    const int q = F.lane & 15, g = F.lane >> 4;
    const int qrowA = b * SEQ + r * GRIDW + c0, qrowB = qrowA + GRIDW;
    bf16x8 qfA[4], qfB[4];
    { const GAS bf16* qp = QK + (size_t)(qrowA + q) * 2048 + h * 128 + 8 * g;
#pragma unroll
      for (int dc = 0; dc < 4; ++dc) { qfA[dc] = *(const GAS bf16x8*)(qp + 32 * dc); qfB[dc] = *(const GAS bf16x8*)(qp + (size_t)GRIDW * 2048 + 32 * dc); } }
    f32x4 oA[8], oB[8];
#pragma unroll
    for (int dt = 0; dt < 8; ++dt) { oA[dt] = (f32x4){0.f, 0.f, 0.f, 0.f}; oB[dt] = oA[dt]; }
    float mA = -1e30f, lA = 0.f, mB = -1e30f, lB = 0.f;
    const int r0A = min(max(r - 4, 0), GROWS - 8), r0B = min(max(r - 3, 0), GROWS - 8), kc0 = min(max(c0 - 8, 0), 32), cq = c0 + q, cs = min(max(cq - 8, 0), 48);
    const GAS bf16* kh = QK + 1024 + h * 128; const GAS bf16* vh = VT + (size_t)(h * 128) * MT;
    AttnK KK; AttnV VV;
    for (int kr = r0A; kr < r0B + 8; ++kr) {
        const int tok = b * SEQ + kr * GRIDW + kc0;
        attn_load_k(KK, kh + (size_t)tok * 2048, q, g); attn_load_v(VV, vh + tok, q, g);
        if (kr < r0A + 8) attn_compute(KK, VV, qfA, oA, mA, lA, F.lane, g, true, kc0, cs, bias_h + (kr - r + 7) * 31, cq);
        if (kr >= r0B)    attn_compute(KK, VV, qfB, oB, mB, lB, F.lane, g, true, kc0, cs, bias_h + (kr - r + 6) * 31, cq);
    }
    for (int cc = 0; cc < 8; ++cc) {
        attn_load_k_ctx(KK, F.lds + ATT_KC_OFF, cc, q, g); attn_load_v_ctx(VV, F.lds + ATT_VC_OFF, cc, q, g);
        attn_compute(KK, VV, qfA, oA, mA, lA, F.lane, g, false, 0, 0, bias_h, 0);
        attn_compute(KK, VV, qfB, oB, mB, lB, F.lane, g, false, 0, 0, bias_h, 0);
    }
    lA += lane_read(lA, F.lane ^ 16); lA += lane_read(lA, F.lane ^ 32); lB += lane_read(lB, F.lane ^ 16); lB += lane_read(lB, F.lane ^ 32);
    const float iA = 1.0f / lA, iB = 1.0f / lB;
    GAS bf16* ap = A + (size_t)(qrowA + q) * 1024 + h * 128 + 4 * g;
#pragma unroll
    for (int dt = 0; dt < 8; ++dt) { v2u w; w.x = pg8::cvt_pk_bf16(oA[dt][0] * iA, oA[dt][1] * iA); w.y = pg8::cvt_pk_bf16(oA[dt][2] * iA, oA[dt][3] * iA); *(GAS v2u*)(ap + 16 * dt) = w;
        v2u x; x.x = pg8::cvt_pk_bf16(oB[dt][0] * iB, oB[dt][1] * iB); x.y = pg8::cvt_pk_bf16(oB[dt][2] * iB, oB[dt][3] * iB); *(GAS v2u*)(ap + (size_t)GRIDW * 1024 + 16 * dt) = x; }
}
__device__ __forceinline__ void attn_phase(Frame& F, int l, bool with_ctx) {
    LAS float* bias = (LAS float*)(F.lds + ATT_BIAS_OFF);
    const GAS float* p_rpb = IN(na_rpb) + (size_t)l * NHEAD * 465;
    for (int i = F.tid; i < NHEAD * 465; i += NTHR) bias[i] = p_rpb[i] * LOG2E;
    const GAS bf16* QK = WSP(bf16, WS_QK); const GAS bf16* VT = WSP(bf16, WS_VT);
    for (int wgi = F.vcu; wgi < 256; wgi += F.G) {
        const int bh = wgi >> 4, b = bh >> 3, h = bh & 7, sub = wgi & 15;
        __syncthreads();
#pragma unroll 4
        for (int i = F.tid; i < 256 * 16; i += NTHR) { const int row = i >> 4, pc = i & 15;
            *(LAS v4u*)(F.lds + ATT_KC_OFF + row * ATT_KC_PITCH + pc * 16) = *(const GAS v4u*)(QK + (size_t)(ML + b * CTXL + row) * 2048 + 1024 + h * 128 + 8 * pc); }
#pragma unroll 4
        for (int i = F.tid; i < 128 * 32; i += NTHR) { const int row = i >> 5, pc = i & 31;
            *(LAS v4u*)(F.lds + ATT_VC_OFF + row * ATT_VC_PITCH + pc * 16) = *(const GAS v4u*)(VT + (size_t)(h * 128 + row) * MT + ML + b * CTXL + 8 * pc); }
        __syncthreads();
        const int rb = sub * 2 + (F.wave >> 2), c0 = 16 * (F.wave & 3);
#if defined(ATT_SINGLE)
        for (int rr = 0; rr < 8; ++rr) { const int r = rb * 8 + rr; attn_tile(F, true, b, h, r, c0, b * SEQ + r * GRIDW + c0, bias + h * 465); }
#else
        for (int rr = 0; rr < 8; rr += 2) attn_pair(F, b, h, rb * 8 + rr, c0, bias + h * 465);
#endif
        if (with_ctx) {
            if ((F.wave & 3) == 0) { const int t = sub; if ((F.wave >> 2) == (t & 1)) attn_tile(F, false, b, h, 0, 0, ML + b * CTXL + 16 * t, bias + h * 465); }
        }
    }
    __syncthreads();
}

constexpr int FFTN = 16384, FFT_PHYS = FFTN + FFTN / 16;
__device__ __forceinline__ int phys(int i) { return i + ((i >> 6) << 2); }
__device__ __forceinline__ f32x2 tw32k(const LAS f32x2* TH, const LAS f32x2* TL, int n) { return cmul(TH[n >> 7], TL[n & 127]); }
template <bool INV> __device__ __forceinline__ void r4(f32x2& x0, f32x2& x1, f32x2& x2, f32x2& x3) {
    const f32x2 a = x0 + x2, c = x0 - x2, b = x1 + x3, e = x1 - x3;
    const f32x2 d = INV ? (f32x2){-e.y, e.x} : (f32x2){e.y, -e.x};
    x0 = a + b; x1 = c + d; x2 = a - b; x3 = c - d;
}
template <bool INV> __device__ __forceinline__ void dft16(f32x2 (&x)[16]) {
#pragma unroll
    for (int b = 0; b < 4; ++b) r4<INV>(x[b], x[4 + b], x[8 + b], x[12 + b]);
    const float sg = INV ? -1.f : 1.f;
    const f32x2 W1 = {0.92387953251f, -0.38268343236f * sg}, W2 = {0.70710678118f, -0.70710678118f * sg}, W3 = {0.38268343236f, -0.92387953251f * sg},
                W4 = {0.f, -1.f * sg}, W6 = {-0.70710678118f, -0.70710678118f * sg}, W9 = {-0.92387953251f, 0.38268343236f * sg};
    x[5] = cmul(x[5], W1); x[9] = cmul(x[9], W2); x[13] = cmul(x[13], W3);
    x[6] = cmul(x[6], W2); x[10] = cmul(x[10], W4); x[14] = cmul(x[14], W6);
    x[7] = cmul(x[7], W3); x[11] = cmul(x[11], W6); x[15] = cmul(x[15], W9);
#pragma unroll
    for (int c = 0; c < 4; ++c) r4<INV>(x[4 * c], x[4 * c + 1], x[4 * c + 2], x[4 * c + 3]);
}
template <bool INV> __device__ __forceinline__ void bfly16(f32x2 (&x)[16], const LAS f32x2* TH, const LAS f32x2* TL, int tw) {
    f32x2 W = tw32k(TH, TL, tw); if (INV) W.y = -W.y;
    if (INV) { f32x2 p = W;
#pragma unroll
        for (int q = 1; q < 16; ++q) { x[q] = cmul(x[q], p); if (q < 15) p = cmul(p, W); } }
    dft16<INV>(x);
    if (!INV) { f32x2 p = W;
#pragma unroll
        for (int r = 1; r < 16; ++r) { x[4 * (r & 3) + (r >> 2)] = cmul(x[4 * (r & 3) + (r >> 2)], p); if (r < 15) p = cmul(p, W); } }
}
template <bool INV> __device__ __forceinline__ void pass16(LAS f32x2* X, const LAS f32x2* TH, const LAS f32x2* TL, int base, int stride, int tw) {
    f32x2 x[16];
#pragma unroll
    for (int q = 0; q < 16; ++q) x[q] = X[base + q * stride];
    bfly16<INV>(x, TH, TL, tw);
#pragma unroll
    for (int c = 0; c < 4; ++c)
#pragma unroll
        for (int d = 0; d < 4; ++d) X[base + (c + 4 * d) * stride] = x[4 * c + d];
}
template <bool INV> __device__ __forceinline__ void pass16_s4(LAS f32x2* X, const LAS f32x2* TH, const LAS f32x2* TL, int blk, int h) {
#pragma unroll 1
    for (int s = 0; s < 2; ++s) {
        LAS f32x2* P = X + blk * 68 + 2 * h + s;
        f32x2 x[16];
#pragma unroll
        for (int q = 0; q < 16; ++q) x[q] = P[4 * q];
        bfly16<INV>(x, TH, TL, (2 * h + s) * 512);
#pragma unroll
        for (int c = 0; c < 4; ++c)
#pragma unroll
            for (int d = 0; d < 4; ++d) P[4 * (c + 4 * d)] = x[4 * c + d];
    }
}
template <bool INV> __device__ __forceinline__ void pass4_s1(LAS f32x2* X, int b) {
    LAS f32x4* P = (LAS f32x4*)(X + 4 * b + ((b >> 4) << 2));
    const f32x4 u = P[0], v = P[1];
    f32x2 x0 = {u.x, u.y}, x1 = {u.z, u.w}, x2 = {v.x, v.y}, x3 = {v.z, v.w};
    r4<INV>(x0, x1, x2, x3);
    P[0] = (f32x4){x0.x, x0.y, x1.x, x1.y}; P[1] = (f32x4){x2.x, x2.y, x3.x, x3.y};
}
__device__ __forceinline__ void fft_fwd_head(LAS f32x2* X, const LAS f32x2* TH, const LAS f32x2* TL, int tid) {
#pragma unroll 1
    for (int i = 0; i < 2; ++i) { const int j = tid + NTHR * i; pass16<false>(X, TH, TL, j + ((j >> 6) << 2), 1088, 2 * j); }
    __syncthreads();
#pragma unroll 1
    for (int i = 0; i < 2; ++i) { const int b = tid + NTHR * i, j = b & 63, blk = b >> 6; pass16<false>(X, TH, TL, blk * 1088 + j, 68, 32 * j); }
    __syncthreads();
    pass16_s4<false>(X, TH, TL, tid >> 1, tid & 1);
    __syncthreads();
}
__device__ __forceinline__ void fft_fwd(LAS f32x2* X, const LAS f32x2* TH, const LAS f32x2* TL, int tid) {
    fft_fwd_head(X, TH, TL, tid);
#pragma unroll 2
    for (int i = 0; i < 8; ++i) pass4_s1<false>(X, tid + NTHR * i);
    __syncthreads();
}
__device__ __forceinline__ void fft_inv_tail(LAS f32x2* X, const LAS f32x2* TH, const LAS f32x2* TL, int tid) {
    pass16_s4<true>(X, TH, TL, tid >> 1, tid & 1);
    __syncthreads();
#pragma unroll 1
    for (int i = 0; i < 2; ++i) { const int b = tid + NTHR * i, j = b & 63, blk = b >> 6; pass16<true>(X, TH, TL, blk * 1088 + j, 68, 32 * j); }
    __syncthreads();
#pragma unroll 1
    for (int i = 0; i < 2; ++i) { const int j = tid + NTHR * i; pass16<true>(X, TH, TL, j + ((j >> 6) << 2), 1088, 2 * j); }
    __syncthreads();
}
__device__ __forceinline__ void fft_inv(LAS f32x2* X, const LAS f32x2* TH, const LAS f32x2* TL, int tid) {
#pragma unroll 2
    for (int i = 0; i < 8; ++i) pass4_s1<true>(X, tid + NTHR * i);
    __syncthreads();
    fft_inv_tail(X, TH, TL, tid);
}
__device__ __forceinline__ int freq_pos(int k) { return phys(((k & 15) << 10) | (((k >> 4) & 15) << 6) | (((k >> 8) & 15) << 2) | (k >> 12)); }

__device__ __forceinline__ float conv3(const GAS float* p, int n, int Lq, float w0, float w1, float w2, float bb) {
    float a = p[n] * w1 + bb; if (n > 0) a += p[n - 1] * w0; if (n < Lq - 1) a += p[n + 1] * w2; return a;
}
__device__ __forceinline__ f32x4 conv3v(const GAS float* p, int n0, int Lq, float w0, float w1, float w2, float bb) {
    const f32x4 c = *(const GAS f32x4*)(p + n0); const float l = n0 > 0 ? p[n0 - 1] : 0.f, r = n0 + 4 < Lq ? p[n0 + 4] : 0.f;
    return (f32x4){w0 * l + w1 * c.x + w2 * c.y + bb, w0 * c.x + w1 * c.y + w2 * c.z + bb, w0 * c.y + w1 * c.z + w2 * c.w + bb, w0 * c.z + w1 * c.w + w2 * r + bb};
}
__device__ __forceinline__ void tw4(const LAS f32x2* TH, const LAS f32x2* TL, int n0, f32x2 (&w)[4]) {
    const f32x2 th = TH[n0 >> 7]; const LAS f32x4* tl = (const LAS f32x4*)(TL + (n0 & 127)); const f32x4 a = tl[0], b = tl[1];
    w[0] = cmul(th, (f32x2){a.x, a.y}); w[1] = cmul(th, (f32x2){a.z, a.w}); w[2] = cmul(th, (f32x2){b.x, b.y}); w[3] = cmul(th, (f32x2){b.z, b.w});
}

#define LT() ({ int lt_ = tid; asm volatile("" : "+v"(lt_)); lt_; })
__device__ __forceinline__ void hyena_latent(Frame& F, int l, int ch, LAS f32x2* X, const LAS f32x2* TH, const LAS f32x2* TL, GAS f32x2* KS, bool wr = true) {
    GAS float* T32 = WSP(float, WS_T32);
    GAS float* hv = T32 + (size_t)(512 + ch) * MT; const GAS float* hx1 = T32 + (size_t)(1024 + ch) * MT; const GAS float* hx2 = T32 + (size_t)(1536 + ch) * MT;
    const GAS float* cw = IN(hy_conv_w) + (size_t)l * 3 * 1536; const GAS float* cb = IN(hy_conv_b) + (size_t)l * 1536;
    const GAS float* HF = WSP(float, WS_HF); const GAS float* p_hb = IN(hy_bias) + (size_t)l * 2 * HYW + ch;
    const int tid = F.tid;
    GAS f32x4* KE4 = (GAS f32x4*)KS;
    f32x4 kreg[16];
    for (int o = 0; o < 2; ++o) {
        const GAS float* hf = HF + (size_t)(o * 1024 + ch) * SEQ; const GAS float* hbr = HF + (size_t)(o * 1024 + 512 + ch) * SEQ;
        const float bias = p_hb[o * HYW];
        const float vw0 = cw[ch], vw1 = cw[1536 + ch], vw2 = cw[3072 + ch], vbb = cb[ch];
        const GAS float* hx = o == 0 ? hx1 : hx2; const int xo = o == 0 ? 512 : 1024;
        const float xw0 = cw[xo + ch], xw1 = cw[1536 + xo + ch], xw2 = cw[3072 + xo + ch], xbb = cb[xo + ch];
        for (int par = 0; par < 2; ++par) {
#if defined(PROBE_ELEM)
            for (int rep_ = 0; rep_ < 2; ++rep_)
#endif
#pragma unroll
            for (int i = 0; i < 8; ++i) { const int g = LT() + NTHR * i, n0 = 4 * g; const f32x4 f = *(const GAS f32x4*)(hf + n0), bk = *(const GAS f32x4*)(hbr + n0);
                LAS f32x4* XP = (LAS f32x4*)(X + phys(n0));
                if (par == 0) { XP[0] = (f32x4){f.x + bk.x, 0.f, f.y + bk.y, 0.f}; XP[1] = (f32x4){f.z + bk.z, 0.f, f.w + bk.w, 0.f}; }
                else { f32x2 w[4]; tw4(TH, TL, n0, w); const f32x4 d = f - bk;
                    XP[0] = (f32x4){w[0].x * d.x, w[0].y * d.x, w[1].x * d.y, w[1].y * d.y}; XP[1] = (f32x4){w[2].x * d.z, w[2].y * d.z, w[3].x * d.w, w[3].y * d.w}; } }
            __syncthreads();
            fft_fwd_head(X, TH, TL, tid);
#pragma unroll
            for (int i = 0; i < 8; ++i) { const int b = LT() + NTHR * i; const LAS f32x4* P = (const LAS f32x4*)(X + 4 * b + ((b >> 4) << 2)); const f32x4 u = P[0], v = P[1];
                f32x2 x0 = {u.x, u.y}, x1 = {u.z, u.w}, x2 = {v.x, v.y}, x3 = {v.z, v.w}; r4<false>(x0, x1, x2, x3);
                kreg[2 * i] = (f32x4){x0.x, x0.y, x1.x, x1.y}; kreg[2 * i + 1] = (f32x4){x2.x, x2.y, x3.x, x3.y}; }
            __syncthreads();
#if defined(PROBE_ELEM)
            for (int rep_ = 0; rep_ < 2; ++rep_)
#endif
#pragma unroll 2
            for (int i = 0; i < 8; ++i) { const int g = LT() + NTHR * i, n0 = 4 * g;
                f32x4 z0, z1; if (o == 0) { z0 = conv3v(hv, n0, SEQ, vw0, vw1, vw2, vbb); z1 = conv3v(hv + SEQ, n0, SEQ, vw0, vw1, vw2, vbb); } else { z0 = *(const GAS f32x4*)(hv + n0); z1 = *(const GAS f32x4*)(hv + SEQ + n0); }
                LAS f32x4* XP = (LAS f32x4*)(X + phys(n0));
                if (par == 0) { XP[0] = (f32x4){z0.x, z1.x, z0.y, z1.y}; XP[1] = (f32x4){z0.z, z1.z, z0.w, z1.w}; }
                else { f32x2 w[4]; tw4(TH, TL, n0, w);
                    const f32x2 a0 = cmul((f32x2){z0.x, z1.x}, w[0]), a1 = cmul((f32x2){z0.y, z1.y}, w[1]), a2 = cmul((f32x2){z0.z, z1.z}, w[2]), a3 = cmul((f32x2){z0.w, z1.w}, w[3]);
                    XP[0] = (f32x4){a0.x, a0.y, a1.x, a1.y}; XP[1] = (f32x4){a2.x, a2.y, a3.x, a3.y}; } }
            __syncthreads();
#if defined(PROBE_FFTCORE)
            fft_fwd(X, TH, TL, tid); fft_inv(X, TH, TL, tid);
            for (int i = 0; i < 8; ++i) { const int g = LT() + NTHR * i; LAS f32x4* XP = (LAS f32x4*)(X + phys(4 * g)); XP[0] = XP[0] * (1.0f / 16384.0f); XP[1] = XP[1] * (1.0f / 16384.0f); }
            __syncthreads();
#endif
            fft_fwd_head(X, TH, TL, tid);
#pragma unroll
            for (int i = 0; i < 8; ++i) { const int b = LT() + NTHR * i; LAS f32x4* P = (LAS f32x4*)(X + 4 * b + ((b >> 4) << 2)); const f32x4 u = P[0], v = P[1], k0 = kreg[2 * i], k1 = kreg[2 * i + 1];
                f32x2 x0 = {u.x, u.y}, x1 = {u.z, u.w}, x2 = {v.x, v.y}, x3 = {v.z, v.w}; r4<false>(x0, x1, x2, x3);
                x0 = cmul(x0, (f32x2){k0.x, k0.y}); x1 = cmul(x1, (f32x2){k0.z, k0.w}); x2 = cmul(x2, (f32x2){k1.x, k1.y}); x3 = cmul(x3, (f32x2){k1.z, k1.w});
                r4<true>(x0, x1, x2, x3);
                P[0] = (f32x4){x0.x, x0.y, x1.x, x1.y}; P[1] = (f32x4){x2.x, x2.y, x3.x, x3.y};
                if (i & 1) asm volatile("" ::: "memory"); }
            __syncthreads();
            fft_inv_tail(X, TH, TL, tid);
            if (par == 0) {
#pragma unroll
                for (int i = 0; i < 8; ++i) { const int g = LT() + NTHR * i; const LAS f32x4* XP = (const LAS f32x4*)(X + phys(4 * g)); KE4[2 * g] = XP[0]; KE4[2 * g + 1] = XP[1]; }
                __syncthreads();
            }
        }
#pragma unroll 4
        for (int i = 0; i < 8; ++i) { const int g = LT() + NTHR * i, n0 = 4 * g;
            f32x4 z0, z1; if (o == 0) { z0 = conv3v(hv, n0, SEQ, vw0, vw1, vw2, vbb); z1 = conv3v(hv + SEQ, n0, SEQ, vw0, vw1, vw2, vbb); } else { z0 = *(const GAS f32x4*)(hv + n0); z1 = *(const GAS f32x4*)(hv + SEQ + n0); }
            const f32x4 g0 = conv3v(hx, n0, SEQ, xw0, xw1, xw2, xbb), g1 = conv3v(hx + SEQ, n0, SEQ, xw0, xw1, xw2, xbb);
            const f32x4 e0 = KE4[2 * g], e1 = KE4[2 * g + 1];
            LAS f32x4* XP = (LAS f32x4*)(X + phys(n0)); const f32x4 u0 = XP[0], u1 = XP[1];
            f32x2 w[4]; tw4(TH, TL, n0, w);
            const f32x2 c0 = cmul((f32x2){u0.x, u0.y}, cconj(w[0])), c1 = cmul((f32x2){u0.z, u0.w}, cconj(w[1])), c2 = cmul((f32x2){u1.x, u1.y}, cconj(w[2])), c3 = cmul((f32x2){u1.z, u1.w}, cconj(w[3]));
            const float sc = 1.0f / 32768.0f;
            const f32x2 y0 = ((f32x2){e0.x, e0.y} + c0) * sc + (f32x2){z0.x, z1.x} * bias, y1 = ((f32x2){e0.z, e0.w} + c1) * sc + (f32x2){z0.y, z1.y} * bias,
                        y2 = ((f32x2){e1.x, e1.y} + c2) * sc + (f32x2){z0.z, z1.z} * bias, y3 = ((f32x2){e1.z, e1.w} + c3) * sc + (f32x2){z0.w, z1.w} * bias;
            XP[0] = (f32x4){g0.x * y0.x, g0.y * y1.x, g0.z * y2.x, g0.w * y3.x};
            XP[1] = (f32x4){g1.x * y0.y, g1.y * y1.y, g1.z * y2.y, g1.w * y3.y}; }
        __syncthreads();
#pragma unroll
        for (int i = 0; i < 8; ++i) { const int g = LT() + NTHR * i, n0 = 4 * g; const LAS f32x4* XP = (const LAS f32x4*)(X + phys(n0)); if (wr) { *(GAS f32x4*)(hv + n0) = XP[0]; *(GAS f32x4*)(hv + SEQ + n0) = XP[1]; } }
        __syncthreads();
    }
}
__device__ __forceinline__ void fourier_latent(Frame& F, int b, int gq, int m, LAS f32x2* X, const LAS f32x2* TH, const LAS f32x2* TL, bool wr = true) {
    GAS float* T32 = WSP(float, WS_T32);
    GAS float* ra = T32 + (size_t)(gq * 128 + m) * MT + b * SEQ; GAS float* rb = T32 + (size_t)(gq * 128 + 64 + m) * MT + b * SEQ;
    const int tid = F.tid;
#pragma unroll
    for (int i = 0; i < 8; ++i) { const int g = LT() + NTHR * i, n0 = 4 * g; const f32x4 a = *(const GAS f32x4*)(ra + n0), c = *(const GAS f32x4*)(rb + n0);
        LAS f32x4* XP = (LAS f32x4*)(X + phys(n0)); XP[0] = (f32x4){a.x, c.x, a.y, c.y}; XP[1] = (f32x4){a.z, c.z, a.w, c.w}; }
    __syncthreads();
    fft_fwd(X, TH, TL, tid);
    const float sc = 6.9053396600248786e-4f;
#pragma unroll 2
    for (int i = 0; i < 8; ++i) { const int g = LT() + NTHR * i, k0 = 4 * g; f32x4 oa, ob;
#pragma unroll
        for (int e = 0; e < 4; ++e) { const int k = k0 + e; const f32x2 u = X[freq_pos(k)], v = X[freq_pos((FFTN - k) & (FFTN - 1))];
            if (m != 0) { oa[e] = u.x * sc; ob[e] = v.x * sc; } else { oa[e] = (u.x + v.x) * (0.5f * sc); ob[e] = (u.y + v.y) * (0.5f * sc); } }
        if (wr) { *(GAS f32x4*)(ra + k0) = oa; *(GAS f32x4*)(rb + k0) = ob; } }
    __syncthreads();
}
__device__ __forceinline__ void hyena_ctx(Frame& F, int l, int ch, LAS float* S, bool wr = true) {
    GAS float* T32 = WSP(float, WS_T32);
    GAS float* hv = T32 + (size_t)(512 + ch) * MT + ML; const GAS float* hx1 = T32 + (size_t)(1024 + ch) * MT + ML; const GAS float* hx2 = T32 + (size_t)(1536 + ch) * MT + ML;
    const GAS float* cw = IN(hy_conv_w) + (size_t)l * 3 * 1536; const GAS float* cb = IN(hy_conv_b) + (size_t)l * 1536;
    const GAS float* HFC = WSP(float, WS_HFC); const GAS float* p_hb = IN(hy_bias) + (size_t)l * 2 * HYW + ch;
    LAS float* zb = S; LAS float* hfl = S + 512; LAS float* hbl = S + 768;
    const int n = F.tid & 255, b = F.tid >> 8;
    __syncthreads();
    zb[b * 256 + n] = conv3(hv + b * CTXL, n, CTXL, cw[ch], cw[1536 + ch], cw[3072 + ch], cb[ch]);
    for (int o = 0; o < 2; ++o) {
        if (F.tid < 256) hfl[n] = HFC[(size_t)(o * 1024 + ch) * CTXL + n]; else hbl[n] = HFC[(size_t)(o * 1024 + 512 + ch) * CTXL + n];
        __syncthreads();
        float y = 0.f;
        for (int mI = 0; mI < CTXL; ++mI) { const int d = n - mI; y += zb[b * 256 + mI] * (d >= 0 ? hfl[d] : hbl[CTXL + d]); }
        y += p_hb[o * HYW] * zb[b * 256 + n];
        const GAS float* hx = o == 0 ? hx1 : hx2; const int xo = o == 0 ? 512 : 1024;
        const float r = conv3(hx + b * CTXL, n, CTXL, cw[xo + ch], cw[1536 + xo + ch], cw[3072 + xo + ch], cb[xo + ch]) * y;
        __syncthreads();
        if (o == 0) zb[b * 256 + n] = r; else if (wr) hv[b * CTXL + n] = r;
        __syncthreads();
    }
}
__device__ __forceinline__ void fourier_ctx(Frame& F, int item, LAS float* S, bool wr = true) {
    GAS float* T32 = WSP(float, WS_T32);
    const int b = item >> 7, gq = (item >> 5) & 3, m0 = (item & 31) * 2;
    LAS float* cs = S; LAS float* re = S + 256; LAS float* im = S + 256 + 512;
    __syncthreads();
    if (F.tid < 256) cs[F.tid] = cospif((float)F.tid * (1.0f / 128.0f));
    { const int mm = F.tid >> 8, n = F.tid & 255;
      re[F.tid] = T32[(size_t)(gq * 128 + m0 + mm) * MT + ML + b * CTXL + n]; im[F.tid] = T32[(size_t)(gq * 128 + 64 + m0 + mm) * MT + ML + b * CTXL + n]; }
    __syncthreads();
    const int k = F.tid & 255, mm = F.tid >> 8, m = m0 + mm;
    const float sc = 5.5242717280199031e-3f;
    float cr = 0.f, ci = 0.f, sr = 0.f, si = 0.f;
#pragma unroll 4
    for (int n = 0; n < 256; ++n) { const int ix = (k * n) & 255; const float c = cs[ix], sn = cs[(ix - 64) & 255]; const float a = re[mm * 256 + n], bq = im[mm * 256 + n];
        cr += a * c; ci += bq * c; sr += a * sn; si += bq * sn; }
    float oa, ob;
    if (m != 0) { oa = cr + si; ob = cr - si; } else { oa = cr; ob = ci; }
    if (wr) { T32[(size_t)(gq * 128 + m) * MT + ML + b * CTXL + k] = oa * sc; T32[(size_t)(gq * 128 + 64 + m) * MT + ML + b * CTXL + k] = ob * sc; }
    __syncthreads();
}
__device__ __forceinline__ void fft_phase(Frame& F, int l, bool with_ctx) {
    LAS f32x2* X = (LAS f32x2*)F.lds;
    LAS f32x2* TH = (LAS f32x2*)(F.lds + TW_OFF); LAS f32x2* TL = TH + 128;
    if (F.tid < 256) { const int a = F.tid & 127; const float fr = F.tid < 128 ? (float)(128 * a) * (1.0f / 16384.0f) : (float)a * (1.0f / 16384.0f);
        float sn, cn; sincospif(fr, &sn, &cn); (F.tid < 128 ? TH : TL)[a] = (f32x2){cn, -sn}; }
    __syncthreads();
#if defined(PROBE_HYENA)
    { const bool wr0 = opaque_int(0) != 0; for (int ch = F.vcu; ch < HYW; ch += F.G) hyena_latent(F, l, ch, X, TH, TL, WSP(f32x2, WS_KS) + (size_t)F.vcu * 2 * FFTN, wr0); }
#endif
    for (int ch = F.vcu; ch < HYW; ch += F.G) hyena_latent(F, l, ch, X, TH, TL, WSP(f32x2, WS_KS) + (size_t)F.vcu * 2 * FFTN);
#if defined(PROBE_FOUR)
    { const bool wr0 = opaque_int(0) != 0; for (int fu = F.vcu; fu < 512; fu += F.G) fourier_latent(F, fu >> 8, (fu >> 6) & 3, fu & 63, X, TH, TL, wr0); }
#endif
    for (int fu = F.vcu; fu < 512; fu += F.G) fourier_latent(F, fu >> 8, (fu >> 6) & 3, fu & 63, X, TH, TL);
    if (with_ctx) {
        LAS float* S = (LAS float*)F.lds;
#if defined(PROBE_CTX)
        { const bool wr0 = opaque_int(0) != 0; for (int ch = F.vcu; ch < HYW; ch += F.G) hyena_ctx(F, l, ch, S, wr0); for (int it = F.vcu; it < 256; it += F.G) fourier_ctx(F, it, S, wr0); }
#endif
        for (int ch = F.vcu; ch < HYW; ch += F.G) hyena_ctx(F, l, ch, S);
        for (int it = F.vcu; it < 256; it += F.G) fourier_ctx(F, it, S);
    }
}

__device__ __forceinline__ void merge_phase(Frame& F, int l, bool with_ctx) {
    const GAS bf16* A = WSP(bf16, WS_A); const GAS float* T32 = WSP(float, WS_T32); GAS bf16* H = WSP(bf16, WS_H);
    const GAS float* gain = IN(mix_norm_g) + (size_t)l * DM;
    LAS float* tile = (LAS float*)F.lds;
    const int TI = with_ctx ? 65 : 64;
    for (int it = F.vcu; it < 512; it += F.G) {
        const int tok0 = it * TI;
        for (int tk = F.wave; tk < TI; tk += NWAVES) {
            const size_t row = (size_t)(tok0 + tk);
            const v4u r0 = *(const GAS v4u*)(A + row * 1024 + 8 * F.lane), r1 = *(const GAS v4u*)(A + row * 1024 + 512 + 8 * F.lane);
            float v[16];
            v[0] = bf2f(r0.x & 0xffff); v[1] = bf2f(r0.x >> 16); v[2] = bf2f(r0.y & 0xffff); v[3] = bf2f(r0.y >> 16); v[4] = bf2f(r0.z & 0xffff); v[5] = bf2f(r0.z >> 16); v[6] = bf2f(r0.w & 0xffff); v[7] = bf2f(r0.w >> 16);
            v[8] = bf2f(r1.x & 0xffff); v[9] = bf2f(r1.x >> 16); v[10] = bf2f(r1.y & 0xffff); v[11] = bf2f(r1.y >> 16); v[12] = bf2f(r1.z & 0xffff); v[13] = bf2f(r1.z >> 16); v[14] = bf2f(r1.w & 0xffff); v[15] = bf2f(r1.w >> 16);
            float ss = 0.f;
#pragma unroll
            for (int j = 0; j < 16; ++j) ss += v[j] * v[j];
            const float rstd = 1.0f / sqrtf(wave_sum(ss, F.lane) * (1.0f / NAW) + EPS);
            const f32x4 g0 = *(const GAS f32x4*)(gain + 8 * F.lane), g1 = *(const GAS f32x4*)(gain + 8 * F.lane + 4), g2 = *(const GAS f32x4*)(gain + 512 + 8 * F.lane), g3 = *(const GAS f32x4*)(gain + 512 + 8 * F.lane + 4);
            v4u o0, o1;
            o0.x = pk2(v[0] * rstd * g0.x, v[1] * rstd * g0.y); o0.y = pk2(v[2] * rstd * g0.z, v[3] * rstd * g0.w); o0.z = pk2(v[4] * rstd * g1.x, v[5] * rstd * g1.y); o0.w = pk2(v[6] * rstd * g1.z, v[7] * rstd * g1.w);
            o1.x = pk2(v[8] * rstd * g2.x, v[9] * rstd * g2.y); o1.y = pk2(v[10] * rstd * g2.z, v[11] * rstd * g2.w); o1.z = pk2(v[12] * rstd * g3.x, v[13] * rstd * g3.y); o1.w = pk2(v[14] * rstd * g3.z, v[15] * rstd * g3.w);
            *(GAS v4u*)(H + row * DM + 8 * F.lane) = o0; *(GAS v4u*)(H + row * DM + 512 + 8 * F.lane) = o1;
        }
        for (int grp = 0; grp < 2; ++grp) {
            __syncthreads();
            for (int c8 = F.wave * 64; c8 < F.wave * 64 + 64; c8 += 8) {
                float v[8], w[8];
#pragma unroll
                for (int u = 0; u < 8; ++u) { const GAS float* src = T32 + (size_t)(grp * 512 + c8 + u) * MT + tok0; v[u] = src[F.lane]; w[u] = (TI > 64 && F.lane == 0) ? src[64] : 0.f; }
#pragma unroll
                for (int u = 0; u < 8; ++u) { tile[(c8 + u) * 65 + F.lane] = v[u]; if (TI > 64 && F.lane == 0) tile[(c8 + u) * 65 + 64] = w[u]; }
            }
            __syncthreads();
            for (int tk = F.wave; tk < TI; tk += NWAVES) {
                float vv[8]; float ss = 0.f;
#pragma unroll
                for (int i = 0; i < 8; ++i) { const int chn = F.lane + 64 * i; int srow = chn;
                    if (grp == 0) { const int cc = chn & 127; srow = (chn & ~127) + (cc <= 64 ? cc : 192 - cc); }
                    vv[i] = tile[srow * 65 + tk]; ss += vv[i] * vv[i]; }
                const float rstd = 1.0f / sqrtf(wave_sum(ss, F.lane) * (1.0f / 512.0f) + EPS);
                GAS bf16* hp = H + (size_t)(tok0 + tk) * DM + NAW + grp * 512;
#pragma unroll
                for (int i = 0; i < 8; ++i) { const int chn = F.lane + 64 * i; hp[chn] = (bf16)f2bf(vv[i] * rstd * gain[NAW + grp * 512 + chn]); }
            }
        }
    }
}

#define REFRESH(F) do { int t_ = threadIdx.x; asm volatile("" : "+v"(t_)); F.tid = t_; F.lane = t_ & 63; F.wave = __builtin_amdgcn_readfirstlane(t_ >> 6); \
    GAS unsigned char* w_ = args.ws; asm volatile("" : "+s"(w_)); F.ws = w_; GAS float* o_ = args.out; asm volatile("" : "+s"(o_)); F.out = o_; } while (0)
#if defined(PROBE_BAR)
#define GRID_BAR_EXTRA(b) xcd_barrier(b)
#else
#define GRID_BAR_EXTRA(b) do {} while (0)
#endif
#ifndef REP_P1
#define REP_P1 1
#endif
#ifndef REP_P6
#define REP_P6 1
#endif
#ifndef REP_ATT
#define REP_ATT 1
#endif
#ifndef REP_PA
#define REP_PA 1
#endif
#ifndef REP_NORM
#define REP_NORM 1
#endif
#ifndef REP_FILT
#define REP_FILT 1
#endif
#ifndef REP_MERGE
#define REP_MERGE 1
#endif
#ifndef REP_EDGE
#define REP_EDGE 1
#endif
__global__ void __launch_bounds__(NTHR, 2) fwd_kernel(Args args) {
    extern __shared__ __attribute__((aligned(16))) unsigned char lds[];
    Frame F;
    F.lds = (LAS unsigned char*)lds;
    F.tid = threadIdx.x; F.lane = F.tid & 63; F.wave = __builtin_amdgcn_readfirstlane(F.tid >> 6);
    F.G = gridDim.x; { const int bx = blockIdx.x; F.vcu = (F.G % 8 == 0) ? (bx % 8) * (F.G / 8) + bx / 8 : bx; }
    F.ws = args.ws; F.out = args.out;
    volatile LAS unsigned* MISC = (volatile LAS unsigned*)(F.lds + MISC_OFF);
    for (int u = F.tid; u < 64; u += NTHR) MISC[u] = 0u;
    __syncthreads();
    XcdBarrier bar = xcd_barrier_post((unsigned*)(F.ws + WS_CTL) + CW_BAR, MISC + 8);
    LAS unsigned char* ring = F.lds;
#define GRID_BAR() do { unsigned* bp_ = bar.bar; unsigned bx_ = bar.x; asm volatile("" : "+s"(bp_), "+s"(bx_)); XcdBarrier b_ = bar; b_.bar = bp_; b_.x = bx_; xcd_barrier(b_); GRID_BAR_EXTRA(b_); } while (0)


#if !defined(OFF_PA)
    for (int rep = 0, nrep = opaque_int(REP_PA); rep < nrep; ++rep) { REFRESH(F); pa_adaln(F); __syncthreads(); pa_weights(F); __syncthreads(); pa_ctx_copy(F); }
#endif

    GRID_BAR();

    for (int l = 0; l < DEPTH; ++l) {
        const bool uc = l < DEPTH - 1;
        const int npm = uc ? PMT : PML;
        const GAS float* MODL = WSP(float, WS_MOD) + (size_t)l * 3 * (NMOD * DM);

#if !defined(OFF_P0)
        for (int rep = 0, nrep = opaque_int(REP_NORM); rep < nrep; ++rep) { REFRESH(F); norm_phase(F, l, 0, true, (l > 0 && rep == 0) ? 4 : 0); __syncthreads(); }
        for (int rep = 0, nrep = opaque_int(REP_FILT); rep < nrep; ++rep) { REFRESH(F); filter_phase(F, l, uc); __syncthreads(); }
#endif

        GRID_BAR();
        {
            const char* Hb = (const char*)WSP(bf16, WS_H); const char* Wb = (const char*)(WSP(bf16, WS_WIN) + (size_t)l * DIN * DM);
            pg8::Sched2 S; S.n1 = PMT * 8; S.nM1 = PMT; S.nN1 = 8; S.n2 = 12 * PMT; S.nM2 = 12; S.nN2 = PMT; S.G = F.G; S.c = (int)blockIdx.x;
            S.A1 = Hb; S.B1 = Wb; S.A2 = Wb + (size_t)2048 * DM * 2; S.B2 = Hb; S.tstep = (size_t)256 * DM * 2;
            EpiIn E{WSP(bf16, WS_QK), WSP(bf16, WS_VT), WSP(float, WS_T32)};

#if !defined(OFF_P1)
            for (int rep = 0, nrep = opaque_int(REP_P1); rep < nrep; ++rep) { pg8::gemm_phase<EpiIn, pg8::Sched2, true, true>(ring, DM, DM, S, E); __syncthreads();
#if defined(PROBE_REPBAR)
                if (rep + 1 < nrep) GRID_BAR();
#endif
            }
#endif

        }
        GRID_BAR();

#if !defined(OFF_ATT)
        for (int rep = 0, nrep = opaque_int(REP_ATT); rep < nrep; ++rep) { REFRESH(F); attn_phase(F, l, uc); }
#endif
#if !defined(OFF_FFT)
        REFRESH(F); fft_phase(F, l, uc);
#endif

        GRID_BAR();

#if !defined(OFF_P3)
        for (int rep = 0, nrep = opaque_int(REP_MERGE); rep < nrep; ++rep) { REFRESH(F); merge_phase(F, l, uc); __syncthreads(); }
#endif

        GRID_BAR();
        {
            pg8::Sched2 S; S.n1 = PML * 8; S.nM1 = PML; S.nN1 = 8; S.n2 = 0; S.nM2 = 1; S.nN2 = 1; S.G = F.G; S.c = (int)blockIdx.x;
            S.A1 = (const char*)WSP(bf16, WS_H); S.B1 = (const char*)(WSP(bf16, WS_WOUT) + (size_t)l * DM * DM); S.A2 = S.A1; S.B2 = S.B1; S.tstep = (size_t)256 * DM * 2;
            EpiRes E{l == 0 ? IN(x) : F.out, WSP(float, WS_XC), F.out, WSP(float, WS_XC), MODL + 2 * DM, 0};
#if defined(PROBE_P4)
            { EpiResT<true> E0{E.base_l, E.base_c, E.out_l, E.out_c, E.gate, opaque_int(0)}; pg8::gemm_phase<EpiResT<true>, pg8::Sched2, true, true>(ring, DM, DM, S, E0); __syncthreads(); }
#endif
#if !defined(OFF_P4)
            pg8::gemm_phase<EpiRes, pg8::Sched2, true, true>(ring, DM, DM, S, E);
#endif
            if (uc) {
                __syncthreads();
                pg8::SchedK SK; SK.nsub = 16 * 4; SK.nN = 8; SK.ksplit = 4; SK.pm0 = PML; SK.G = F.G; SK.c = (int)blockIdx.x; SK.A = S.A1; SK.B = S.B1; SK.tstep = S.tstep; SK.kbytes = 512 * 2;
                EpiSlab EA{WSP(float, WS_SLAB), MODL + 2 * DM};
#if !defined(OFF_P4)
                pg8::gemm_phase<EpiSlab, pg8::SchedK, true, true>(ring, DM, 512, SK, EA);
#endif
            }
        }
        GRID_BAR();

#if !defined(OFF_P5)
        for (int rep = 0, nrep = opaque_int(REP_NORM); rep < nrep; ++rep) { REFRESH(F); norm_phase(F, l, 1, uc, rep == 0 ? 4 : 0); }
#endif

        GRID_BAR();
        {
            pg8::Sched2 S; S.n1 = npm * 44; S.nM1 = npm; S.nN1 = 44; S.n2 = 0; S.nM2 = 1; S.nN2 = 1; S.G = F.G; S.c = (int)blockIdx.x;
            S.A1 = (const char*)WSP(bf16, WS_H); S.B1 = (const char*)(WSP(bf16, WS_WUP) + (size_t)l * 2 * DFF * DM); S.A2 = S.A1; S.B2 = S.B1; S.tstep = (size_t)256 * DM * 2;
            GAS float* EG = WSP(float, WS_EDGE);
            EpiUp E{WSP(bf16, WS_HID), EG, EG + EDGE_ELEMS, EG + 2 * EDGE_ELEMS, IN(ffn_conv_w) + (size_t)l * 3 * DFF, IN(ffn_conv_b) + (size_t)l * DFF};

#if !defined(OFF_P6)
            for (int rep = 0, nrep = opaque_int(REP_P6); rep < nrep; ++rep) { pg8::gemm_phase<EpiUp, pg8::Sched2, true, true>(ring, DM, DM, S, E); __syncthreads();
#if defined(PROBE_REPBAR)
                if (rep + 1 < nrep) GRID_BAR();
#endif
            }
#endif

        }
        GRID_BAR();

#if !defined(OFF_P6B)
        for (int rep = 0, nrep = opaque_int(REP_EDGE); rep < nrep; ++rep) { REFRESH(F); edge_fix_phase(F, l, uc); }
#endif

        GRID_BAR();
        {
            pg8::Sched2 S; S.n1 = PML * 8; S.nM1 = PML; S.nN1 = 8; S.n2 = 0; S.nM2 = 1; S.nN2 = 1; S.G = F.G; S.c = (int)blockIdx.x;
            S.A1 = (const char*)WSP(bf16, WS_HID); S.B1 = (const char*)(WSP(bf16, WS_WDN) + (size_t)l * DM * DFF); S.A2 = S.A1; S.B2 = S.B1; S.tstep = (size_t)256 * DFF * 2;
            EpiRes E{F.out, WSP(float, WS_XC), F.out, WSP(float, WS_XC), MODL + 5 * DM, 0};
#if defined(PROBE_P7)
            { EpiResT<true> E0{E.base_l, E.base_c, E.out_l, E.out_c, E.gate, opaque_int(0)}; pg8::gemm_phase<EpiResT<true>, pg8::Sched2, true, true>(ring, DFF, DFF, S, E0); __syncthreads(); }
#endif
#if !defined(OFF_P7)
            pg8::gemm_phase<EpiRes, pg8::Sched2, true, true>(ring, DFF, DFF, S, E);
#endif
            if (uc) {
                __syncthreads();
                pg8::SchedK SK; SK.nsub = 16 * 4; SK.nN = 8; SK.ksplit = 4; SK.pm0 = PML; SK.G = F.G; SK.c = (int)blockIdx.x; SK.A = S.A1; SK.B = S.B1; SK.tstep = S.tstep; SK.kbytes = 1408 * 2;
                EpiSlab EA{WSP(float, WS_SLAB), MODL + 5 * DM};
#if !defined(OFF_P7)
                pg8::gemm_phase<EpiSlab, pg8::SchedK, true, true>(ring, DFF, 1408, SK, EA);
#endif
            }
        }
        GRID_BAR();
    }
    REFRESH(F); final_norm_phase(F);
}

extern "C" void kernel_launch(void* const* d_in, const int* in_sizes, int n_in, void* d_out, int out_size, void* d_ws, size_t ws_size, hipStream_t stream) {
    static int grid = 0;
    if (grid == 0) {
        if (n_in != 26 || in_sizes[0] != ML * DM || out_size != ML * DM || ws_size < WS_END) { fprintf(stderr, "kernel_launch: unexpected shapes (n_in %d, in0 %d, out %d, ws %zu < %zu)\n", n_in, n_in > 0 ? in_sizes[0] : -1, out_size, ws_size, (size_t)WS_END); grid = -1; return; }
        int dev = 0, cus = 0, per_cu = 0;
        if (hipGetDevice(&dev) != hipSuccess || hipDeviceGetAttribute(&cus, hipDeviceAttributeMultiprocessorCount, dev) != hipSuccess) { grid = -1; return; }
        if (hipFuncSetAttribute((const void*)fwd_kernel, hipFuncAttributeMaxDynamicSharedMemorySize, LDS_BYTES) != hipSuccess) { fprintf(stderr, "kernel_launch: hipFuncSetAttribute failed\n"); grid = -1; return; }
        if (hipOccupancyMaxActiveBlocksPerMultiprocessor(&per_cu, (const void*)fwd_kernel, NTHR, LDS_BYTES) != hipSuccess || per_cu < 1) { fprintf(stderr, "kernel_launch: occupancy query reports %d\n", per_cu); }
        (void)hipGetLastError();
        grid = cus;
    }
    if (grid < 0) return;
    if (hipMemsetAsync((char*)d_ws + WS_CTL, 0, CTL_ZERO_BYTES, stream) != hipSuccess) return;
    Args a{};
    for (int i = 0; i < 26; ++i) a.in[i] = (const GAS float*)d_in[i];
    a.out = (GAS float*)d_out; a.ws = (GAS unsigned char*)d_ws;
    hipLaunchKernelGGL(fwd_kernel, dim3(grid), dim3(NTHR), LDS_BYTES, stream, a);
}
```
